# Optimizing an MI355X kernel written in HIP

```python
import jax, jax.numpy as jnp
from jax import lax
import numpy as np

D_MODEL = 1024
BATCH = 4
SEQ = 8192
DEPTH = 2

CHUNK = 64
MIX_WIDTH = D_MODEL
POOL_WIDTH = MIX_WIDTH // 2
POOL_WINDOWS = (2, 4, 8, 16)
POOL_GROUPS = len(POOL_WINDOWS)
POOL_GW = POOL_WIDTH // POOL_GROUPS
ATT_WIDTH = MIX_WIDTH - POOL_WIDTH
N_HEADS = 8
HEAD_DIM = ATT_WIDTH // N_HEADS
LEFT_CHUNKS = 8
LEFT = LEFT_CHUNKS * CHUNK
BAND = LEFT + CHUNK
MAX_REL = 128
N_REL = 2 * MAX_REL + 1
IN_WIDTH = POOL_WIDTH + 3 * ATT_WIDTH
N_GROUPS = 4
EXPERTS_PER_GROUP = 8
N_EXPERTS = N_GROUPS * EXPERTS_PER_GROUP
TOP_K = 2
D_EXPERT = D_MODEL // 2
EXPERT_BLOCK = 128
EPS = 1e-6
NEG_INF = -1e30

kernel_name = "hybrid_pool_chunkattn_hmoe_adaln"


def rmsnorm(x, g):
    xf = x.astype(jnp.float32)
    y = xf * lax.rsqrt(jnp.mean(xf * xf, axis=-1, keepdims=True) + EPS)
    return (y * g.astype(jnp.float32)).astype(x.dtype)


def pool_mixer(u, w, scale):
    B, S, _ = u.shape
    uf = u.astype(jnp.float32)
    cs0 = jnp.concatenate([jnp.zeros((B, 1, POOL_WIDTH), jnp.float32), jnp.cumsum(uf, axis=1)], axis=1)
    outs = []
    for gi, win in enumerate(POOL_WINDOWS):
        sl = slice(gi * POOL_GW, (gi + 1) * POOL_GW)
        csg = cs0[..., sl]
        lag = jnp.concatenate([jnp.zeros((B, win - 1, POOL_GW), jnp.float32), csg[:, :S + 1 - win]], axis=1)
        cnt = jnp.minimum(jnp.arange(S) + 1, win).astype(jnp.float32)[None, :, None]
        outs.append((csg[:, 1:] - lag) / cnt - uf[..., sl])
    p = jnp.stack(outs, axis=2).astype(u.dtype)
    p = jnp.einsum('bsgc,gcd->bsgd', p, w).reshape(B, S, POOL_WIDTH)
    return p * scale


def chunk_attention(q, k, v, bias):
    B, S, H, Dh = q.shape
    nc = S // CHUNK
    kp = jnp.pad(k, ((0, 0), (LEFT, 0), (0, 0), (0, 0)))
    vp = jnp.pad(v, ((0, 0), (LEFT, 0), (0, 0), (0, 0)))
    kpos = jnp.arange(BAND)
    sm_scale = HEAD_DIM ** -0.5

    def one_chunk(i):
        s0 = i * CHUNK
        qc = lax.dynamic_slice_in_dim(q, s0, CHUNK, axis=1)
        kc = lax.dynamic_slice_in_dim(kp, s0, BAND, axis=1)
        vc = lax.dynamic_slice_in_dim(vp, s0, BAND, axis=1)
        s = jnp.einsum('bqhd,bkhd->bhqk', qc, kc).astype(jnp.float32) * sm_scale + bias[None]
        valid = kpos >= LEFT - s0
        s = jnp.where(valid[None, None, None, :], s, NEG_INF)
        p = jax.nn.softmax(s, axis=-1).astype(v.dtype)
        return jnp.einsum('bhqk,bkhd->bqhd', p, vc)

    o = lax.map(one_chunk, jnp.arange(nc))
    return o.transpose(1, 0, 2, 3, 4).reshape(B, S, H * Dh)


def hier_moe(h, rg_w, rg_b, re_w, re_b, w_gate, w_up, w_down):
    B, S, D = h.shape
    N = B * S
    t = h.reshape(N, D)
    g_prob = jax.nn.softmax((t @ rg_w + rg_b).astype(jnp.float32), axis=-1)
    g_p, g_idx = lax.top_k(g_prob, 1)
    e_logits = (t @ re_w + re_b).astype(jnp.float32).reshape(N, N_GROUPS, EXPERTS_PER_GROUP)
    e_in = jnp.take_along_axis(e_logits, g_idx[:, :, None], axis=1)[:, 0]
    e_top, e_loc = lax.top_k(e_in, TOP_K)
    e_w = jax.nn.softmax(e_top, axis=-1) * g_p
    e_id = g_idx * EXPERTS_PER_GROUP + e_loc

    flat_e = e_id.reshape(-1)
    flat_tok = jnp.repeat(jnp.arange(N, dtype=jnp.int32), TOP_K)
    flat_w = e_w.reshape(-1)
    order = jnp.argsort(flat_e, stable=True)
    se = flat_e[order]
    counts = jnp.bincount(flat_e, length=N_EXPERTS)
    padded = ((counts + EXPERT_BLOCK - 1) // EXPERT_BLOCK) * EXPERT_BLOCK
    pad_end = jnp.cumsum(padded)
    pad_start = pad_end - padded
    start = jnp.cumsum(counts) - counts
    dest = pad_start[se] + jnp.arange(N * TOP_K) - start[se]
    P = N * TOP_K + N_EXPERTS * EXPERT_BLOCK
    nblk = P // EXPERT_BLOCK
    buf_tok = jnp.full((P,), N, jnp.int32).at[dest].set(flat_tok[order])
    buf_w = jnp.zeros((P,), jnp.float32).at[dest].set(flat_w[order])
    blk_e = jnp.minimum(jnp.searchsorted(pad_end, jnp.arange(nblk) * EXPERT_BLOCK, side='right'),
                        N_EXPERTS - 1)
    t_pad = jnp.concatenate([t, jnp.zeros((1, D), t.dtype)], axis=0)
    xb = t_pad[buf_tok].reshape(nblk, EXPERT_BLOCK, D)

    def expert_block(args):
        xblk, e = args
        return (jax.nn.silu(xblk @ w_gate[e]) * (xblk @ w_up[e])) @ w_down[e]

    yb = lax.map(expert_block, (xb, blk_e)).reshape(P, D)
    yb = yb * buf_w[:, None].astype(yb.dtype)
    out = jnp.zeros((N + 1, D), yb.dtype).at[buf_tok].add(yb)[:N]
    return out.reshape(B, S, D)


def setup_inputs(seed: int = 0) -> dict:
    key = jax.random.key(seed)
    ks = jax.random.split(key, 24)
    f32 = jnp.float32
    L, D = DEPTH, D_MODEL
    nrm = lambda k, shape, s: jax.random.normal(k, shape, f32) * s
    return {
        "x": nrm(ks[0], (BATCH, SEQ, D), 1.0),
        "c": nrm(ks[1], (BATCH, D), 1.0),
        "ada_w": nrm(ks[2], (L, D, 6 * D), 0.5 * D ** -0.5),
        "ada_b": nrm(ks[3], (L, 6 * D), 0.02),
        "norm1_g": 1.0 + nrm(ks[4], (L, D), 0.05),
        "norm2_g": 1.0 + nrm(ks[5], (L, D), 0.05),
        "w_in": nrm(ks[6], (L, D, IN_WIDTH), D ** -0.5),
        "pool_w": nrm(ks[7], (L, POOL_GROUPS, POOL_GW, POOL_GW), POOL_GW ** -0.5),
        "pool_scale": 1.0 + nrm(ks[8], (L, POOL_WIDTH), 0.1),
        "q_norm_g": 1.0 + nrm(ks[9], (L, HEAD_DIM), 0.05),
        "k_norm_g": 1.0 + nrm(ks[10], (L, HEAD_DIM), 0.05),
        "rel_bias": nrm(ks[11], (N_HEADS, N_REL), 0.1),
        "w_out": nrm(ks[12], (L, MIX_WIDTH, D), MIX_WIDTH ** -0.5),
        "router_group_w": nrm(ks[13], (L, D, N_GROUPS), D ** -0.5),
        "router_group_b": nrm(ks[14], (L, N_GROUPS), 0.01),
        "router_expert_w": nrm(ks[15], (L, D, N_EXPERTS), D ** -0.5),
        "router_expert_b": nrm(ks[16], (L, N_EXPERTS), 0.01),
        "moe_w_gate": nrm(ks[17], (L, N_EXPERTS, D, D_EXPERT), D ** -0.5),
        "moe_w_up": nrm(ks[18], (L, N_EXPERTS, D, D_EXPERT), D ** -0.5),
        "moe_w_down": nrm(ks[19], (L, N_EXPERTS, D_EXPERT, D), D_EXPERT ** -0.5),
    }


def reference(x, c, ada_w, ada_b, norm1_g, norm2_g, w_in, pool_w, pool_scale, q_norm_g, k_norm_g,
              rel_bias, w_out, router_group_w, router_group_b, router_expert_w, router_expert_b,
              moe_w_gate, moe_w_up, moe_w_down):
    B, S, D = x.shape
    rel = LEFT + jnp.arange(CHUNK)[:, None] - jnp.arange(BAND)[None, :]
    rel_idx = jnp.clip(rel, -MAX_REL, MAX_REL) + MAX_REL
    bias = rel_bias.astype(jnp.float32)[:, rel_idx]
    c_act = jax.nn.silu(c)
    for l in range(DEPTH):
        mod = (c_act @ ada_w[l] + ada_b[l])[:, None, :]
        sh1, sc1, g1, sh2, sc2, g2 = jnp.split(mod, 6, axis=-1)

        h = rmsnorm(x, norm1_g[l]) * (1.0 + sc1) + sh1
        z = h @ w_in[l]
        u = z[..., :POOL_WIDTH]
        q, k, v = jnp.split(z[..., POOL_WIDTH:], 3, axis=-1)
        q = rmsnorm(q.reshape(B, S, N_HEADS, HEAD_DIM), q_norm_g[l])
        k = rmsnorm(k.reshape(B, S, N_HEADS, HEAD_DIM), k_norm_g[l])
        v = v.reshape(B, S, N_HEADS, HEAD_DIM)
        pool_out = pool_mixer(u, pool_w[l], pool_scale[l])
        att_out = chunk_attention(q, k, v, bias)
        mix = jnp.concatenate([pool_out, att_out], axis=-1) @ w_out[l]
        x = x + g1 * mix

        h2 = rmsnorm(x, norm2_g[l]) * (1.0 + sc2) + sh2
        x = x + g2 * hier_moe(h2, router_group_w[l], router_group_b[l], router_expert_w[l],
                              router_expert_b[l], moe_w_gate[l], moe_w_up[l], moe_w_down[l])
    return x
```

```cpp
#include <hip/hip_runtime.h>
#include <hip/hip_cooperative_groups.h>
#include <cstdio>
#include <cstdint>
namespace cg = cooperative_groups;

#define LAS __attribute__((address_space(3)))
typedef unsigned short bf16_t;
typedef short bf16x8 __attribute__((ext_vector_type(8)));
typedef float f32x4 __attribute__((ext_vector_type(4)));
typedef float f32x16 __attribute__((ext_vector_type(16)));
typedef unsigned u32x4 __attribute__((ext_vector_type(4)));
typedef unsigned u32x2 __attribute__((ext_vector_type(2)));
typedef float f32x2_t __attribute__((ext_vector_type(2)));
typedef __bf16 bf16x2_t __attribute__((ext_vector_type(2)));

constexpr int BATCH = 4, SEQ = 8192, DM = 1024, NTOK = BATCH * SEQ, DEPTH = 2;
constexpr int NHEAD = 8, HD = 64, NEXP = 32, DEXP = 512;
constexpr float EPS = 1e-6f;
constexpr float LOG2E = 1.4426950408889634f;
constexpr int NSTREAM = 2, STOK = NTOK / NSTREAM, LCAP = STOK, SBATCH = BATCH / NSTREAM;
struct Ctx { int s, lb, GS, tok0; };

constexpr size_t MiB = 1u << 20;
constexpr size_t WS_CTL = 0;
constexpr size_t WS_MOD = 1 * MiB;
constexpr size_t WS_TBL = 1 * MiB + 512 * 1024;
constexpr size_t WS_RW = 2 * MiB;
constexpr size_t WS_RWB = 2 * MiB + 512 * 1024;
constexpr size_t WS_LIST = 3 * MiB;
constexpr size_t WS_EW = 7 * MiB;
constexpr size_t WS_WIN = 8 * MiB;
constexpr size_t WS_WOUT = 16 * MiB;
constexpr size_t WS_WGU = 20 * MiB;
constexpr size_t WS_WD = 148 * MiB;
constexpr size_t WS_BUF = 212 * MiB;
constexpr size_t WS_SREG = 276 * MiB;
constexpr size_t WS_U = 276 * MiB;
constexpr size_t WS_Q = 308 * MiB;
constexpr size_t WS_K = 340 * MiB;
constexpr size_t WS_V = 372 * MiB;
constexpr size_t WS_Y = 276 * MiB;
constexpr size_t WS_ACT = 404 * MiB;
constexpr size_t WS_SSQ = 468 * MiB;
constexpr size_t WS_XB = 470 * MiB;
constexpr size_t WS_END = 534 * MiB;

constexpr int LDS_BYTES = 147456;
constexpr int NWAVES = 8, NTHREADS = 512;

struct Params {
    const float* in[20];
    float* out;
    unsigned char* ws;
    int ph_lo, ph_hi;
};

__device__ __forceinline__ unsigned char* sreg(unsigned char* ws, int s) { return ws + WS_SREG + (size_t)s * (64 * MiB); }
__device__ __forceinline__ bf16_t* s_U(unsigned char* ws, const Ctx& cx) { return (bf16_t*)sreg(ws, cx.s) - (size_t)cx.tok0 * 512; }
__device__ __forceinline__ bf16_t* s_Q(unsigned char* ws, const Ctx& cx) { return (bf16_t*)(sreg(ws, cx.s) + 16 * MiB); }
__device__ __forceinline__ bf16_t* s_K(unsigned char* ws, const Ctx& cx) { return (bf16_t*)(sreg(ws, cx.s) + 32 * MiB); }
__device__ __forceinline__ bf16_t* s_V(unsigned char* ws, const Ctx& cx) { return (bf16_t*)(sreg(ws, cx.s) + 48 * MiB); }
__device__ __forceinline__ int* s_list(unsigned char* ws, const Ctx& cx) { return (int*)(ws + WS_LIST) + (size_t)cx.s * NEXP * LCAP; }
__device__ __forceinline__ int* s_cnt(unsigned char* ws, const Ctx& cx, int l) { return (int*)(ws + WS_CTL) + (cx.s * DEPTH + l) * 32; }
__device__ __forceinline__ unsigned cvtpk(float lo, float hi) { f32x2_t v = {lo, hi}; bf16x2_t b = __builtin_convertvector(v, bf16x2_t); return __builtin_bit_cast(unsigned, b); }
__device__ __forceinline__ float bf_lo(unsigned w) { return __uint_as_float(w << 16); }
__device__ __forceinline__ float bf_hi(unsigned w) { return __uint_as_float(w & 0xffff0000u); }
__device__ __forceinline__ float fast_exp2(float x) { return __builtin_amdgcn_exp2f(x); }
__device__ __forceinline__ float fast_rcp(float x) { return __builtin_amdgcn_rcpf(x); }

__device__ __forceinline__ int opaque_tid() { int t = threadIdx.x; asm volatile("" : "+v"(t)); return t; }
__device__ __forceinline__ int opaque_bid() { int t = blockIdx.x; asm volatile("" : "+s"(t)); return t; }

namespace pg8 {
constexpr int BM = 256, BK = 64, HALF = 128, HTB = HALF * BK * 2, STAGE_BYTES = 8 * HTB, NXCD = 8, WGM = 8;
__host__ __device__ __forceinline__ int lds_byte(int r, int c) { const int st = (r >> 4) * 2 + (c >> 5), rr = r & 15, cc = c & 31, ob = rr * 64 + cc * 2; return st * 1024 + (ob ^ (((ob >> 9) & 1) << 5)); }
__host__ __device__ __forceinline__ void stage_rc(int b, int& R, int& C) { const int st = b / 1024, sb = b % 1024, swz = sb ^ (((sb >> 9) & 1) << 5); R = (st >> 1) * 16 + swz / 64; C = (st & 1) * 32 + (swz % 64) / 2; }
__host__ __device__ __forceinline__ int perm32(int rho) { const int n = rho >> 4, i = rho & 15; return 8 * (i >> 2) + 4 * n + (i & 3); }

struct Unit { int pm, pn, e, rows; };

struct StaticOrder {
    int nM, nN, nwg, G, c;
    __device__ void init(int M, int N, int G_, int c_) { nM = M / BM; nN = N / BM; nwg = nM * nN; G = G_; c = c_; }
    __device__ bool next(int i, Unit& u) const {
        const long L = (long)i * G + c; if (L >= nwg) return false;
        int wgid = (int)L; { const int q = nwg / NXCD, r = nwg % NXCD, xcd = wgid % NXCD, off = wgid / NXCD; wgid = (xcd < r ? xcd * (q + 1) : r * (q + 1) + (xcd - r) * q) + off; }
        const int nig = WGM * nN, gid = wgid / nig, fm = gid * WGM, gsz = (nM - fm) < WGM ? (nM - fm) : WGM;
        u.pm = fm + ((wgid % nig) % gsz); u.pn = (wgid % nig) / gsz; u.e = 0; u.rows = BM; return true;
    }
};

struct OffsetOrder {
    StaticOrder s; int dpm, dpn;
    __device__ void init(int M, int N, int G_, int c_, int dpm_, int dpn_) { s.init(M, N, G_, c_); dpm = dpm_; dpn = dpn_; }
    __device__ bool next(int i, Unit& u) const { const bool ok = s.next(i, u); u.pm += dpm; u.pn += dpn; return ok; }
};

struct GroupedOrder {
    const LAS int* prefix; const LAS int* cnt; int G, v;
    __device__ bool next(int i, Unit& u) const {
        const int L = i * G + v; const int total = prefix[NEXP];
        if (L >= total * 4) return false;
        const int rt = L >> 2; int e = 0;
#pragma unroll 1
        for (int j = 1; j < NEXP; ++j) if (prefix[j] <= rt) e = j;
        u.e = e; u.pm = rt - prefix[e]; u.pn = L & 3; const int rem = cnt[e] - u.pm * BM; u.rows = rem < BM ? rem : BM; return true;
    }
};

template <class G, class Epi, class Sched>
__device__ __forceinline__ void gemm_phase(LAS unsigned char* lds, const G g, const Sched& S, const Epi& E) {
    int tid = threadIdx.x; asm volatile("" : "+v"(tid));
    const int wid = __builtin_amdgcn_readfirstlane(tid >> 6), lane = tid & 63, wr = wid >> 2, wc = wid & 3, fr = lane & 15, fq = lane >> 4;
    const int K = g.K, nt = K / BK;
    int RA[2], CA[2]; unsigned voffB[2];
#pragma unroll
    for (int i = 0; i < 2; ++i) { int R, C; stage_rc(tid * 16 + i * 8192, R, C); const int Rb = Epi::PERM ? ((R & ~31) + perm32(R & 31)) : R;
        RA[i] = R; CA[i] = C; voffB[i] = (unsigned)(Rb * K + C) * 2u; }
    const size_t kstep = (size_t)(BK * 2);
    const size_t hstep = (size_t)HALF * K * 2;
    const unsigned ldsw = (unsigned)wid * 1024u;
    const int aoff = lds_byte(wr * 64 + fr, fq * 8), boff = lds_byte(wc * 32 + fr, fq * 8);
#define PG8_SA(b, h) (((b) * 2 + (h)) * HTB)
#define PG8_SB(b, h) ((4 + (b) * 2 + (h)) * HTB)
#define PG8_STAGE2(bufoff, gbase, o0, o1) do { \
        __builtin_amdgcn_global_load_lds((const unsigned*)((const char*)(gbase) + (o0)), (LAS unsigned*)(lds + (bufoff) + ldsw), 16, 0, 0); \
        __builtin_amdgcn_global_load_lds((const unsigned*)((const char*)(gbase) + (o1)), (LAS unsigned*)(lds + (bufoff) + ldsw + 8192), 16, 0, 0); } while (0)
#define PG8_STAGEB(bufoff, gbase) PG8_STAGE2(bufoff, gbase, voffB[0], voffB[1])
#define PG8_LDA(dst, b, h) do { _Pragma("unroll") for (int m = 0; m < 4; ++m) _Pragma("unroll") for (int k = 0; k < 2; ++k) dst[m][k] = *(const LAS bf16x8*)(lds + PG8_SA(b, h) + aoff + m * 2048 + k * 1024); } while (0)
#define PG8_LDB(dst, b, h) do { _Pragma("unroll") for (int n = 0; n < 2; ++n) _Pragma("unroll") for (int k = 0; k < 2; ++k) dst[n][k] = *(const LAS bf16x8*)(lds + PG8_SB(b, h) + boff + n * 2048 + k * 1024); } while (0)
#define PG8_MMA(ai, bj, At, Bt) do { __builtin_amdgcn_s_setprio(1); _Pragma("unroll") for (int m = 0; m < 4; ++m) _Pragma("unroll") for (int n = 0; n < 2; ++n) _Pragma("unroll") for (int k = 0; k < 2; ++k) \
        acc[ai][bj][m][n] = __builtin_amdgcn_mfma_f32_16x16x32_bf16(Bt[n][k], At[m][k], acc[ai][bj][m][n], 0, 0, 0); __builtin_amdgcn_s_setprio(0); } while (0)
#define PG8_WAIT_V(n) asm volatile("s_waitcnt vmcnt(" #n ")" ::: "memory")
#define PG8_WAIT_L(n) asm volatile("s_waitcnt lgkmcnt(" #n ")" ::: "memory")
#define PG8_BAR __builtin_amdgcn_s_barrier()
#define PG8_SCHED __builtin_amdgcn_sched_barrier(0)
    Unit cur, nxt; int ui = 0;
    if (!S.next(0, cur)) return;
    f32x4 acc[2][2][4][2];
#pragma unroll
    for (int a = 0; a < 2; ++a)
#pragma unroll
        for (int b = 0; b < 2; ++b)
#pragma unroll
            for (int m = 0; m < 4; ++m)
#pragma unroll
                for (int n = 0; n < 2; ++n) acc[a][b][m][n] = (f32x4){0.f, 0.f, 0.f, 0.f};
    bf16x8 At[4][2], B0[2][2], B1[2][2];
    const char* cA = g.a_base(cur); const char* cB = g.b_base(cur);
    unsigned c00 = g.a_off(cur, RA[0], CA[0]), c01 = g.a_off(cur, RA[1], CA[1]), c10 = g.a_off(cur, HALF + RA[0], CA[0]), c11 = g.a_off(cur, HALF + RA[1], CA[1]);
    PG8_STAGEB(PG8_SB(0, 0), cB); PG8_STAGEB(PG8_SB(0, 1), cB + hstep); PG8_STAGE2(PG8_SA(0, 0), cA, c00, c01); PG8_STAGE2(PG8_SA(0, 1), cA, c10, c11);
    if (wr == 1) PG8_BAR;
    PG8_WAIT_V(2); PG8_BAR;
    PG8_STAGEB(PG8_SB(1, 0), cB + kstep); PG8_STAGE2(PG8_SA(1, 0), cA + kstep, c00, c01); PG8_STAGEB(PG8_SB(1, 1), cB + hstep + kstep);
    PG8_WAIT_V(6); PG8_BAR;
    for (;;) {
        const bool has_next = S.next(ui + 1, nxt);
        const char* nA = has_next ? g.a_base(nxt) : cA; const char* nB = has_next ? g.b_base(nxt) : cB;
        unsigned n00 = c00, n01 = c01, n10 = c10, n11 = c11;
        if (G::GATHER && has_next) { n00 = g.a_off(nxt, RA[0], CA[0]); n01 = g.a_off(nxt, RA[1], CA[1]); n10 = g.a_off(nxt, HALF + RA[0], CA[0]); n11 = g.a_off(nxt, HALF + RA[1], CA[1]); }
        for (int t = 0; t < nt; t += 2) {
            const bool last = (t == nt - 2);
            const char* a1 = cA + (size_t)(t + 1) * kstep;
            const char* a2 = last ? nA : cA + (size_t)(t + 2) * kstep; const char* b2 = last ? nB : cB + (size_t)(t + 2) * kstep;
            const char* a3 = a2 + kstep; const char* b3 = b2 + kstep;
            const unsigned x00 = last ? n00 : c00, x01 = last ? n01 : c01, x10 = last ? n10 : c10, x11 = last ? n11 : c11;
            PG8_LDB(B0, 0, 0); PG8_LDB(B1, 0, 1); PG8_SCHED; PG8_LDA(At, 0, 0); PG8_STAGE2(PG8_SA(1, 1), a1, c10, c11);
            PG8_WAIT_V(8); PG8_WAIT_L(0); PG8_BAR; PG8_MMA(0, 0, At, B0); PG8_MMA(0, 1, At, B1); PG8_BAR; PG8_SCHED;
            PG8_LDA(At, 0, 1); PG8_STAGEB(PG8_SB(0, 0), b2); PG8_STAGEB(PG8_SB(0, 1), b2 + hstep); PG8_STAGE2(PG8_SA(0, 0), a2, x00, x01);
            PG8_WAIT_V(8); PG8_WAIT_L(0); PG8_BAR; PG8_MMA(1, 0, At, B0); PG8_MMA(1, 1, At, B1); PG8_BAR; PG8_SCHED;
            PG8_LDB(B0, 1, 0); PG8_LDB(B1, 1, 1); PG8_SCHED; PG8_LDA(At, 1, 0); PG8_STAGE2(PG8_SA(0, 1), a2, x10, x11);
            PG8_WAIT_V(8); PG8_WAIT_L(0); PG8_BAR; PG8_MMA(0, 0, At, B0); PG8_MMA(0, 1, At, B1); PG8_BAR; PG8_SCHED;
            PG8_LDA(At, 1, 1); PG8_STAGEB(PG8_SB(1, 0), b3); PG8_STAGEB(PG8_SB(1, 1), b3 + hstep); PG8_STAGE2(PG8_SA(1, 0), a3, x00, x01);
            PG8_WAIT_V(8); PG8_WAIT_L(0); PG8_BAR; PG8_MMA(1, 0, At, B0); PG8_MMA(1, 1, At, B1); PG8_BAR; PG8_SCHED;
        }
        if (wr == 0) PG8_BAR;
        E(acc, cur, wr, wc, fr, fq);
        if (!has_next) break;
#pragma unroll
        for (int a = 0; a < 2; ++a)
#pragma unroll
            for (int b = 0; b < 2; ++b)
#pragma unroll
                for (int m = 0; m < 4; ++m)
#pragma unroll
                    for (int n = 0; n < 2; ++n) acc[a][b][m][n] = (f32x4){0.f, 0.f, 0.f, 0.f};
        cur = nxt; cA = nA; cB = nB; c00 = n00; c01 = n01; c10 = n10; c11 = n11; ++ui;
        if (wr == 1) PG8_BAR;
    }
    PG8_WAIT_V(0);
    PG8_BAR;
#undef PG8_SA
#undef PG8_SB
#undef PG8_STAGE2
#undef PG8_STAGEB
#undef PG8_LDA
#undef PG8_LDB
#undef PG8_MMA
#undef PG8_WAIT_V
#undef PG8_WAIT_L
#undef PG8_BAR
#undef PG8_SCHED
}
}
using pg8::Unit;

struct DenseGemm {
    static constexpr bool GATHER = false;
    const bf16_t* A; const bf16_t* Bt; int K;
    __device__ __forceinline__ const char* a_base(const Unit& u) const { return (const char*)A + (size_t)u.pm * 256 * K * 2; }
    __device__ __forceinline__ const char* b_base(const Unit& u) const { return (const char*)Bt + (size_t)u.pn * 256 * K * 2; }
    __device__ __forceinline__ unsigned a_off(const Unit&, int r, int c) const { return (unsigned)(r * K + c) * 2u; }
};
struct GatherGemm {
    static constexpr bool GATHER = true;
    const bf16_t* A; const bf16_t* Bt; const int* list; int K; int a_shift;
    size_t b_expert_stride;
    __device__ __forceinline__ const char* a_base(const Unit&) const { return (const char*)A; }
    __device__ __forceinline__ const char* b_base(const Unit& u) const { return (const char*)Bt + (size_t)u.e * b_expert_stride + (size_t)u.pn * 256 * K * 2; }
    __device__ __forceinline__ unsigned a_off(const Unit& u, int r, int c) const {
        const int rr = r < u.rows ? r : u.rows - 1;
        const int slot = list[(size_t)u.e * LCAP + u.pm * 256 + rr];
        return (unsigned)((slot >> a_shift) * K + c) * 2u;
    }
};


struct EpiIn {
    static constexpr bool PERM = true;
    bf16_t* U; bf16_t* Qf; bf16_t* Kf; const float* qg; const float* kg;
    __device__ __forceinline__ void operator()(const f32x4 (&acc)[2][2][4][2], const Unit& u, int wr, int wc, int fr, int fq) const {
        if (u.pn < 2) {
#pragma unroll
            for (int ai = 0; ai < 2; ++ai)
#pragma unroll
                for (int m = 0; m < 4; ++m) {
                    const int row = u.pm * 256 + ai * 128 + wr * 64 + m * 16 + fr;
#pragma unroll
                    for (int bj = 0; bj < 2; ++bj) {
                        const f32x4 v0 = acc[ai][bj][m][0], v1 = acc[ai][bj][m][1];
                        u32x4 w; w.x = cvtpk(v0[0], v0[1]); w.y = cvtpk(v0[2], v0[3]); w.z = cvtpk(v1[0], v1[1]); w.w = cvtpk(v1[2], v1[3]);
                        *(u32x4*)(U + (size_t)row * 512 + u.pn * 256 + bj * 128 + wc * 32 + fq * 8) = w;
                    }
                }
        } else {
            const bool isq = u.pn < 4;
            const float* gg = isq ? qg : kg; bf16_t* dst = isq ? Qf : Kf;
            const float osc = isq ? 0.125f * LOG2E : 1.0f;
            const int head = (u.pn & 1) * 4 + wc;
            f32x4 gv[2][2];
#pragma unroll
            for (int bj = 0; bj < 2; ++bj)
#pragma unroll
                for (int n = 0; n < 2; ++n) gv[bj][n] = *(const f32x4*)(gg + bj * 32 + fq * 8 + n * 4) * osc;
#pragma unroll
            for (int ai = 0; ai < 2; ++ai)
#pragma unroll
                for (int m = 0; m < 4; ++m) {
                    float ss = 0.f;
#pragma unroll
                    for (int bj = 0; bj < 2; ++bj)
#pragma unroll
                        for (int n = 0; n < 2; ++n) { const f32x4 v = acc[ai][bj][m][n]; ss += (v[0] * v[0] + v[1] * v[1]) + (v[2] * v[2] + v[3] * v[3]); }
                    ss += __shfl_xor(ss, 16); ss += __shfl_xor(ss, 32);
                    const float rstd = rsqrtf(ss * (1.0f / 64.0f) + EPS);
                    const int row = u.pm * 256 + ai * 128 + wr * 64 + m * 16 + fr;
                    const int b = (row >> 13) & (SBATCH - 1), s = row & (SEQ - 1), rb = s >> 5, r32 = s & 31;
#pragma unroll
                    for (int bj = 0; bj < 2; ++bj) {
                        const f32x4 v0 = acc[ai][bj][m][0] * rstd * gv[bj][0], v1 = acc[ai][bj][m][1] * rstd * gv[bj][1];
                        u32x4 w; w.x = cvtpk(v0[0], v0[1]); w.y = cvtpk(v0[2], v0[3]); w.z = cvtpk(v1[0], v1[1]); w.w = cvtpk(v1[2], v1[3]);
                        const int d0 = 2 * bj + (fq >> 1), hi = fq & 1;
                        const size_t piece = (((size_t)(b * NHEAD + head) * 256 + rb) * 4 + d0);
                        *(u32x4*)(dst + (piece * 64 + hi * 32 + r32) * 8) = w;
                    }
                }
        }
    }
};

struct EpiVt {
    static constexpr bool PERM = true;
    bf16_t* Vf;
    __device__ __forceinline__ void operator()(const f32x4 (&acc)[2][2][4][2], const Unit& u, int wr, int wc, int fr, int fq) const {
#pragma unroll
        for (int ai = 0; ai < 2; ++ai)
#pragma unroll
            for (int m = 0; m < 4; ++m) {
                const int hd = u.pm * 256 + ai * 128 + wr * 64 + m * 16 + fr;
                const int head = hd >> 6, dblk = (hd >> 5) & 1, dl = hd & 31;
#pragma unroll
                for (int bj = 0; bj < 2; ++bj) {
                    const int tok0 = u.pn * 256 + bj * 128 + wc * 32;
                    const int b = (tok0 >> 13) & (SBATCH - 1), kb = (tok0 & (SEQ - 1)) >> 5;
                    const size_t piece = ((((size_t)(b * NHEAD + head) * 256 + kb) * 2 + (fq >> 1)) * 2 + dblk);
#pragma unroll
                    for (int n = 0; n < 2; ++n) {
                        const f32x4 v = acc[ai][bj][m][n];
                        u32x2 w; w.x = cvtpk(v[0], v[1]); w.y = cvtpk(v[2], v[3]);
                        *(u32x2*)((char*)Vf + (piece * 64 + n * 32 + dl) * 16 + (fq & 1) * 8) = w;
                    }
                }
            }
    }
};

template <bool XF>
struct EpiOutB {
    static constexpr bool PERM = true;
    const float* xf; bf16_t* XB; const float* g1; float* ssq;
    __device__ __forceinline__ void operator()(const f32x4 (&acc)[2][2][4][2], const Unit& u, int wr, int wc, int fr, int fq) const {
        const int b = (u.pm * 256) >> 13;
        const int col0 = u.pn * 256 + wc * 32 + 8 * fq;
        f32x4 gv[2][2];
#pragma unroll
        for (int bj = 0; bj < 2; ++bj)
#pragma unroll
            for (int n = 0; n < 2; ++n) gv[bj][n] = *(const f32x4*)(g1 + (size_t)b * 6144 + col0 + bj * 128 + n * 4);
#pragma unroll
        for (int ai = 0; ai < 2; ++ai)
#pragma unroll
            for (int m = 0; m < 4; ++m) {
                const int row = u.pm * 256 + ai * 128 + wr * 64 + m * 16 + fr;
                const size_t off = (size_t)row * DM + col0;
                f32x4 xb[2][2];
                if (XF) {
#pragma unroll
                    for (int bj = 0; bj < 2; ++bj) { xb[bj][0] = *(const f32x4*)(xf + off + bj * 128); xb[bj][1] = *(const f32x4*)(xf + off + bj * 128 + 4); }
                } else {
#pragma unroll
                    for (int bj = 0; bj < 2; ++bj) { const u32x4 w = *(const u32x4*)(XB + off + bj * 128);
                        xb[bj][0] = (f32x4){bf_lo(w.x), bf_hi(w.x), bf_lo(w.y), bf_hi(w.y)}; xb[bj][1] = (f32x4){bf_lo(w.z), bf_hi(w.z), bf_lo(w.w), bf_hi(w.w)}; }
                }
                float ss = 0.f;
#pragma unroll
                for (int bj = 0; bj < 2; ++bj) {
                    const f32x4 x0 = xb[bj][0] + gv[bj][0] * acc[ai][bj][m][0], x1 = xb[bj][1] + gv[bj][1] * acc[ai][bj][m][1];
                    u32x4 w; w.x = cvtpk(x0[0], x0[1]); w.y = cvtpk(x0[2], x0[3]); w.z = cvtpk(x1[0], x1[1]); w.w = cvtpk(x1[2], x1[3]);
                    *(u32x4*)(XB + off + bj * 128) = w;
                    const float r0 = bf_lo(w.x), r1 = bf_hi(w.x), r2 = bf_lo(w.y), r3 = bf_hi(w.y), r4 = bf_lo(w.z), r5 = bf_hi(w.z), r6 = bf_lo(w.w), r7 = bf_hi(w.w);
                    ss += ((r0 * r0 + r1 * r1) + (r2 * r2 + r3 * r3)) + ((r4 * r4 + r5 * r5) + (r6 * r6 + r7 * r7));
                }
                ss += __shfl_xor(ss, 16); ss += __shfl_xor(ss, 32);
                if (fq == 0) ssq[(size_t)row * 16 + u.pn * 4 + wc] = ss;
            }
    }
};

struct EpiGU {
    static constexpr bool PERM = true;
    bf16_t* ACT; const int* list;
    __device__ __forceinline__ void operator()(const f32x4 (&acc)[2][2][4][2], const Unit& u, int wr, int wc, int fr, int fq) const {
#pragma unroll
        for (int ai = 0; ai < 2; ++ai)
#pragma unroll
            for (int m = 0; m < 4; ++m) {
                const int r = ai * 128 + wr * 64 + m * 16 + fr;
                if (r < u.rows) {
                    const int slot = list[(size_t)u.e * LCAP + u.pm * 256 + r];
                    float o[8];
#pragma unroll
                    for (int n = 0; n < 2; ++n)
#pragma unroll
                        for (int e = 0; e < 4; ++e) { const float gte = acc[ai][0][m][n][e], up = acc[ai][1][m][n][e];
                            o[n * 4 + e] = gte * fast_rcp(1.0f + fast_exp2(-gte * LOG2E)) * up; }
                    u32x4 w; w.x = cvtpk(o[0], o[1]); w.y = cvtpk(o[2], o[3]); w.z = cvtpk(o[4], o[5]); w.w = cvtpk(o[6], o[7]);
                    *(u32x4*)(ACT + (size_t)slot * DEXP + u.pn * 128 + wc * 32 + fq * 8) = w;
                }
            }
    }
};

struct EpiDn {
    static constexpr bool PERM = true;
    bf16_t* Y; const int* list; const float* ew;
    __device__ __forceinline__ void operator()(const f32x4 (&acc)[2][2][4][2], const Unit& u, int wr, int wc, int fr, int fq) const {
#pragma unroll
        for (int ai = 0; ai < 2; ++ai)
#pragma unroll
            for (int m = 0; m < 4; ++m) {
                const int r = ai * 128 + wr * 64 + m * 16 + fr;
                if (r < u.rows) {
                    const int slot = list[(size_t)u.e * LCAP + u.pm * 256 + r];
                    const float w8 = ew[slot];
#pragma unroll
                    for (int bj = 0; bj < 2; ++bj) {
                        const f32x4 v0 = acc[ai][bj][m][0] * w8, v1 = acc[ai][bj][m][1] * w8;
                        u32x4 w; w.x = cvtpk(v0[0], v0[1]); w.y = cvtpk(v0[2], v0[3]); w.z = cvtpk(v1[0], v1[1]); w.w = cvtpk(v1[2], v1[3]);
                        *(u32x4*)(Y + (size_t)slot * DM + u.pn * 256 + bj * 128 + wc * 32 + fq * 8) = w;
                    }
                }
            }
    }
};

struct TItem { const float* src; bf16_t* dst; int N, dstK, koff, k0, n0, map; };
__device__ __forceinline__ int t_rowmap(int map, int n) {
    if (map == 0) return n;
    if (map == 1) { if (n < 512 || n >= 1536) return n; const int t = n & 255, wc = t >> 6, bj = (t >> 5) & 1, c = t & 31; return (n & ~255) + 128 * bj + 32 * wc + c; }
    return 256 * (n >> 7) + 128 * (map - 2) + (n & 127);
}
__device__ __forceinline__ void t_load(const TItem& d, f32x4 (&v)[16], int lane) {
    const int kr = lane >> 4, c4 = lane & 15;
#pragma unroll
    for (int i = 0; i < 16; ++i) v[i] = *(const f32x4*)(d.src + (size_t)(d.k0 + 4 * i + kr) * d.N + d.n0 + 4 * c4);
}
__device__ __forceinline__ void t_process(const TItem& d, const f32x4 (&v)[16], LAS float* scr, int lane) {
    const int kr = lane >> 4, c4 = lane & 15;
#pragma unroll
    for (int i = 0; i < 16; ++i) { LAS float* s = scr + (4 * i + kr) * 65 + 4 * c4; s[0] = v[i][0]; s[1] = v[i][1]; s[2] = v[i][2]; s[3] = v[i][3]; }
    asm volatile("s_waitcnt lgkmcnt(0)" ::: "memory");
    const int nr = lane >> 3, kc = lane & 7;
#pragma unroll
    for (int i = 0; i < 8; ++i) { const int n = 8 * i + nr; const LAS float* s = scr + (8 * kc) * 65 + n;
        u32x4 o; o.x = cvtpk(s[0], s[65]); o.y = cvtpk(s[2 * 65], s[3 * 65]); o.z = cvtpk(s[4 * 65], s[5 * 65]); o.w = cvtpk(s[6 * 65], s[7 * 65]);
        *(u32x4*)(d.dst + (size_t)t_rowmap(d.map, d.n0 + n) * d.dstK + d.koff + d.k0 + 8 * kc) = o; }
    asm volatile("s_waitcnt lgkmcnt(0)" ::: "memory");
}
constexpr int T_IN = 512, T_OUT = 128, T_E = 128, T_MOE = NEXP * 3 * T_E, T_PER_LAYER = T_IN + T_OUT + T_MOE;
constexpr int T_NA = T_PER_LAYER + T_IN + T_OUT, T_NB = T_MOE;
constexpr int CONV_S1 = 6144, CONV_T1 = 3584;
__device__ __forceinline__ void t_decode_lr(const Params& p, int l, int r, TItem& d) {
    unsigned char* ws = p.ws;
    if (r < T_IN) { d.src = p.in[6] + (size_t)l * 1024 * 2048; d.N = 2048; d.dst = (bf16_t*)(ws + WS_WIN) + (size_t)l * 2048 * 1024; d.dstK = 1024; d.koff = 0; d.k0 = (r >> 5) * 64; d.n0 = (r & 31) * 64; d.map = 1; return; }
    r -= T_IN;
    if (r < T_OUT) { d.src = p.in[12] + ((size_t)l * 1024 + 512) * 1024; d.N = 1024; d.dst = (bf16_t*)(ws + WS_WOUT) + (size_t)l * 1024 * 1024; d.dstK = 1024; d.koff = 512; d.k0 = (r >> 4) * 64; d.n0 = (r & 15) * 64; d.map = 0; return; }
    r -= T_OUT;
    const int e = r / (3 * T_E); int q = r % (3 * T_E);
    if (q < 2 * T_E) { const int up = q >= T_E; if (up) q -= T_E;
        d.src = p.in[up ? 18 : 17] + ((size_t)l * NEXP + e) * 1024 * 512; d.N = 512; d.dst = (bf16_t*)(ws + WS_WGU) + ((size_t)l * NEXP + e) * 1024 * 1024; d.dstK = 1024; d.koff = 0; d.k0 = (q >> 3) * 64; d.n0 = (q & 7) * 64; d.map = 2 + up; return; }
    q -= 2 * T_E;
    d.src = p.in[19] + ((size_t)l * NEXP + e) * 512 * 1024; d.N = 1024; d.dst = (bf16_t*)(ws + WS_WD) + ((size_t)l * NEXP + e) * 1024 * 512; d.dstK = 512; d.koff = 0; d.k0 = (q >> 4) * 64; d.n0 = (q & 15) * 64; d.map = 0;
}
template <bool SPACE_B>
__device__ __forceinline__ void t_decode(const Params& p, int it, TItem& d) {
    if (SPACE_B) t_decode_lr(p, 1, T_IN + T_OUT + it, d);
    else if (it < T_PER_LAYER) t_decode_lr(p, 0, it, d);
    else t_decode_lr(p, 1, it - T_PER_LAYER, d);
}
template <bool SPACE_B>
__device__ __forceinline__ void t_run(const Params& p, int it, int stride, int nit, LAS float* scr, int lane) {
    if (it >= nit) return;
    TItem dA, dB; f32x4 vA[16], vB[16];
    t_decode<SPACE_B>(p, it, dA); t_load(dA, vA, lane);
    for (;;) {
        int nx = it + stride; const bool hasB = nx < nit;
        if (hasB) { t_decode<SPACE_B>(p, nx, dB); t_load(dB, vB, lane); }
        t_process(dA, vA, scr, lane);
        if (!hasB) break;
        it = nx + stride; const bool hasA = it < nit;
        if (hasA) { t_decode<SPACE_B>(p, it, dA); t_load(dA, vA, lane); }
        t_process(dB, vB, scr, lane);
        if (!hasA) break;
    }
}
__device__ __forceinline__ void conv_publish(unsigned* convdone) {
    asm volatile("s_waitcnt vmcnt(0)" ::: "memory");
    __syncthreads();
    if (threadIdx.x == 0) { __builtin_amdgcn_fence(__ATOMIC_RELEASE, "agent"); asm volatile("s_waitcnt vmcnt(0)" ::: "memory");
        __hip_atomic_fetch_add(convdone, 1u, __ATOMIC_RELAXED, __HIP_MEMORY_SCOPE_AGENT); }
}
__device__ __forceinline__ void tail_convert(const Params& p, LAS unsigned char* lds, int total_units, int v, int G, int first, int count, unsigned* convdone) {
    const int tid = opaque_tid(), lane = tid & 63, wave = tid >> 6;
    const int rem = total_units % G;
    const int nshare = rem ? G - rem : G, sidx = rem ? v - rem : v;
    __syncthreads();
    if (sidx >= 0) t_run<true>(p, first + sidx + nshare * wave, nshare * NWAVES, first + count, (LAS float*)(lds + wave * 16640), lane);
    conv_publish(convdone);
}

__device__ __forceinline__ void phase_prologue(const Params& p, LAS unsigned char* lds) {
    const int tid = opaque_tid(), lane = tid & 63, wave = tid >> 6, G = gridDim.x;
    unsigned char* ws = p.ws;
    {
        LAS float* cact = (LAS float*)lds;
        LAS float* red = (LAS float*)(lds + 16384);
        const float* c = p.in[1];
        for (int i = tid; i < 4096; i += NTHREADS) { const float v = c[i]; cact[i] = v / (1.0f + __expf(-v)); }
        __syncthreads();
        float* mod = (float*)(ws + WS_MOD);
        for (int item = blockIdx.x; item < 2 * 192; item += G) {
            const int l = item / 192, cgp = item % 192;
            const float* W = p.in[2] + (size_t)l * 1024 * 6144 + cgp * 32;
            const int col = lane & 31, rsub = lane >> 5;
            float a0 = 0.f, a1 = 0.f, a2 = 0.f, a3 = 0.f;
#pragma unroll 16
            for (int i = 0; i < 64; ++i) { const int k = wave * 128 + 2 * i + rsub; const float w = W[(size_t)k * 6144 + col];
                a0 += cact[k] * w; a1 += cact[1024 + k] * w; a2 += cact[2048 + k] * w; a3 += cact[3072 + k] * w; }
            a0 += __shfl_xor(a0, 32); a1 += __shfl_xor(a1, 32); a2 += __shfl_xor(a2, 32); a3 += __shfl_xor(a3, 32);
            if (lane < 32) { red[(wave * 4 + 0) * 32 + col] = a0; red[(wave * 4 + 1) * 32 + col] = a1; red[(wave * 4 + 2) * 32 + col] = a2; red[(wave * 4 + 3) * 32 + col] = a3; }
            __syncthreads();
            if (tid < 128) { const int b = tid >> 5, cc = tid & 31; float s = 0.f;
#pragma unroll
                for (int w = 0; w < 8; ++w) s += red[(w * 4 + b) * 32 + cc];
                mod[(size_t)(l * 4 + b) * 6144 + cgp * 32 + cc] = s + p.in[3][l * 6144 + cgp * 32 + cc]; }
            __syncthreads();
        }
    }
    {
        float* tbl = (float*)(ws + WS_TBL);
        for (int job = blockIdx.x; job < 2; job += G) {
            const int l = job;
            LAS float* sm = (LAS float*)(lds + 32768);
            float mq = 0.f, mk = 0.f, mb = 0.f;
            if (tid < 64) { mq = fabsf(p.in[9][l * 64 + tid]); mk = fabsf(p.in[10][l * 64 + tid]); }
            for (int i = tid; i < NHEAD * 257; i += NTHREADS) mb = fmaxf(mb, fabsf(p.in[11][i]));
#pragma unroll
            for (int o = 1; o < 64; o <<= 1) { mq = fmaxf(mq, __shfl_xor(mq, o)); mk = fmaxf(mk, __shfl_xor(mk, o)); mb = fmaxf(mb, __shfl_xor(mb, o)); }
            if (lane == 0) { sm[wave * 4 + 0] = mq; sm[wave * 4 + 1] = mk; sm[wave * 4 + 2] = mb; }
            __syncthreads();
            mq = 0.f; mk = 0.f; mb = 0.f;
            for (int w = 0; w < 8; ++w) { mq = fmaxf(mq, sm[w * 4 + 0]); mk = fmaxf(mk, sm[w * 4 + 1]); mb = fmaxf(mb, sm[w * 4 + 2]); }
            const float shift = LOG2E * (8.0f * mq * mk + mb);
            for (int i = tid; i < NHEAD * 256; i += NTHREADS) { const int h = i >> 8, j = i & 255; int rel = j - 63; if (rel > 128) rel = 128;
                tbl[(size_t)l * 2048 + i] = (j < 255) ? p.in[11][h * 257 + rel + 128] * LOG2E - shift : 0.f; }
            __syncthreads();
        }
        for (int job = blockIdx.x; job < 2 * 48; job += G) {
            const int l = job / 48, n = job % 48;
            bf16_t* hi = (bf16_t*)(ws + WS_RW) + (size_t)l * 2 * 48 * 1024;
            bf16_t* lo = hi + 48 * 1024;
            for (int k = tid; k < 1024; k += NTHREADS) {
                float w = 0.f;
                if (n < 32) w = p.in[15][((size_t)l * 1024 + k) * 32 + n]; else if (n < 36) w = p.in[13][((size_t)l * 1024 + k) * 4 + (n - 32)];
                const unsigned h2 = cvtpk(w, 0.f) & 0xffffu; const float r = w - bf_lo(h2);
                const size_t idx = ((size_t)((k >> 5) * 3 + (n >> 4)) * 64 + ((k & 31) >> 3) * 16 + (n & 15)) * 8 + (k & 7);
                hi[idx] = (bf16_t)h2; lo[idx] = (bf16_t)(cvtpk(r, 0.f) & 0xffffu);
            }
            if (tid == 0) { float bsv = 0.f; if (n < 32) bsv = p.in[16][l * 32 + n]; else if (n < 36) bsv = p.in[14][l * 4 + (n - 32)]; ((float*)(ws + WS_RWB))[l * 48 + n] = bsv; }
        }
    }
    __syncthreads();
    {
        LAS float* wsc = (LAS float*)lds;
        LAS float* pwl = (LAS float*)(lds + 32768);
        for (int item = blockIdx.x; item < 2 * 4 * 16; item += G) {
            const int l = item >> 6, g = (item >> 4) & 3, nb = item & 15;
            const float* wo = p.in[12] + ((size_t)l * 1024 + g * 128) * 1024 + nb * 64;
            const float* sc = p.in[8] + l * 512 + g * 128;
            const float* pw = p.in[7] + ((size_t)l * 4 + g) * 128 * 128;
            for (int i = tid; i < 128 * 64; i += NTHREADS) { const int d = i >> 6, n = i & 63; wsc[i] = wo[(size_t)d * 1024 + n] * sc[d]; }
            for (int i = tid; i < 128 * 128 / 4; i += NTHREADS) *(LAS f32x4*)(pwl + 4 * i) = *(const f32x4*)(pw + 4 * i);
            __syncthreads();
            const int n = tid & 63, cgp = tid >> 6;
            float a[16];
#pragma unroll
            for (int j = 0; j < 16; ++j) a[j] = 0.f;
#pragma unroll 2
            for (int d4 = 0; d4 < 32; ++d4) {
                const float w0 = wsc[(4 * d4 + 0) * 64 + n], w1 = wsc[(4 * d4 + 1) * 64 + n], w2 = wsc[(4 * d4 + 2) * 64 + n], w3 = wsc[(4 * d4 + 3) * 64 + n];
#pragma unroll
                for (int j = 0; j < 16; ++j) { const f32x4 pv = *(const LAS f32x4*)(pwl + (cgp * 16 + j) * 128 + 4 * d4); a[j] += (pv[0] * w0 + pv[1] * w1) + (pv[2] * w2 + pv[3] * w3); }
            }
            bf16_t* dst = (bf16_t*)(ws + WS_WOUT) + ((size_t)l * 1024 + nb * 64 + n) * 1024 + g * 128 + cgp * 16;
            u32x4 o0, o1; o0.x = cvtpk(a[0], a[1]); o0.y = cvtpk(a[2], a[3]); o0.z = cvtpk(a[4], a[5]); o0.w = cvtpk(a[6], a[7]);
            o1.x = cvtpk(a[8], a[9]); o1.y = cvtpk(a[10], a[11]); o1.z = cvtpk(a[12], a[13]); o1.w = cvtpk(a[14], a[15]);
            *(u32x4*)dst = o0; *(u32x4*)(dst + 8) = o1;
            __syncthreads();
        }
    }
    {
        LAS float* scr = (LAS float*)(lds + wave * 16640);
        t_run<false>(p, blockIdx.x * NWAVES + wave, G * NWAVES, T_NA, scr, lane);
    }
}

__device__ __forceinline__ f32x4 y_pair_sum(const bf16_t* Y, size_t row, int c) {
    const u32x2 y0 = *(const u32x2*)(Y + (size_t)(2 * row) * DM + c), y1 = *(const u32x2*)(Y + (size_t)(2 * row + 1) * DM + c);
    f32x4 ys; ys[0] = bf_lo(y0.x) + bf_lo(y1.x); ys[1] = bf_hi(y0.x) + bf_hi(y1.x); ys[2] = bf_lo(y0.y) + bf_lo(y1.y); ys[3] = bf_hi(y0.y) + bf_hi(y1.y); return ys;
}
template <int NR, bool UPD>
__device__ __forceinline__ void norm1_rows(const Params& p, int l, int row0, int lane) {
    const float* mod = (const float*)(p.ws + WS_MOD);
    const float* gn = p.in[4] + l * 1024;
    bf16_t* H = (bf16_t*)(p.ws + WS_BUF);
    const bf16_t* Y = (const bf16_t*)(p.ws + WS_Y);
    bf16_t* XB = (bf16_t*)(p.ws + WS_XB);
    const int b = row0 >> 13;
    f32x4 v[NR][4];
    if (!UPD) {
#pragma unroll
        for (int r = 0; r < NR; ++r)
#pragma unroll
            for (int j = 0; j < 4; ++j) v[r][j] = *(const f32x4*)(p.in[0] + (size_t)(row0 + r) * DM + 4 * lane + 256 * j);
    } else {
        const float* g2 = mod + (size_t)((l - 1) * 4 + b) * 6144 + 5120;
        f32x4 ys[NR][4];
#pragma unroll
        for (int r = 0; r < NR; ++r)
#pragma unroll
            for (int j = 0; j < 4; ++j) { const int c = 4 * lane + 256 * j; const u32x2 xw = *(const u32x2*)(XB + (size_t)(row0 + r) * DM + c);
                v[r][j] = (f32x4){bf_lo(xw.x), bf_hi(xw.x), bf_lo(xw.y), bf_hi(xw.y)}; ys[r][j] = y_pair_sum(Y, row0 + r, c); }
#pragma unroll
        for (int j = 0; j < 4; ++j) { const f32x4 gg = *(const f32x4*)(g2 + 4 * lane + 256 * j);
#pragma unroll
            for (int r = 0; r < NR; ++r) { const f32x4 xn = v[r][j] + gg * ys[r][j]; u32x2 xw; xw.x = cvtpk(xn[0], xn[1]); xw.y = cvtpk(xn[2], xn[3]);
                *(u32x2*)(XB + (size_t)(row0 + r) * DM + 4 * lane + 256 * j) = xw;
                v[r][j] = (f32x4){bf_lo(xw.x), bf_hi(xw.x), bf_lo(xw.y), bf_hi(xw.y)}; } }
    }
    float ss[NR];
#pragma unroll
    for (int r = 0; r < NR; ++r) { ss[r] = 0.f;
#pragma unroll
        for (int j = 0; j < 4; ++j) ss[r] += (v[r][j][0] * v[r][j][0] + v[r][j][1] * v[r][j][1]) + (v[r][j][2] * v[r][j][2] + v[r][j][3] * v[r][j][3]); }
#pragma unroll
    for (int o = 1; o < 64; o <<= 1)
#pragma unroll
        for (int r = 0; r < NR; ++r) ss[r] += __shfl_xor(ss[r], o);
    const float* sh = mod + (size_t)(l * 4 + b) * 6144; const float* sc = sh + 1024;
#pragma unroll
    for (int j = 0; j < 4; ++j) {
        const int c = 4 * lane + 256 * j;
        const f32x4 g = *(const f32x4*)(gn + c), s1 = *(const f32x4*)(sc + c), s0 = *(const f32x4*)(sh + c);
        const f32x4 a = g * (s1 + 1.0f);
#pragma unroll
        for (int r = 0; r < NR; ++r) {
            const float rstd = rsqrtf(ss[r] * (1.0f / DM) + EPS);
            const f32x4 h = v[r][j] * rstd * a + s0;
            u32x2 w; w.x = cvtpk(h[0], h[1]); w.y = cvtpk(h[2], h[3]);
            *(u32x2*)(H + (size_t)(row0 + r) * DM + c) = w;
        }
    }
}
__device__ __forceinline__ void phase_norm1(const Params& p, int l, const Ctx& cx) {
    const int tid = opaque_tid(), lane = tid & 63, wave = tid >> 6;
    const int gw = cx.lb * NWAVES + wave, NGW = cx.GS * NWAVES;
    if (l == 0) { for (int rq = gw; rq < STOK / 4; rq += NGW) norm1_rows<4, false>(p, l, cx.tok0 + rq * 4, lane); }
    else { for (int rq = gw; rq < STOK / 2; rq += NGW) norm1_rows<2, true>(p, l, cx.tok0 + rq * 2, lane); }
}

__device__ __forceinline__ void phase_final(const Params& p, const Ctx& cx) {
    const int tid = opaque_tid(), lane = tid & 63, wave = tid >> 6;
    const int gw = cx.lb * NWAVES + wave, NGW = cx.GS * NWAVES;
    const float* mod = (const float*)(p.ws + WS_MOD);
    const bf16_t* Y = (const bf16_t*)(p.ws + WS_Y);
    const bf16_t* XB = (const bf16_t*)(p.ws + WS_XB);
    constexpr int NR = 4;
    for (int rq = gw; rq < STOK / NR; rq += NGW) {
        const int row0 = cx.tok0 + rq * NR, b = row0 >> 13;
        const float* g2 = mod + (size_t)((DEPTH - 1) * 4 + b) * 6144 + 5120;
        f32x4 v[NR][4], ys[NR][4];
#pragma unroll
        for (int r = 0; r < NR; ++r)
#pragma unroll
            for (int j = 0; j < 4; ++j) { const int c = 4 * lane + 256 * j; const u32x2 xw = *(const u32x2*)(XB + (size_t)(row0 + r) * DM + c);
                v[r][j] = (f32x4){bf_lo(xw.x), bf_hi(xw.x), bf_lo(xw.y), bf_hi(xw.y)}; ys[r][j] = y_pair_sum(Y, row0 + r, c); }
#pragma unroll
        for (int j = 0; j < 4; ++j) { const f32x4 gg = *(const f32x4*)(g2 + 4 * lane + 256 * j);
#pragma unroll
            for (int r = 0; r < NR; ++r) *(f32x4*)(p.out + (size_t)(row0 + r) * DM + 4 * lane + 256 * j) = v[r][j] + gg * ys[r][j]; }
    }
}

__device__ __forceinline__ int crow(int r, int hi) { return (r & 3) + 8 * (r >> 2) + 4 * hi; }

__device__ __forceinline__ void pool_strip(const Params& p, const bf16_t* U, int strip, int lane) {
    bf16_t* MIX = (bf16_t*)(p.ws + WS_BUF);
    const int tok0 = strip * 16, s0 = tok0 & (SEQ - 1);
    const int win = 2 << (lane >> 4);
    float S[8];
#pragma unroll
    for (int j = 0; j < 8; ++j) S[j] = 0.f;
#pragma unroll
    for (int d = 1; d < 16; ++d) {
        if (d < win && s0 - d >= 0) {
            const u32x4 w = *(const u32x4*)(U + (size_t)(tok0 - d) * 512 + lane * 8);
            S[0] += bf_lo(w.x); S[1] += bf_hi(w.x); S[2] += bf_lo(w.y); S[3] += bf_hi(w.y); S[4] += bf_lo(w.z); S[5] += bf_hi(w.z); S[6] += bf_lo(w.w); S[7] += bf_hi(w.w);
        }
    }
#pragma unroll 4
    for (int i = 0; i < 16; ++i) {
        const int s = s0 + i;
        const u32x4 w = *(const u32x4*)(U + (size_t)(tok0 + i) * 512 + lane * 8);
        float uv[8] = {bf_lo(w.x), bf_hi(w.x), bf_lo(w.y), bf_hi(w.y), bf_lo(w.z), bf_hi(w.z), bf_lo(w.w), bf_hi(w.w)};
#pragma unroll
        for (int j = 0; j < 8; ++j) S[j] += uv[j];
        const int cn = (s + 1 < win) ? s + 1 : win;
        const float inv = 1.0f / (float)cn;
        float o[8];
#pragma unroll
        for (int j = 0; j < 8; ++j) o[j] = S[j] * inv - uv[j];
        u32x4 ow; ow.x = cvtpk(o[0], o[1]); ow.y = cvtpk(o[2], o[3]); ow.z = cvtpk(o[4], o[5]); ow.w = cvtpk(o[6], o[7]);
        *(u32x4*)(MIX + (size_t)(tok0 + i) * DM + lane * 8) = ow;
        if (s - win + 1 >= 0) {
            const u32x4 x = *(const u32x4*)(U + (size_t)(tok0 + i - win + 1) * 512 + lane * 8);
            S[0] -= bf_lo(x.x); S[1] -= bf_hi(x.x); S[2] -= bf_lo(x.y); S[3] -= bf_hi(x.y); S[4] -= bf_lo(x.z); S[5] -= bf_hi(x.z); S[6] -= bf_lo(x.w); S[7] -= bf_hi(x.w);
        }
    }
}

__device__ __forceinline__ void attn_unit(const Params& p, const Ctx& cx, int bl, int h, int ch, int qh, int lane, const LAS float* tbl, LAS bf16_t* stg) {
    const int b = cx.s * SBATCH + bl;
    const int r32 = lane & 31, hi = lane >> 5;
    const char* Qf = (const char*)s_Q(p.ws, cx); const char* Kf = (const char*)s_K(p.ws, cx); const char* Vf = (const char*)s_V(p.ws, cx);
    bf16_t* MIX = (bf16_t*)(p.ws + WS_BUF);
    const size_t bh = (size_t)(bl * NHEAD + h) * 256;
    bf16x8 qr[4];
#pragma unroll
    for (int d0 = 0; d0 < 4; ++d0) qr[d0] = *(const bf16x8*)(Qf + (((bh + ch * 2 + qh) * 4 + d0) * 64 + lane) * 16);
    f32x16 o0 = {}, o1 = {};
    float lsum = 0.f;
    const LAS float* th = tbl + h * 256;
    const float cfar = th[254];
    const int t0 = ch < 8 ? 8 - ch : 0;
    const char* kbase = Kf + (bh * 4 * 64 + lane) * 16 + (ptrdiff_t)(ch - 8) * 8192;
    const char* vbase = Vf + (bh * 4 * 64 + lane) * 16 + (ptrdiff_t)(ch - 8) * 8192;
    bf16x8 kk[8];
    { const char* kp_ = kbase + (ptrdiff_t)t0 * 8192;
#pragma unroll
      for (int i = 0; i < 8; ++i) kk[i] = *(const bf16x8*)(kp_ + i * 1024); }
#pragma unroll 1
    for (int t = t0; t <= 8; ++t) {
        bf16x8 vv[8];
        { const char* vp_ = vbase + (ptrdiff_t)t * 8192;
#pragma unroll
          for (int i = 0; i < 8; ++i) vv[i] = *(const bf16x8*)(vp_ + i * 1024); }
        f32x16 p0, p1;
        if (t <= 5) {
#pragma unroll
            for (int r = 0; r < 16; ++r) { p0[r] = cfar; p1[r] = cfar; }
        } else {
            const int base_ = 64 * (8 - t) + 32 * qh + r32 + 63 - 4 * hi;
#pragma unroll
            for (int r = 0; r < 16; ++r) { const int kj = (r & 3) + 8 * (r >> 2); p0[r] = th[base_ - kj]; p1[r] = th[base_ - kj - 32]; }
        }
#pragma unroll
        for (int d0 = 0; d0 < 4; ++d0) {
            p0 = __builtin_amdgcn_mfma_f32_32x32x16_bf16(kk[d0], qr[d0], p0, 0, 0, 0);
            p1 = __builtin_amdgcn_mfma_f32_32x32x16_bf16(kk[4 + d0], qr[d0], p1, 0, 0, 0);
        }
        if (t < 8) {
            const char* kp_ = kbase + (ptrdiff_t)(t + 1) * 8192;
#pragma unroll
            for (int i = 0; i < 8; ++i) kk[i] = *(const bf16x8*)(kp_ + i * 1024);
        }
        float sacc = 0.f;
#pragma unroll
        for (int r = 0; r < 16; ++r) { p0[r] = fast_exp2(p0[r]); p1[r] = fast_exp2(p1[r]); sacc += p0[r] + p1[r]; }
        lsum += sacc;
        u32x4 pa[2][2];
#pragma unroll
        for (int s = 0; s < 2; ++s) {
            pa[0][s].x = cvtpk(p0[8 * s + 0], p0[8 * s + 1]); pa[0][s].y = cvtpk(p0[8 * s + 2], p0[8 * s + 3]); pa[0][s].z = cvtpk(p0[8 * s + 4], p0[8 * s + 5]); pa[0][s].w = cvtpk(p0[8 * s + 6], p0[8 * s + 7]);
            pa[1][s].x = cvtpk(p1[8 * s + 0], p1[8 * s + 1]); pa[1][s].y = cvtpk(p1[8 * s + 2], p1[8 * s + 3]); pa[1][s].z = cvtpk(p1[8 * s + 4], p1[8 * s + 5]); pa[1][s].w = cvtpk(p1[8 * s + 6], p1[8 * s + 7]);
        }
#pragma unroll
        for (int blk = 0; blk < 2; ++blk)
#pragma unroll
            for (int s = 0; s < 2; ++s) {
                const bf16x8 pf = __builtin_bit_cast(bf16x8, pa[blk][s]);
                o0 = __builtin_amdgcn_mfma_f32_32x32x16_bf16(pf, vv[(blk * 2 + s) * 2 + 0], o0, 0, 0, 0);
                o1 = __builtin_amdgcn_mfma_f32_32x32x16_bf16(pf, vv[(blk * 2 + s) * 2 + 1], o1, 0, 0, 0);
            }
    }
    lsum += __shfl_xor(lsum, 32);
    const float linv = 1.0f / lsum;
#pragma unroll
    for (int r = 0; r < 16; ++r) {
        const int q = crow(r, hi);
        const float li = __shfl(linv, q);
        stg[q * 72 + r32] = (bf16_t)(cvtpk(o0[r] * li, 0.f) & 0xffffu);
        stg[q * 72 + 32 + r32] = (bf16_t)(cvtpk(o1[r] * li, 0.f) & 0xffffu);
    }
    asm volatile("s_waitcnt lgkmcnt(0)" ::: "memory");
    bf16_t* orow = MIX + ((size_t)b * SEQ + ch * 64 + qh * 32 + (lane >> 3)) * DM + 512 + h * 64 + (lane & 7) * 8;
    const LAS bf16_t* srow = stg + (lane >> 3) * 72 + (lane & 7) * 8;
#pragma unroll
    for (int i = 0; i < 4; ++i) *(u32x4*)(orow + (size_t)i * 8 * DM) = *(const LAS u32x4*)(srow + i * 8 * 72);
    asm volatile("s_waitcnt lgkmcnt(0)" ::: "memory");
}

__device__ __forceinline__ void phase_mixer(const Params& p, int l, LAS unsigned char* lds, const Ctx& cx) {
    const int tid = opaque_tid(), lane = tid & 63, wave = tid >> 6;
    LAS float* tbl = (LAS float*)lds;
    const float* gt = (const float*)(p.ws + WS_TBL) + (size_t)l * 2048;
    for (int i = tid; i < 2048; i += NTHREADS) tbl[i] = gt[i];
    __syncthreads();
    const int gw = cx.lb * NWAVES + wave, NGW = cx.GS * NWAVES;
    LAS bf16_t* stg = (LAS bf16_t*)(lds + 8192 + wave * 4608);
    const bf16_t* U = s_U(p.ws, cx);
    for (int it = gw; it < STOK / 16; it += NGW) pool_strip(p, U, cx.tok0 / 16 + it, lane);
    constexpr int NPAIR = SBATCH * NHEAD;
    if (cx.GS % 8 == 0) {
        const int x = cx.lb & 7, lw = (cx.lb >> 3) * NWAVES + wave, nlw = (cx.GS >> 3) * NWAVES;
        for (int pr = x; pr < NPAIR; pr += 8)
            for (int u = lw; u < 256; u += nlw) attn_unit(p, cx, pr >> 3, pr & 7, u >> 1, u & 1, lane, tbl, stg);
    } else {
        for (int wu = gw; wu < NPAIR * 256; wu += NGW) attn_unit(p, cx, wu >> 11, (wu >> 8) & 7, (wu >> 1) & 127, wu & 1, lane, tbl, stg);
    }
}

__device__ __forceinline__ void phase_route(const Params& p, int l, LAS unsigned char* lds, const Ctx& cx) {
    const int tid = opaque_tid(), lane = tid & 63, wave = __builtin_amdgcn_readfirstlane(tid >> 6);
    LAS float* a2c = (LAS float*)(lds + 49152);
    LAS float* shc = (LAS float*)(lds + 49152 + 1024);
    LAS float* lg = (LAS float*)(lds + 53248) + wave * (16 * 48);
    LAS int* lcnt = (LAS int*)(lds + 77824);
    LAS int* gbase = (LAS int*)(lds + 77824 + 128);
    LAS int* tmp_e = (LAS int*)(lds + 77824 + 256);
    LAS int* tmp_r = (LAS int*)(lds + 77824 + 256 + 1024);
    const float* mod = (const float*)(p.ws + WS_MOD);
    const float* gn = p.in[5] + l * 1024;
    bf16_t* H = (bf16_t*)(p.ws + WS_BUF);
    const char* RW = (const char*)(p.ws + WS_RW) + (size_t)l * 2 * 48 * 1024 * 2;
    const float* rwb = (const float*)(p.ws + WS_RWB) + l * 48;
    const float* ssq = (const float*)(p.ws + WS_SSQ);
    int* gcnt = s_cnt(p.ws, cx, l);
    int* list = s_list(p.ws, cx);
    float* ew = (float*)(p.ws + WS_EW);
    const int r = lane & 15, kg = lane >> 4;
    for (int itl = cx.lb; itl < STOK / 128; itl += cx.GS) {
        const int it = cx.tok0 / 128 + itl;
        const int row0 = it * 128 + wave * 16, row = row0 + r, b = (it * 128) >> 13;
        const bf16_t* xr = (const bf16_t*)(p.ws + WS_XB) + (size_t)row * DM + 8 * kg;
        float ss; { const f32x4 q4 = *(const f32x4*)(ssq + (size_t)row * 16 + 4 * kg); ss = (q4[0] + q4[1]) + (q4[2] + q4[3]); }
        ss += __shfl_xor(ss, 16); ss += __shfl_xor(ss, 32);
        const float rstd = rsqrtf(ss * (1.0f / DM) + EPS);
        const float* sh = mod + (size_t)(l * 4 + b) * 6144 + 3072; const float* sc = sh + 1024;
        f32x4 acc[3];
#pragma unroll
        for (int nb = 0; nb < 3; ++nb) acc[nb] = (f32x4){0.f, 0.f, 0.f, 0.f};
#pragma unroll 1
        for (int c = 0; c < 4; ++c) {
            u32x4 xs[8];
#pragma unroll
            for (int i = 0; i < 8; ++i) xs[i] = *(const u32x4*)(xr + 256 * c + 32 * i);
            __syncthreads();
            if (c == 0 && tid < 32) lcnt[tid] = 0;
#pragma unroll
            for (int i = 0; i < 6; ++i) { const int q = wave * 6 + i; const char* src = RW + (q < 24 ? (size_t)(c * 24 + q) * 1024 : (size_t)98304 + (size_t)(c * 24 + q - 24) * 1024);
                __builtin_amdgcn_global_load_lds((const unsigned*)(src + lane * 16), (LAS unsigned*)(lds + q * 1024), 16, 0, 0); }
            if (tid < 256) { const int k = 256 * c + tid; a2c[tid] = gn[k] * (1.0f + sc[k]); shc[tid] = sh[k]; }
            asm volatile("s_waitcnt vmcnt(0)" ::: "memory");
            __syncthreads();
#pragma unroll
            for (int i = 0; i < 8; ++i) {
                float hv[8];
#pragma unroll
                for (int q = 0; q < 2; ++q) {
                    const f32x4 a = *(const LAS f32x4*)(a2c + 32 * i + 8 * kg + 4 * q), s0 = *(const LAS f32x4*)(shc + 32 * i + 8 * kg + 4 * q);
                    const f32x4 xv = q == 0 ? (f32x4){bf_lo(xs[i].x), bf_hi(xs[i].x), bf_lo(xs[i].y), bf_hi(xs[i].y)} : (f32x4){bf_lo(xs[i].z), bf_hi(xs[i].z), bf_lo(xs[i].w), bf_hi(xs[i].w)};
                    const f32x4 hh = xv * rstd * a + s0;
                    hv[4 * q + 0] = hh[0]; hv[4 * q + 1] = hh[1]; hv[4 * q + 2] = hh[2]; hv[4 * q + 3] = hh[3];
                }
                u32x4 hp; hp.x = cvtpk(hv[0], hv[1]); hp.y = cvtpk(hv[2], hv[3]); hp.z = cvtpk(hv[4], hv[5]); hp.w = cvtpk(hv[6], hv[7]);
                *(u32x4*)(H + (size_t)row * DM + 256 * c + 32 * i + 8 * kg) = hp;
                u32x4 lp;
                lp.x = cvtpk(hv[0] - bf_lo(hp.x), hv[1] - bf_hi(hp.x)); lp.y = cvtpk(hv[2] - bf_lo(hp.y), hv[3] - bf_hi(hp.y));
                lp.z = cvtpk(hv[4] - bf_lo(hp.z), hv[5] - bf_hi(hp.z)); lp.w = cvtpk(hv[6] - bf_lo(hp.w), hv[7] - bf_hi(hp.w));
                const bf16x8 xhi = __builtin_bit_cast(bf16x8, hp), xlo = __builtin_bit_cast(bf16x8, lp);
#pragma unroll
                for (int nb = 0; nb < 3; ++nb) {
                    const bf16x8 whi = *(const LAS bf16x8*)(lds + (i * 3 + nb) * 1024 + lane * 16);
                    const bf16x8 wlo = *(const LAS bf16x8*)(lds + 24576 + (i * 3 + nb) * 1024 + lane * 16);
                    acc[nb] = __builtin_amdgcn_mfma_f32_16x16x32_bf16(whi, xhi, acc[nb], 0, 0, 0);
                    acc[nb] = __builtin_amdgcn_mfma_f32_16x16x32_bf16(whi, xlo, acc[nb], 0, 0, 0);
                    acc[nb] = __builtin_amdgcn_mfma_f32_16x16x32_bf16(wlo, xhi, acc[nb], 0, 0, 0);
                }
            }
        }
#pragma unroll
        for (int nb = 0; nb < 3; ++nb)
#pragma unroll
            for (int q = 0; q < 4; ++q) lg[r * 48 + 16 * nb + 4 * kg + q] = acc[nb][q];
        asm volatile("s_waitcnt lgkmcnt(0)" ::: "memory");
        if (lane < 16) {
            const LAS float* my = lg + lane * 48;
            float gl[4]; int gi = 0; float gm;
#pragma unroll
            for (int i = 0; i < 4; ++i) gl[i] = my[32 + i] + rwb[32 + i];
            gm = gl[0];
#pragma unroll
            for (int i = 1; i < 4; ++i) if (gl[i] > gm) { gm = gl[i]; gi = i; }
            float den = 0.f;
#pragma unroll
            for (int i = 0; i < 4; ++i) den += __expf(gl[i] - gm);
            const float gpv = 1.0f / den;
            float el[8];
#pragma unroll
            for (int i = 0; i < 8; ++i) el[i] = my[8 * gi + i] + rwb[8 * gi + i];
            int i0 = 0; float v0 = el[0];
#pragma unroll
            for (int i = 1; i < 8; ++i) if (el[i] > v0) { v0 = el[i]; i0 = i; }
            int i1 = -1; float v1 = -3.0e38f;
#pragma unroll
            for (int i = 0; i < 8; ++i) if (i != i0 && el[i] > v1) { v1 = el[i]; i1 = i; }
            const float dd = __expf(v1 - v0);
            const float w0 = gpv / (1.0f + dd), w1 = gpv * dd / (1.0f + dd);
            const int e0 = 8 * gi + i0, e1 = 8 * gi + i1;
            const int tok = row0 + lane, lt = wave * 16 + lane;
            ew[2 * tok] = w0; ew[2 * tok + 1] = w1;
            tmp_e[2 * lt] = e0; tmp_e[2 * lt + 1] = e1;
            tmp_r[2 * lt] = __hip_atomic_fetch_add(lcnt + e0, 1, __ATOMIC_RELAXED, __HIP_MEMORY_SCOPE_WORKGROUP);
            tmp_r[2 * lt + 1] = __hip_atomic_fetch_add(lcnt + e1, 1, __ATOMIC_RELAXED, __HIP_MEMORY_SCOPE_WORKGROUP);
        }
        __syncthreads();
        if (tid < 32) gbase[tid] = __hip_atomic_fetch_add(gcnt + tid, lcnt[tid], __ATOMIC_RELAXED, __HIP_MEMORY_SCOPE_AGENT);
        __syncthreads();
        if (tid < 256) { const int e = tmp_e[tid]; list[(size_t)e * LCAP + gbase[e] + tmp_r[tid]] = it * 256 + tid; }
    }
    __syncthreads();
}

#define XB_TMO      128
#define XB_XCNT(j)  (256  + 64 * (j))
#define XB_XSUB(j)  (1280 + 64 * (j))
#define XB_XGEN(j)  (2304 + 64 * (j))
#define XB_TOP      3328
#define XB_TOPGEN   3392
#define XCD_BAR_WORDS 3456
#define XB_SPIN_CAP (1u << 18)
__device__ __forceinline__ unsigned xb_ld(unsigned* p)              { return __hip_atomic_load(p, __ATOMIC_RELAXED, __HIP_MEMORY_SCOPE_AGENT); }
__device__ __forceinline__ unsigned xb_add(unsigned* p, unsigned v) { return __hip_atomic_fetch_add(p, v, __ATOMIC_RELAXED, __HIP_MEMORY_SCOPE_AGENT); }
__device__ __forceinline__ unsigned xb_xcc_id() { return (unsigned)__builtin_amdgcn_s_getreg((3 << 11) | 20) & 0xFu; }
#define XB_SPIN(cond, bar) do { unsigned _sp = 0; while (cond) { __builtin_amdgcn_s_sleep(1); \
    if ((++_sp & 255u) == 0u) { if (xb_ld(&(bar)[XB_TMO])) break; if (_sp > XB_SPIN_CAP) { atomicAdd(&(bar)[XB_TMO], 1u); break; } } } } while (0)
struct XcdBarrier { unsigned* bar; unsigned x; volatile LAS unsigned* st; unsigned G; };
__device__ __forceinline__ XcdBarrier xcd_barrier_post(unsigned* bar, volatile LAS unsigned* st, unsigned G) {
    XcdBarrier b; b.bar = bar; b.x = xb_xcc_id(); b.st = st; b.G = G;
    if (threadIdx.x == 0) (void)xb_add(&bar[XB_XCNT(b.x)], 1u);
    return b;
}
__device__ __forceinline__ void xcd_barrier_complete(unsigned* bar, unsigned x, unsigned G, unsigned& nloc, unsigned& nx) {
    unsigned sum, cnt, mine, sp = 0u;
    for (;;) {
        sum = 0u; cnt = 0u; mine = 0u;
#pragma unroll
        for (unsigned j = 0; j < 16; ++j) { const unsigned c = xb_ld(&bar[XB_XCNT(j)]); sum += c; cnt += (c > 0u) ? 1u : 0u; mine = (j == x) ? c : mine; }
        if (sum == G) break;
        __builtin_amdgcn_s_sleep(1);
        if ((++sp & 255u) == 0u) { if (xb_ld(&bar[XB_TMO])) break; if (sp > XB_SPIN_CAP) { atomicAdd(&bar[XB_TMO], 1u); break; } }
    }
    nloc = mine > 0u ? mine : 1u; nx = cnt > 0u ? cnt : 1u;
}
__device__ __forceinline__ void xcd_barrier(const XcdBarrier& b) {
    asm volatile("s_waitcnt vmcnt(0)" ::: "memory");
    __syncthreads();
    if (threadIdx.x == 0) {
        unsigned* bar = b.bar; unsigned bx = b.x; asm volatile("" : "+s"(bar), "+s"(bx));
        __builtin_amdgcn_s_waitcnt(0);
        unsigned nloc = b.st[0], nx = b.st[1];
        if (nloc == 0u) { xcd_barrier_complete(bar, bx, b.G, nloc, nx); b.st[0] = nloc; b.st[1] = nx; }
        const unsigned old = xb_add(&bar[XB_XSUB(bx)], 1u);
        const unsigned gen = old / nloc;
        if (old + 1u == (gen + 1u) * nloc) {
            __builtin_amdgcn_fence(__ATOMIC_RELEASE, "agent");
            asm volatile("s_waitcnt vmcnt(0)" ::: "memory");
            const unsigned og = xb_add(&bar[XB_TOP], 1u);
            const unsigned tg = og / nx;
            if (og + 1u == (tg + 1u) * nx) xb_add(&bar[XB_TOPGEN], 1u);
            else XB_SPIN(xb_ld(&bar[XB_TOPGEN]) == tg, bar);
            __builtin_amdgcn_fence(__ATOMIC_ACQUIRE, "agent");
            xb_add(&bar[XB_XGEN(bx)], 1u);
            asm volatile("s_waitcnt vmcnt(0)" ::: "memory");
        } else {
            XB_SPIN(xb_ld(&bar[XB_XGEN(bx)]) == gen, bar);
            __builtin_amdgcn_fence(__ATOMIC_ACQUIRE, "agent");
            asm volatile("s_waitcnt vmcnt(0)" ::: "memory");
        }
    }
    __syncthreads();
}

__device__ __forceinline__ void load_prefix(const Params& p, int l, LAS int* pre, LAS int* cntl, const Ctx& cx) {
    const int* gcnt = s_cnt(p.ws, cx, l);
    if (threadIdx.x == 0) { int a = 0; for (int e = 0; e < NEXP; ++e) { const int c = gcnt[e]; cntl[e] = c; pre[e] = a; a += (c + 255) >> 8; } pre[NEXP] = a; }
    __syncthreads();
}

__global__ void __launch_bounds__(NTHREADS, 2) fwd_kernel(Params p) {
    extern __shared__ __attribute__((aligned(16))) unsigned char lds_raw[];
    LAS unsigned char* lds = (LAS unsigned char*)lds_raw;
    const int G = gridDim.x;
    unsigned char* ws = p.ws;
    volatile LAS unsigned* bst = (volatile LAS unsigned*)(lds + LDS_BYTES - 16);
    if (threadIdx.x < 4) bst[threadIdx.x] = 0u;
    __syncthreads();
    const XcdBarrier bar_all = xcd_barrier_post((unsigned*)(ws + WS_CTL) + 4096, bst, (unsigned)G);
    Ctx cx; cx.s = ((int)blockIdx.x >> 3) & 1; cx.lb = ((int)blockIdx.x & 7) | (((int)blockIdx.x >> 4) << 3); cx.GS = G >> 1; cx.tok0 = cx.s * STOK;
    const int vcu = (cx.lb & 7) * (cx.GS >> 3) + (cx.lb >> 3);
    const XcdBarrier bar = xcd_barrier_post((unsigned*)(ws + WS_CTL) + 8192 + cx.s * XCD_BAR_WORDS, bst + 2, (unsigned)cx.GS);
#define SYNC() xcd_barrier(bar)
    phase_prologue(p, lds);
    xcd_barrier(bar_all);
    unsigned* convdone = (unsigned*)(ws + WS_CTL) + 128;
    if (cx.s == 1) {
        const int tid_ = opaque_tid();
        t_run<true>(p, cx.lb * NWAVES + (tid_ >> 6), cx.GS * NWAVES, CONV_S1, (LAS float*)(lds + (tid_ >> 6) * 16640), tid_ & 63);
        conv_publish(convdone);
    }
#pragma unroll 1
    for (int l = 0; l < DEPTH; ++l) {
        phase_norm1(p, l, cx);
        SYNC();
        {
            {
                DenseGemm g{(const bf16_t*)(ws + WS_BUF), (const bf16_t*)(ws + WS_WIN) + (size_t)l * 2048 * 1024, 1024};
                pg8::OffsetOrder S; S.init(STOK, 1536, cx.GS, cx.lb, cx.tok0 / 256, 0);
                EpiIn E{s_U(ws, cx), s_Q(ws, cx), s_K(ws, cx), p.in[9] + l * 64, p.in[10] + l * 64};
                pg8::gemm_phase(lds, g, S, E);
            }
            {
                DenseGemm g{(const bf16_t*)(ws + WS_WIN) + (size_t)l * 2048 * 1024 + (size_t)1536 * 1024, (const bf16_t*)(ws + WS_BUF), 1024};
                pg8::OffsetOrder S; S.init(512, STOK, cx.GS, cx.lb, 0, cx.tok0 / 256);
                EpiVt E{s_V(ws, cx)};
                pg8::gemm_phase(lds, g, S, E);
            }
        }
        SYNC();
        phase_mixer(p, l, lds, cx);
        SYNC();
        {
            DenseGemm g{(const bf16_t*)(ws + WS_BUF), (const bf16_t*)(ws + WS_WOUT) + (size_t)l * 1024 * 1024, 1024};
            pg8::OffsetOrder S; S.init(STOK, 1024, cx.GS, cx.lb, cx.tok0 / 256, 0);
            const float* g1p = (const float*)(ws + WS_MOD) + (size_t)(l * 4) * 6144 + 2048;
            if (l == 0) { EpiOutB<true> E{p.in[0], (bf16_t*)(ws + WS_XB), g1p, (float*)(ws + WS_SSQ)}; pg8::gemm_phase(lds, g, S, E); }
            else { EpiOutB<false> E{nullptr, (bf16_t*)(ws + WS_XB), g1p, (float*)(ws + WS_SSQ)}; pg8::gemm_phase(lds, g, S, E); }
        }
        SYNC();
        phase_route(p, l, lds, cx);
        SYNC();
        {
            if (l == 1) {
                if (threadIdx.x == 0) { unsigned sp = 0;
                    while (__hip_atomic_load(convdone, __ATOMIC_RELAXED, __HIP_MEMORY_SCOPE_AGENT) < 3u * (unsigned)cx.GS) { __builtin_amdgcn_s_sleep(8); if (++sp > (1u << 22)) break; }
                    __builtin_amdgcn_fence(__ATOMIC_ACQUIRE, "agent"); asm volatile("s_waitcnt vmcnt(0)" ::: "memory"); }
                __syncthreads();
            }
            LAS int* pre = (LAS int*)(lds + pg8::STAGE_BYTES); LAS int* cntl = pre + 64;
            load_prefix(p, l, pre, cntl, cx);
            GatherGemm g{(const bf16_t*)(ws + WS_BUF), (const bf16_t*)(ws + WS_WGU) + (size_t)l * NEXP * 1024 * 1024, s_list(ws, cx), 1024, 1, (size_t)1024 * 1024 * 2};
            pg8::GroupedOrder S{pre, cntl, cx.GS, vcu};
            EpiGU E{(bf16_t*)(ws + WS_ACT), s_list(ws, cx)};
            const int total_units = pre[NEXP] * 4;
            pg8::gemm_phase(lds, g, S, E);
            if (l == 0 && cx.s == 0) tail_convert(p, lds, total_units, vcu, cx.GS, CONV_S1, CONV_T1, convdone);
        }
        SYNC();
        {
            LAS int* pre = (LAS int*)(lds + pg8::STAGE_BYTES); LAS int* cntl = pre + 64;
            load_prefix(p, l, pre, cntl, cx);
            GatherGemm g{(const bf16_t*)(ws + WS_ACT), (const bf16_t*)(ws + WS_WD) + (size_t)l * NEXP * 1024 * 512, s_list(ws, cx), 512, 0, (size_t)1024 * 512 * 2};
            pg8::GroupedOrder S{pre, cntl, cx.GS, vcu};
            EpiDn E{(bf16_t*)(ws + WS_Y), s_list(ws, cx), (const float*)(ws + WS_EW)};
            const int total_units = pre[NEXP] * 4;
            pg8::gemm_phase(lds, g, S, E);
            if (l == 0 && cx.s == 0) tail_convert(p, lds, total_units, vcu, cx.GS, CONV_S1 + CONV_T1, T_NB - CONV_S1 - CONV_T1, convdone);
        }
        SYNC();
    }
    phase_final(p, cx);
#undef SYNC
}

extern "C" void kernel_launch(void* const* d_in, const int* in_sizes, int n_in, void* d_out, int out_size, void* d_ws, size_t ws_size, hipStream_t stream) {
    static int grid = 0;
    if (grid == 0) {
        if (n_in != 20 || out_size != NTOK * DM || ws_size < WS_END) { fprintf(stderr, "kernel_launch: unexpected shapes (n_in %d out %d ws %zu)\n", n_in, out_size, ws_size); grid = -1; return; }
        int dev = 0, cus = 0, per_cu = 0;
        hipGetDevice(&dev);
        hipDeviceGetAttribute(&cus, hipDeviceAttributeMultiprocessorCount, dev);
        hipFuncSetAttribute((const void*)fwd_kernel, hipFuncAttributeMaxDynamicSharedMemorySize, LDS_BYTES);
        hipOccupancyMaxActiveBlocksPerMultiprocessor(&per_cu, (const void*)fwd_kernel, NTHREADS, LDS_BYTES);
        if (per_cu < 1) per_cu = 1;
        if (per_cu > 1) per_cu = 1;
        grid = (cus * per_cu) & ~15;
        (void)hipGetLastError();
    }
    if (grid < 0) return;
    if (hipMemsetAsync((char*)d_ws + WS_CTL, 0, 65536, stream) != hipSuccess) { fprintf(stderr, "memset failed\n"); return; }
    Params p{};
    for (int i = 0; i < 20; ++i) p.in[i] = (const float*)d_in[i];
    p.out = (float*)d_out; p.ws = (unsigned char*)d_ws; p.ph_lo = 0; p.ph_hi = 16;
    void* args[] = {&p};
    hipError_t e = hipLaunchCooperativeKernel((const void*)fwd_kernel, dim3(grid), dim3(NTHREADS), args, LDS_BYTES, stream);
    if (e != hipSuccess) fprintf(stderr, "cooperative launch failed: %s (grid %d)\n", hipGetErrorString(e), grid);
}
```

```cpp
#include <hip/hip_runtime.h>
#include <hip/hip_cooperative_groups.h>
#include <cstdio>
#include <cstdint>
namespace cg = cooperative_groups;

#define LAS __attribute__((address_space(3)))
typedef unsigned short bf16_t;
typedef short bf16x8 __attribute__((ext_vector_type(8)));
typedef float f32x4 __attribute__((ext_vector_type(4)));
typedef float f32x16 __attribute__((ext_vector_type(16)));
typedef unsigned u32x4 __attribute__((ext_vector_type(4)));
typedef unsigned u32x2 __attribute__((ext_vector_type(2)));
typedef float f32x2_t __attribute__((ext_vector_type(2)));
typedef __bf16 bf16x2_t __attribute__((ext_vector_type(2)));

constexpr int BATCH = 4, SEQ = 8192, DM = 1024, NTOK = BATCH * SEQ, DEPTH = 2;
constexpr int NHEAD = 8, HD = 64, NEXP = 32, DEXP = 512;
constexpr float EPS = 1e-6f;
constexpr float LOG2E = 1.4426950408889634f;

constexpr size_t MiB = 1u << 20;
constexpr size_t WS_CTL = 0;
constexpr size_t WS_MOD = 1 * MiB;
constexpr size_t WS_TBL = 1 * MiB + 512 * 1024;
constexpr size_t WS_RW = 2 * MiB;
constexpr size_t WS_RWB = 2 * MiB + 512 * 1024;
constexpr size_t WS_LIST = 3 * MiB;
constexpr size_t WS_EW = 7 * MiB;
constexpr size_t WS_WIN = 8 * MiB;
constexpr size_t WS_WOUT = 16 * MiB;
constexpr size_t WS_WGU = 20 * MiB;
constexpr size_t WS_WD = 148 * MiB;
constexpr size_t WS_BUF = 212 * MiB;
constexpr size_t WS_U = 276 * MiB;
constexpr size_t WS_Q = 308 * MiB;
constexpr size_t WS_K = 340 * MiB;
constexpr size_t WS_V = 372 * MiB;
constexpr size_t WS_Y = 276 * MiB;
constexpr size_t WS_ACT = 404 * MiB;
constexpr size_t WS_SSQ = 468 * MiB;
constexpr size_t WS_XB = 470 * MiB;
constexpr size_t WS_END = 534 * MiB;

constexpr int LDS_BYTES = 147456;
constexpr int NWAVES = 8, NTHREADS = 512;

struct Params {
    const float* in[20];
    float* out;
    unsigned char* ws;
    int ph_lo, ph_hi;
};

__device__ __forceinline__ unsigned cvtpk(float lo, float hi) { f32x2_t v = {lo, hi}; bf16x2_t b = __builtin_convertvector(v, bf16x2_t); return __builtin_bit_cast(unsigned, b); }
__device__ __forceinline__ float bf_lo(unsigned w) { return __uint_as_float(w << 16); }
__device__ __forceinline__ float bf_hi(unsigned w) { return __uint_as_float(w & 0xffff0000u); }
__device__ __forceinline__ float fast_exp2(float x) { return __builtin_amdgcn_exp2f(x); }
__device__ __forceinline__ float fast_rcp(float x) { return __builtin_amdgcn_rcpf(x); }

__device__ __forceinline__ int opaque_tid() { int t = threadIdx.x; asm volatile("" : "+v"(t)); return t; }
__device__ __forceinline__ int opaque_bid() { int t = blockIdx.x; asm volatile("" : "+s"(t)); return t; }

namespace pg8 {
constexpr int BM = 256, BK = 64, HALF = 128, HTB = HALF * BK * 2, STAGE_BYTES = 8 * HTB, NXCD = 8, WGM = 8;
__host__ __device__ __forceinline__ int lds_byte(int r, int c) { const int st = (r >> 4) * 2 + (c >> 5), rr = r & 15, cc = c & 31, ob = rr * 64 + cc * 2; return st * 1024 + (ob ^ (((ob >> 9) & 1) << 5)); }
__host__ __device__ __forceinline__ void stage_rc(int b, int& R, int& C) { const int st = b / 1024, sb = b % 1024, swz = sb ^ (((sb >> 9) & 1) << 5); R = (st >> 1) * 16 + swz / 64; C = (st & 1) * 32 + (swz % 64) / 2; }
__host__ __device__ __forceinline__ int perm32(int rho) { const int n = rho >> 4, i = rho & 15; return 8 * (i >> 2) + 4 * n + (i & 3); }

struct Unit { int pm, pn, e, rows; };

struct StaticOrder {
    int nM, nN, nwg, G, c;
    __device__ void init(int M, int N, int G_, int c_) { nM = M / BM; nN = N / BM; nwg = nM * nN; G = G_; c = c_; }
    __device__ bool next(int i, Unit& u) const {
        const long L = (long)i * G + c; if (L >= nwg) return false;
        int wgid = (int)L; { const int q = nwg / NXCD, r = nwg % NXCD, xcd = wgid % NXCD, off = wgid / NXCD; wgid = (xcd < r ? xcd * (q + 1) : r * (q + 1) + (xcd - r) * q) + off; }
        const int nig = WGM * nN, gid = wgid / nig, fm = gid * WGM, gsz = (nM - fm) < WGM ? (nM - fm) : WGM;
        u.pm = fm + ((wgid % nig) % gsz); u.pn = (wgid % nig) / gsz; u.e = 0; u.rows = BM; return true;
    }
};

struct GroupedOrder {
    const LAS int* prefix; const LAS int* cnt; int G, v;
    __device__ bool next(int i, Unit& u) const {
        const int L = i * G + v; const int total = prefix[NEXP];
        if (L >= total * 4) return false;
        const int rt = L >> 2; int e = 0;
#pragma unroll 1
        for (int j = 1; j < NEXP; ++j) if (prefix[j] <= rt) e = j;
        u.e = e; u.pm = rt - prefix[e]; u.pn = L & 3; const int rem = cnt[e] - u.pm * BM; u.rows = rem < BM ? rem : BM; return true;
    }
};

template <class G, class Epi, class Sched>
__device__ __forceinline__ void gemm_phase(LAS unsigned char* lds, const G g, const Sched& S, const Epi& E) {
    int tid = threadIdx.x; asm volatile("" : "+v"(tid));
    const int wid = __builtin_amdgcn_readfirstlane(tid >> 6), lane = tid & 63, wr = wid >> 2, wc = wid & 3, fr = lane & 15, fq = lane >> 4;
    const int K = g.K, nt = K / BK;
    int RA[2], CA[2]; unsigned voffB[2];
#pragma unroll
    for (int i = 0; i < 2; ++i) { int R, C; stage_rc(tid * 16 + i * 8192, R, C); const int Rb = Epi::PERM ? ((R & ~31) + perm32(R & 31)) : R;
        RA[i] = R; CA[i] = C; voffB[i] = (unsigned)(Rb * K + C) * 2u; }
    const size_t kstep = (size_t)(BK * 2);
    const size_t hstep = (size_t)HALF * K * 2;
    const unsigned ldsw = (unsigned)wid * 1024u;
    const int aoff = lds_byte(wr * 64 + fr, fq * 8), boff = lds_byte(wc * 32 + fr, fq * 8);
#define PG8_SA(b, h) (((b) * 2 + (h)) * HTB)
#define PG8_SB(b, h) ((4 + (b) * 2 + (h)) * HTB)
#define PG8_STAGE2(bufoff, gbase, o0, o1) do { \
        __builtin_amdgcn_global_load_lds((const unsigned*)((const char*)(gbase) + (o0)), (LAS unsigned*)(lds + (bufoff) + ldsw), 16, 0, 0); \
        __builtin_amdgcn_global_load_lds((const unsigned*)((const char*)(gbase) + (o1)), (LAS unsigned*)(lds + (bufoff) + ldsw + 8192), 16, 0, 0); } while (0)
#define PG8_STAGEB(bufoff, gbase) PG8_STAGE2(bufoff, gbase, voffB[0], voffB[1])
#define PG8_LDA(dst, b, h) do { _Pragma("unroll") for (int m = 0; m < 4; ++m) _Pragma("unroll") for (int k = 0; k < 2; ++k) dst[m][k] = *(const LAS bf16x8*)(lds + PG8_SA(b, h) + aoff + m * 2048 + k * 1024); } while (0)
#define PG8_LDB(dst, b, h) do { _Pragma("unroll") for (int n = 0; n < 2; ++n) _Pragma("unroll") for (int k = 0; k < 2; ++k) dst[n][k] = *(const LAS bf16x8*)(lds + PG8_SB(b, h) + boff + n * 2048 + k * 1024); } while (0)
#define PG8_MMA(ai, bj, At, Bt) do { __builtin_amdgcn_s_setprio(1); _Pragma("unroll") for (int m = 0; m < 4; ++m) _Pragma("unroll") for (int n = 0; n < 2; ++n) _Pragma("unroll") for (int k = 0; k < 2; ++k) \
        acc[ai][bj][m][n] = __builtin_amdgcn_mfma_f32_16x16x32_bf16(Bt[n][k], At[m][k], acc[ai][bj][m][n], 0, 0, 0); __builtin_amdgcn_s_setprio(0); } while (0)
#define PG8_WAIT_V(n) asm volatile("s_waitcnt vmcnt(" #n ")" ::: "memory")
#define PG8_WAIT_L(n) asm volatile("s_waitcnt lgkmcnt(" #n ")" ::: "memory")
#define PG8_BAR __builtin_amdgcn_s_barrier()
#define PG8_SCHED __builtin_amdgcn_sched_barrier(0)
    Unit cur, nxt; int ui = 0;
    if (!S.next(0, cur)) return;
    f32x4 acc[2][2][4][2];
#pragma unroll
    for (int a = 0; a < 2; ++a)
#pragma unroll
        for (int b = 0; b < 2; ++b)
#pragma unroll
            for (int m = 0; m < 4; ++m)
#pragma unroll
                for (int n = 0; n < 2; ++n) acc[a][b][m][n] = (f32x4){0.f, 0.f, 0.f, 0.f};
    bf16x8 At[4][2], B0[2][2], B1[2][2];
    const char* cA = g.a_base(cur); const char* cB = g.b_base(cur);
    unsigned c00 = g.a_off(cur, RA[0], CA[0]), c01 = g.a_off(cur, RA[1], CA[1]), c10 = g.a_off(cur, HALF + RA[0], CA[0]), c11 = g.a_off(cur, HALF + RA[1], CA[1]);
    PG8_STAGEB(PG8_SB(0, 0), cB); PG8_STAGEB(PG8_SB(0, 1), cB + hstep); PG8_STAGE2(PG8_SA(0, 0), cA, c00, c01); PG8_STAGE2(PG8_SA(0, 1), cA, c10, c11);
    if (wr == 1) PG8_BAR;
    PG8_WAIT_V(2); PG8_BAR;
    PG8_STAGEB(PG8_SB(1, 0), cB + kstep); PG8_STAGE2(PG8_SA(1, 0), cA + kstep, c00, c01); PG8_STAGEB(PG8_SB(1, 1), cB + hstep + kstep);
    PG8_WAIT_V(6); PG8_BAR;
    for (;;) {
        const bool has_next = S.next(ui + 1, nxt);
        const char* nA = has_next ? g.a_base(nxt) : cA; const char* nB = has_next ? g.b_base(nxt) : cB;
        unsigned n00 = c00, n01 = c01, n10 = c10, n11 = c11;
        if (G::GATHER && has_next) { n00 = g.a_off(nxt, RA[0], CA[0]); n01 = g.a_off(nxt, RA[1], CA[1]); n10 = g.a_off(nxt, HALF + RA[0], CA[0]); n11 = g.a_off(nxt, HALF + RA[1], CA[1]); }
        for (int t = 0; t < nt; t += 2) {
            const bool last = (t == nt - 2);
            const char* a1 = cA + (size_t)(t + 1) * kstep;
            const char* a2 = last ? nA : cA + (size_t)(t + 2) * kstep; const char* b2 = last ? nB : cB + (size_t)(t + 2) * kstep;
            const char* a3 = a2 + kstep; const char* b3 = b2 + kstep;
            const unsigned x00 = last ? n00 : c00, x01 = last ? n01 : c01, x10 = last ? n10 : c10, x11 = last ? n11 : c11;
            PG8_LDB(B0, 0, 0); PG8_LDB(B1, 0, 1); PG8_SCHED; PG8_LDA(At, 0, 0); PG8_STAGE2(PG8_SA(1, 1), a1, c10, c11);
            PG8_WAIT_V(8); PG8_WAIT_L(0); PG8_BAR; PG8_MMA(0, 0, At, B0); PG8_MMA(0, 1, At, B1); PG8_BAR; PG8_SCHED;
            PG8_LDA(At, 0, 1); PG8_STAGEB(PG8_SB(0, 0), b2); PG8_STAGEB(PG8_SB(0, 1), b2 + hstep); PG8_STAGE2(PG8_SA(0, 0), a2, x00, x01);
            PG8_WAIT_V(8); PG8_WAIT_L(0); PG8_BAR; PG8_MMA(1, 0, At, B0); PG8_MMA(1, 1, At, B1); PG8_BAR; PG8_SCHED;
            PG8_LDB(B0, 1, 0); PG8_LDB(B1, 1, 1); PG8_SCHED; PG8_LDA(At, 1, 0); PG8_STAGE2(PG8_SA(0, 1), a2, x10, x11);
            PG8_WAIT_V(8); PG8_WAIT_L(0); PG8_BAR; PG8_MMA(0, 0, At, B0); PG8_MMA(0, 1, At, B1); PG8_BAR; PG8_SCHED;
            PG8_LDA(At, 1, 1); PG8_STAGEB(PG8_SB(1, 0), b3); PG8_STAGEB(PG8_SB(1, 1), b3 + hstep); PG8_STAGE2(PG8_SA(1, 0), a3, x00, x01);
            PG8_WAIT_V(8); PG8_WAIT_L(0); PG8_BAR; PG8_MMA(1, 0, At, B0); PG8_MMA(1, 1, At, B1); PG8_BAR; PG8_SCHED;
        }
        if (wr == 0) PG8_BAR;
        E(acc, cur, wr, wc, fr, fq);
        if (!has_next) break;
#pragma unroll
        for (int a = 0; a < 2; ++a)
#pragma unroll
            for (int b = 0; b < 2; ++b)
#pragma unroll
                for (int m = 0; m < 4; ++m)
#pragma unroll
                    for (int n = 0; n < 2; ++n) acc[a][b][m][n] = (f32x4){0.f, 0.f, 0.f, 0.f};
        cur = nxt; cA = nA; cB = nB; c00 = n00; c01 = n01; c10 = n10; c11 = n11; ++ui;
        if (wr == 1) PG8_BAR;
    }
    PG8_WAIT_V(0);
    PG8_BAR;
#undef PG8_SA
#undef PG8_SB
#undef PG8_STAGE2
#undef PG8_STAGEB
#undef PG8_LDA
#undef PG8_LDB
#undef PG8_MMA
#undef PG8_WAIT_V
#undef PG8_WAIT_L
#undef PG8_BAR
#undef PG8_SCHED
}
}
using pg8::Unit;

struct DenseGemm {
    static constexpr bool GATHER = false;
    const bf16_t* A; const bf16_t* Bt; int K;
    __device__ __forceinline__ const char* a_base(const Unit& u) const { return (const char*)A + (size_t)u.pm * 256 * K * 2; }
    __device__ __forceinline__ const char* b_base(const Unit& u) const { return (const char*)Bt + (size_t)u.pn * 256 * K * 2; }
    __device__ __forceinline__ unsigned a_off(const Unit&, int r, int c) const { return (unsigned)(r * K + c) * 2u; }
};
struct GatherGemm {
    static constexpr bool GATHER = true;
    const bf16_t* A; const bf16_t* Bt; const int* list; int K; int a_shift;
    size_t b_expert_stride;
    __device__ __forceinline__ const char* a_base(const Unit&) const { return (const char*)A; }
    __device__ __forceinline__ const char* b_base(const Unit& u) const { return (const char*)Bt + (size_t)u.e * b_expert_stride + (size_t)u.pn * 256 * K * 2; }
    __device__ __forceinline__ unsigned a_off(const Unit& u, int r, int c) const {
        const int rr = r < u.rows ? r : u.rows - 1;
        const int slot = list[(size_t)u.e * NTOK + u.pm * 256 + rr];
        return (unsigned)((slot >> a_shift) * K + c) * 2u;
    }
};


struct EpiIn {
    static constexpr bool PERM = true;
    bf16_t* U; bf16_t* Qf; bf16_t* Kf; const float* qg; const float* kg;
    __device__ __forceinline__ void operator()(const f32x4 (&acc)[2][2][4][2], const Unit& u, int wr, int wc, int fr, int fq) const {
        if (u.pn < 2) {
#pragma unroll
            for (int ai = 0; ai < 2; ++ai)
#pragma unroll
                for (int m = 0; m < 4; ++m) {
                    const int row = u.pm * 256 + ai * 128 + wr * 64 + m * 16 + fr;
#pragma unroll
                    for (int bj = 0; bj < 2; ++bj) {
                        const f32x4 v0 = acc[ai][bj][m][0], v1 = acc[ai][bj][m][1];
                        u32x4 w; w.x = cvtpk(v0[0], v0[1]); w.y = cvtpk(v0[2], v0[3]); w.z = cvtpk(v1[0], v1[1]); w.w = cvtpk(v1[2], v1[3]);
                        *(u32x4*)(U + (size_t)row * 512 + u.pn * 256 + bj * 128 + wc * 32 + fq * 8) = w;
                    }
                }
        } else {
            const bool isq = u.pn < 4;
            const float* gg = isq ? qg : kg; bf16_t* dst = isq ? Qf : Kf;
            const float osc = isq ? 0.125f * LOG2E : 1.0f;
            const int head = (u.pn & 1) * 4 + wc;
            f32x4 gv[2][2];
#pragma unroll
            for (int bj = 0; bj < 2; ++bj)
#pragma unroll
                for (int n = 0; n < 2; ++n) gv[bj][n] = *(const f32x4*)(gg + bj * 32 + fq * 8 + n * 4) * osc;
#pragma unroll
            for (int ai = 0; ai < 2; ++ai)
#pragma unroll
                for (int m = 0; m < 4; ++m) {
                    float ss = 0.f;
#pragma unroll
                    for (int bj = 0; bj < 2; ++bj)
#pragma unroll
                        for (int n = 0; n < 2; ++n) { const f32x4 v = acc[ai][bj][m][n]; ss += (v[0] * v[0] + v[1] * v[1]) + (v[2] * v[2] + v[3] * v[3]); }
                    ss += __shfl_xor(ss, 16); ss += __shfl_xor(ss, 32);
                    const float rstd = rsqrtf(ss * (1.0f / 64.0f) + EPS);
                    const int row = u.pm * 256 + ai * 128 + wr * 64 + m * 16 + fr;
                    const int b = row >> 13, s = row & (SEQ - 1), rb = s >> 5, r32 = s & 31;
#pragma unroll
                    for (int bj = 0; bj < 2; ++bj) {
                        const f32x4 v0 = acc[ai][bj][m][0] * rstd * gv[bj][0], v1 = acc[ai][bj][m][1] * rstd * gv[bj][1];
                        u32x4 w; w.x = cvtpk(v0[0], v0[1]); w.y = cvtpk(v0[2], v0[3]); w.z = cvtpk(v1[0], v1[1]); w.w = cvtpk(v1[2], v1[3]);
                        const int d0 = 2 * bj + (fq >> 1), hi = fq & 1;
                        const size_t piece = (((size_t)(b * NHEAD + head) * 256 + rb) * 4 + d0);
                        *(u32x4*)(dst + (piece * 64 + hi * 32 + r32) * 8) = w;
                    }
                }
        }
    }
};

struct EpiVt {
    static constexpr bool PERM = true;
    bf16_t* Vf;
    __device__ __forceinline__ void operator()(const f32x4 (&acc)[2][2][4][2], const Unit& u, int wr, int wc, int fr, int fq) const {
#pragma unroll
        for (int ai = 0; ai < 2; ++ai)
#pragma unroll
            for (int m = 0; m < 4; ++m) {
                const int hd = u.pm * 256 + ai * 128 + wr * 64 + m * 16 + fr;
                const int head = hd >> 6, dblk = (hd >> 5) & 1, dl = hd & 31;
#pragma unroll
                for (int bj = 0; bj < 2; ++bj) {
                    const int tok0 = u.pn * 256 + bj * 128 + wc * 32;
                    const int b = tok0 >> 13, kb = (tok0 & (SEQ - 1)) >> 5;
                    const size_t piece = ((((size_t)(b * NHEAD + head) * 256 + kb) * 2 + (fq >> 1)) * 2 + dblk);
#pragma unroll
                    for (int n = 0; n < 2; ++n) {
                        const f32x4 v = acc[ai][bj][m][n];
                        u32x2 w; w.x = cvtpk(v[0], v[1]); w.y = cvtpk(v[2], v[3]);
                        *(u32x2*)((char*)Vf + (piece * 64 + n * 32 + dl) * 16 + (fq & 1) * 8) = w;
                    }
                }
            }
    }
};

template <bool XF>
struct EpiOutB {
    static constexpr bool PERM = true;
    const float* xf; bf16_t* XB; const float* g1; float* ssq;
    __device__ __forceinline__ void operator()(const f32x4 (&acc)[2][2][4][2], const Unit& u, int wr, int wc, int fr, int fq) const {
        const int b = (u.pm * 256) >> 13;
        const int col0 = u.pn * 256 + wc * 32 + 8 * fq;
        f32x4 gv[2][2];
#pragma unroll
        for (int bj = 0; bj < 2; ++bj)
#pragma unroll
            for (int n = 0; n < 2; ++n) gv[bj][n] = *(const f32x4*)(g1 + (size_t)b * 6144 + col0 + bj * 128 + n * 4);
#pragma unroll
        for (int ai = 0; ai < 2; ++ai)
#pragma unroll
            for (int m = 0; m < 4; ++m) {
                const int row = u.pm * 256 + ai * 128 + wr * 64 + m * 16 + fr;
                const size_t off = (size_t)row * DM + col0;
                f32x4 xb[2][2];
                if (XF) {
#pragma unroll
                    for (int bj = 0; bj < 2; ++bj) { xb[bj][0] = *(const f32x4*)(xf + off + bj * 128); xb[bj][1] = *(const f32x4*)(xf + off + bj * 128 + 4); }
                } else {
#pragma unroll
                    for (int bj = 0; bj < 2; ++bj) { const u32x4 w = *(const u32x4*)(XB + off + bj * 128);
                        xb[bj][0] = (f32x4){bf_lo(w.x), bf_hi(w.x), bf_lo(w.y), bf_hi(w.y)}; xb[bj][1] = (f32x4){bf_lo(w.z), bf_hi(w.z), bf_lo(w.w), bf_hi(w.w)}; }
                }
                float ss = 0.f;
#pragma unroll
                for (int bj = 0; bj < 2; ++bj) {
                    const f32x4 x0 = xb[bj][0] + gv[bj][0] * acc[ai][bj][m][0], x1 = xb[bj][1] + gv[bj][1] * acc[ai][bj][m][1];
                    u32x4 w; w.x = cvtpk(x0[0], x0[1]); w.y = cvtpk(x0[2], x0[3]); w.z = cvtpk(x1[0], x1[1]); w.w = cvtpk(x1[2], x1[3]);
                    *(u32x4*)(XB + off + bj * 128) = w;
                    const float r0 = bf_lo(w.x), r1 = bf_hi(w.x), r2 = bf_lo(w.y), r3 = bf_hi(w.y), r4 = bf_lo(w.z), r5 = bf_hi(w.z), r6 = bf_lo(w.w), r7 = bf_hi(w.w);
                    ss += ((r0 * r0 + r1 * r1) + (r2 * r2 + r3 * r3)) + ((r4 * r4 + r5 * r5) + (r6 * r6 + r7 * r7));
                }
                ss += __shfl_xor(ss, 16); ss += __shfl_xor(ss, 32);
                if (fq == 0) ssq[(size_t)row * 16 + u.pn * 4 + wc] = ss;
            }
    }
};

struct EpiGU {
    static constexpr bool PERM = true;
    bf16_t* ACT; const int* list;
    __device__ __forceinline__ void operator()(const f32x4 (&acc)[2][2][4][2], const Unit& u, int wr, int wc, int fr, int fq) const {
#pragma unroll
        for (int ai = 0; ai < 2; ++ai)
#pragma unroll
            for (int m = 0; m < 4; ++m) {
                const int r = ai * 128 + wr * 64 + m * 16 + fr;
                if (r < u.rows) {
                    const int slot = list[(size_t)u.e * NTOK + u.pm * 256 + r];
                    float o[8];
#pragma unroll
                    for (int n = 0; n < 2; ++n)
#pragma unroll
                        for (int e = 0; e < 4; ++e) { const float gte = acc[ai][0][m][n][e], up = acc[ai][1][m][n][e];
                            o[n * 4 + e] = gte * fast_rcp(1.0f + fast_exp2(-gte * LOG2E)) * up; }
                    u32x4 w; w.x = cvtpk(o[0], o[1]); w.y = cvtpk(o[2], o[3]); w.z = cvtpk(o[4], o[5]); w.w = cvtpk(o[6], o[7]);
                    *(u32x4*)(ACT + (size_t)slot * DEXP + u.pn * 128 + wc * 32 + fq * 8) = w;
                }
            }
    }
};

struct EpiDn {
    static constexpr bool PERM = true;
    unsigned char* Y8; const int* list; const float* ew;
    __device__ __forceinline__ void operator()(const f32x4 (&acc)[2][2][4][2], const Unit& u, int wr, int wc, int fr, int fq) const {
#pragma unroll
        for (int ai = 0; ai < 2; ++ai)
#pragma unroll
            for (int m = 0; m < 4; ++m) {
                const int r = ai * 128 + wr * 64 + m * 16 + fr;
                if (r < u.rows) {
                    const int slot = list[(size_t)u.e * NTOK + u.pm * 256 + r];
                    const float w8 = ew[slot] * 16.0f;
#pragma unroll
                    for (int bj = 0; bj < 2; ++bj) {
                        const f32x4 v0 = acc[ai][bj][m][0] * w8, v1 = acc[ai][bj][m][1] * w8;
                        int lo = 0, hi = 0;
                        lo = __builtin_amdgcn_cvt_pk_fp8_f32(v0[0], v0[1], lo, false); lo = __builtin_amdgcn_cvt_pk_fp8_f32(v0[2], v0[3], lo, true);
                        hi = __builtin_amdgcn_cvt_pk_fp8_f32(v1[0], v1[1], hi, false); hi = __builtin_amdgcn_cvt_pk_fp8_f32(v1[2], v1[3], hi, true);
                        u32x2 w; w.x = (unsigned)lo; w.y = (unsigned)hi;
                        *(u32x2*)(Y8 + (size_t)slot * DM + u.pn * 256 + bj * 128 + wc * 32 + fq * 8) = w;
                    }
                }
            }
    }
};

struct TItem { const float* src; bf16_t* dst; int N, dstK, koff, k0, n0, map; };
__device__ __forceinline__ int t_rowmap(int map, int n) {
    if (map == 0) return n;
    if (map == 1) { if (n < 512 || n >= 1536) return n; const int t = n & 255, wc = t >> 6, bj = (t >> 5) & 1, c = t & 31; return (n & ~255) + 128 * bj + 32 * wc + c; }
    return 256 * (n >> 7) + 128 * (map - 2) + (n & 127);
}
__device__ __forceinline__ void t_load(const TItem& d, f32x4 (&v)[16], int lane) {
    const int kr = lane >> 4, c4 = lane & 15;
#pragma unroll
    for (int i = 0; i < 16; ++i) v[i] = *(const f32x4*)(d.src + (size_t)(d.k0 + 4 * i + kr) * d.N + d.n0 + 4 * c4);
}
__device__ __forceinline__ void t_process(const TItem& d, const f32x4 (&v)[16], LAS float* scr, int lane) {
    const int kr = lane >> 4, c4 = lane & 15;
#pragma unroll
    for (int i = 0; i < 16; ++i) { LAS float* s = scr + (4 * i + kr) * 65 + 4 * c4; s[0] = v[i][0]; s[1] = v[i][1]; s[2] = v[i][2]; s[3] = v[i][3]; }
    asm volatile("s_waitcnt lgkmcnt(0)" ::: "memory");
    const int nr = lane >> 3, kc = lane & 7;
#pragma unroll
    for (int i = 0; i < 8; ++i) { const int n = 8 * i + nr; const LAS float* s = scr + (8 * kc) * 65 + n;
        u32x4 o; o.x = cvtpk(s[0], s[65]); o.y = cvtpk(s[2 * 65], s[3 * 65]); o.z = cvtpk(s[4 * 65], s[5 * 65]); o.w = cvtpk(s[6 * 65], s[7 * 65]);
        *(u32x4*)(d.dst + (size_t)t_rowmap(d.map, d.n0 + n) * d.dstK + d.koff + d.k0 + 8 * kc) = o; }
    asm volatile("s_waitcnt lgkmcnt(0)" ::: "memory");
}
constexpr int T_IN = 512, T_OUT = 128, T_E = 128, T_MOE = NEXP * 3 * T_E, T_PER_LAYER = T_IN + T_OUT + T_MOE;
constexpr int T_NA = T_PER_LAYER + T_IN + T_OUT, T_NB = T_MOE;
__device__ __forceinline__ void t_decode_lr(const Params& p, int l, int r, TItem& d) {
    unsigned char* ws = p.ws;
    if (r < T_IN) { d.src = p.in[6] + (size_t)l * 1024 * 2048; d.N = 2048; d.dst = (bf16_t*)(ws + WS_WIN) + (size_t)l * 2048 * 1024; d.dstK = 1024; d.koff = 0; d.k0 = (r >> 5) * 64; d.n0 = (r & 31) * 64; d.map = 1; return; }
    r -= T_IN;
    if (r < T_OUT) { d.src = p.in[12] + ((size_t)l * 1024 + 512) * 1024; d.N = 1024; d.dst = (bf16_t*)(ws + WS_WOUT) + (size_t)l * 1024 * 1024; d.dstK = 1024; d.koff = 512; d.k0 = (r >> 4) * 64; d.n0 = (r & 15) * 64; d.map = 0; return; }
    r -= T_OUT;
    const int e = r / (3 * T_E); int q = r % (3 * T_E);
    if (q < 2 * T_E) { const int up = q >= T_E; if (up) q -= T_E;
        d.src = p.in[up ? 18 : 17] + ((size_t)l * NEXP + e) * 1024 * 512; d.N = 512; d.dst = (bf16_t*)(ws + WS_WGU) + ((size_t)l * NEXP + e) * 1024 * 1024; d.dstK = 1024; d.koff = 0; d.k0 = (q >> 3) * 64; d.n0 = (q & 7) * 64; d.map = 2 + up; return; }
    q -= 2 * T_E;
    d.src = p.in[19] + ((size_t)l * NEXP + e) * 512 * 1024; d.N = 1024; d.dst = (bf16_t*)(ws + WS_WD) + ((size_t)l * NEXP + e) * 1024 * 512; d.dstK = 512; d.koff = 0; d.k0 = (q >> 4) * 64; d.n0 = (q & 15) * 64; d.map = 0;
}
template <bool SPACE_B>
__device__ __forceinline__ void t_decode(const Params& p, int it, TItem& d) {
    if (SPACE_B) t_decode_lr(p, 1, T_IN + T_OUT + it, d);
    else if (it < T_PER_LAYER) t_decode_lr(p, 0, it, d);
    else t_decode_lr(p, 1, it - T_PER_LAYER, d);
}
template <bool SPACE_B>
__device__ __forceinline__ void t_run(const Params& p, int it, int stride, int nit, LAS float* scr, int lane) {
    if (it >= nit) return;
    TItem dA, dB; f32x4 vA[16], vB[16];
    t_decode<SPACE_B>(p, it, dA); t_load(dA, vA, lane);
    for (;;) {
        int nx = it + stride; const bool hasB = nx < nit;
        if (hasB) { t_decode<SPACE_B>(p, nx, dB); t_load(dB, vB, lane); }
        t_process(dA, vA, scr, lane);
        if (!hasB) break;
        it = nx + stride; const bool hasA = it < nit;
        if (hasA) { t_decode<SPACE_B>(p, it, dA); t_load(dA, vA, lane); }
        t_process(dB, vB, scr, lane);
        if (!hasA) break;
    }
}
__device__ __forceinline__ void tail_convert(const Params& p, LAS unsigned char* lds, int total_units, int v, int first, int count) {
    const int tid = opaque_tid(), lane = tid & 63, wave = tid >> 6, G = gridDim.x;
    const int rem = total_units % G;
    const int nshare = rem ? G - rem : G, sidx = rem ? v - rem : v;
    __syncthreads();
    if (sidx >= 0) t_run<true>(p, first + sidx + nshare * wave, nshare * NWAVES, first + count, (LAS float*)(lds + wave * 16640), lane);
    __syncthreads();
}

__device__ __forceinline__ void phase_prologue(const Params& p, LAS unsigned char* lds) {
    const int tid = opaque_tid(), lane = tid & 63, wave = tid >> 6, G = gridDim.x;
    unsigned char* ws = p.ws;
    {
        LAS float* cact = (LAS float*)lds;
        LAS float* red = (LAS float*)(lds + 16384);
        const float* c = p.in[1];
        for (int i = tid; i < 4096; i += NTHREADS) { const float v = c[i]; cact[i] = v / (1.0f + __expf(-v)); }
        __syncthreads();
        float* mod = (float*)(ws + WS_MOD);
        for (int item = blockIdx.x; item < 2 * 192; item += G) {
            const int l = item / 192, cgp = item % 192;
            const float* W = p.in[2] + (size_t)l * 1024 * 6144 + cgp * 32;
            const int col = lane & 31, rsub = lane >> 5;
            float a0 = 0.f, a1 = 0.f, a2 = 0.f, a3 = 0.f;
#pragma unroll 16
            for (int i = 0; i < 64; ++i) { const int k = wave * 128 + 2 * i + rsub; const float w = W[(size_t)k * 6144 + col];
                a0 += cact[k] * w; a1 += cact[1024 + k] * w; a2 += cact[2048 + k] * w; a3 += cact[3072 + k] * w; }
            a0 += __shfl_xor(a0, 32); a1 += __shfl_xor(a1, 32); a2 += __shfl_xor(a2, 32); a3 += __shfl_xor(a3, 32);
            if (lane < 32) { red[(wave * 4 + 0) * 32 + col] = a0; red[(wave * 4 + 1) * 32 + col] = a1; red[(wave * 4 + 2) * 32 + col] = a2; red[(wave * 4 + 3) * 32 + col] = a3; }
            __syncthreads();
            if (tid < 128) { const int b = tid >> 5, cc = tid & 31; float s = 0.f;
#pragma unroll
                for (int w = 0; w < 8; ++w) s += red[(w * 4 + b) * 32 + cc];
                mod[(size_t)(l * 4 + b) * 6144 + cgp * 32 + cc] = s + p.in[3][l * 6144 + cgp * 32 + cc]; }
            __syncthreads();
        }
    }
    {
        float* tbl = (float*)(ws + WS_TBL);
        for (int job = blockIdx.x; job < 2; job += G) {
            const int l = job;
            LAS float* sm = (LAS float*)(lds + 32768);
            float mq = 0.f, mk = 0.f, mb = 0.f;
            if (tid < 64) { mq = fabsf(p.in[9][l * 64 + tid]); mk = fabsf(p.in[10][l * 64 + tid]); }
            for (int i = tid; i < NHEAD * 257; i += NTHREADS) mb = fmaxf(mb, fabsf(p.in[11][i]));
#pragma unroll
            for (int o = 1; o < 64; o <<= 1) { mq = fmaxf(mq, __shfl_xor(mq, o)); mk = fmaxf(mk, __shfl_xor(mk, o)); mb = fmaxf(mb, __shfl_xor(mb, o)); }
            if (lane == 0) { sm[wave * 4 + 0] = mq; sm[wave * 4 + 1] = mk; sm[wave * 4 + 2] = mb; }
            __syncthreads();
            mq = 0.f; mk = 0.f; mb = 0.f;
            for (int w = 0; w < 8; ++w) { mq = fmaxf(mq, sm[w * 4 + 0]); mk = fmaxf(mk, sm[w * 4 + 1]); mb = fmaxf(mb, sm[w * 4 + 2]); }
            const float shift = LOG2E * (8.0f * mq * mk + mb);
            for (int i = tid; i < NHEAD * 256; i += NTHREADS) { const int h = i >> 8, j = i & 255; int rel = j - 63; if (rel > 128) rel = 128;
                tbl[(size_t)l * 2048 + i] = (j < 255) ? p.in[11][h * 257 + rel + 128] * LOG2E - shift : 0.f; }
            __syncthreads();
        }
        for (int job = blockIdx.x; job < 2 * 48; job += G) {
            const int l = job / 48, n = job % 48;
            bf16_t* hi = (bf16_t*)(ws + WS_RW) + (size_t)l * 2 * 48 * 1024;
            bf16_t* lo = hi + 48 * 1024;
            for (int k = tid; k < 1024; k += NTHREADS) {
                float w = 0.f;
                if (n < 32) w = p.in[15][((size_t)l * 1024 + k) * 32 + n]; else if (n < 36) w = p.in[13][((size_t)l * 1024 + k) * 4 + (n - 32)];
                const unsigned h2 = cvtpk(w, 0.f) & 0xffffu; const float r = w - bf_lo(h2);
                const size_t idx = ((size_t)((k >> 5) * 3 + (n >> 4)) * 64 + ((k & 31) >> 3) * 16 + (n & 15)) * 8 + (k & 7);
                hi[idx] = (bf16_t)h2; lo[idx] = (bf16_t)(cvtpk(r, 0.f) & 0xffffu);
            }
            if (tid == 0) { float bsv = 0.f; if (n < 32) bsv = p.in[16][l * 32 + n]; else if (n < 36) bsv = p.in[14][l * 4 + (n - 32)]; ((float*)(ws + WS_RWB))[l * 48 + n] = bsv; }
        }
    }
    __syncthreads();
    {
        LAS float* wsc = (LAS float*)lds;
        LAS float* pwl = (LAS float*)(lds + 32768);
        for (int item = blockIdx.x; item < 2 * 4 * 16; item += G) {
            const int l = item >> 6, g = (item >> 4) & 3, nb = item & 15;
            const float* wo = p.in[12] + ((size_t)l * 1024 + g * 128) * 1024 + nb * 64;
            const float* sc = p.in[8] + l * 512 + g * 128;
            const float* pw = p.in[7] + ((size_t)l * 4 + g) * 128 * 128;
            for (int i = tid; i < 128 * 64; i += NTHREADS) { const int d = i >> 6, n = i & 63; wsc[i] = wo[(size_t)d * 1024 + n] * sc[d]; }
            for (int i = tid; i < 128 * 128 / 4; i += NTHREADS) *(LAS f32x4*)(pwl + 4 * i) = *(const f32x4*)(pw + 4 * i);
            __syncthreads();
            const int n = tid & 63, cgp = tid >> 6;
            float a[16];
#pragma unroll
            for (int j = 0; j < 16; ++j) a[j] = 0.f;
#pragma unroll 2
            for (int d4 = 0; d4 < 32; ++d4) {
                const float w0 = wsc[(4 * d4 + 0) * 64 + n], w1 = wsc[(4 * d4 + 1) * 64 + n], w2 = wsc[(4 * d4 + 2) * 64 + n], w3 = wsc[(4 * d4 + 3) * 64 + n];
#pragma unroll
                for (int j = 0; j < 16; ++j) { const f32x4 pv = *(const LAS f32x4*)(pwl + (cgp * 16 + j) * 128 + 4 * d4); a[j] += (pv[0] * w0 + pv[1] * w1) + (pv[2] * w2 + pv[3] * w3); }
            }
            bf16_t* dst = (bf16_t*)(ws + WS_WOUT) + ((size_t)l * 1024 + nb * 64 + n) * 1024 + g * 128 + cgp * 16;
            u32x4 o0, o1; o0.x = cvtpk(a[0], a[1]); o0.y = cvtpk(a[2], a[3]); o0.z = cvtpk(a[4], a[5]); o0.w = cvtpk(a[6], a[7]);
            o1.x = cvtpk(a[8], a[9]); o1.y = cvtpk(a[10], a[11]); o1.z = cvtpk(a[12], a[13]); o1.w = cvtpk(a[14], a[15]);
            *(u32x4*)dst = o0; *(u32x4*)(dst + 8) = o1;
            __syncthreads();
        }
    }
    {
        LAS float* scr = (LAS float*)(lds + wave * 16640);
        t_run<false>(p, blockIdx.x * NWAVES + wave, G * NWAVES, T_NA, scr, lane);
    }
}

typedef float f32x2v __attribute__((ext_vector_type(2)));
__device__ __forceinline__ f32x4 y_pair_sum(const unsigned char* Y8, size_t row, int c) {
    const int a = *(const int*)(Y8 + (size_t)(2 * row) * DM + c), b = *(const int*)(Y8 + (size_t)(2 * row + 1) * DM + c);
    const f32x2v a0 = __builtin_amdgcn_cvt_pk_f32_fp8(a, false), a1 = __builtin_amdgcn_cvt_pk_f32_fp8(a, true);
    const f32x2v b0 = __builtin_amdgcn_cvt_pk_f32_fp8(b, false), b1 = __builtin_amdgcn_cvt_pk_f32_fp8(b, true);
    f32x4 ys; ys[0] = (a0[0] + b0[0]) * 0.0625f; ys[1] = (a0[1] + b0[1]) * 0.0625f; ys[2] = (a1[0] + b1[0]) * 0.0625f; ys[3] = (a1[1] + b1[1]) * 0.0625f; return ys;
}
template <int NR, bool UPD>
__device__ __forceinline__ void norm1_rows(const Params& p, int l, int row0, int lane) {
    const float* mod = (const float*)(p.ws + WS_MOD);
    const float* gn = p.in[4] + l * 1024;
    bf16_t* H = (bf16_t*)(p.ws + WS_BUF);
    const unsigned char* Y = (const unsigned char*)(p.ws + WS_Y);
    bf16_t* XB = (bf16_t*)(p.ws + WS_XB);
    const int b = row0 >> 13;
    f32x4 v[NR][4];
    if (!UPD) {
#pragma unroll
        for (int r = 0; r < NR; ++r)
#pragma unroll
            for (int j = 0; j < 4; ++j) v[r][j] = *(const f32x4*)(p.in[0] + (size_t)(row0 + r) * DM + 4 * lane + 256 * j);
    } else {
        const float* g2 = mod + (size_t)((l - 1) * 4 + b) * 6144 + 5120;
        f32x4 ys[NR][4];
#pragma unroll
        for (int r = 0; r < NR; ++r)
#pragma unroll
            for (int j = 0; j < 4; ++j) { const int c = 4 * lane + 256 * j; const u32x2 xw = *(const u32x2*)(XB + (size_t)(row0 + r) * DM + c);
                v[r][j] = (f32x4){bf_lo(xw.x), bf_hi(xw.x), bf_lo(xw.y), bf_hi(xw.y)}; ys[r][j] = y_pair_sum(Y, row0 + r, c); }
#pragma unroll
        for (int j = 0; j < 4; ++j) { const f32x4 gg = *(const f32x4*)(g2 + 4 * lane + 256 * j);
#pragma unroll
            for (int r = 0; r < NR; ++r) { const f32x4 xn = v[r][j] + gg * ys[r][j]; u32x2 xw; xw.x = cvtpk(xn[0], xn[1]); xw.y = cvtpk(xn[2], xn[3]);
                *(u32x2*)(XB + (size_t)(row0 + r) * DM + 4 * lane + 256 * j) = xw;
                v[r][j] = (f32x4){bf_lo(xw.x), bf_hi(xw.x), bf_lo(xw.y), bf_hi(xw.y)}; } }
    }
    float ss[NR];
#pragma unroll
    for (int r = 0; r < NR; ++r) { ss[r] = 0.f;
#pragma unroll
        for (int j = 0; j < 4; ++j) ss[r] += (v[r][j][0] * v[r][j][0] + v[r][j][1] * v[r][j][1]) + (v[r][j][2] * v[r][j][2] + v[r][j][3] * v[r][j][3]); }
#pragma unroll
    for (int o = 1; o < 64; o <<= 1)
#pragma unroll
        for (int r = 0; r < NR; ++r) ss[r] += __shfl_xor(ss[r], o);
    const float* sh = mod + (size_t)(l * 4 + b) * 6144; const float* sc = sh + 1024;
#pragma unroll
    for (int j = 0; j < 4; ++j) {
        const int c = 4 * lane + 256 * j;
        const f32x4 g = *(const f32x4*)(gn + c), s1 = *(const f32x4*)(sc + c), s0 = *(const f32x4*)(sh + c);
        const f32x4 a = g * (s1 + 1.0f);
#pragma unroll
        for (int r = 0; r < NR; ++r) {
            const float rstd = rsqrtf(ss[r] * (1.0f / DM) + EPS);
            const f32x4 h = v[r][j] * rstd * a + s0;
            u32x2 w; w.x = cvtpk(h[0], h[1]); w.y = cvtpk(h[2], h[3]);
            *(u32x2*)(H + (size_t)(row0 + r) * DM + c) = w;
        }
    }
}
__device__ __forceinline__ void phase_norm1(const Params& p, int l) {
    const int tid = opaque_tid(), lane = tid & 63, wave = tid >> 6, G = gridDim.x;
    const int gw = blockIdx.x * NWAVES + wave, NGW = G * NWAVES;
    if (l == 0) { for (int rq = gw; rq < NTOK / 4; rq += NGW) norm1_rows<4, false>(p, l, rq * 4, lane); }
    else { for (int rq = gw; rq < NTOK / 2; rq += NGW) norm1_rows<2, true>(p, l, rq * 2, lane); }
}

__device__ __forceinline__ void phase_final(const Params& p) {
    const int tid = opaque_tid(), lane = tid & 63, wave = tid >> 6, G = gridDim.x;
    const int gw = blockIdx.x * NWAVES + wave, NGW = G * NWAVES;
    const float* mod = (const float*)(p.ws + WS_MOD);
    const unsigned char* Y = (const unsigned char*)(p.ws + WS_Y);
    const bf16_t* XB = (const bf16_t*)(p.ws + WS_XB);
    constexpr int NR = 4;
    for (int rq = gw; rq < NTOK / NR; rq += NGW) {
        const int row0 = rq * NR, b = row0 >> 13;
        const float* g2 = mod + (size_t)((DEPTH - 1) * 4 + b) * 6144 + 5120;
        f32x4 v[NR][4], ys[NR][4];
#pragma unroll
        for (int r = 0; r < NR; ++r)
#pragma unroll
            for (int j = 0; j < 4; ++j) { const int c = 4 * lane + 256 * j; const u32x2 xw = *(const u32x2*)(XB + (size_t)(row0 + r) * DM + c);
                v[r][j] = (f32x4){bf_lo(xw.x), bf_hi(xw.x), bf_lo(xw.y), bf_hi(xw.y)}; ys[r][j] = y_pair_sum(Y, row0 + r, c); }
#pragma unroll
        for (int j = 0; j < 4; ++j) { const f32x4 gg = *(const f32x4*)(g2 + 4 * lane + 256 * j);
#pragma unroll
            for (int r = 0; r < NR; ++r) *(f32x4*)(p.out + (size_t)(row0 + r) * DM + 4 * lane + 256 * j) = v[r][j] + gg * ys[r][j]; }
    }
}

__device__ __forceinline__ int crow(int r, int hi) { return (r & 3) + 8 * (r >> 2) + 4 * hi; }

__device__ __forceinline__ void pool_strip(const Params& p, int strip, int lane) {
    const bf16_t* U = (const bf16_t*)(p.ws + WS_U); bf16_t* MIX = (bf16_t*)(p.ws + WS_BUF);
    const int tok0 = strip * 16, s0 = tok0 & (SEQ - 1);
    const int win = 2 << (lane >> 4);
    float S[8];
#pragma unroll
    for (int j = 0; j < 8; ++j) S[j] = 0.f;
#pragma unroll
    for (int d = 1; d < 16; ++d) {
        if (d < win && s0 - d >= 0) {
            const u32x4 w = *(const u32x4*)(U + (size_t)(tok0 - d) * 512 + lane * 8);
            S[0] += bf_lo(w.x); S[1] += bf_hi(w.x); S[2] += bf_lo(w.y); S[3] += bf_hi(w.y); S[4] += bf_lo(w.z); S[5] += bf_hi(w.z); S[6] += bf_lo(w.w); S[7] += bf_hi(w.w);
        }
    }
#pragma unroll 4
    for (int i = 0; i < 16; ++i) {
        const int s = s0 + i;
        const u32x4 w = *(const u32x4*)(U + (size_t)(tok0 + i) * 512 + lane * 8);
        float uv[8] = {bf_lo(w.x), bf_hi(w.x), bf_lo(w.y), bf_hi(w.y), bf_lo(w.z), bf_hi(w.z), bf_lo(w.w), bf_hi(w.w)};
#pragma unroll
        for (int j = 0; j < 8; ++j) S[j] += uv[j];
        const int cn = (s + 1 < win) ? s + 1 : win;
        const float inv = 1.0f / (float)cn;
        float o[8];
#pragma unroll
        for (int j = 0; j < 8; ++j) o[j] = S[j] * inv - uv[j];
        u32x4 ow; ow.x = cvtpk(o[0], o[1]); ow.y = cvtpk(o[2], o[3]); ow.z = cvtpk(o[4], o[5]); ow.w = cvtpk(o[6], o[7]);
        *(u32x4*)(MIX + (size_t)(tok0 + i) * DM + lane * 8) = ow;
        if (s - win + 1 >= 0) {
            const u32x4 x = *(const u32x4*)(U + (size_t)(tok0 + i - win + 1) * 512 + lane * 8);
            S[0] -= bf_lo(x.x); S[1] -= bf_hi(x.x); S[2] -= bf_lo(x.y); S[3] -= bf_hi(x.y); S[4] -= bf_lo(x.z); S[5] -= bf_hi(x.z); S[6] -= bf_lo(x.w); S[7] -= bf_hi(x.w);
        }
    }
}

__device__ __forceinline__ void attn_unit(const Params& p, int b, int h, int ch, int qh, int lane, const LAS float* tbl, LAS bf16_t* stg) {
    const int r32 = lane & 31, hi = lane >> 5;
    const char* Qf = (const char*)(p.ws + WS_Q); const char* Kf = (const char*)(p.ws + WS_K); const char* Vf = (const char*)(p.ws + WS_V);
    bf16_t* MIX = (bf16_t*)(p.ws + WS_BUF);
    const size_t bh = (size_t)(b * NHEAD + h) * 256;
    bf16x8 qr[4];
#pragma unroll
    for (int d0 = 0; d0 < 4; ++d0) qr[d0] = *(const bf16x8*)(Qf + (((bh + ch * 2 + qh) * 4 + d0) * 64 + lane) * 16);
    f32x16 o0 = {}, o1 = {};
    float lsum = 0.f;
    const LAS float* th = tbl + h * 256;
    const float cfar = th[254];
    const int t0 = ch < 8 ? 8 - ch : 0;
    const char* kbase = Kf + (bh * 4 * 64 + lane) * 16 + (ptrdiff_t)(ch - 8) * 8192;
    const char* vbase = Vf + (bh * 4 * 64 + lane) * 16 + (ptrdiff_t)(ch - 8) * 8192;
    bf16x8 kk[8];
    { const char* kp_ = kbase + (ptrdiff_t)t0 * 8192;
#pragma unroll
      for (int i = 0; i < 8; ++i) kk[i] = *(const bf16x8*)(kp_ + i * 1024); }
#pragma unroll 1
    for (int t = t0; t <= 8; ++t) {
        bf16x8 vv[8];
        { const char* vp_ = vbase + (ptrdiff_t)t * 8192;
#pragma unroll
          for (int i = 0; i < 8; ++i) vv[i] = *(const bf16x8*)(vp_ + i * 1024); }
        f32x16 p0, p1;
        if (t <= 5) {
#pragma unroll
            for (int r = 0; r < 16; ++r) { p0[r] = cfar; p1[r] = cfar; }
        } else {
            const int base_ = 64 * (8 - t) + 32 * qh + r32 + 63 - 4 * hi;
#pragma unroll
            for (int r = 0; r < 16; ++r) { const int kj = (r & 3) + 8 * (r >> 2); p0[r] = th[base_ - kj]; p1[r] = th[base_ - kj - 32]; }
        }
#pragma unroll
        for (int d0 = 0; d0 < 4; ++d0) {
            p0 = __builtin_amdgcn_mfma_f32_32x32x16_bf16(kk[d0], qr[d0], p0, 0, 0, 0);
            p1 = __builtin_amdgcn_mfma_f32_32x32x16_bf16(kk[4 + d0], qr[d0], p1, 0, 0, 0);
        }
        if (t < 8) {
            const char* kp_ = kbase + (ptrdiff_t)(t + 1) * 8192;
#pragma unroll
            for (int i = 0; i < 8; ++i) kk[i] = *(const bf16x8*)(kp_ + i * 1024);
        }
        float sacc = 0.f;
#pragma unroll
        for (int r = 0; r < 16; ++r) { p0[r] = fast_exp2(p0[r]); p1[r] = fast_exp2(p1[r]); sacc += p0[r] + p1[r]; }
        lsum += sacc;
        u32x4 pa[2][2];
#pragma unroll
        for (int s = 0; s < 2; ++s) {
            pa[0][s].x = cvtpk(p0[8 * s + 0], p0[8 * s + 1]); pa[0][s].y = cvtpk(p0[8 * s + 2], p0[8 * s + 3]); pa[0][s].z = cvtpk(p0[8 * s + 4], p0[8 * s + 5]); pa[0][s].w = cvtpk(p0[8 * s + 6], p0[8 * s + 7]);
            pa[1][s].x = cvtpk(p1[8 * s + 0], p1[8 * s + 1]); pa[1][s].y = cvtpk(p1[8 * s + 2], p1[8 * s + 3]); pa[1][s].z = cvtpk(p1[8 * s + 4], p1[8 * s + 5]); pa[1][s].w = cvtpk(p1[8 * s + 6], p1[8 * s + 7]);
        }
#pragma unroll
        for (int blk = 0; blk < 2; ++blk)
#pragma unroll
            for (int s = 0; s < 2; ++s) {
                const bf16x8 pf = __builtin_bit_cast(bf16x8, pa[blk][s]);
                o0 = __builtin_amdgcn_mfma_f32_32x32x16_bf16(pf, vv[(blk * 2 + s) * 2 + 0], o0, 0, 0, 0);
                o1 = __builtin_amdgcn_mfma_f32_32x32x16_bf16(pf, vv[(blk * 2 + s) * 2 + 1], o1, 0, 0, 0);
            }
    }
    lsum += __shfl_xor(lsum, 32);
    const float linv = 1.0f / lsum;
#pragma unroll
    for (int r = 0; r < 16; ++r) {
        const int q = crow(r, hi);
        const float li = __shfl(linv, q);
        stg[q * 72 + r32] = (bf16_t)(cvtpk(o0[r] * li, 0.f) & 0xffffu);
        stg[q * 72 + 32 + r32] = (bf16_t)(cvtpk(o1[r] * li, 0.f) & 0xffffu);
    }
    asm volatile("s_waitcnt lgkmcnt(0)" ::: "memory");
    bf16_t* orow = MIX + ((size_t)b * SEQ + ch * 64 + qh * 32 + (lane >> 3)) * DM + 512 + h * 64 + (lane & 7) * 8;
    const LAS bf16_t* srow = stg + (lane >> 3) * 72 + (lane & 7) * 8;
#pragma unroll
    for (int i = 0; i < 4; ++i) *(u32x4*)(orow + (size_t)i * 8 * DM) = *(const LAS u32x4*)(srow + i * 8 * 72);
    asm volatile("s_waitcnt lgkmcnt(0)" ::: "memory");
}

__device__ __forceinline__ void phase_mixer(const Params& p, int l, LAS unsigned char* lds) {
    const int tid = opaque_tid(), lane = tid & 63, wave = tid >> 6, G = gridDim.x;
    LAS float* tbl = (LAS float*)lds;
    const float* gt = (const float*)(p.ws + WS_TBL) + (size_t)l * 2048;
    for (int i = tid; i < 2048; i += NTHREADS) tbl[i] = gt[i];
    __syncthreads();
    const int gw = blockIdx.x * NWAVES + wave, NGW = G * NWAVES;
    LAS bf16_t* stg = (LAS bf16_t*)(lds + 8192 + wave * 4608);
    for (int it = gw; it < NTOK / 16; it += NGW) pool_strip(p, it, lane);
    if (G % 8 == 0) {
        const int x = (int)blockIdx.x & 7, lw = ((int)blockIdx.x >> 3) * NWAVES + wave, nlw = (G >> 3) * NWAVES;
        for (int pr = x; pr < BATCH * NHEAD; pr += 8)
            for (int u = lw; u < 256; u += nlw) attn_unit(p, pr >> 3, pr & 7, u >> 1, u & 1, lane, tbl, stg);
    } else {
        for (int wu = gw; wu < BATCH * NHEAD * 256; wu += NGW) attn_unit(p, wu >> 11, (wu >> 8) & 7, (wu >> 1) & 127, wu & 1, lane, tbl, stg);
    }
}

__device__ __forceinline__ void phase_route(const Params& p, int l, LAS unsigned char* lds) {
    const int tid = opaque_tid(), lane = tid & 63, wave = __builtin_amdgcn_readfirstlane(tid >> 6), G = gridDim.x;
    LAS float* a2c = (LAS float*)(lds + 49152);
    LAS float* shc = (LAS float*)(lds + 49152 + 1024);
    LAS float* lg = (LAS float*)(lds + 53248) + wave * (16 * 48);
    LAS int* lcnt = (LAS int*)(lds + 77824);
    LAS int* gbase = (LAS int*)(lds + 77824 + 128);
    LAS int* tmp_e = (LAS int*)(lds + 77824 + 256);
    LAS int* tmp_r = (LAS int*)(lds + 77824 + 256 + 1024);
    const float* mod = (const float*)(p.ws + WS_MOD);
    const float* gn = p.in[5] + l * 1024;
    bf16_t* H = (bf16_t*)(p.ws + WS_BUF);
    const char* RW = (const char*)(p.ws + WS_RW) + (size_t)l * 2 * 48 * 1024 * 2;
    const float* rwb = (const float*)(p.ws + WS_RWB) + l * 48;
    const float* ssq = (const float*)(p.ws + WS_SSQ);
    int* gcnt = (int*)(p.ws + WS_CTL) + l * 32;
    int* list = (int*)(p.ws + WS_LIST);
    float* ew = (float*)(p.ws + WS_EW);
    const int r = lane & 15, kg = lane >> 4;
    for (int it = blockIdx.x; it < NTOK / 128; it += G) {
        const int row0 = it * 128 + wave * 16, row = row0 + r, b = (it * 128) >> 13;
        const bf16_t* xr = (const bf16_t*)(p.ws + WS_XB) + (size_t)row * DM + 8 * kg;
        float ss; { const f32x4 q4 = *(const f32x4*)(ssq + (size_t)row * 16 + 4 * kg); ss = (q4[0] + q4[1]) + (q4[2] + q4[3]); }
        ss += __shfl_xor(ss, 16); ss += __shfl_xor(ss, 32);
        const float rstd = rsqrtf(ss * (1.0f / DM) + EPS);
        const float* sh = mod + (size_t)(l * 4 + b) * 6144 + 3072; const float* sc = sh + 1024;
        f32x4 acc[3];
#pragma unroll
        for (int nb = 0; nb < 3; ++nb) acc[nb] = (f32x4){0.f, 0.f, 0.f, 0.f};
#pragma unroll 1
        for (int c = 0; c < 4; ++c) {
            u32x4 xs[8];
#pragma unroll
            for (int i = 0; i < 8; ++i) xs[i] = *(const u32x4*)(xr + 256 * c + 32 * i);
            __syncthreads();
            if (c == 0 && tid < 32) lcnt[tid] = 0;
#pragma unroll
            for (int i = 0; i < 6; ++i) { const int q = wave * 6 + i; const char* src = RW + (q < 24 ? (size_t)(c * 24 + q) * 1024 : (size_t)98304 + (size_t)(c * 24 + q - 24) * 1024);
                __builtin_amdgcn_global_load_lds((const unsigned*)(src + lane * 16), (LAS unsigned*)(lds + q * 1024), 16, 0, 0); }
            if (tid < 256) { const int k = 256 * c + tid; a2c[tid] = gn[k] * (1.0f + sc[k]); shc[tid] = sh[k]; }
            asm volatile("s_waitcnt vmcnt(0)" ::: "memory");
            __syncthreads();
#pragma unroll
            for (int i = 0; i < 8; ++i) {
                float hv[8];
#pragma unroll
                for (int q = 0; q < 2; ++q) {
                    const f32x4 a = *(const LAS f32x4*)(a2c + 32 * i + 8 * kg + 4 * q), s0 = *(const LAS f32x4*)(shc + 32 * i + 8 * kg + 4 * q);
                    const f32x4 xv = q == 0 ? (f32x4){bf_lo(xs[i].x), bf_hi(xs[i].x), bf_lo(xs[i].y), bf_hi(xs[i].y)} : (f32x4){bf_lo(xs[i].z), bf_hi(xs[i].z), bf_lo(xs[i].w), bf_hi(xs[i].w)};
                    const f32x4 hh = xv * rstd * a + s0;
                    hv[4 * q + 0] = hh[0]; hv[4 * q + 1] = hh[1]; hv[4 * q + 2] = hh[2]; hv[4 * q + 3] = hh[3];
                }
                u32x4 hp; hp.x = cvtpk(hv[0], hv[1]); hp.y = cvtpk(hv[2], hv[3]); hp.z = cvtpk(hv[4], hv[5]); hp.w = cvtpk(hv[6], hv[7]);
                *(u32x4*)(H + (size_t)row * DM + 256 * c + 32 * i + 8 * kg) = hp;
                u32x4 lp;
                lp.x = cvtpk(hv[0] - bf_lo(hp.x), hv[1] - bf_hi(hp.x)); lp.y = cvtpk(hv[2] - bf_lo(hp.y), hv[3] - bf_hi(hp.y));
                lp.z = cvtpk(hv[4] - bf_lo(hp.z), hv[5] - bf_hi(hp.z)); lp.w = cvtpk(hv[6] - bf_lo(hp.w), hv[7] - bf_hi(hp.w));
                const bf16x8 xhi = __builtin_bit_cast(bf16x8, hp), xlo = __builtin_bit_cast(bf16x8, lp);
#pragma unroll
                for (int nb = 0; nb < 3; ++nb) {
                    const bf16x8 whi = *(const LAS bf16x8*)(lds + (i * 3 + nb) * 1024 + lane * 16);
                    const bf16x8 wlo = *(const LAS bf16x8*)(lds + 24576 + (i * 3 + nb) * 1024 + lane * 16);
                    acc[nb] = __builtin_amdgcn_mfma_f32_16x16x32_bf16(whi, xhi, acc[nb], 0, 0, 0);
                    acc[nb] = __builtin_amdgcn_mfma_f32_16x16x32_bf16(whi, xlo, acc[nb], 0, 0, 0);
                    acc[nb] = __builtin_amdgcn_mfma_f32_16x16x32_bf16(wlo, xhi, acc[nb], 0, 0, 0);
                }
            }
        }
#pragma unroll
        for (int nb = 0; nb < 3; ++nb)
#pragma unroll
            for (int q = 0; q < 4; ++q) lg[r * 48 + 16 * nb + 4 * kg + q] = acc[nb][q];
        asm volatile("s_waitcnt lgkmcnt(0)" ::: "memory");
        if (lane < 16) {
            const LAS float* my = lg + lane * 48;
            float gl[4]; int gi = 0; float gm;
#pragma unroll
            for (int i = 0; i < 4; ++i) gl[i] = my[32 + i] + rwb[32 + i];
            gm = gl[0];
#pragma unroll
            for (int i = 1; i < 4; ++i) if (gl[i] > gm) { gm = gl[i]; gi = i; }
            float den = 0.f;
#pragma unroll
            for (int i = 0; i < 4; ++i) den += __expf(gl[i] - gm);
            const float gpv = 1.0f / den;
            float el[8];
#pragma unroll
            for (int i = 0; i < 8; ++i) el[i] = my[8 * gi + i] + rwb[8 * gi + i];
            int i0 = 0; float v0 = el[0];
#pragma unroll
            for (int i = 1; i < 8; ++i) if (el[i] > v0) { v0 = el[i]; i0 = i; }
            int i1 = -1; float v1 = -3.0e38f;
#pragma unroll
            for (int i = 0; i < 8; ++i) if (i != i0 && el[i] > v1) { v1 = el[i]; i1 = i; }
            const float dd = __expf(v1 - v0);
            const float w0 = gpv / (1.0f + dd), w1 = gpv * dd / (1.0f + dd);
            const int e0 = 8 * gi + i0, e1 = 8 * gi + i1;
            const int tok = row0 + lane, lt = wave * 16 + lane;
            ew[2 * tok] = w0; ew[2 * tok + 1] = w1;
            tmp_e[2 * lt] = e0; tmp_e[2 * lt + 1] = e1;
            tmp_r[2 * lt] = __hip_atomic_fetch_add(lcnt + e0, 1, __ATOMIC_RELAXED, __HIP_MEMORY_SCOPE_WORKGROUP);
            tmp_r[2 * lt + 1] = __hip_atomic_fetch_add(lcnt + e1, 1, __ATOMIC_RELAXED, __HIP_MEMORY_SCOPE_WORKGROUP);
        }
        __syncthreads();
        if (tid < 32) gbase[tid] = __hip_atomic_fetch_add(gcnt + tid, lcnt[tid], __ATOMIC_RELAXED, __HIP_MEMORY_SCOPE_AGENT);
        __syncthreads();
        if (tid < 256) { const int e = tmp_e[tid]; list[(size_t)e * NTOK + gbase[e] + tmp_r[tid]] = it * 256 + tid; }
    }
    __syncthreads();
}

#define XB_TMO      128
#define XB_XCNT(j)  (256  + 64 * (j))
#define XB_XSUB(j)  (1280 + 64 * (j))
#define XB_XGEN(j)  (2304 + 64 * (j))
#define XB_TOP      3328
#define XB_TOPGEN   3392
#define XCD_BAR_WORDS 3456
#define XB_SPIN_CAP (1u << 18)
__device__ __forceinline__ unsigned xb_ld(unsigned* p)              { return __hip_atomic_load(p, __ATOMIC_RELAXED, __HIP_MEMORY_SCOPE_AGENT); }
__device__ __forceinline__ unsigned xb_add(unsigned* p, unsigned v) { return __hip_atomic_fetch_add(p, v, __ATOMIC_RELAXED, __HIP_MEMORY_SCOPE_AGENT); }
__device__ __forceinline__ unsigned xb_xcc_id() { return (unsigned)__builtin_amdgcn_s_getreg((3 << 11) | 20) & 0xFu; }
#define XB_SPIN(cond, bar) do { unsigned _sp = 0; while (cond) { __builtin_amdgcn_s_sleep(1); \
    if ((++_sp & 255u) == 0u) { if (xb_ld(&(bar)[XB_TMO])) break; if (_sp > XB_SPIN_CAP) { atomicAdd(&(bar)[XB_TMO], 1u); break; } } } } while (0)
struct XcdBarrier { unsigned* bar; unsigned x; volatile LAS unsigned* st; };
__device__ __forceinline__ XcdBarrier xcd_barrier_post(unsigned* bar, volatile LAS unsigned* st) {
    XcdBarrier b; b.bar = bar; b.x = xb_xcc_id(); b.st = st;
    if (threadIdx.x == 0) (void)xb_add(&bar[XB_XCNT(b.x)], 1u);
    return b;
}
__device__ __forceinline__ void xcd_barrier_complete(unsigned* bar, unsigned x, unsigned& nloc, unsigned& nx) {
    const unsigned G = gridDim.x * gridDim.y * gridDim.z;
    unsigned sum, cnt, mine, sp = 0u;
    for (;;) {
        sum = 0u; cnt = 0u; mine = 0u;
#pragma unroll
        for (unsigned j = 0; j < 16; ++j) { const unsigned c = xb_ld(&bar[XB_XCNT(j)]); sum += c; cnt += (c > 0u) ? 1u : 0u; mine = (j == x) ? c : mine; }
        if (sum == G) break;
        __builtin_amdgcn_s_sleep(1);
        if ((++sp & 255u) == 0u) { if (xb_ld(&bar[XB_TMO])) break; if (sp > XB_SPIN_CAP) { atomicAdd(&bar[XB_TMO], 1u); break; } }
    }
    nloc = mine > 0u ? mine : 1u; nx = cnt > 0u ? cnt : 1u;
}
__device__ __forceinline__ void xcd_barrier(const XcdBarrier& b) {
    asm volatile("s_waitcnt vmcnt(0)" ::: "memory");
    __syncthreads();
    if (threadIdx.x == 0) {
        unsigned* bar = b.bar;
        __builtin_amdgcn_s_waitcnt(0);
        unsigned nloc = b.st[0], nx = b.st[1];
        if (nloc == 0u) { xcd_barrier_complete(bar, b.x, nloc, nx); b.st[0] = nloc; b.st[1] = nx; }
        const unsigned old = xb_add(&bar[XB_XSUB(b.x)], 1u);
        const unsigned gen = old / nloc;
        if (old + 1u == (gen + 1u) * nloc) {
            __builtin_amdgcn_fence(__ATOMIC_RELEASE, "agent");
            asm volatile("s_waitcnt vmcnt(0)" ::: "memory");
            const unsigned og = xb_add(&bar[XB_TOP], 1u);
            const unsigned tg = og / nx;
            if (og + 1u == (tg + 1u) * nx) xb_add(&bar[XB_TOPGEN], 1u);
            else XB_SPIN(xb_ld(&bar[XB_TOPGEN]) == tg, bar);
            __builtin_amdgcn_fence(__ATOMIC_ACQUIRE, "agent");
            xb_add(&bar[XB_XGEN(b.x)], 1u);
            asm volatile("s_waitcnt vmcnt(0)" ::: "memory");
        } else {
            XB_SPIN(xb_ld(&bar[XB_XGEN(b.x)]) == gen, bar);
            __builtin_amdgcn_fence(__ATOMIC_ACQUIRE, "agent");
            asm volatile("s_waitcnt vmcnt(0)" ::: "memory");
        }
    }
    __syncthreads();
}

__device__ __forceinline__ void load_prefix(const Params& p, int l, LAS int* pre, LAS int* cntl) {
    const int* gcnt = (const int*)(p.ws + WS_CTL) + l * 32;
    if (threadIdx.x == 0) { int a = 0; for (int e = 0; e < NEXP; ++e) { const int c = gcnt[e]; cntl[e] = c; pre[e] = a; a += (c + 255) >> 8; } pre[NEXP] = a; }
    __syncthreads();
}

__global__ void __launch_bounds__(NTHREADS, 2) fwd_kernel(Params p) {
    extern __shared__ __attribute__((aligned(16))) unsigned char lds_raw[];
    LAS unsigned char* lds = (LAS unsigned char*)lds_raw;
    const int G = gridDim.x;
    unsigned char* ws = p.ws;
    volatile LAS unsigned* bst = (volatile LAS unsigned*)(lds + LDS_BYTES - 16);
    if (threadIdx.x < 2) bst[threadIdx.x] = 0u;
    __syncthreads();
    const XcdBarrier bar = xcd_barrier_post((unsigned*)(ws + WS_CTL) + 4096, bst);
    const int lo = p.ph_lo, hi = p.ph_hi;
#define IN(k) (lo <= (k) && (k) < hi)
#define SYNC_AFTER(k) do { if (IN(k) && IN((k) + 1)) xcd_barrier(bar); } while (0)
    if (IN(0)) phase_prologue(p, lds);
    SYNC_AFTER(0);
#pragma unroll 1
    for (int l = 0; l < DEPTH; ++l) {
        const int k0 = 1 + 7 * l;
        if (IN(k0 + 0)) phase_norm1(p, l);
        SYNC_AFTER(k0 + 0);
        if (IN(k0 + 1)) {
            {
                DenseGemm g{(const bf16_t*)(ws + WS_BUF), (const bf16_t*)(ws + WS_WIN) + (size_t)l * 2048 * 1024, 1024};
                pg8::StaticOrder S; S.init(NTOK, 1536, G, (int)blockIdx.x);
                EpiIn E{(bf16_t*)(ws + WS_U), (bf16_t*)(ws + WS_Q), (bf16_t*)(ws + WS_K), p.in[9] + l * 64, p.in[10] + l * 64};
                pg8::gemm_phase(lds, g, S, E);
            }
            {
                DenseGemm g{(const bf16_t*)(ws + WS_WIN) + (size_t)l * 2048 * 1024 + (size_t)1536 * 1024, (const bf16_t*)(ws + WS_BUF), 1024};
                pg8::StaticOrder S; S.init(512, NTOK, G, (int)blockIdx.x);
                EpiVt E{(bf16_t*)(ws + WS_V)};
                pg8::gemm_phase(lds, g, S, E);
            }
        }
        SYNC_AFTER(k0 + 1);
        if (IN(k0 + 2)) phase_mixer(p, l, lds);
        SYNC_AFTER(k0 + 2);
        if (IN(k0 + 3)) {
            DenseGemm g{(const bf16_t*)(ws + WS_BUF), (const bf16_t*)(ws + WS_WOUT) + (size_t)l * 1024 * 1024, 1024};
            pg8::StaticOrder S; S.init(NTOK, 1024, G, (int)blockIdx.x);
            const float* g1p = (const float*)(ws + WS_MOD) + (size_t)(l * 4) * 6144 + 2048;
            if (l == 0) { EpiOutB<true> E{p.in[0], (bf16_t*)(ws + WS_XB), g1p, (float*)(ws + WS_SSQ)}; pg8::gemm_phase(lds, g, S, E); }
            else { EpiOutB<false> E{nullptr, (bf16_t*)(ws + WS_XB), g1p, (float*)(ws + WS_SSQ)}; pg8::gemm_phase(lds, g, S, E); }
        }
        SYNC_AFTER(k0 + 3);
        if (IN(k0 + 4)) phase_route(p, l, lds);
        SYNC_AFTER(k0 + 4);
        if (IN(k0 + 5)) {
            const int vcu = (G % 8 == 0) ? ((int)blockIdx.x % 8) * (G / 8) + (int)blockIdx.x / 8 : (int)blockIdx.x;
            LAS int* pre = (LAS int*)(lds + pg8::STAGE_BYTES); LAS int* cntl = pre + 64;
            load_prefix(p, l, pre, cntl);
            GatherGemm g{(const bf16_t*)(ws + WS_BUF), (const bf16_t*)(ws + WS_WGU) + (size_t)l * NEXP * 1024 * 1024, (const int*)(ws + WS_LIST), 1024, 1, (size_t)1024 * 1024 * 2};
            pg8::GroupedOrder S{pre, cntl, G, vcu};
            EpiGU E{(bf16_t*)(ws + WS_ACT), (const int*)(ws + WS_LIST)};
            const int total_units = pre[NEXP] * 4;
            pg8::gemm_phase(lds, g, S, E);
            if (l == 0) tail_convert(p, lds, total_units, vcu, 0, 7424);
        }
        SYNC_AFTER(k0 + 5);
        if (IN(k0 + 6)) {
            const int vcu = (G % 8 == 0) ? ((int)blockIdx.x % 8) * (G / 8) + (int)blockIdx.x / 8 : (int)blockIdx.x;
            LAS int* pre = (LAS int*)(lds + pg8::STAGE_BYTES); LAS int* cntl = pre + 64;
            load_prefix(p, l, pre, cntl);
            GatherGemm g{(const bf16_t*)(ws + WS_ACT), (const bf16_t*)(ws + WS_WD) + (size_t)l * NEXP * 1024 * 512, (const int*)(ws + WS_LIST), 512, 0, (size_t)1024 * 512 * 2};
            pg8::GroupedOrder S{pre, cntl, G, vcu};
            EpiDn E{(unsigned char*)(ws + WS_Y), (const int*)(ws + WS_LIST), (const float*)(ws + WS_EW)};
            const int total_units = pre[NEXP] * 4;
            pg8::gemm_phase(lds, g, S, E);
            if (l == 0) tail_convert(p, lds, total_units, vcu, 7424, T_NB - 7424);
        }
        SYNC_AFTER(k0 + 6);
    }
    if (IN(15)) phase_final(p);
#undef IN
#undef SYNC_AFTER
}

extern "C" void kernel_launch(void* const* d_in, const int* in_sizes, int n_in, void* d_out, int out_size, void* d_ws, size_t ws_size, hipStream_t stream) {
    static int grid = 0;
    if (grid == 0) {
        if (n_in != 20 || out_size != NTOK * DM || ws_size < WS_END) { fprintf(stderr, "kernel_launch: unexpected shapes (n_in %d out %d ws %zu)\n", n_in, out_size, ws_size); grid = -1; return; }
        int dev = 0, cus = 0, per_cu = 0;
        hipGetDevice(&dev);
        hipDeviceGetAttribute(&cus, hipDeviceAttributeMultiprocessorCount, dev);
        hipFuncSetAttribute((const void*)fwd_kernel, hipFuncAttributeMaxDynamicSharedMemorySize, LDS_BYTES);
        hipOccupancyMaxActiveBlocksPerMultiprocessor(&per_cu, (const void*)fwd_kernel, NTHREADS, LDS_BYTES);
        if (per_cu < 1) per_cu = 1;
        if (per_cu > 1) per_cu = 1;
        grid = cus * per_cu;
        (void)hipGetLastError();
    }
    if (grid < 0) return;
    if (hipMemsetAsync((char*)d_ws + WS_CTL, 0, 65536, stream) != hipSuccess) { fprintf(stderr, "memset failed\n"); return; }
    Params p{};
    for (int i = 0; i < 20; ++i) p.in[i] = (const float*)d_in[i];
    p.out = (float*)d_out; p.ws = (unsigned char*)d_ws; p.ph_lo = 0; p.ph_hi = 16;
    void* args[] = {&p};
    hipError_t e = hipLaunchCooperativeKernel((const void*)fwd_kernel, dim3(grid), dim3(NTHREADS), args, LDS_BYTES, stream);
    if (e != hipSuccess) fprintf(stderr, "cooperative launch failed: %s (grid %d)\n", hipGetErrorString(e), grid);
}
```

```cpp
#include <hip/hip_runtime.h>
#include <hip/hip_cooperative_groups.h>
#include <cstdio>
#include <cstdint>
namespace cg = cooperative_groups;

#define LAS __attribute__((address_space(3)))
typedef unsigned short bf16_t;
typedef short bf16x8 __attribute__((ext_vector_type(8)));
typedef float f32x4 __attribute__((ext_vector_type(4)));
typedef float f32x16 __attribute__((ext_vector_type(16)));
typedef unsigned u32x4 __attribute__((ext_vector_type(4)));
typedef unsigned u32x2 __attribute__((ext_vector_type(2)));
typedef float f32x2_t __attribute__((ext_vector_type(2)));
typedef __bf16 bf16x2_t __attribute__((ext_vector_type(2)));

constexpr int BATCH = 4, SEQ = 8192, DM = 1024, NTOK = BATCH * SEQ, DEPTH = 2;
constexpr int NHEAD = 8, HD = 64, NEXP = 32, DEXP = 512;
constexpr float EPS = 1e-6f;
constexpr float LOG2E = 1.4426950408889634f;

constexpr size_t MiB = 1u << 20;
constexpr size_t WS_CTL = 0;
constexpr size_t WS_MOD = 1 * MiB;
constexpr size_t WS_TBL = 1 * MiB + 512 * 1024;
constexpr size_t WS_RW = 2 * MiB;
constexpr size_t WS_RWB = 2 * MiB + 512 * 1024;
constexpr size_t WS_LIST = 3 * MiB;
constexpr size_t WS_EW = 7 * MiB;
constexpr size_t WS_WIN = 8 * MiB;
constexpr size_t WS_WOUT = 16 * MiB;
constexpr size_t WS_WGU = 20 * MiB;
constexpr size_t WS_WD = 148 * MiB;
constexpr size_t WS_BUF = 212 * MiB;
constexpr size_t WS_U = 276 * MiB;
constexpr size_t WS_Q = 308 * MiB;
constexpr size_t WS_K = 340 * MiB;
constexpr size_t WS_V = 372 * MiB;
constexpr size_t WS_Y = 276 * MiB;
constexpr size_t WS_ACT = 404 * MiB;
constexpr size_t WS_SSQ = 468 * MiB;
constexpr size_t WS_XB = 470 * MiB;
constexpr size_t WS_END = 534 * MiB;

constexpr int LDS_BYTES = 147456;
constexpr int NWAVES = 8, NTHREADS = 512;

struct Params {
    const float* in[20];
    float* out;
    unsigned char* ws;
    int ph_lo, ph_hi;
};

__device__ __forceinline__ unsigned cvtpk(float lo, float hi) { f32x2_t v = {lo, hi}; bf16x2_t b = __builtin_convertvector(v, bf16x2_t); return __builtin_bit_cast(unsigned, b); }
__device__ __forceinline__ float bf_lo(unsigned w) { return __uint_as_float(w << 16); }
__device__ __forceinline__ float bf_hi(unsigned w) { return __uint_as_float(w & 0xffff0000u); }
__device__ __forceinline__ float fast_exp2(float x) { return __builtin_amdgcn_exp2f(x); }
__device__ __forceinline__ float fast_rcp(float x) { return __builtin_amdgcn_rcpf(x); }

__device__ __forceinline__ int opaque_tid() { int t = threadIdx.x; asm volatile("" : "+v"(t)); return t; }
__device__ __forceinline__ int opaque_bid() { int t = blockIdx.x; asm volatile("" : "+s"(t)); return t; }

namespace pg8 {
constexpr int BM = 256, BK = 64, HALF = 128, HTB = HALF * BK * 2, STAGE_BYTES = 8 * HTB, NXCD = 8, WGM = 8;
__host__ __device__ __forceinline__ int lds_byte(int r, int c) { const int st = (r >> 4) * 2 + (c >> 5), rr = r & 15, cc = c & 31, ob = rr * 64 + cc * 2; return st * 1024 + (ob ^ (((ob >> 9) & 1) << 5)); }
__host__ __device__ __forceinline__ void stage_rc(int b, int& R, int& C) { const int st = b / 1024, sb = b % 1024, swz = sb ^ (((sb >> 9) & 1) << 5); R = (st >> 1) * 16 + swz / 64; C = (st & 1) * 32 + (swz % 64) / 2; }
__host__ __device__ __forceinline__ int perm32(int rho) { const int n = rho >> 4, i = rho & 15; return 8 * (i >> 2) + 4 * n + (i & 3); }

struct Unit { int pm, pn, e, rows; };

struct StaticOrder {
    int nM, nN, nwg, G, c;
    __device__ void init(int M, int N, int G_, int c_) { nM = M / BM; nN = N / BM; nwg = nM * nN; G = G_; c = c_; }
    __device__ bool next(int i, Unit& u) const {
        const long L = (long)i * G + c; if (L >= nwg) return false;
        int wgid = (int)L; { const int q = nwg / NXCD, r = nwg % NXCD, xcd = wgid % NXCD, off = wgid / NXCD; wgid = (xcd < r ? xcd * (q + 1) : r * (q + 1) + (xcd - r) * q) + off; }
        const int nig = WGM * nN, gid = wgid / nig, fm = gid * WGM, gsz = (nM - fm) < WGM ? (nM - fm) : WGM;
        u.pm = fm + ((wgid % nig) % gsz); u.pn = (wgid % nig) / gsz; u.e = 0; u.rows = BM; return true;
    }
};

struct GroupedOrder {
    const LAS int* prefix; const LAS int* cnt; int G, v;
    __device__ bool next(int i, Unit& u) const {
        const int L = i * G + v; const int total = prefix[NEXP];
        if (L >= total * 4) return false;
        const int rt = L >> 2; int e = 0;
#pragma unroll 1
        for (int j = 1; j < NEXP; ++j) if (prefix[j] <= rt) e = j;
        u.e = e; u.pm = rt - prefix[e]; u.pn = L & 3; const int rem = cnt[e] - u.pm * BM; u.rows = rem < BM ? rem : BM; return true;
    }
};

template <class G, class Epi, class Sched>
__device__ __forceinline__ void gemm_phase(LAS unsigned char* lds, const G g, const Sched& S, const Epi& E) {
    int tid = threadIdx.x; asm volatile("" : "+v"(tid));
    const int wid = __builtin_amdgcn_readfirstlane(tid >> 6), lane = tid & 63, wr = wid >> 2, wc = wid & 3, fr = lane & 15, fq = lane >> 4;
    const int K = g.K, nt = K / BK;
    int RA[2], CA[2]; unsigned voffB[2];
#pragma unroll
    for (int i = 0; i < 2; ++i) { int R, C; stage_rc(tid * 16 + i * 8192, R, C); const int Rb = Epi::PERM ? ((R & ~31) + perm32(R & 31)) : R;
        RA[i] = R; CA[i] = C; voffB[i] = (unsigned)(Rb * K + C) * 2u; }
    const size_t kstep = (size_t)(BK * 2);
    const size_t hstep = (size_t)HALF * K * 2;
    const unsigned ldsw = (unsigned)wid * 1024u;
    const int aoff = lds_byte(wr * 64 + fr, fq * 8), boff = lds_byte(wc * 32 + fr, fq * 8);
#define PG8_SA(b, h) (((b) * 2 + (h)) * HTB)
#define PG8_SB(b, h) ((4 + (b) * 2 + (h)) * HTB)
#define PG8_STAGE2(bufoff, gbase, o0, o1) do { \
        __builtin_amdgcn_global_load_lds((const unsigned*)((const char*)(gbase) + (o0)), (LAS unsigned*)(lds + (bufoff) + ldsw), 16, 0, 0); \
        __builtin_amdgcn_global_load_lds((const unsigned*)((const char*)(gbase) + (o1)), (LAS unsigned*)(lds + (bufoff) + ldsw + 8192), 16, 0, 0); } while (0)
#define PG8_STAGEB(bufoff, gbase) PG8_STAGE2(bufoff, gbase, voffB[0], voffB[1])
#define PG8_LDA(dst, b, h) do { _Pragma("unroll") for (int m = 0; m < 4; ++m) _Pragma("unroll") for (int k = 0; k < 2; ++k) dst[m][k] = *(const LAS bf16x8*)(lds + PG8_SA(b, h) + aoff + m * 2048 + k * 1024); } while (0)
#define PG8_LDB(dst, b, h) do { _Pragma("unroll") for (int n = 0; n < 2; ++n) _Pragma("unroll") for (int k = 0; k < 2; ++k) dst[n][k] = *(const LAS bf16x8*)(lds + PG8_SB(b, h) + boff + n * 2048 + k * 1024); } while (0)
#define PG8_MMA(ai, bj, At, Bt) do { __builtin_amdgcn_s_setprio(1); _Pragma("unroll") for (int m = 0; m < 4; ++m) _Pragma("unroll") for (int n = 0; n < 2; ++n) _Pragma("unroll") for (int k = 0; k < 2; ++k) \
        acc[ai][bj][m][n] = __builtin_amdgcn_mfma_f32_16x16x32_bf16(Bt[n][k], At[m][k], acc[ai][bj][m][n], 0, 0, 0); __builtin_amdgcn_s_setprio(0); } while (0)
#define PG8_WAIT_V(n) asm volatile("s_waitcnt vmcnt(" #n ")" ::: "memory")
#define PG8_WAIT_L(n) asm volatile("s_waitcnt lgkmcnt(" #n ")" ::: "memory")
#define PG8_BAR __builtin_amdgcn_s_barrier()
#define PG8_SCHED __builtin_amdgcn_sched_barrier(0)
    Unit cur, nxt; int ui = 0;
    if (!S.next(0, cur)) return;
    f32x4 acc[2][2][4][2];
#pragma unroll
    for (int a = 0; a < 2; ++a)
#pragma unroll
        for (int b = 0; b < 2; ++b)
#pragma unroll
            for (int m = 0; m < 4; ++m)
#pragma unroll
                for (int n = 0; n < 2; ++n) acc[a][b][m][n] = (f32x4){0.f, 0.f, 0.f, 0.f};
    bf16x8 At[4][2], B0[2][2], B1[2][2];
    const char* cA = g.a_base(cur); const char* cB = g.b_base(cur);
    unsigned c00 = g.a_off(cur, RA[0], CA[0]), c01 = g.a_off(cur, RA[1], CA[1]), c10 = g.a_off(cur, HALF + RA[0], CA[0]), c11 = g.a_off(cur, HALF + RA[1], CA[1]);
    PG8_STAGEB(PG8_SB(0, 0), cB); PG8_STAGEB(PG8_SB(0, 1), cB + hstep); PG8_STAGE2(PG8_SA(0, 0), cA, c00, c01); PG8_STAGE2(PG8_SA(0, 1), cA, c10, c11);
    if (wr == 1) PG8_BAR;
    PG8_WAIT_V(2); PG8_BAR;
    PG8_STAGEB(PG8_SB(1, 0), cB + kstep); PG8_STAGE2(PG8_SA(1, 0), cA + kstep, c00, c01); PG8_STAGEB(PG8_SB(1, 1), cB + hstep + kstep);
    PG8_WAIT_V(6); PG8_BAR;
    for (;;) {
        const bool has_next = S.next(ui + 1, nxt);
        const char* nA = has_next ? g.a_base(nxt) : cA; const char* nB = has_next ? g.b_base(nxt) : cB;
        unsigned n00 = c00, n01 = c01, n10 = c10, n11 = c11;
        if (G::GATHER && has_next) { n00 = g.a_off(nxt, RA[0], CA[0]); n01 = g.a_off(nxt, RA[1], CA[1]); n10 = g.a_off(nxt, HALF + RA[0], CA[0]); n11 = g.a_off(nxt, HALF + RA[1], CA[1]); }
        for (int t = 0; t < nt; t += 2) {
            const bool last = (t == nt - 2);
            const char* a1 = cA + (size_t)(t + 1) * kstep;
            const char* a2 = last ? nA : cA + (size_t)(t + 2) * kstep; const char* b2 = last ? nB : cB + (size_t)(t + 2) * kstep;
            const char* a3 = a2 + kstep; const char* b3 = b2 + kstep;
            const unsigned x00 = last ? n00 : c00, x01 = last ? n01 : c01, x10 = last ? n10 : c10, x11 = last ? n11 : c11;
            PG8_LDB(B0, 0, 0); PG8_LDB(B1, 0, 1); PG8_SCHED; PG8_LDA(At, 0, 0); PG8_STAGE2(PG8_SA(1, 1), a1, c10, c11);
            PG8_WAIT_V(8); PG8_WAIT_L(0); PG8_BAR; PG8_MMA(0, 0, At, B0); PG8_MMA(0, 1, At, B1); PG8_BAR; PG8_SCHED;
            PG8_LDA(At, 0, 1); PG8_STAGEB(PG8_SB(0, 0), b2); PG8_STAGEB(PG8_SB(0, 1), b2 + hstep); PG8_STAGE2(PG8_SA(0, 0), a2, x00, x01);
            PG8_WAIT_V(8); PG8_WAIT_L(0); PG8_BAR; PG8_MMA(1, 0, At, B0); PG8_MMA(1, 1, At, B1); PG8_BAR; PG8_SCHED;
            PG8_LDB(B0, 1, 0); PG8_LDB(B1, 1, 1); PG8_SCHED; PG8_LDA(At, 1, 0); PG8_STAGE2(PG8_SA(0, 1), a2, x10, x11);
            PG8_WAIT_V(8); PG8_WAIT_L(0); PG8_BAR; PG8_MMA(0, 0, At, B0); PG8_MMA(0, 1, At, B1); PG8_BAR; PG8_SCHED;
            PG8_LDA(At, 1, 1); PG8_STAGEB(PG8_SB(1, 0), b3); PG8_STAGEB(PG8_SB(1, 1), b3 + hstep); PG8_STAGE2(PG8_SA(1, 0), a3, x00, x01);
            PG8_WAIT_V(8); PG8_WAIT_L(0); PG8_BAR; PG8_MMA(1, 0, At, B0); PG8_MMA(1, 1, At, B1); PG8_BAR; PG8_SCHED;
        }
        if (wr == 0) PG8_BAR;
        E(acc, cur, wr, wc, fr, fq);
        if (!has_next) break;
#pragma unroll
        for (int a = 0; a < 2; ++a)
#pragma unroll
            for (int b = 0; b < 2; ++b)
#pragma unroll
                for (int m = 0; m < 4; ++m)
#pragma unroll
                    for (int n = 0; n < 2; ++n) acc[a][b][m][n] = (f32x4){0.f, 0.f, 0.f, 0.f};
        cur = nxt; cA = nA; cB = nB; c00 = n00; c01 = n01; c10 = n10; c11 = n11; ++ui;
        if (wr == 1) PG8_BAR;
    }
    PG8_WAIT_V(0);
    PG8_BAR;
#undef PG8_SA
#undef PG8_SB
#undef PG8_STAGE2
#undef PG8_STAGEB
#undef PG8_LDA
#undef PG8_LDB
#undef PG8_MMA
#undef PG8_WAIT_V
#undef PG8_WAIT_L
#undef PG8_BAR
#undef PG8_SCHED
}
}
using pg8::Unit;

struct DenseGemm {
    static constexpr bool GATHER = false;
    const bf16_t* A; const bf16_t* Bt; int K;
    __device__ __forceinline__ const char* a_base(const Unit& u) const { return (const char*)A + (size_t)u.pm * 256 * K * 2; }
    __device__ __forceinline__ const char* b_base(const Unit& u) const { return (const char*)Bt + (size_t)u.pn * 256 * K * 2; }
    __device__ __forceinline__ unsigned a_off(const Unit&, int r, int c) const { return (unsigned)(r * K + c) * 2u; }
};
struct GatherGemm {
    static constexpr bool GATHER = true;
    const bf16_t* A; const bf16_t* Bt; const int* list; int K; int a_shift;
    size_t b_expert_stride;
    __device__ __forceinline__ const char* a_base(const Unit&) const { return (const char*)A; }
    __device__ __forceinline__ const char* b_base(const Unit& u) const { return (const char*)Bt + (size_t)u.e * b_expert_stride + (size_t)u.pn * 256 * K * 2; }
    __device__ __forceinline__ unsigned a_off(const Unit& u, int r, int c) const {
        const int rr = r < u.rows ? r : u.rows - 1;
        const int slot = list[(size_t)u.e * NTOK + u.pm * 256 + rr];
        return (unsigned)((slot >> a_shift) * K + c) * 2u;
    }
};


struct EpiIn {
    static constexpr bool PERM = true;
    bf16_t* U; bf16_t* Qf; bf16_t* Kf; const float* qg; const float* kg;
    __device__ __forceinline__ void operator()(const f32x4 (&acc)[2][2][4][2], const Unit& u, int wr, int wc, int fr, int fq) const {
        if (u.pn < 2) {
#pragma unroll
            for (int ai = 0; ai < 2; ++ai)
#pragma unroll
                for (int m = 0; m < 4; ++m) {
                    const int row = u.pm * 256 + ai * 128 + wr * 64 + m * 16 + fr;
#pragma unroll
                    for (int bj = 0; bj < 2; ++bj) {
                        const f32x4 v0 = acc[ai][bj][m][0], v1 = acc[ai][bj][m][1];
                        u32x4 w; w.x = cvtpk(v0[0], v0[1]); w.y = cvtpk(v0[2], v0[3]); w.z = cvtpk(v1[0], v1[1]); w.w = cvtpk(v1[2], v1[3]);
                        *(u32x4*)(U + (size_t)row * 512 + u.pn * 256 + bj * 128 + wc * 32 + fq * 8) = w;
                    }
                }
        } else {
            const bool isq = u.pn < 4;
            const float* gg = isq ? qg : kg; bf16_t* dst = isq ? Qf : Kf;
            const float osc = isq ? 0.125f * LOG2E : 1.0f;
            const int head = (u.pn & 1) * 4 + wc;
            f32x4 gv[2][2];
#pragma unroll
            for (int bj = 0; bj < 2; ++bj)
#pragma unroll
                for (int n = 0; n < 2; ++n) gv[bj][n] = *(const f32x4*)(gg + bj * 32 + fq * 8 + n * 4) * osc;
#pragma unroll
            for (int ai = 0; ai < 2; ++ai)
#pragma unroll
                for (int m = 0; m < 4; ++m) {
                    float ss = 0.f;
#pragma unroll
                    for (int bj = 0; bj < 2; ++bj)
#pragma unroll
                        for (int n = 0; n < 2; ++n) { const f32x4 v = acc[ai][bj][m][n]; ss += (v[0] * v[0] + v[1] * v[1]) + (v[2] * v[2] + v[3] * v[3]); }
                    ss += __shfl_xor(ss, 16); ss += __shfl_xor(ss, 32);
                    const float rstd = rsqrtf(ss * (1.0f / 64.0f) + EPS);
                    const int row = u.pm * 256 + ai * 128 + wr * 64 + m * 16 + fr;
                    const int b = row >> 13, s = row & (SEQ - 1), rb = s >> 5, r32 = s & 31;
#pragma unroll
                    for (int bj = 0; bj < 2; ++bj) {
                        const f32x4 v0 = acc[ai][bj][m][0] * rstd * gv[bj][0], v1 = acc[ai][bj][m][1] * rstd * gv[bj][1];
                        u32x4 w; w.x = cvtpk(v0[0], v0[1]); w.y = cvtpk(v0[2], v0[3]); w.z = cvtpk(v1[0], v1[1]); w.w = cvtpk(v1[2], v1[3]);
                        const int d0 = 2 * bj + (fq >> 1), hi = fq & 1;
                        const size_t piece = (((size_t)(b * NHEAD + head) * 256 + rb) * 4 + d0);
                        *(u32x4*)(dst + (piece * 64 + hi * 32 + r32) * 8) = w;
                    }
                }
        }
    }
};

struct EpiVt {
    static constexpr bool PERM = true;
    bf16_t* Vf;
    __device__ __forceinline__ void operator()(const f32x4 (&acc)[2][2][4][2], const Unit& u, int wr, int wc, int fr, int fq) const {
#pragma unroll
        for (int ai = 0; ai < 2; ++ai)
#pragma unroll
            for (int m = 0; m < 4; ++m) {
                const int hd = u.pm * 256 + ai * 128 + wr * 64 + m * 16 + fr;
                const int head = hd >> 6, dblk = (hd >> 5) & 1, dl = hd & 31;
#pragma unroll
                for (int bj = 0; bj < 2; ++bj) {
                    const int tok0 = u.pn * 256 + bj * 128 + wc * 32;
                    const int b = tok0 >> 13, kb = (tok0 & (SEQ - 1)) >> 5;
                    const size_t piece = ((((size_t)(b * NHEAD + head) * 256 + kb) * 2 + (fq >> 1)) * 2 + dblk);
#pragma unroll
                    for (int n = 0; n < 2; ++n) {
                        const f32x4 v = acc[ai][bj][m][n];
                        u32x2 w; w.x = cvtpk(v[0], v[1]); w.y = cvtpk(v[2], v[3]);
                        *(u32x2*)((char*)Vf + (piece * 64 + n * 32 + dl) * 16 + (fq & 1) * 8) = w;
                    }
                }
            }
    }
};

template <bool XF>
struct EpiOutB {
    static constexpr bool PERM = true;
    const float* xf; bf16_t* XB; const float* g1; float* ssq;
    __device__ __forceinline__ void operator()(const f32x4 (&acc)[2][2][4][2], const Unit& u, int wr, int wc, int fr, int fq) const {
        const int b = (u.pm * 256) >> 13;
        const int col0 = u.pn * 256 + wc * 32 + 8 * fq;
        f32x4 gv[2][2];
#pragma unroll
        for (int bj = 0; bj < 2; ++bj)
#pragma unroll
            for (int n = 0; n < 2; ++n) gv[bj][n] = *(const f32x4*)(g1 + (size_t)b * 6144 + col0 + bj * 128 + n * 4);
#pragma unroll
        for (int ai = 0; ai < 2; ++ai)
#pragma unroll
            for (int m = 0; m < 4; ++m) {
                const int row = u.pm * 256 + ai * 128 + wr * 64 + m * 16 + fr;
                const size_t off = (size_t)row * DM + col0;
                f32x4 xb[2][2];
                if (XF) {
#pragma unroll
                    for (int bj = 0; bj < 2; ++bj) { xb[bj][0] = *(const f32x4*)(xf + off + bj * 128); xb[bj][1] = *(const f32x4*)(xf + off + bj * 128 + 4); }
                } else {
#pragma unroll
                    for (int bj = 0; bj < 2; ++bj) { const u32x4 w = *(const u32x4*)(XB + off + bj * 128);
                        xb[bj][0] = (f32x4){bf_lo(w.x), bf_hi(w.x), bf_lo(w.y), bf_hi(w.y)}; xb[bj][1] = (f32x4){bf_lo(w.z), bf_hi(w.z), bf_lo(w.w), bf_hi(w.w)}; }
                }
                float ss = 0.f;
#pragma unroll
                for (int bj = 0; bj < 2; ++bj) {
                    const f32x4 x0 = xb[bj][0] + gv[bj][0] * acc[ai][bj][m][0], x1 = xb[bj][1] + gv[bj][1] * acc[ai][bj][m][1];
                    u32x4 w; w.x = cvtpk(x0[0], x0[1]); w.y = cvtpk(x0[2], x0[3]); w.z = cvtpk(x1[0], x1[1]); w.w = cvtpk(x1[2], x1[3]);
                    *(u32x4*)(XB + off + bj * 128) = w;
                    const float r0 = bf_lo(w.x), r1 = bf_hi(w.x), r2 = bf_lo(w.y), r3 = bf_hi(w.y), r4 = bf_lo(w.z), r5 = bf_hi(w.z), r6 = bf_lo(w.w), r7 = bf_hi(w.w);
                    ss += ((r0 * r0 + r1 * r1) + (r2 * r2 + r3 * r3)) + ((r4 * r4 + r5 * r5) + (r6 * r6 + r7 * r7));
                }
                ss += __shfl_xor(ss, 16); ss += __shfl_xor(ss, 32);
                if (fq == 0) ssq[(size_t)row * 16 + u.pn * 4 + wc] = ss;
            }
    }
};

struct EpiGU {
    static constexpr bool PERM = true;
    bf16_t* ACT; const int* list;
    __device__ __forceinline__ void operator()(const f32x4 (&acc)[2][2][4][2], const Unit& u, int wr, int wc, int fr, int fq) const {
#pragma unroll
        for (int ai = 0; ai < 2; ++ai)
#pragma unroll
            for (int m = 0; m < 4; ++m) {
                const int r = ai * 128 + wr * 64 + m * 16 + fr;
                if (r < u.rows) {
                    const int slot = list[(size_t)u.e * NTOK + u.pm * 256 + r];
                    float o[8];
#pragma unroll
                    for (int n = 0; n < 2; ++n)
#pragma unroll
                        for (int e = 0; e < 4; ++e) { const float gte = acc[ai][0][m][n][e], up = acc[ai][1][m][n][e];
                            o[n * 4 + e] = gte * fast_rcp(1.0f + fast_exp2(-gte * LOG2E)) * up; }
                    u32x4 w; w.x = cvtpk(o[0], o[1]); w.y = cvtpk(o[2], o[3]); w.z = cvtpk(o[4], o[5]); w.w = cvtpk(o[6], o[7]);
                    *(u32x4*)(ACT + (size_t)slot * DEXP + u.pn * 128 + wc * 32 + fq * 8) = w;
                }
            }
    }
};

struct EpiDn {
    static constexpr bool PERM = true;
    unsigned char* Y8; const int* list; const float* ew;
    __device__ __forceinline__ void operator()(const f32x4 (&acc)[2][2][4][2], const Unit& u, int wr, int wc, int fr, int fq) const {
#pragma unroll
        for (int ai = 0; ai < 2; ++ai)
#pragma unroll
            for (int m = 0; m < 4; ++m) {
                const int r = ai * 128 + wr * 64 + m * 16 + fr;
                if (r < u.rows) {
                    const int slot = list[(size_t)u.e * NTOK + u.pm * 256 + r];
                    const float w8 = ew[slot] * 16.0f;
#pragma unroll
                    for (int bj = 0; bj < 2; ++bj) {
                        const f32x4 v0 = acc[ai][bj][m][0] * w8, v1 = acc[ai][bj][m][1] * w8;
                        int lo = 0, hi = 0;
                        lo = __builtin_amdgcn_cvt_pk_fp8_f32(v0[0], v0[1], lo, false); lo = __builtin_amdgcn_cvt_pk_fp8_f32(v0[2], v0[3], lo, true);
                        hi = __builtin_amdgcn_cvt_pk_fp8_f32(v1[0], v1[1], hi, false); hi = __builtin_amdgcn_cvt_pk_fp8_f32(v1[2], v1[3], hi, true);
                        u32x2 w; w.x = (unsigned)lo; w.y = (unsigned)hi;
                        *(u32x2*)(Y8 + (size_t)slot * DM + u.pn * 256 + bj * 128 + wc * 32 + fq * 8) = w;
                    }
                }
            }
    }
};

struct TItem { const float* src; bf16_t* dst; int N, dstK, koff, k0, n0, map; };
__device__ __forceinline__ int t_rowmap(int map, int n) {
    if (map == 0) return n;
    if (map == 1) { if (n < 512 || n >= 1536) return n; const int t = n & 255, wc = t >> 6, bj = (t >> 5) & 1, c = t & 31; return (n & ~255) + 128 * bj + 32 * wc + c; }
    return 256 * (n >> 7) + 128 * (map - 2) + (n & 127);
}
__device__ __forceinline__ void t_load(const TItem& d, f32x4 (&v)[16], int lane) {
    const int kr = lane >> 4, c4 = lane & 15;
#pragma unroll
    for (int i = 0; i < 16; ++i) v[i] = *(const f32x4*)(d.src + (size_t)(d.k0 + 4 * i + kr) * d.N + d.n0 + 4 * c4);
}
__device__ __forceinline__ void t_process(const TItem& d, const f32x4 (&v)[16], LAS float* scr, int lane) {
    const int kr = lane >> 4, c4 = lane & 15;
#pragma unroll
    for (int i = 0; i < 16; ++i) { LAS float* s = scr + (4 * i + kr) * 65 + 4 * c4; s[0] = v[i][0]; s[1] = v[i][1]; s[2] = v[i][2]; s[3] = v[i][3]; }
    asm volatile("s_waitcnt lgkmcnt(0)" ::: "memory");
    const int nr = lane >> 3, kc = lane & 7;
#pragma unroll
    for (int i = 0; i < 8; ++i) { const int n = 8 * i + nr; const LAS float* s = scr + (8 * kc) * 65 + n;
        u32x4 o; o.x = cvtpk(s[0], s[65]); o.y = cvtpk(s[2 * 65], s[3 * 65]); o.z = cvtpk(s[4 * 65], s[5 * 65]); o.w = cvtpk(s[6 * 65], s[7 * 65]);
        *(u32x4*)(d.dst + (size_t)t_rowmap(d.map, d.n0 + n) * d.dstK + d.koff + d.k0 + 8 * kc) = o; }
    asm volatile("s_waitcnt lgkmcnt(0)" ::: "memory");
}
constexpr int T_IN = 512, T_OUT = 128, T_E = 128, T_MOE = NEXP * 3 * T_E, T_PER_LAYER = T_IN + T_OUT + T_MOE;
constexpr int T_NA = T_PER_LAYER + T_IN + T_OUT, T_NB = T_MOE;
__device__ __forceinline__ void t_decode_lr(const Params& p, int l, int r, TItem& d) {
    unsigned char* ws = p.ws;
    if (r < T_IN) { d.src = p.in[6] + (size_t)l * 1024 * 2048; d.N = 2048; d.dst = (bf16_t*)(ws + WS_WIN) + (size_t)l * 2048 * 1024; d.dstK = 1024; d.koff = 0; d.k0 = (r >> 5) * 64; d.n0 = (r & 31) * 64; d.map = 1; return; }
    r -= T_IN;
    if (r < T_OUT) { d.src = p.in[12] + ((size_t)l * 1024 + 512) * 1024; d.N = 1024; d.dst = (bf16_t*)(ws + WS_WOUT) + (size_t)l * 1024 * 1024; d.dstK = 1024; d.koff = 512; d.k0 = (r >> 4) * 64; d.n0 = (r & 15) * 64; d.map = 0; return; }
    r -= T_OUT;
    const int e = r / (3 * T_E); int q = r % (3 * T_E);
    if (q < 2 * T_E) { const int up = q >= T_E; if (up) q -= T_E;
        d.src = p.in[up ? 18 : 17] + ((size_t)l * NEXP + e) * 1024 * 512; d.N = 512; d.dst = (bf16_t*)(ws + WS_WGU) + ((size_t)l * NEXP + e) * 1024 * 1024; d.dstK = 1024; d.koff = 0; d.k0 = (q >> 3) * 64; d.n0 = (q & 7) * 64; d.map = 2 + up; return; }
    q -= 2 * T_E;
    d.src = p.in[19] + ((size_t)l * NEXP + e) * 512 * 1024; d.N = 1024; d.dst = (bf16_t*)(ws + WS_WD) + ((size_t)l * NEXP + e) * 1024 * 512; d.dstK = 512; d.koff = 0; d.k0 = (q >> 4) * 64; d.n0 = (q & 15) * 64; d.map = 0;
}
template <bool SPACE_B>
__device__ __forceinline__ void t_decode(const Params& p, int it, TItem& d) {
    if (SPACE_B) t_decode_lr(p, 1, T_IN + T_OUT + it, d);
    else if (it < T_PER_LAYER) t_decode_lr(p, 0, it, d);
    else t_decode_lr(p, 1, it - T_PER_LAYER, d);
}
template <bool SPACE_B>
__device__ __forceinline__ void t_run(const Params& p, int it, int stride, int nit, LAS float* scr, int lane) {
    if (it >= nit) return;
    TItem dA, dB; f32x4 vA[16], vB[16];
    t_decode<SPACE_B>(p, it, dA); t_load(dA, vA, lane);
    for (;;) {
        int nx = it + stride; const bool hasB = nx < nit;
        if (hasB) { t_decode<SPACE_B>(p, nx, dB); t_load(dB, vB, lane); }
        t_process(dA, vA, scr, lane);
        if (!hasB) break;
        it = nx + stride; const bool hasA = it < nit;
        if (hasA) { t_decode<SPACE_B>(p, it, dA); t_load(dA, vA, lane); }
        t_process(dB, vB, scr, lane);
        if (!hasA) break;
    }
}
__device__ __forceinline__ void tail_convert(const Params& p, LAS unsigned char* lds, int total_units, int v, int first, int count) {
    const int tid = opaque_tid(), lane = tid & 63, wave = tid >> 6, G = gridDim.x;
    const int rem = total_units % G;
    const int nshare = rem ? G - rem : G, sidx = rem ? v - rem : v;
    __syncthreads();
    if (sidx >= 0) t_run<true>(p, first + sidx + nshare * wave, nshare * NWAVES, first + count, (LAS float*)(lds + wave * 16640), lane);
    __syncthreads();
}

__device__ __forceinline__ void phase_prologue(const Params& p, LAS unsigned char* lds) {
    const int tid = opaque_tid(), lane = tid & 63, wave = tid >> 6, G = gridDim.x;
    unsigned char* ws = p.ws;
    {
        LAS float* cact = (LAS float*)lds;
        LAS float* red = (LAS float*)(lds + 16384);
        const float* c = p.in[1];
        for (int i = tid; i < 4096; i += NTHREADS) { const float v = c[i]; cact[i] = v / (1.0f + __expf(-v)); }
        __syncthreads();
        float* mod = (float*)(ws + WS_MOD);
        for (int item = blockIdx.x; item < 2 * 192; item += G) {
            const int l = item / 192, cgp = item % 192;
            const float* W = p.in[2] + (size_t)l * 1024 * 6144 + cgp * 32;
            const int col = lane & 31, rsub = lane >> 5;
            float a0 = 0.f, a1 = 0.f, a2 = 0.f, a3 = 0.f;
#pragma unroll 16
            for (int i = 0; i < 64; ++i) { const int k = wave * 128 + 2 * i + rsub; const float w = W[(size_t)k * 6144 + col];
                a0 += cact[k] * w; a1 += cact[1024 + k] * w; a2 += cact[2048 + k] * w; a3 += cact[3072 + k] * w; }
            a0 += __shfl_xor(a0, 32); a1 += __shfl_xor(a1, 32); a2 += __shfl_xor(a2, 32); a3 += __shfl_xor(a3, 32);
            if (lane < 32) { red[(wave * 4 + 0) * 32 + col] = a0; red[(wave * 4 + 1) * 32 + col] = a1; red[(wave * 4 + 2) * 32 + col] = a2; red[(wave * 4 + 3) * 32 + col] = a3; }
            __syncthreads();
            if (tid < 128) { const int b = tid >> 5, cc = tid & 31; float s = 0.f;
#pragma unroll
                for (int w = 0; w < 8; ++w) s += red[(w * 4 + b) * 32 + cc];
                mod[(size_t)(l * 4 + b) * 6144 + cgp * 32 + cc] = s + p.in[3][l * 6144 + cgp * 32 + cc]; }
            __syncthreads();
        }
    }
    {
        float* tbl = (float*)(ws + WS_TBL);
        for (int job = blockIdx.x; job < 2; job += G) {
            const int l = job;
            LAS float* sm = (LAS float*)(lds + 32768);
            float mq = 0.f, mk = 0.f, mb = 0.f;
            if (tid < 64) { mq = fabsf(p.in[9][l * 64 + tid]); mk = fabsf(p.in[10][l * 64 + tid]); }
            for (int i = tid; i < NHEAD * 257; i += NTHREADS) mb = fmaxf(mb, fabsf(p.in[11][i]));
#pragma unroll
            for (int o = 1; o < 64; o <<= 1) { mq = fmaxf(mq, __shfl_xor(mq, o)); mk = fmaxf(mk, __shfl_xor(mk, o)); mb = fmaxf(mb, __shfl_xor(mb, o)); }
            if (lane == 0) { sm[wave * 4 + 0] = mq; sm[wave * 4 + 1] = mk; sm[wave * 4 + 2] = mb; }
            __syncthreads();
            mq = 0.f; mk = 0.f; mb = 0.f;
            for (int w = 0; w < 8; ++w) { mq = fmaxf(mq, sm[w * 4 + 0]); mk = fmaxf(mk, sm[w * 4 + 1]); mb = fmaxf(mb, sm[w * 4 + 2]); }
            const float shift = LOG2E * (8.0f * mq * mk + mb);
            for (int i = tid; i < NHEAD * 256; i += NTHREADS) { const int h = i >> 8, j = i & 255; int rel = j - 63; if (rel > 128) rel = 128;
                tbl[(size_t)l * 2048 + i] = (j < 255) ? p.in[11][h * 257 + rel + 128] * LOG2E - shift : 0.f; }
            __syncthreads();
        }
        for (int job = blockIdx.x; job < 2 * 48; job += G) {
            const int l = job / 48, n = job % 48;
            bf16_t* hi = (bf16_t*)(ws + WS_RW) + (size_t)l * 2 * 48 * 1024;
            bf16_t* lo = hi + 48 * 1024;
            for (int k = tid; k < 1024; k += NTHREADS) {
                float w = 0.f;
                if (n < 32) w = p.in[15][((size_t)l * 1024 + k) * 32 + n]; else if (n < 36) w = p.in[13][((size_t)l * 1024 + k) * 4 + (n - 32)];
                const unsigned h2 = cvtpk(w, 0.f) & 0xffffu; const float r = w - bf_lo(h2);
                const size_t idx = ((size_t)((k >> 5) * 3 + (n >> 4)) * 64 + ((k & 31) >> 3) * 16 + (n & 15)) * 8 + (k & 7);
                hi[idx] = (bf16_t)h2; lo[idx] = (bf16_t)(cvtpk(r, 0.f) & 0xffffu);
            }
            if (tid == 0) { float bsv = 0.f; if (n < 32) bsv = p.in[16][l * 32 + n]; else if (n < 36) bsv = p.in[14][l * 4 + (n - 32)]; ((float*)(ws + WS_RWB))[l * 48 + n] = bsv; }
        }
    }
    __syncthreads();
    {
        LAS float* wsc = (LAS float*)lds;
        LAS float* pwl = (LAS float*)(lds + 32768);
        for (int item = blockIdx.x; item < 2 * 4 * 16; item += G) {
            const int l = item >> 6, g = (item >> 4) & 3, nb = item & 15;
            const float* wo = p.in[12] + ((size_t)l * 1024 + g * 128) * 1024 + nb * 64;
            const float* sc = p.in[8] + l * 512 + g * 128;
            const float* pw = p.in[7] + ((size_t)l * 4 + g) * 128 * 128;
            for (int i = tid; i < 128 * 64; i += NTHREADS) { const int d = i >> 6, n = i & 63; wsc[i] = wo[(size_t)d * 1024 + n] * sc[d]; }
            for (int i = tid; i < 128 * 128 / 4; i += NTHREADS) *(LAS f32x4*)(pwl + 4 * i) = *(const f32x4*)(pw + 4 * i);
            __syncthreads();
            const int n = tid & 63, cgp = tid >> 6;
            float a[16];
#pragma unroll
            for (int j = 0; j < 16; ++j) a[j] = 0.f;
#pragma unroll 2
            for (int d4 = 0; d4 < 32; ++d4) {
                const float w0 = wsc[(4 * d4 + 0) * 64 + n], w1 = wsc[(4 * d4 + 1) * 64 + n], w2 = wsc[(4 * d4 + 2) * 64 + n], w3 = wsc[(4 * d4 + 3) * 64 + n];
#pragma unroll
                for (int j = 0; j < 16; ++j) { const f32x4 pv = *(const LAS f32x4*)(pwl + (cgp * 16 + j) * 128 + 4 * d4); a[j] += (pv[0] * w0 + pv[1] * w1) + (pv[2] * w2 + pv[3] * w3); }
            }
            bf16_t* dst = (bf16_t*)(ws + WS_WOUT) + ((size_t)l * 1024 + nb * 64 + n) * 1024 + g * 128 + cgp * 16;
            u32x4 o0, o1; o0.x = cvtpk(a[0], a[1]); o0.y = cvtpk(a[2], a[3]); o0.z = cvtpk(a[4], a[5]); o0.w = cvtpk(a[6], a[7]);
            o1.x = cvtpk(a[8], a[9]); o1.y = cvtpk(a[10], a[11]); o1.z = cvtpk(a[12], a[13]); o1.w = cvtpk(a[14], a[15]);
            *(u32x4*)dst = o0; *(u32x4*)(dst + 8) = o1;
            __syncthreads();
        }
    }
    {
        LAS float* scr = (LAS float*)(lds + wave * 16640);
        t_run<false>(p, blockIdx.x * NWAVES + wave, G * NWAVES, T_NA, scr, lane);
    }
}

typedef float f32x2v __attribute__((ext_vector_type(2)));
__device__ __forceinline__ f32x4 y_pair_sum(const unsigned char* Y8, size_t row, int c) {
    const int a = *(const int*)(Y8 + (size_t)(2 * row) * DM + c), b = *(const int*)(Y8 + (size_t)(2 * row + 1) * DM + c);
    const f32x2v a0 = __builtin_amdgcn_cvt_pk_f32_fp8(a, false), a1 = __builtin_amdgcn_cvt_pk_f32_fp8(a, true);
    const f32x2v b0 = __builtin_amdgcn_cvt_pk_f32_fp8(b, false), b1 = __builtin_amdgcn_cvt_pk_f32_fp8(b, true);
    f32x4 ys; ys[0] = (a0[0] + b0[0]) * 0.0625f; ys[1] = (a0[1] + b0[1]) * 0.0625f; ys[2] = (a1[0] + b1[0]) * 0.0625f; ys[3] = (a1[1] + b1[1]) * 0.0625f; return ys;
}
template <int NR, bool UPD>
__device__ __forceinline__ void norm1_rows(const Params& p, int l, int row0, int lane) {
    const float* mod = (const float*)(p.ws + WS_MOD);
    const float* gn = p.in[4] + l * 1024;
    bf16_t* H = (bf16_t*)(p.ws + WS_BUF);
    const unsigned char* Y = (const unsigned char*)(p.ws + WS_Y);
    bf16_t* XB = (bf16_t*)(p.ws + WS_XB);
    const int b = row0 >> 13;
    f32x4 v[NR][4];
    if (!UPD) {
#pragma unroll
        for (int r = 0; r < NR; ++r)
#pragma unroll
            for (int j = 0; j < 4; ++j) v[r][j] = *(const f32x4*)(p.in[0] + (size_t)(row0 + r) * DM + 4 * lane + 256 * j);
    } else {
        const float* g2 = mod + (size_t)((l - 1) * 4 + b) * 6144 + 5120;
        f32x4 ys[NR][4];
#pragma unroll
        for (int r = 0; r < NR; ++r)
#pragma unroll
            for (int j = 0; j < 4; ++j) { const int c = 4 * lane + 256 * j; const u32x2 xw = *(const u32x2*)(XB + (size_t)(row0 + r) * DM + c);
                v[r][j] = (f32x4){bf_lo(xw.x), bf_hi(xw.x), bf_lo(xw.y), bf_hi(xw.y)}; ys[r][j] = y_pair_sum(Y, row0 + r, c); }
#pragma unroll
        for (int j = 0; j < 4; ++j) { const f32x4 gg = *(const f32x4*)(g2 + 4 * lane + 256 * j);
#pragma unroll
            for (int r = 0; r < NR; ++r) { const f32x4 xn = v[r][j] + gg * ys[r][j]; u32x2 xw; xw.x = cvtpk(xn[0], xn[1]); xw.y = cvtpk(xn[2], xn[3]);
                *(u32x2*)(XB + (size_t)(row0 + r) * DM + 4 * lane + 256 * j) = xw;
                v[r][j] = (f32x4){bf_lo(xw.x), bf_hi(xw.x), bf_lo(xw.y), bf_hi(xw.y)}; } }
    }
    float ss[NR];
#pragma unroll
    for (int r = 0; r < NR; ++r) { ss[r] = 0.f;
#pragma unroll
        for (int j = 0; j < 4; ++j) ss[r] += (v[r][j][0] * v[r][j][0] + v[r][j][1] * v[r][j][1]) + (v[r][j][2] * v[r][j][2] + v[r][j][3] * v[r][j][3]); }
#pragma unroll
    for (int o = 1; o < 64; o <<= 1)
#pragma unroll
        for (int r = 0; r < NR; ++r) ss[r] += __shfl_xor(ss[r], o);
    const float* sh = mod + (size_t)(l * 4 + b) * 6144; const float* sc = sh + 1024;
#pragma unroll
    for (int j = 0; j < 4; ++j) {
        const int c = 4 * lane + 256 * j;
        const f32x4 g = *(const f32x4*)(gn + c), s1 = *(const f32x4*)(sc + c), s0 = *(const f32x4*)(sh + c);
        const f32x4 a = g * (s1 + 1.0f);
#pragma unroll
        for (int r = 0; r < NR; ++r) {
            const float rstd = rsqrtf(ss[r] * (1.0f / DM) + EPS);
            const f32x4 h = v[r][j] * rstd * a + s0;
            u32x2 w; w.x = cvtpk(h[0], h[1]); w.y = cvtpk(h[2], h[3]);
            *(u32x2*)(H + (size_t)(row0 + r) * DM + c) = w;
        }
    }
}
__device__ __forceinline__ void phase_norm1(const Params& p, int l) {
    const int tid = opaque_tid(), lane = tid & 63, wave = tid >> 6, G = gridDim.x;
    const int gw = blockIdx.x * NWAVES + wave, NGW = G * NWAVES;
    if (l == 0) { for (int rq = gw; rq < NTOK / 4; rq += NGW) norm1_rows<4, false>(p, l, rq * 4, lane); }
    else { for (int rq = gw; rq < NTOK / 2; rq += NGW) norm1_rows<2, true>(p, l, rq * 2, lane); }
}

__device__ __forceinline__ void phase_final(const Params& p) {
    const int tid = opaque_tid(), lane = tid & 63, wave = tid >> 6, G = gridDim.x;
    const int gw = blockIdx.x * NWAVES + wave, NGW = G * NWAVES;
    const float* mod = (const float*)(p.ws + WS_MOD);
    const unsigned char* Y = (const unsigned char*)(p.ws + WS_Y);
    const bf16_t* XB = (const bf16_t*)(p.ws + WS_XB);
    constexpr int NR = 4;
    for (int rq = gw; rq < NTOK / NR; rq += NGW) {
        const int row0 = rq * NR, b = row0 >> 13;
        const float* g2 = mod + (size_t)((DEPTH - 1) * 4 + b) * 6144 + 5120;
        f32x4 v[NR][4], ys[NR][4];
#pragma unroll
        for (int r = 0; r < NR; ++r)
#pragma unroll
            for (int j = 0; j < 4; ++j) { const int c = 4 * lane + 256 * j; const u32x2 xw = *(const u32x2*)(XB + (size_t)(row0 + r) * DM + c);
                v[r][j] = (f32x4){bf_lo(xw.x), bf_hi(xw.x), bf_lo(xw.y), bf_hi(xw.y)}; ys[r][j] = y_pair_sum(Y, row0 + r, c); }
#pragma unroll
        for (int j = 0; j < 4; ++j) { const f32x4 gg = *(const f32x4*)(g2 + 4 * lane + 256 * j);
#pragma unroll
            for (int r = 0; r < NR; ++r) *(f32x4*)(p.out + (size_t)(row0 + r) * DM + 4 * lane + 256 * j) = v[r][j] + gg * ys[r][j]; }
    }
}

__device__ __forceinline__ int crow(int r, int hi) { return (r & 3) + 8 * (r >> 2) + 4 * hi; }

__device__ __forceinline__ void pool_strip(const Params& p, int strip, int lane) {
    const bf16_t* U = (const bf16_t*)(p.ws + WS_U); bf16_t* MIX = (bf16_t*)(p.ws + WS_BUF);
    const int tok0 = strip * 16, s0 = tok0 & (SEQ - 1);
    const int win = 2 << (lane >> 4);
    float S[8];
#pragma unroll
    for (int j = 0; j < 8; ++j) S[j] = 0.f;
#pragma unroll
    for (int d = 1; d < 16; ++d) {
        if (d < win && s0 - d >= 0) {
            const u32x4 w = *(const u32x4*)(U + (size_t)(tok0 - d) * 512 + lane * 8);
            S[0] += bf_lo(w.x); S[1] += bf_hi(w.x); S[2] += bf_lo(w.y); S[3] += bf_hi(w.y); S[4] += bf_lo(w.z); S[5] += bf_hi(w.z); S[6] += bf_lo(w.w); S[7] += bf_hi(w.w);
        }
    }
#pragma unroll 4
    for (int i = 0; i < 16; ++i) {
        const int s = s0 + i;
        const u32x4 w = *(const u32x4*)(U + (size_t)(tok0 + i) * 512 + lane * 8);
        float uv[8] = {bf_lo(w.x), bf_hi(w.x), bf_lo(w.y), bf_hi(w.y), bf_lo(w.z), bf_hi(w.z), bf_lo(w.w), bf_hi(w.w)};
#pragma unroll
        for (int j = 0; j < 8; ++j) S[j] += uv[j];
        const int cn = (s + 1 < win) ? s + 1 : win;
        const float inv = 1.0f / (float)cn;
        float o[8];
#pragma unroll
        for (int j = 0; j < 8; ++j) o[j] = S[j] * inv - uv[j];
        u32x4 ow; ow.x = cvtpk(o[0], o[1]); ow.y = cvtpk(o[2], o[3]); ow.z = cvtpk(o[4], o[5]); ow.w = cvtpk(o[6], o[7]);
        *(u32x4*)(MIX + (size_t)(tok0 + i) * DM + lane * 8) = ow;
        if (s - win + 1 >= 0) {
            const u32x4 x = *(const u32x4*)(U + (size_t)(tok0 + i - win + 1) * 512 + lane * 8);
            S[0] -= bf_lo(x.x); S[1] -= bf_hi(x.x); S[2] -= bf_lo(x.y); S[3] -= bf_hi(x.y); S[4] -= bf_lo(x.z); S[5] -= bf_hi(x.z); S[6] -= bf_lo(x.w); S[7] -= bf_hi(x.w);
        }
    }
}

__device__ __forceinline__ void attn_unit(const Params& p, int b, int h, int ch, int qh, int lane, const LAS float* tbl, LAS bf16_t* stg) {
    const int r32 = lane & 31, hi = lane >> 5;
    const char* Qf = (const char*)(p.ws + WS_Q); const char* Kf = (const char*)(p.ws + WS_K); const char* Vf = (const char*)(p.ws + WS_V);
    bf16_t* MIX = (bf16_t*)(p.ws + WS_BUF);
    const size_t bh = (size_t)(b * NHEAD + h) * 256;
    bf16x8 qr[4];
#pragma unroll
    for (int d0 = 0; d0 < 4; ++d0) qr[d0] = *(const bf16x8*)(Qf + (((bh + ch * 2 + qh) * 4 + d0) * 64 + lane) * 16);
    f32x16 o0 = {}, o1 = {};
    float lsum = 0.f;
    const LAS float* th = tbl + h * 256;
    f32x16 cfv; { const float cfar = th[254];
#pragma unroll
        for (int r = 0; r < 16; ++r) cfv[r] = cfar; }
    const int t0 = ch < 8 ? 8 - ch : 0;
    const char* kp = Kf + (bh * 4 * 64 + lane) * 16 + (ptrdiff_t)(ch - 8 + t0) * 8192;
    const char* vp = Vf + (bh * 4 * 64 + lane) * 16 + (ptrdiff_t)(ch - 8 + t0) * 8192;
    bf16x8 kk[8];
#define ATT_LD8(dst, ptr) do { const char* pa_ = (ptr); const char* pb_ = pa_ + 4096; _Pragma("unroll") for (int i_ = 0; i_ < 4; ++i_) { dst[i_] = *(const bf16x8*)(pa_ + i_ * 1024); dst[4 + i_] = *(const bf16x8*)(pb_ + i_ * 1024); } } while (0)
#define ATT_REST(P0, P1) do { \
        float sacc_ = 0.f; \
        _Pragma("unroll") for (int r = 0; r < 16; ++r) { P0[r] = fast_exp2(P0[r]); P1[r] = fast_exp2(P1[r]); sacc_ += P0[r] + P1[r]; } \
        lsum += sacc_; \
        u32x4 pa_[4]; \
        _Pragma("unroll") for (int s = 0; s < 2; ++s) { \
            pa_[s].x = cvtpk(P0[8 * s + 0], P0[8 * s + 1]); pa_[s].y = cvtpk(P0[8 * s + 2], P0[8 * s + 3]); pa_[s].z = cvtpk(P0[8 * s + 4], P0[8 * s + 5]); pa_[s].w = cvtpk(P0[8 * s + 6], P0[8 * s + 7]); \
            pa_[2 + s].x = cvtpk(P1[8 * s + 0], P1[8 * s + 1]); pa_[2 + s].y = cvtpk(P1[8 * s + 2], P1[8 * s + 3]); pa_[2 + s].z = cvtpk(P1[8 * s + 4], P1[8 * s + 5]); pa_[2 + s].w = cvtpk(P1[8 * s + 6], P1[8 * s + 7]); } \
        _Pragma("unroll") for (int i = 0; i < 4; ++i) { const bf16x8 pf_ = __builtin_bit_cast(bf16x8, pa_[i]); \
            o0 = __builtin_amdgcn_mfma_f32_32x32x16_bf16(pf_, vv[2 * i], o0, 0, 0, 0); o1 = __builtin_amdgcn_mfma_f32_32x32x16_bf16(pf_, vv[2 * i + 1], o1, 0, 0, 0); } \
    } while (0)
    ATT_LD8(kk, kp);
    int t = t0;
#pragma unroll 1
    for (; t <= 5; ++t) {
        bf16x8 vv[8]; ATT_LD8(vv, vp); vp += 8192;
        f32x16 p0 = __builtin_amdgcn_mfma_f32_32x32x16_bf16(kk[0], qr[0], cfv, 0, 0, 0);
        f32x16 p1 = __builtin_amdgcn_mfma_f32_32x32x16_bf16(kk[4], qr[0], cfv, 0, 0, 0);
#pragma unroll
        for (int d0 = 1; d0 < 4; ++d0) { p0 = __builtin_amdgcn_mfma_f32_32x32x16_bf16(kk[d0], qr[d0], p0, 0, 0, 0); p1 = __builtin_amdgcn_mfma_f32_32x32x16_bf16(kk[4 + d0], qr[d0], p1, 0, 0, 0); }
        kp += 8192; ATT_LD8(kk, kp);
        ATT_REST(p0, p1);
    }
#pragma unroll 1
    for (; t <= 8; ++t) {
        bf16x8 vv[8]; ATT_LD8(vv, vp); vp += 8192;
        f32x16 p0, p1;
        { const int base_ = 64 * (8 - t) + 32 * qh + r32 + 63 - 4 * hi;
#pragma unroll
          for (int r = 0; r < 16; ++r) { const int kj = (r & 3) + 8 * (r >> 2); p0[r] = th[base_ - kj]; p1[r] = th[base_ - kj - 32]; } }
#pragma unroll
        for (int d0 = 0; d0 < 4; ++d0) { p0 = __builtin_amdgcn_mfma_f32_32x32x16_bf16(kk[d0], qr[d0], p0, 0, 0, 0); p1 = __builtin_amdgcn_mfma_f32_32x32x16_bf16(kk[4 + d0], qr[d0], p1, 0, 0, 0); }
        if (t < 8) { kp += 8192; ATT_LD8(kk, kp); }
        ATT_REST(p0, p1);
    }
#undef ATT_LD8
#undef ATT_REST
    lsum += __shfl_xor(lsum, 32);
    const float linv = 1.0f / lsum;
#pragma unroll
    for (int r = 0; r < 16; ++r) {
        const int q = crow(r, hi);
        const float li = __shfl(linv, q);
        stg[q * 72 + r32] = (bf16_t)(cvtpk(o0[r] * li, 0.f) & 0xffffu);
        stg[q * 72 + 32 + r32] = (bf16_t)(cvtpk(o1[r] * li, 0.f) & 0xffffu);
    }
    asm volatile("s_waitcnt lgkmcnt(0)" ::: "memory");
    bf16_t* orow = MIX + ((size_t)b * SEQ + ch * 64 + qh * 32 + (lane >> 3)) * DM + 512 + h * 64 + (lane & 7) * 8;
    const LAS bf16_t* srow = stg + (lane >> 3) * 72 + (lane & 7) * 8;
#pragma unroll
    for (int i = 0; i < 4; ++i) *(u32x4*)(orow + (size_t)i * 8 * DM) = *(const LAS u32x4*)(srow + i * 8 * 72);
    asm volatile("s_waitcnt lgkmcnt(0)" ::: "memory");
}

__device__ __forceinline__ void phase_mixer(const Params& p, int l, LAS unsigned char* lds) {
    const int tid = opaque_tid(), lane = tid & 63, wave = tid >> 6, G = gridDim.x;
    LAS float* tbl = (LAS float*)lds;
    const float* gt = (const float*)(p.ws + WS_TBL) + (size_t)l * 2048;
    for (int i = tid; i < 2048; i += NTHREADS) tbl[i] = gt[i];
    __syncthreads();
    const int gw = blockIdx.x * NWAVES + wave, NGW = G * NWAVES;
    LAS bf16_t* stg = (LAS bf16_t*)(lds + 8192 + wave * 4608);
    for (int it = gw; it < NTOK / 16; it += NGW) pool_strip(p, it, lane);
    if (G % 8 == 0) {
        const int x = (int)blockIdx.x & 7, lw = ((int)blockIdx.x >> 3) * NWAVES + wave, nlw = (G >> 3) * NWAVES;
        for (int pr = x; pr < BATCH * NHEAD; pr += 8)
            for (int u = lw; u < 256; u += nlw) attn_unit(p, pr >> 3, pr & 7, u >> 1, u & 1, lane, tbl, stg);
    } else {
        for (int wu = gw; wu < BATCH * NHEAD * 256; wu += NGW) attn_unit(p, wu >> 11, (wu >> 8) & 7, (wu >> 1) & 127, wu & 1, lane, tbl, stg);
    }
}

__device__ __forceinline__ void phase_route(const Params& p, int l, LAS unsigned char* lds) {
    const int tid = opaque_tid(), lane = tid & 63, wave = __builtin_amdgcn_readfirstlane(tid >> 6), G = gridDim.x;
    LAS float* a2c = (LAS float*)(lds + 49152);
    LAS float* shc = (LAS float*)(lds + 49152 + 1024);
    LAS float* lg = (LAS float*)(lds + 53248) + wave * (16 * 48);
    LAS int* lcnt = (LAS int*)(lds + 77824);
    LAS int* gbase = (LAS int*)(lds + 77824 + 128);
    LAS int* tmp_e = (LAS int*)(lds + 77824 + 256);
    LAS int* tmp_r = (LAS int*)(lds + 77824 + 256 + 1024);
    const float* mod = (const float*)(p.ws + WS_MOD);
    const float* gn = p.in[5] + l * 1024;
    bf16_t* H = (bf16_t*)(p.ws + WS_BUF);
    const char* RW = (const char*)(p.ws + WS_RW) + (size_t)l * 2 * 48 * 1024 * 2;
    const float* rwb = (const float*)(p.ws + WS_RWB) + l * 48;
    const float* ssq = (const float*)(p.ws + WS_SSQ);
    int* gcnt = (int*)(p.ws + WS_CTL) + l * 32;
    int* list = (int*)(p.ws + WS_LIST);
    float* ew = (float*)(p.ws + WS_EW);
    const int r = lane & 15, kg = lane >> 4;
    for (int it = blockIdx.x; it < NTOK / 128; it += G) {
        const int row0 = it * 128 + wave * 16, row = row0 + r, b = (it * 128) >> 13;
        const bf16_t* xr = (const bf16_t*)(p.ws + WS_XB) + (size_t)row * DM + 8 * kg;
        float ss; { const f32x4 q4 = *(const f32x4*)(ssq + (size_t)row * 16 + 4 * kg); ss = (q4[0] + q4[1]) + (q4[2] + q4[3]); }
        ss += __shfl_xor(ss, 16); ss += __shfl_xor(ss, 32);
        const float rstd = rsqrtf(ss * (1.0f / DM) + EPS);
        const float* sh = mod + (size_t)(l * 4 + b) * 6144 + 3072; const float* sc = sh + 1024;
        f32x4 acc[3];
#pragma unroll
        for (int nb = 0; nb < 3; ++nb) acc[nb] = (f32x4){0.f, 0.f, 0.f, 0.f};
#pragma unroll 1
        for (int c = 0; c < 4; ++c) {
            u32x4 xs[8];
#pragma unroll
            for (int i = 0; i < 8; ++i) xs[i] = *(const u32x4*)(xr + 256 * c + 32 * i);
            __syncthreads();
            if (c == 0 && tid < 32) lcnt[tid] = 0;
#pragma unroll
            for (int i = 0; i < 6; ++i) { const int q = wave * 6 + i; const char* src = RW + (q < 24 ? (size_t)(c * 24 + q) * 1024 : (size_t)98304 + (size_t)(c * 24 + q - 24) * 1024);
                __builtin_amdgcn_global_load_lds((const unsigned*)(src + lane * 16), (LAS unsigned*)(lds + q * 1024), 16, 0, 0); }
            if (tid < 256) { const int k = 256 * c + tid; a2c[tid] = gn[k] * (1.0f + sc[k]); shc[tid] = sh[k]; }
            asm volatile("s_waitcnt vmcnt(0)" ::: "memory");
            __syncthreads();
#pragma unroll
            for (int i = 0; i < 8; ++i) {
                float hv[8];
#pragma unroll
                for (int q = 0; q < 2; ++q) {
                    const f32x4 a = *(const LAS f32x4*)(a2c + 32 * i + 8 * kg + 4 * q), s0 = *(const LAS f32x4*)(shc + 32 * i + 8 * kg + 4 * q);
                    const f32x4 xv = q == 0 ? (f32x4){bf_lo(xs[i].x), bf_hi(xs[i].x), bf_lo(xs[i].y), bf_hi(xs[i].y)} : (f32x4){bf_lo(xs[i].z), bf_hi(xs[i].z), bf_lo(xs[i].w), bf_hi(xs[i].w)};
                    const f32x4 hh = xv * rstd * a + s0;
                    hv[4 * q + 0] = hh[0]; hv[4 * q + 1] = hh[1]; hv[4 * q + 2] = hh[2]; hv[4 * q + 3] = hh[3];
                }
                u32x4 hp; hp.x = cvtpk(hv[0], hv[1]); hp.y = cvtpk(hv[2], hv[3]); hp.z = cvtpk(hv[4], hv[5]); hp.w = cvtpk(hv[6], hv[7]);
                *(u32x4*)(H + (size_t)row * DM + 256 * c + 32 * i + 8 * kg) = hp;
                u32x4 lp;
                lp.x = cvtpk(hv[0] - bf_lo(hp.x), hv[1] - bf_hi(hp.x)); lp.y = cvtpk(hv[2] - bf_lo(hp.y), hv[3] - bf_hi(hp.y));
                lp.z = cvtpk(hv[4] - bf_lo(hp.z), hv[5] - bf_hi(hp.z)); lp.w = cvtpk(hv[6] - bf_lo(hp.w), hv[7] - bf_hi(hp.w));
                const bf16x8 xhi = __builtin_bit_cast(bf16x8, hp), xlo = __builtin_bit_cast(bf16x8, lp);
#pragma unroll
                for (int nb = 0; nb < 3; ++nb) {
                    const bf16x8 whi = *(const LAS bf16x8*)(lds + (i * 3 + nb) * 1024 + lane * 16);
                    const bf16x8 wlo = *(const LAS bf16x8*)(lds + 24576 + (i * 3 + nb) * 1024 + lane * 16);
                    acc[nb] = __builtin_amdgcn_mfma_f32_16x16x32_bf16(whi, xhi, acc[nb], 0, 0, 0);
                    acc[nb] = __builtin_amdgcn_mfma_f32_16x16x32_bf16(whi, xlo, acc[nb], 0, 0, 0);
                    acc[nb] = __builtin_amdgcn_mfma_f32_16x16x32_bf16(wlo, xhi, acc[nb], 0, 0, 0);
                }
            }
        }
#pragma unroll
        for (int nb = 0; nb < 3; ++nb)
#pragma unroll
            for (int q = 0; q < 4; ++q) lg[r * 48 + 16 * nb + 4 * kg + q] = acc[nb][q];
        asm volatile("s_waitcnt lgkmcnt(0)" ::: "memory");
        if (lane < 16) {
            const LAS float* my = lg + lane * 48;
            float gl[4]; int gi = 0; float gm;
#pragma unroll
            for (int i = 0; i < 4; ++i) gl[i] = my[32 + i] + rwb[32 + i];
            gm = gl[0];
#pragma unroll
            for (int i = 1; i < 4; ++i) if (gl[i] > gm) { gm = gl[i]; gi = i; }
            float den = 0.f;
#pragma unroll
            for (int i = 0; i < 4; ++i) den += __expf(gl[i] - gm);
            const float gpv = 1.0f / den;
            float el[8];
#pragma unroll
            for (int i = 0; i < 8; ++i) el[i] = my[8 * gi + i] + rwb[8 * gi + i];
            int i0 = 0; float v0 = el[0];
#pragma unroll
            for (int i = 1; i < 8; ++i) if (el[i] > v0) { v0 = el[i]; i0 = i; }
            int i1 = -1; float v1 = -3.0e38f;
#pragma unroll
            for (int i = 0; i < 8; ++i) if (i != i0 && el[i] > v1) { v1 = el[i]; i1 = i; }
            const float dd = __expf(v1 - v0);
            const float w0 = gpv / (1.0f + dd), w1 = gpv * dd / (1.0f + dd);
            const int e0 = 8 * gi + i0, e1 = 8 * gi + i1;
            const int tok = row0 + lane, lt = wave * 16 + lane;
            ew[2 * tok] = w0; ew[2 * tok + 1] = w1;
            tmp_e[2 * lt] = e0; tmp_e[2 * lt + 1] = e1;
            tmp_r[2 * lt] = __hip_atomic_fetch_add(lcnt + e0, 1, __ATOMIC_RELAXED, __HIP_MEMORY_SCOPE_WORKGROUP);
            tmp_r[2 * lt + 1] = __hip_atomic_fetch_add(lcnt + e1, 1, __ATOMIC_RELAXED, __HIP_MEMORY_SCOPE_WORKGROUP);
        }
        __syncthreads();
        if (tid < 32) gbase[tid] = __hip_atomic_fetch_add(gcnt + tid, lcnt[tid], __ATOMIC_RELAXED, __HIP_MEMORY_SCOPE_AGENT);
        __syncthreads();
        if (tid < 256) { const int e = tmp_e[tid]; list[(size_t)e * NTOK + gbase[e] + tmp_r[tid]] = it * 256 + tid; }
    }
    __syncthreads();
}

#define XB_TMO      128
#define XB_XCNT(j)  (256  + 64 * (j))
#define XB_XSUB(j)  (1280 + 64 * (j))
#define XB_XGEN(j)  (2304 + 64 * (j))
#define XB_TOP      3328
#define XB_TOPGEN   3392
#define XCD_BAR_WORDS 3456
#define XB_SPIN_CAP (1u << 18)
__device__ __forceinline__ unsigned xb_ld(unsigned* p)              { return __hip_atomic_load(p, __ATOMIC_RELAXED, __HIP_MEMORY_SCOPE_AGENT); }
__device__ __forceinline__ unsigned xb_add(unsigned* p, unsigned v) { return __hip_atomic_fetch_add(p, v, __ATOMIC_RELAXED, __HIP_MEMORY_SCOPE_AGENT); }
__device__ __forceinline__ unsigned xb_xcc_id() { return (unsigned)__builtin_amdgcn_s_getreg((3 << 11) | 20) & 0xFu; }
#define XB_SPIN(cond, bar) do { unsigned _sp = 0; while (cond) { __builtin_amdgcn_s_sleep(1); \
    if ((++_sp & 255u) == 0u) { if (xb_ld(&(bar)[XB_TMO])) break; if (_sp > XB_SPIN_CAP) { atomicAdd(&(bar)[XB_TMO], 1u); break; } } } } while (0)
struct XcdBarrier { unsigned* bar; unsigned x; volatile LAS unsigned* st; };
__device__ __forceinline__ XcdBarrier xcd_barrier_post(unsigned* bar, volatile LAS unsigned* st) {
    XcdBarrier b; b.bar = bar; b.x = xb_xcc_id(); b.st = st;
    if (threadIdx.x == 0) (void)xb_add(&bar[XB_XCNT(b.x)], 1u);
    return b;
}
__device__ __forceinline__ void xcd_barrier_complete(unsigned* bar, unsigned x, unsigned& nloc, unsigned& nx) {
    const unsigned G = gridDim.x * gridDim.y * gridDim.z;
    unsigned sum, cnt, mine, sp = 0u;
    for (;;) {
        sum = 0u; cnt = 0u; mine = 0u;
#pragma unroll
        for (unsigned j = 0; j < 16; ++j) { const unsigned c = xb_ld(&bar[XB_XCNT(j)]); sum += c; cnt += (c > 0u) ? 1u : 0u; mine = (j == x) ? c : mine; }
        if (sum == G) break;
        __builtin_amdgcn_s_sleep(1);
        if ((++sp & 255u) == 0u) { if (xb_ld(&bar[XB_TMO])) break; if (sp > XB_SPIN_CAP) { atomicAdd(&bar[XB_TMO], 1u); break; } }
    }
    nloc = mine > 0u ? mine : 1u; nx = cnt > 0u ? cnt : 1u;
}
__device__ __forceinline__ void xcd_barrier(const XcdBarrier& b) {
    asm volatile("s_waitcnt vmcnt(0)" ::: "memory");
    __syncthreads();
    if (threadIdx.x == 0) {
        unsigned* bar = b.bar;
        __builtin_amdgcn_s_waitcnt(0);
        unsigned nloc = b.st[0], nx = b.st[1];
        if (nloc == 0u) { xcd_barrier_complete(bar, b.x, nloc, nx); b.st[0] = nloc; b.st[1] = nx; }
        const unsigned old = xb_add(&bar[XB_XSUB(b.x)], 1u);
        const unsigned gen = old / nloc;
        if (old + 1u == (gen + 1u) * nloc) {
            __builtin_amdgcn_fence(__ATOMIC_RELEASE, "agent");
            asm volatile("s_waitcnt vmcnt(0)" ::: "memory");
            const unsigned og = xb_add(&bar[XB_TOP], 1u);
            const unsigned tg = og / nx;
            if (og + 1u == (tg + 1u) * nx) xb_add(&bar[XB_TOPGEN], 1u);
            else XB_SPIN(xb_ld(&bar[XB_TOPGEN]) == tg, bar);
            __builtin_amdgcn_fence(__ATOMIC_ACQUIRE, "agent");
            xb_add(&bar[XB_XGEN(b.x)], 1u);
            asm volatile("s_waitcnt vmcnt(0)" ::: "memory");
        } else {
            XB_SPIN(xb_ld(&bar[XB_XGEN(b.x)]) == gen, bar);
            __builtin_amdgcn_fence(__ATOMIC_ACQUIRE, "agent");
            asm volatile("s_waitcnt vmcnt(0)" ::: "memory");
        }
    }
    __syncthreads();
}

__device__ __forceinline__ void load_prefix(const Params& p, int l, LAS int* pre, LAS int* cntl) {
    const int* gcnt = (const int*)(p.ws + WS_CTL) + l * 32;
    if (threadIdx.x == 0) { int a = 0; for (int e = 0; e < NEXP; ++e) { const int c = gcnt[e]; cntl[e] = c; pre[e] = a; a += (c + 255) >> 8; } pre[NEXP] = a; }
    __syncthreads();
}

__global__ void __launch_bounds__(NTHREADS, 2) fwd_kernel(Params p) {
    extern __shared__ __attribute__((aligned(16))) unsigned char lds_raw[];
    LAS unsigned char* lds = (LAS unsigned char*)lds_raw;
    const int G = gridDim.x;
    unsigned char* ws = p.ws;
    volatile LAS unsigned* bst = (volatile LAS unsigned*)(lds + LDS_BYTES - 16);
    if (threadIdx.x < 2) bst[threadIdx.x] = 0u;
    __syncthreads();
    const XcdBarrier bar = xcd_barrier_post((unsigned*)(ws + WS_CTL) + 4096, bst);
    const int lo = p.ph_lo, hi = p.ph_hi;
#define IN(k) (lo <= (k) && (k) < hi)
#define SYNC_AFTER(k) do { if (IN(k) && IN((k) + 1)) xcd_barrier(bar); } while (0)
    if (IN(0)) phase_prologue(p, lds);
    SYNC_AFTER(0);
#pragma unroll 1
    for (int l = 0; l < DEPTH; ++l) {
        const int k0 = 1 + 7 * l;
        if (IN(k0 + 0)) phase_norm1(p, l);
        SYNC_AFTER(k0 + 0);
        if (IN(k0 + 1)) {
            {
                DenseGemm g{(const bf16_t*)(ws + WS_BUF), (const bf16_t*)(ws + WS_WIN) + (size_t)l * 2048 * 1024, 1024};
                pg8::StaticOrder S; S.init(NTOK, 1536, G, (int)blockIdx.x);
                EpiIn E{(bf16_t*)(ws + WS_U), (bf16_t*)(ws + WS_Q), (bf16_t*)(ws + WS_K), p.in[9] + l * 64, p.in[10] + l * 64};
                pg8::gemm_phase(lds, g, S, E);
            }
            {
                DenseGemm g{(const bf16_t*)(ws + WS_WIN) + (size_t)l * 2048 * 1024 + (size_t)1536 * 1024, (const bf16_t*)(ws + WS_BUF), 1024};
                pg8::StaticOrder S; S.init(512, NTOK, G, (int)blockIdx.x);
                EpiVt E{(bf16_t*)(ws + WS_V)};
                pg8::gemm_phase(lds, g, S, E);
            }
        }
        SYNC_AFTER(k0 + 1);
        if (IN(k0 + 2)) phase_mixer(p, l, lds);
        SYNC_AFTER(k0 + 2);
        if (IN(k0 + 3)) {
            DenseGemm g{(const bf16_t*)(ws + WS_BUF), (const bf16_t*)(ws + WS_WOUT) + (size_t)l * 1024 * 1024, 1024};
            pg8::StaticOrder S; S.init(NTOK, 1024, G, (int)blockIdx.x);
            const float* g1p = (const float*)(ws + WS_MOD) + (size_t)(l * 4) * 6144 + 2048;
            if (l == 0) { EpiOutB<true> E{p.in[0], (bf16_t*)(ws + WS_XB), g1p, (float*)(ws + WS_SSQ)}; pg8::gemm_phase(lds, g, S, E); }
            else { EpiOutB<false> E{nullptr, (bf16_t*)(ws + WS_XB), g1p, (float*)(ws + WS_SSQ)}; pg8::gemm_phase(lds, g, S, E); }
        }
        SYNC_AFTER(k0 + 3);
        if (IN(k0 + 4)) phase_route(p, l, lds);
        SYNC_AFTER(k0 + 4);
        if (IN(k0 + 5)) {
            const int vcu = (G % 8 == 0) ? ((int)blockIdx.x % 8) * (G / 8) + (int)blockIdx.x / 8 : (int)blockIdx.x;
            LAS int* pre = (LAS int*)(lds + pg8::STAGE_BYTES); LAS int* cntl = pre + 64;
            load_prefix(p, l, pre, cntl);
            GatherGemm g{(const bf16_t*)(ws + WS_BUF), (const bf16_t*)(ws + WS_WGU) + (size_t)l * NEXP * 1024 * 1024, (const int*)(ws + WS_LIST), 1024, 1, (size_t)1024 * 1024 * 2};
            pg8::GroupedOrder S{pre, cntl, G, vcu};
            EpiGU E{(bf16_t*)(ws + WS_ACT), (const int*)(ws + WS_LIST)};
            const int total_units = pre[NEXP] * 4;
            pg8::gemm_phase(lds, g, S, E);
            if (l == 0) tail_convert(p, lds, total_units, vcu, 0, 7424);
        }
        SYNC_AFTER(k0 + 5);
        if (IN(k0 + 6)) {
            const int vcu = (G % 8 == 0) ? ((int)blockIdx.x % 8) * (G / 8) + (int)blockIdx.x / 8 : (int)blockIdx.x;
            LAS int* pre = (LAS int*)(lds + pg8::STAGE_BYTES); LAS int* cntl = pre + 64;
            load_prefix(p, l, pre, cntl);
            GatherGemm g{(const bf16_t*)(ws + WS_ACT), (const bf16_t*)(ws + WS_WD) + (size_t)l * NEXP * 1024 * 512, (const int*)(ws + WS_LIST), 512, 0, (size_t)1024 * 512 * 2};
            pg8::GroupedOrder S{pre, cntl, G, vcu};
            EpiDn E{(unsigned char*)(ws + WS_Y), (const int*)(ws + WS_LIST), (const float*)(ws + WS_EW)};
            const int total_units = pre[NEXP] * 4;
            pg8::gemm_phase(lds, g, S, E);
            if (l == 0) tail_convert(p, lds, total_units, vcu, 7424, T_NB - 7424);
        }
        SYNC_AFTER(k0 + 6);
    }
    if (IN(15)) phase_final(p);
#undef IN
#undef SYNC_AFTER
}

extern "C" void kernel_launch(void* const* d_in, const int* in_sizes, int n_in, void* d_out, int out_size, void* d_ws, size_t ws_size, hipStream_t stream) {
    static int grid = 0;
    if (grid == 0) {
        if (n_in != 20 || out_size != NTOK * DM || ws_size < WS_END) { fprintf(stderr, "kernel_launch: unexpected shapes (n_in %d out %d ws %zu)\n", n_in, out_size, ws_size); grid = -1; return; }
        int dev = 0, cus = 0, per_cu = 0;
        hipGetDevice(&dev);
        hipDeviceGetAttribute(&cus, hipDeviceAttributeMultiprocessorCount, dev);
        hipFuncSetAttribute((const void*)fwd_kernel, hipFuncAttributeMaxDynamicSharedMemorySize, LDS_BYTES);
        hipOccupancyMaxActiveBlocksPerMultiprocessor(&per_cu, (const void*)fwd_kernel, NTHREADS, LDS_BYTES);
        if (per_cu < 1) per_cu = 1;
        if (per_cu > 1) per_cu = 1;
        grid = cus * per_cu;
        (void)hipGetLastError();
    }
    if (grid < 0) return;
    if (hipMemsetAsync((char*)d_ws + WS_CTL, 0, 65536, stream) != hipSuccess) { fprintf(stderr, "memset failed\n"); return; }
    Params p{};
    for (int i = 0; i < 20; ++i) p.in[i] = (const float*)d_in[i];
    p.out = (float*)d_out; p.ws = (unsigned char*)d_ws; p.ph_lo = 0; p.ph_hi = 16;
    void* args[] = {&p};
    hipError_t e = hipLaunchCooperativeKernel((const void*)fwd_kernel, dim3(grid), dim3(NTHREADS), args, LDS_BYTES, stream);
    if (e != hipSuccess) fprintf(stderr, "cooperative launch failed: %s (grid %d)\n", hipGetErrorString(e), grid);
}
```

```cpp
#include <hip/hip_runtime.h>
#include <hip/hip_cooperative_groups.h>
#include <cstdio>
#include <cstdint>
namespace cg = cooperative_groups;

#define LAS __attribute__((address_space(3)))
typedef unsigned short bf16_t;
typedef short bf16x8 __attribute__((ext_vector_type(8)));
typedef float f32x4 __attribute__((ext_vector_type(4)));
typedef float f32x16 __attribute__((ext_vector_type(16)));
typedef unsigned u32x4 __attribute__((ext_vector_type(4)));
typedef unsigned u32x2 __attribute__((ext_vector_type(2)));
typedef float f32x2_t __attribute__((ext_vector_type(2)));
typedef __bf16 bf16x2_t __attribute__((ext_vector_type(2)));

constexpr int BATCH = 4, SEQ = 8192, DM = 1024, NTOK = BATCH * SEQ, DEPTH = 2;
constexpr int NHEAD = 8, HD = 64, NEXP = 32, DEXP = 512;
constexpr float EPS = 1e-6f;
constexpr float LOG2E = 1.4426950408889634f;

constexpr size_t MiB = 1u << 20;
constexpr size_t WS_CTL = 0;
constexpr size_t WS_MOD = 1 * MiB;
constexpr size_t WS_TBL = 1 * MiB + 512 * 1024;
constexpr size_t WS_RW = 2 * MiB;
constexpr size_t WS_RWB = 2 * MiB + 512 * 1024;
constexpr size_t WS_LIST = 3 * MiB;
constexpr size_t WS_EW = 7 * MiB;
constexpr size_t WS_WIN = 8 * MiB;
constexpr size_t WS_WOUT = 16 * MiB;
constexpr size_t WS_WGU = 20 * MiB;
constexpr size_t WS_WD = 148 * MiB;
constexpr size_t WS_BUF = 212 * MiB;
constexpr size_t WS_U = 276 * MiB;
constexpr size_t WS_Q = 308 * MiB;
constexpr size_t WS_K = 340 * MiB;
constexpr size_t WS_V = 372 * MiB;
constexpr size_t WS_Y = 276 * MiB;
constexpr size_t WS_ACT = 404 * MiB;
constexpr size_t WS_SSQ = 468 * MiB;
constexpr size_t WS_XB = 470 * MiB;
constexpr size_t WS_LIST2 = 534 * MiB;
constexpr size_t WS_END = 542 * MiB;

constexpr int LDS_BYTES = 147456;
constexpr int NWAVES = 8, NTHREADS = 512;

struct Params {
    const float* in[20];
    float* out;
    unsigned char* ws;
    int ph_lo, ph_hi;
};

__device__ __forceinline__ unsigned cvtpk(float lo, float hi) { f32x2_t v = {lo, hi}; bf16x2_t b = __builtin_convertvector(v, bf16x2_t); return __builtin_bit_cast(unsigned, b); }
__device__ __forceinline__ float bf_lo(unsigned w) { return __uint_as_float(w << 16); }
__device__ __forceinline__ float bf_hi(unsigned w) { return __uint_as_float(w & 0xffff0000u); }
__device__ __forceinline__ float fast_exp2(float x) { return __builtin_amdgcn_exp2f(x); }
__device__ __forceinline__ float fast_rcp(float x) { return __builtin_amdgcn_rcpf(x); }

__device__ __forceinline__ int opaque_tid() { int t = threadIdx.x; asm volatile("" : "+v"(t)); return t; }
__device__ __forceinline__ int opaque_bid() { int t = blockIdx.x; asm volatile("" : "+s"(t)); return t; }

namespace pg8 {
constexpr int BM = 256, BK = 64, HALF = 128, HTB = HALF * BK * 2, STAGE_BYTES = 8 * HTB, NXCD = 8, WGM = 8;
__host__ __device__ __forceinline__ int lds_byte(int r, int c) { const int st = (r >> 4) * 2 + (c >> 5), rr = r & 15, cc = c & 31, ob = rr * 64 + cc * 2; return st * 1024 + (ob ^ (((ob >> 9) & 1) << 5)); }
__host__ __device__ __forceinline__ void stage_rc(int b, int& R, int& C) { const int st = b / 1024, sb = b % 1024, swz = sb ^ (((sb >> 9) & 1) << 5); R = (st >> 1) * 16 + swz / 64; C = (st & 1) * 32 + (swz % 64) / 2; }
__host__ __device__ __forceinline__ int perm32(int rho) { const int n = rho >> 4, i = rho & 15; return 8 * (i >> 2) + 4 * n + (i & 3); }

struct Unit { int pm, pn, e, rows; };

struct StaticOrder {
    int nM, nN, nwg, G, c;
    __device__ void init(int M, int N, int G_, int c_) { nM = M / BM; nN = N / BM; nwg = nM * nN; G = G_; c = c_; }
    __device__ bool next(int i, Unit& u) const {
        const long L = (long)i * G + c; if (L >= nwg) return false;
        int wgid = (int)L; { const int q = nwg / NXCD, r = nwg % NXCD, xcd = wgid % NXCD, off = wgid / NXCD; wgid = (xcd < r ? xcd * (q + 1) : r * (q + 1) + (xcd - r) * q) + off; }
        const int nig = WGM * nN, gid = wgid / nig, fm = gid * WGM, gsz = (nM - fm) < WGM ? (nM - fm) : WGM;
        u.pm = fm + ((wgid % nig) % gsz); u.pn = (wgid % nig) / gsz; u.e = 0; u.rows = BM; return true;
    }
};

struct GroupedOrder {
    const LAS int* prefix; const LAS int* cnt; int G, v;
    __device__ bool next(int i, Unit& u) const {
        const int L = i * G + v; const int total = prefix[NEXP];
        if (L >= total * 4) return false;
        const int rt = L >> 2; int e = 0;
#pragma unroll 1
        for (int j = 1; j < NEXP; ++j) if (prefix[j] <= rt) e = j;
        u.e = e; u.pm = rt - prefix[e]; u.pn = L & 3; const int rem = cnt[e] - u.pm * BM; u.rows = rem < BM ? rem : BM; return true;
    }
};

template <class G, class Epi, class Sched>
__device__ __forceinline__ void gemm_phase(LAS unsigned char* lds, const G g, const Sched& S, const Epi& E) {
    int tid = threadIdx.x; asm volatile("" : "+v"(tid));
    const int wid = __builtin_amdgcn_readfirstlane(tid >> 6), lane = tid & 63, wr = wid >> 2, wc = wid & 3, fr = lane & 15, fq = lane >> 4;
    const int K = g.K, nt = K / BK;
    int RA[2], CA[2]; unsigned voffB[2];
#pragma unroll
    for (int i = 0; i < 2; ++i) { int R, C; stage_rc(tid * 16 + i * 8192, R, C); const int Rb = Epi::PERM ? ((R & ~31) + perm32(R & 31)) : R;
        RA[i] = R; CA[i] = C; voffB[i] = (unsigned)(Rb * K + C) * 2u; }
    const size_t kstep = (size_t)(BK * 2);
    const size_t hstep = (size_t)HALF * K * 2;
    const unsigned ldsw = (unsigned)wid * 1024u;
    const int aoff = lds_byte(wr * 64 + fr, fq * 8), boff = lds_byte(wc * 32 + fr, fq * 8);
#define PG8_SA(b, h) (((b) * 2 + (h)) * HTB)
#define PG8_SB(b, h) ((4 + (b) * 2 + (h)) * HTB)
#define PG8_STAGE2(bufoff, gbase, o0, o1) do { \
        __builtin_amdgcn_global_load_lds((const unsigned*)((const char*)(gbase) + (o0)), (LAS unsigned*)(lds + (bufoff) + ldsw), 16, 0, 0); \
        __builtin_amdgcn_global_load_lds((const unsigned*)((const char*)(gbase) + (o1)), (LAS unsigned*)(lds + (bufoff) + ldsw + 8192), 16, 0, 0); } while (0)
#define PG8_STAGEB(bufoff, gbase) PG8_STAGE2(bufoff, gbase, voffB[0], voffB[1])
#define PG8_LDA(dst, b, h) do { _Pragma("unroll") for (int m = 0; m < 4; ++m) _Pragma("unroll") for (int k = 0; k < 2; ++k) dst[m][k] = *(const LAS bf16x8*)(lds + PG8_SA(b, h) + aoff + m * 2048 + k * 1024); } while (0)
#define PG8_LDB(dst, b, h) do { _Pragma("unroll") for (int n = 0; n < 2; ++n) _Pragma("unroll") for (int k = 0; k < 2; ++k) dst[n][k] = *(const LAS bf16x8*)(lds + PG8_SB(b, h) + boff + n * 2048 + k * 1024); } while (0)
#define PG8_MMA(ai, bj, At, Bt) do { __builtin_amdgcn_s_setprio(1); _Pragma("unroll") for (int m = 0; m < 4; ++m) _Pragma("unroll") for (int n = 0; n < 2; ++n) _Pragma("unroll") for (int k = 0; k < 2; ++k) \
        acc[ai][bj][m][n] = __builtin_amdgcn_mfma_f32_16x16x32_bf16(Bt[n][k], At[m][k], acc[ai][bj][m][n], 0, 0, 0); __builtin_amdgcn_s_setprio(0); } while (0)
#define PG8_WAIT_V(n) asm volatile("s_waitcnt vmcnt(" #n ")" ::: "memory")
#define PG8_WAIT_L(n) asm volatile("s_waitcnt lgkmcnt(" #n ")" ::: "memory")
#define PG8_BAR __builtin_amdgcn_s_barrier()
#define PG8_SCHED __builtin_amdgcn_sched_barrier(0)
    Unit cur, nxt; int ui = 0;
    if (!S.next(0, cur)) return;
    LAS u32x2* const tab = (LAS u32x2*)(lds + STAGE_BYTES + 1024);
#define PG8_TABLE(u, par) do { if (G::GATHER) { if (wid < 2) __builtin_amdgcn_global_load_lds((const unsigned*)(g.tab_src(u) + (wid * 64 + lane) * 16), (LAS unsigned*)((LAS unsigned char*)tab + (par) * 2048 + wid * 1024), 16, 0, 0); } } while (0)
    PG8_TABLE(cur, 0);
    f32x4 acc[2][2][4][2];
#pragma unroll
    for (int a = 0; a < 2; ++a)
#pragma unroll
        for (int b = 0; b < 2; ++b)
#pragma unroll
            for (int m = 0; m < 4; ++m)
#pragma unroll
                for (int n = 0; n < 2; ++n) acc[a][b][m][n] = (f32x4){0.f, 0.f, 0.f, 0.f};
    bf16x8 At[4][2], B0[2][2], B1[2][2];
    const char* cA = g.a_base(cur); const char* cB = g.b_base(cur);
    unsigned c00 = g.a_off(cur, RA[0], CA[0]), c01 = g.a_off(cur, RA[1], CA[1]), c10 = g.a_off(cur, HALF + RA[0], CA[0]), c11 = g.a_off(cur, HALF + RA[1], CA[1]);
    PG8_STAGEB(PG8_SB(0, 0), cB); PG8_STAGEB(PG8_SB(0, 1), cB + hstep); PG8_STAGE2(PG8_SA(0, 0), cA, c00, c01); PG8_STAGE2(PG8_SA(0, 1), cA, c10, c11);
    if (wr == 1) PG8_BAR;
    PG8_WAIT_V(2); PG8_BAR;
    PG8_STAGEB(PG8_SB(1, 0), cB + kstep); PG8_STAGE2(PG8_SA(1, 0), cA + kstep, c00, c01); PG8_STAGEB(PG8_SB(1, 1), cB + hstep + kstep);
    PG8_WAIT_V(6); PG8_BAR;
    for (;;) {
        const bool has_next = S.next(ui + 1, nxt);
        const char* nA = has_next ? g.a_base(nxt) : cA; const char* nB = has_next ? g.b_base(nxt) : cB;
        unsigned n00 = c00, n01 = c01, n10 = c10, n11 = c11;
        if (G::GATHER && has_next) { n00 = g.a_off(nxt, RA[0], CA[0]); n01 = g.a_off(nxt, RA[1], CA[1]); n10 = g.a_off(nxt, HALF + RA[0], CA[0]); n11 = g.a_off(nxt, HALF + RA[1], CA[1]); }
        for (int t = 0; t < nt; t += 2) {
            const bool last = (t == nt - 2);
            const char* a1 = cA + (size_t)(t + 1) * kstep;
            const char* a2 = last ? nA : cA + (size_t)(t + 2) * kstep; const char* b2 = last ? nB : cB + (size_t)(t + 2) * kstep;
            const char* a3 = a2 + kstep; const char* b3 = b2 + kstep;
            const unsigned x00 = last ? n00 : c00, x01 = last ? n01 : c01, x10 = last ? n10 : c10, x11 = last ? n11 : c11;
            PG8_LDB(B0, 0, 0); PG8_LDB(B1, 0, 1); PG8_SCHED; PG8_LDA(At, 0, 0); PG8_STAGE2(PG8_SA(1, 1), a1, c10, c11);
            PG8_WAIT_V(8); PG8_WAIT_L(0); PG8_BAR; PG8_MMA(0, 0, At, B0); PG8_MMA(0, 1, At, B1); PG8_BAR; PG8_SCHED;
            PG8_LDA(At, 0, 1); PG8_STAGEB(PG8_SB(0, 0), b2); PG8_STAGEB(PG8_SB(0, 1), b2 + hstep); PG8_STAGE2(PG8_SA(0, 0), a2, x00, x01);
            PG8_WAIT_V(8); PG8_WAIT_L(0); PG8_BAR; PG8_MMA(1, 0, At, B0); PG8_MMA(1, 1, At, B1); PG8_BAR; PG8_SCHED;
            PG8_LDB(B0, 1, 0); PG8_LDB(B1, 1, 1); PG8_SCHED; PG8_LDA(At, 1, 0); PG8_STAGE2(PG8_SA(0, 1), a2, x10, x11);
            PG8_WAIT_V(8); PG8_WAIT_L(0); PG8_BAR; PG8_MMA(0, 0, At, B0); PG8_MMA(0, 1, At, B1); PG8_BAR; PG8_SCHED;
            PG8_LDA(At, 1, 1); PG8_STAGEB(PG8_SB(1, 0), b3); PG8_STAGEB(PG8_SB(1, 1), b3 + hstep); PG8_STAGE2(PG8_SA(1, 0), a3, x00, x01);
            PG8_WAIT_V(8); PG8_WAIT_L(0); PG8_BAR; PG8_MMA(1, 0, At, B0); PG8_MMA(1, 1, At, B1); PG8_BAR; PG8_SCHED;
        }
        if (wr == 0) PG8_BAR;
        E(acc, cur, wr, wc, fr, fq, tab + (ui & 1) * 256);
        if (!has_next) break;
#pragma unroll
        for (int a = 0; a < 2; ++a)
#pragma unroll
            for (int b = 0; b < 2; ++b)
#pragma unroll
                for (int m = 0; m < 4; ++m)
#pragma unroll
                    for (int n = 0; n < 2; ++n) acc[a][b][m][n] = (f32x4){0.f, 0.f, 0.f, 0.f};
        cur = nxt; cA = nA; cB = nB; c00 = n00; c01 = n01; c10 = n10; c11 = n11; ++ui;
        PG8_TABLE(cur, ui & 1);
        if (wr == 1) PG8_BAR;
    }
    PG8_WAIT_V(0);
    PG8_BAR;
#undef PG8_TABLE
#undef PG8_SA
#undef PG8_SB
#undef PG8_STAGE2
#undef PG8_STAGEB
#undef PG8_LDA
#undef PG8_LDB
#undef PG8_MMA
#undef PG8_WAIT_V
#undef PG8_WAIT_L
#undef PG8_BAR
#undef PG8_SCHED
}
}
using pg8::Unit;

struct DenseGemm {
    static constexpr bool GATHER = false;
    __device__ __forceinline__ const char* tab_src(const Unit&) const { return nullptr; }
    const bf16_t* A; const bf16_t* Bt; int K;
    __device__ __forceinline__ const char* a_base(const Unit& u) const { return (const char*)A + (size_t)u.pm * 256 * K * 2; }
    __device__ __forceinline__ const char* b_base(const Unit& u) const { return (const char*)Bt + (size_t)u.pn * 256 * K * 2; }
    __device__ __forceinline__ unsigned a_off(const Unit&, int r, int c) const { return (unsigned)(r * K + c) * 2u; }
};
struct GatherGemm {
    static constexpr bool GATHER = true;
    const bf16_t* A; const bf16_t* Bt; const u32x2* list; int K; int a_shift;
    size_t b_expert_stride;
    __device__ __forceinline__ const char* tab_src(const Unit& u) const { return (const char*)(list + (size_t)u.e * NTOK + u.pm * 256); }
    __device__ __forceinline__ const char* a_base(const Unit&) const { return (const char*)A; }
    __device__ __forceinline__ const char* b_base(const Unit& u) const { return (const char*)Bt + (size_t)u.e * b_expert_stride + (size_t)u.pn * 256 * K * 2; }
    __device__ __forceinline__ unsigned a_off(const Unit& u, int r, int c) const {
        const int rr = r < u.rows ? r : u.rows - 1;
        const int slot = (int)list[(size_t)u.e * NTOK + u.pm * 256 + rr].x;
        return (unsigned)((slot >> a_shift) * K + c) * 2u;
    }
};


struct EpiIn {
    static constexpr bool PERM = true;
    bf16_t* U; bf16_t* Qf; bf16_t* Kf; const float* qg; const float* kg;
    __device__ __forceinline__ void operator()(const f32x4 (&acc)[2][2][4][2], const Unit& u, int wr, int wc, int fr, int fq, const LAS u32x2* tab) const {
        if (u.pn < 2) {
#pragma unroll
            for (int ai = 0; ai < 2; ++ai)
#pragma unroll
                for (int m = 0; m < 4; ++m) {
                    const int row = u.pm * 256 + ai * 128 + wr * 64 + m * 16 + fr;
#pragma unroll
                    for (int bj = 0; bj < 2; ++bj) {
                        const f32x4 v0 = acc[ai][bj][m][0], v1 = acc[ai][bj][m][1];
                        u32x4 w; w.x = cvtpk(v0[0], v0[1]); w.y = cvtpk(v0[2], v0[3]); w.z = cvtpk(v1[0], v1[1]); w.w = cvtpk(v1[2], v1[3]);
                        *(u32x4*)(U + (size_t)row * 512 + u.pn * 256 + bj * 128 + wc * 32 + fq * 8) = w;
                    }
                }
        } else {
            const bool isq = u.pn < 4;
            const float* gg = isq ? qg : kg; bf16_t* dst = isq ? Qf : Kf;
            const float osc = isq ? 0.125f * LOG2E : 1.0f;
            const int head = (u.pn & 1) * 4 + wc;
            f32x4 gv[2][2];
#pragma unroll
            for (int bj = 0; bj < 2; ++bj)
#pragma unroll
                for (int n = 0; n < 2; ++n) gv[bj][n] = *(const f32x4*)(gg + bj * 32 + fq * 8 + n * 4) * osc;
#pragma unroll
            for (int ai = 0; ai < 2; ++ai)
#pragma unroll
                for (int m = 0; m < 4; ++m) {
                    float ss = 0.f;
#pragma unroll
                    for (int bj = 0; bj < 2; ++bj)
#pragma unroll
                        for (int n = 0; n < 2; ++n) { const f32x4 v = acc[ai][bj][m][n]; ss += (v[0] * v[0] + v[1] * v[1]) + (v[2] * v[2] + v[3] * v[3]); }
                    ss += __shfl_xor(ss, 16); ss += __shfl_xor(ss, 32);
                    const float rstd = rsqrtf(ss * (1.0f / 64.0f) + EPS);
                    const int row = u.pm * 256 + ai * 128 + wr * 64 + m * 16 + fr;
                    const int b = row >> 13, s = row & (SEQ - 1), rb = s >> 5, r32 = s & 31;
#pragma unroll
                    for (int bj = 0; bj < 2; ++bj) {
                        const f32x4 v0 = acc[ai][bj][m][0] * rstd * gv[bj][0], v1 = acc[ai][bj][m][1] * rstd * gv[bj][1];
                        u32x4 w; w.x = cvtpk(v0[0], v0[1]); w.y = cvtpk(v0[2], v0[3]); w.z = cvtpk(v1[0], v1[1]); w.w = cvtpk(v1[2], v1[3]);
                        const int d0 = 2 * bj + (fq >> 1), hi = fq & 1;
                        const size_t piece = (((size_t)(b * NHEAD + head) * 256 + rb) * 4 + d0);
                        *(u32x4*)(dst + (piece * 64 + hi * 32 + r32) * 8) = w;
                    }
                }
        }
    }
};

struct EpiVt {
    static constexpr bool PERM = true;
    bf16_t* Vf;
    __device__ __forceinline__ void operator()(const f32x4 (&acc)[2][2][4][2], const Unit& u, int wr, int wc, int fr, int fq, const LAS u32x2* tab) const {
#pragma unroll
        for (int ai = 0; ai < 2; ++ai)
#pragma unroll
            for (int m = 0; m < 4; ++m) {
                const int hd = u.pm * 256 + ai * 128 + wr * 64 + m * 16 + fr;
                const int head = hd >> 6, dblk = (hd >> 5) & 1, dl = hd & 31;
#pragma unroll
                for (int bj = 0; bj < 2; ++bj) {
                    const int tok0 = u.pn * 256 + bj * 128 + wc * 32;
                    const int b = tok0 >> 13, kb = (tok0 & (SEQ - 1)) >> 5;
                    const size_t piece = ((((size_t)(b * NHEAD + head) * 256 + kb) * 2 + (fq >> 1)) * 2 + dblk);
#pragma unroll
                    for (int n = 0; n < 2; ++n) {
                        const f32x4 v = acc[ai][bj][m][n];
                        u32x2 w; w.x = cvtpk(v[0], v[1]); w.y = cvtpk(v[2], v[3]);
                        *(u32x2*)((char*)Vf + (piece * 64 + n * 32 + dl) * 16 + (fq & 1) * 8) = w;
                    }
                }
            }
    }
};

template <bool XF>
struct EpiOutB {
    static constexpr bool PERM = true;
    const float* xf; bf16_t* XB; const float* g1; float* ssq;
    __device__ __forceinline__ void operator()(const f32x4 (&acc)[2][2][4][2], const Unit& u, int wr, int wc, int fr, int fq, const LAS u32x2* tab) const {
        const int b = (u.pm * 256) >> 13;
        const int col0 = u.pn * 256 + wc * 32 + 8 * fq;
        f32x4 gv[2][2];
#pragma unroll
        for (int bj = 0; bj < 2; ++bj)
#pragma unroll
            for (int n = 0; n < 2; ++n) gv[bj][n] = *(const f32x4*)(g1 + (size_t)b * 6144 + col0 + bj * 128 + n * 4);
#pragma unroll
        for (int ai = 0; ai < 2; ++ai)
#pragma unroll
            for (int m = 0; m < 4; ++m) {
                const int row = u.pm * 256 + ai * 128 + wr * 64 + m * 16 + fr;
                const size_t off = (size_t)row * DM + col0;
                f32x4 xb[2][2];
                if (XF) {
#pragma unroll
                    for (int bj = 0; bj < 2; ++bj) { xb[bj][0] = *(const f32x4*)(xf + off + bj * 128); xb[bj][1] = *(const f32x4*)(xf + off + bj * 128 + 4); }
                } else {
#pragma unroll
                    for (int bj = 0; bj < 2; ++bj) { const u32x4 w = *(const u32x4*)(XB + off + bj * 128);
                        xb[bj][0] = (f32x4){bf_lo(w.x), bf_hi(w.x), bf_lo(w.y), bf_hi(w.y)}; xb[bj][1] = (f32x4){bf_lo(w.z), bf_hi(w.z), bf_lo(w.w), bf_hi(w.w)}; }
                }
                float ss = 0.f;
#pragma unroll
                for (int bj = 0; bj < 2; ++bj) {
                    const f32x4 x0 = xb[bj][0] + gv[bj][0] * acc[ai][bj][m][0], x1 = xb[bj][1] + gv[bj][1] * acc[ai][bj][m][1];
                    u32x4 w; w.x = cvtpk(x0[0], x0[1]); w.y = cvtpk(x0[2], x0[3]); w.z = cvtpk(x1[0], x1[1]); w.w = cvtpk(x1[2], x1[3]);
                    *(u32x4*)(XB + off + bj * 128) = w;
                    const float r0 = bf_lo(w.x), r1 = bf_hi(w.x), r2 = bf_lo(w.y), r3 = bf_hi(w.y), r4 = bf_lo(w.z), r5 = bf_hi(w.z), r6 = bf_lo(w.w), r7 = bf_hi(w.w);
                    ss += ((r0 * r0 + r1 * r1) + (r2 * r2 + r3 * r3)) + ((r4 * r4 + r5 * r5) + (r6 * r6 + r7 * r7));
                }
                ss += __shfl_xor(ss, 16); ss += __shfl_xor(ss, 32);
                if (fq == 0) ssq[(size_t)row * 16 + u.pn * 4 + wc] = ss;
            }
    }
};

struct EpiGU {
    static constexpr bool PERM = true;
    bf16_t* ACT;
    __device__ __forceinline__ void operator()(const f32x4 (&acc)[2][2][4][2], const Unit& u, int wr, int wc, int fr, int fq, const LAS u32x2* tab) const {
#pragma unroll
        for (int ai = 0; ai < 2; ++ai)
#pragma unroll
            for (int m = 0; m < 4; ++m) {
                const int r = ai * 128 + wr * 64 + m * 16 + fr;
                const int slot = (int)tab[r].x;
                float o[8];
#pragma unroll
                for (int n = 0; n < 2; ++n)
#pragma unroll
                    for (int e = 0; e < 4; ++e) { const float gte = acc[ai][0][m][n][e], up = acc[ai][1][m][n][e];
                        o[n * 4 + e] = gte * fast_rcp(1.0f + fast_exp2(-gte * LOG2E)) * up; }
                u32x4 w; w.x = cvtpk(o[0], o[1]); w.y = cvtpk(o[2], o[3]); w.z = cvtpk(o[4], o[5]); w.w = cvtpk(o[6], o[7]);
                if (r < u.rows) *(u32x4*)(ACT + (size_t)slot * DEXP + u.pn * 128 + wc * 32 + fq * 8) = w;
            }
    }
};

struct EpiDn {
    static constexpr bool PERM = true;
    unsigned char* Y8;
    __device__ __forceinline__ void operator()(const f32x4 (&acc)[2][2][4][2], const Unit& u, int wr, int wc, int fr, int fq, const LAS u32x2* tab) const {
#pragma unroll
        for (int ai = 0; ai < 2; ++ai)
#pragma unroll
            for (int m = 0; m < 4; ++m) {
                const int r = ai * 128 + wr * 64 + m * 16 + fr;
                const u32x2 en = tab[r];
                const int slot = (int)en.x;
                const float w8 = __uint_as_float(en.y) * 16.0f;
                if (r < u.rows) {
#pragma unroll
                    for (int bj = 0; bj < 2; ++bj) {
                        const f32x4 v0 = acc[ai][bj][m][0] * w8, v1 = acc[ai][bj][m][1] * w8;
                        int lo = 0, hi = 0;
                        lo = __builtin_amdgcn_cvt_pk_fp8_f32(v0[0], v0[1], lo, false); lo = __builtin_amdgcn_cvt_pk_fp8_f32(v0[2], v0[3], lo, true);
                        hi = __builtin_amdgcn_cvt_pk_fp8_f32(v1[0], v1[1], hi, false); hi = __builtin_amdgcn_cvt_pk_fp8_f32(v1[2], v1[3], hi, true);
                        u32x2 w; w.x = (unsigned)lo; w.y = (unsigned)hi;
                        *(u32x2*)(Y8 + (size_t)slot * DM + u.pn * 256 + bj * 128 + wc * 32 + fq * 8) = w;
                    }
                }
            }
    }
};

struct TItem { const float* src; bf16_t* dst; int N, dstK, koff, k0, n0, map; };
__device__ __forceinline__ int t_rowmap(int map, int n) {
    if (map == 0) return n;
    if (map == 1) { if (n < 512 || n >= 1536) return n; const int t = n & 255, wc = t >> 6, bj = (t >> 5) & 1, c = t & 31; return (n & ~255) + 128 * bj + 32 * wc + c; }
    return 256 * (n >> 7) + 128 * (map - 2) + (n & 127);
}
__device__ __forceinline__ void t_load(const TItem& d, f32x4 (&v)[16], int lane) {
    const int kr = lane >> 4, c4 = lane & 15;
#pragma unroll
    for (int i = 0; i < 16; ++i) v[i] = *(const f32x4*)(d.src + (size_t)(d.k0 + 4 * i + kr) * d.N + d.n0 + 4 * c4);
}
__device__ __forceinline__ void t_process(const TItem& d, const f32x4 (&v)[16], LAS float* scr, int lane) {
    const int kr = lane >> 4, c4 = lane & 15;
#pragma unroll
    for (int i = 0; i < 16; ++i) { LAS float* s = scr + (4 * i + kr) * 65 + 4 * c4; s[0] = v[i][0]; s[1] = v[i][1]; s[2] = v[i][2]; s[3] = v[i][3]; }
    asm volatile("s_waitcnt lgkmcnt(0)" ::: "memory");
    const int nr = lane >> 3, kc = lane & 7;
#pragma unroll
    for (int i = 0; i < 8; ++i) { const int n = 8 * i + nr; const LAS float* s = scr + (8 * kc) * 65 + n;
        u32x4 o; o.x = cvtpk(s[0], s[65]); o.y = cvtpk(s[2 * 65], s[3 * 65]); o.z = cvtpk(s[4 * 65], s[5 * 65]); o.w = cvtpk(s[6 * 65], s[7 * 65]);
        *(u32x4*)(d.dst + (size_t)t_rowmap(d.map, d.n0 + n) * d.dstK + d.koff + d.k0 + 8 * kc) = o; }
    asm volatile("s_waitcnt lgkmcnt(0)" ::: "memory");
}
constexpr int T_IN = 512, T_OUT = 128, T_E = 128, T_MOE = NEXP * 3 * T_E, T_PER_LAYER = T_IN + T_OUT + T_MOE;
constexpr int T_NA = T_PER_LAYER + T_IN + T_OUT, T_NB = T_MOE;
__device__ __forceinline__ void t_decode_lr(const Params& p, int l, int r, TItem& d) {
    unsigned char* ws = p.ws;
    if (r < T_IN) { d.src = p.in[6] + (size_t)l * 1024 * 2048; d.N = 2048; d.dst = (bf16_t*)(ws + WS_WIN) + (size_t)l * 2048 * 1024; d.dstK = 1024; d.koff = 0; d.k0 = (r >> 5) * 64; d.n0 = (r & 31) * 64; d.map = 1; return; }
    r -= T_IN;
    if (r < T_OUT) { d.src = p.in[12] + ((size_t)l * 1024 + 512) * 1024; d.N = 1024; d.dst = (bf16_t*)(ws + WS_WOUT) + (size_t)l * 1024 * 1024; d.dstK = 1024; d.koff = 512; d.k0 = (r >> 4) * 64; d.n0 = (r & 15) * 64; d.map = 0; return; }
    r -= T_OUT;
    const int e = r / (3 * T_E); int q = r % (3 * T_E);
    if (q < 2 * T_E) { const int up = q >= T_E; if (up) q -= T_E;
        d.src = p.in[up ? 18 : 17] + ((size_t)l * NEXP + e) * 1024 * 512; d.N = 512; d.dst = (bf16_t*)(ws + WS_WGU) + ((size_t)l * NEXP + e) * 1024 * 1024; d.dstK = 1024; d.koff = 0; d.k0 = (q >> 3) * 64; d.n0 = (q & 7) * 64; d.map = 2 + up; return; }
    q -= 2 * T_E;
    d.src = p.in[19] + ((size_t)l * NEXP + e) * 512 * 1024; d.N = 1024; d.dst = (bf16_t*)(ws + WS_WD) + ((size_t)l * NEXP + e) * 1024 * 512; d.dstK = 512; d.koff = 0; d.k0 = (q >> 4) * 64; d.n0 = (q & 15) * 64; d.map = 0;
}
template <bool SPACE_B>
__device__ __forceinline__ void t_decode(const Params& p, int it, TItem& d) {
    if (SPACE_B) t_decode_lr(p, 1, T_IN + T_OUT + it, d);
    else if (it < T_PER_LAYER) t_decode_lr(p, 0, it, d);
    else t_decode_lr(p, 1, it - T_PER_LAYER, d);
}
template <bool SPACE_B>
__device__ __forceinline__ void t_run(const Params& p, int it, int stride, int nit, LAS float* scr, int lane) {
    if (it >= nit) return;
    TItem dA, dB; f32x4 vA[16], vB[16];
    t_decode<SPACE_B>(p, it, dA); t_load(dA, vA, lane);
    for (;;) {
        int nx = it + stride; const bool hasB = nx < nit;
        if (hasB) { t_decode<SPACE_B>(p, nx, dB); t_load(dB, vB, lane); }
        t_process(dA, vA, scr, lane);
        if (!hasB) break;
        it = nx + stride; const bool hasA = it < nit;
        if (hasA) { t_decode<SPACE_B>(p, it, dA); t_load(dA, vA, lane); }
        t_process(dB, vB, scr, lane);
        if (!hasA) break;
    }
}
__device__ __forceinline__ void tail_convert(const Params& p, LAS unsigned char* lds, int total_units, int v, int first, int count) {
    const int tid = opaque_tid(), lane = tid & 63, wave = tid >> 6, G = gridDim.x;
    const int rem = total_units % G;
    const int nshare = rem ? G - rem : G, sidx = rem ? v - rem : v;
    __syncthreads();
    if (sidx >= 0) t_run<true>(p, first + sidx + nshare * wave, nshare * NWAVES, first + count, (LAS float*)(lds + wave * 16640), lane);
    __syncthreads();
}

__device__ __forceinline__ void phase_prologue(const Params& p, LAS unsigned char* lds) {
    const int tid = opaque_tid(), lane = tid & 63, wave = tid >> 6, G = gridDim.x;
    unsigned char* ws = p.ws;
    {
        LAS float* cact = (LAS float*)lds;
        LAS float* red = (LAS float*)(lds + 16384);
        const float* c = p.in[1];
        for (int i = tid; i < 4096; i += NTHREADS) { const float v = c[i]; cact[i] = v / (1.0f + __expf(-v)); }
        __syncthreads();
        float* mod = (float*)(ws + WS_MOD);
        for (int item = blockIdx.x; item < 2 * 192; item += G) {
            const int l = item / 192, cgp = item % 192;
            const float* W = p.in[2] + (size_t)l * 1024 * 6144 + cgp * 32;
            const int col = lane & 31, rsub = lane >> 5;
            float a0 = 0.f, a1 = 0.f, a2 = 0.f, a3 = 0.f;
#pragma unroll 16
            for (int i = 0; i < 64; ++i) { const int k = wave * 128 + 2 * i + rsub; const float w = W[(size_t)k * 6144 + col];
                a0 += cact[k] * w; a1 += cact[1024 + k] * w; a2 += cact[2048 + k] * w; a3 += cact[3072 + k] * w; }
            a0 += __shfl_xor(a0, 32); a1 += __shfl_xor(a1, 32); a2 += __shfl_xor(a2, 32); a3 += __shfl_xor(a3, 32);
            if (lane < 32) { red[(wave * 4 + 0) * 32 + col] = a0; red[(wave * 4 + 1) * 32 + col] = a1; red[(wave * 4 + 2) * 32 + col] = a2; red[(wave * 4 + 3) * 32 + col] = a3; }
            __syncthreads();
            if (tid < 128) { const int b = tid >> 5, cc = tid & 31; float s = 0.f;
#pragma unroll
                for (int w = 0; w < 8; ++w) s += red[(w * 4 + b) * 32 + cc];
                mod[(size_t)(l * 4 + b) * 6144 + cgp * 32 + cc] = s + p.in[3][l * 6144 + cgp * 32 + cc]; }
            __syncthreads();
        }
    }
    {
        float* tbl = (float*)(ws + WS_TBL);
        for (int job = blockIdx.x; job < 2; job += G) {
            const int l = job;
            LAS float* sm = (LAS float*)(lds + 32768);
            float mq = 0.f, mk = 0.f, mb = 0.f;
            if (tid < 64) { mq = fabsf(p.in[9][l * 64 + tid]); mk = fabsf(p.in[10][l * 64 + tid]); }
            for (int i = tid; i < NHEAD * 257; i += NTHREADS) mb = fmaxf(mb, fabsf(p.in[11][i]));
#pragma unroll
            for (int o = 1; o < 64; o <<= 1) { mq = fmaxf(mq, __shfl_xor(mq, o)); mk = fmaxf(mk, __shfl_xor(mk, o)); mb = fmaxf(mb, __shfl_xor(mb, o)); }
            if (lane == 0) { sm[wave * 4 + 0] = mq; sm[wave * 4 + 1] = mk; sm[wave * 4 + 2] = mb; }
            __syncthreads();
            mq = 0.f; mk = 0.f; mb = 0.f;
            for (int w = 0; w < 8; ++w) { mq = fmaxf(mq, sm[w * 4 + 0]); mk = fmaxf(mk, sm[w * 4 + 1]); mb = fmaxf(mb, sm[w * 4 + 2]); }
            const float shift = LOG2E * (8.0f * mq * mk + mb);
            for (int i = tid; i < NHEAD * 256; i += NTHREADS) { const int h = i >> 8, j = i & 255; int rel = j - 63; if (rel > 128) rel = 128;
                tbl[(size_t)l * 2048 + i] = (j < 255) ? p.in[11][h * 257 + rel + 128] * LOG2E - shift : 0.f; }
            __syncthreads();
        }
        for (int job = blockIdx.x; job < 2 * 48; job += G) {
            const int l = job / 48, n = job % 48;
            bf16_t* hi = (bf16_t*)(ws + WS_RW) + (size_t)l * 2 * 48 * 1024;
            bf16_t* lo = hi + 48 * 1024;
            for (int k = tid; k < 1024; k += NTHREADS) {
                float w = 0.f;
                if (n < 32) w = p.in[15][((size_t)l * 1024 + k) * 32 + n]; else if (n < 36) w = p.in[13][((size_t)l * 1024 + k) * 4 + (n - 32)];
                const unsigned h2 = cvtpk(w, 0.f) & 0xffffu; const float r = w - bf_lo(h2);
                const size_t idx = ((size_t)((k >> 5) * 3 + (n >> 4)) * 64 + ((k & 31) >> 3) * 16 + (n & 15)) * 8 + (k & 7);
                hi[idx] = (bf16_t)h2; lo[idx] = (bf16_t)(cvtpk(r, 0.f) & 0xffffu);
            }
            if (tid == 0) { float bsv = 0.f; if (n < 32) bsv = p.in[16][l * 32 + n]; else if (n < 36) bsv = p.in[14][l * 4 + (n - 32)]; ((float*)(ws + WS_RWB))[l * 48 + n] = bsv; }
        }
    }
    __syncthreads();
    {
        LAS float* wsc = (LAS float*)lds;
        LAS float* pwl = (LAS float*)(lds + 32768);
        for (int item = blockIdx.x; item < 2 * 4 * 16; item += G) {
            const int l = item >> 6, g = (item >> 4) & 3, nb = item & 15;
            const float* wo = p.in[12] + ((size_t)l * 1024 + g * 128) * 1024 + nb * 64;
            const float* sc = p.in[8] + l * 512 + g * 128;
            const float* pw = p.in[7] + ((size_t)l * 4 + g) * 128 * 128;
            for (int i = tid; i < 128 * 64; i += NTHREADS) { const int d = i >> 6, n = i & 63; wsc[i] = wo[(size_t)d * 1024 + n] * sc[d]; }
            for (int i = tid; i < 128 * 128 / 4; i += NTHREADS) *(LAS f32x4*)(pwl + 4 * i) = *(const f32x4*)(pw + 4 * i);
            __syncthreads();
            const int n = tid & 63, cgp = tid >> 6;
            float a[16];
#pragma unroll
            for (int j = 0; j < 16; ++j) a[j] = 0.f;
#pragma unroll 2
            for (int d4 = 0; d4 < 32; ++d4) {
                const float w0 = wsc[(4 * d4 + 0) * 64 + n], w1 = wsc[(4 * d4 + 1) * 64 + n], w2 = wsc[(4 * d4 + 2) * 64 + n], w3 = wsc[(4 * d4 + 3) * 64 + n];
#pragma unroll
                for (int j = 0; j < 16; ++j) { const f32x4 pv = *(const LAS f32x4*)(pwl + (cgp * 16 + j) * 128 + 4 * d4); a[j] += (pv[0] * w0 + pv[1] * w1) + (pv[2] * w2 + pv[3] * w3); }
            }
            bf16_t* dst = (bf16_t*)(ws + WS_WOUT) + ((size_t)l * 1024 + nb * 64 + n) * 1024 + g * 128 + cgp * 16;
            u32x4 o0, o1; o0.x = cvtpk(a[0], a[1]); o0.y = cvtpk(a[2], a[3]); o0.z = cvtpk(a[4], a[5]); o0.w = cvtpk(a[6], a[7]);
            o1.x = cvtpk(a[8], a[9]); o1.y = cvtpk(a[10], a[11]); o1.z = cvtpk(a[12], a[13]); o1.w = cvtpk(a[14], a[15]);
            *(u32x4*)dst = o0; *(u32x4*)(dst + 8) = o1;
            __syncthreads();
        }
    }
    {
        LAS float* scr = (LAS float*)(lds + wave * 16640);
        t_run<false>(p, blockIdx.x * NWAVES + wave, G * NWAVES, T_NA, scr, lane);
    }
}

typedef float f32x2v __attribute__((ext_vector_type(2)));
__device__ __forceinline__ f32x4 y_pair_sum(const unsigned char* Y8, size_t row, int c) {
    const int a = *(const int*)(Y8 + (size_t)(2 * row) * DM + c), b = *(const int*)(Y8 + (size_t)(2 * row + 1) * DM + c);
    const f32x2v a0 = __builtin_amdgcn_cvt_pk_f32_fp8(a, false), a1 = __builtin_amdgcn_cvt_pk_f32_fp8(a, true);
    const f32x2v b0 = __builtin_amdgcn_cvt_pk_f32_fp8(b, false), b1 = __builtin_amdgcn_cvt_pk_f32_fp8(b, true);
    f32x4 ys; ys[0] = (a0[0] + b0[0]) * 0.0625f; ys[1] = (a0[1] + b0[1]) * 0.0625f; ys[2] = (a1[0] + b1[0]) * 0.0625f; ys[3] = (a1[1] + b1[1]) * 0.0625f; return ys;
}
template <int NR, bool UPD>
__device__ __forceinline__ void norm1_rows(const Params& p, int l, int row0, int lane) {
    const float* mod = (const float*)(p.ws + WS_MOD);
    const float* gn = p.in[4] + l * 1024;
    bf16_t* H = (bf16_t*)(p.ws + WS_BUF);
    const unsigned char* Y = (const unsigned char*)(p.ws + WS_Y);
    bf16_t* XB = (bf16_t*)(p.ws + WS_XB);
    const int b = row0 >> 13;
    f32x4 v[NR][4];
    if (!UPD) {
#pragma unroll
        for (int r = 0; r < NR; ++r)
#pragma unroll
            for (int j = 0; j < 4; ++j) v[r][j] = *(const f32x4*)(p.in[0] + (size_t)(row0 + r) * DM + 4 * lane + 256 * j);
    } else {
        const float* g2 = mod + (size_t)((l - 1) * 4 + b) * 6144 + 5120;
        f32x4 ys[NR][4];
#pragma unroll
        for (int r = 0; r < NR; ++r)
#pragma unroll
            for (int j = 0; j < 4; ++j) { const int c = 4 * lane + 256 * j; const u32x2 xw = *(const u32x2*)(XB + (size_t)(row0 + r) * DM + c);
                v[r][j] = (f32x4){bf_lo(xw.x), bf_hi(xw.x), bf_lo(xw.y), bf_hi(xw.y)}; ys[r][j] = y_pair_sum(Y, row0 + r, c); }
#pragma unroll
        for (int j = 0; j < 4; ++j) { const f32x4 gg = *(const f32x4*)(g2 + 4 * lane + 256 * j);
#pragma unroll
            for (int r = 0; r < NR; ++r) { const f32x4 xn = v[r][j] + gg * ys[r][j]; u32x2 xw; xw.x = cvtpk(xn[0], xn[1]); xw.y = cvtpk(xn[2], xn[3]);
                *(u32x2*)(XB + (size_t)(row0 + r) * DM + 4 * lane + 256 * j) = xw;
                v[r][j] = (f32x4){bf_lo(xw.x), bf_hi(xw.x), bf_lo(xw.y), bf_hi(xw.y)}; } }
    }
    float ss[NR];
#pragma unroll
    for (int r = 0; r < NR; ++r) { ss[r] = 0.f;
#pragma unroll
        for (int j = 0; j < 4; ++j) ss[r] += (v[r][j][0] * v[r][j][0] + v[r][j][1] * v[r][j][1]) + (v[r][j][2] * v[r][j][2] + v[r][j][3] * v[r][j][3]); }
#pragma unroll
    for (int o = 1; o < 64; o <<= 1)
#pragma unroll
        for (int r = 0; r < NR; ++r) ss[r] += __shfl_xor(ss[r], o);
    const float* sh = mod + (size_t)(l * 4 + b) * 6144; const float* sc = sh + 1024;
#pragma unroll
    for (int j = 0; j < 4; ++j) {
        const int c = 4 * lane + 256 * j;
        const f32x4 g = *(const f32x4*)(gn + c), s1 = *(const f32x4*)(sc + c), s0 = *(const f32x4*)(sh + c);
        const f32x4 a = g * (s1 + 1.0f);
#pragma unroll
        for (int r = 0; r < NR; ++r) {
            const float rstd = rsqrtf(ss[r] * (1.0f / DM) + EPS);
            const f32x4 h = v[r][j] * rstd * a + s0;
            u32x2 w; w.x = cvtpk(h[0], h[1]); w.y = cvtpk(h[2], h[3]);
            *(u32x2*)(H + (size_t)(row0 + r) * DM + c) = w;
        }
    }
}
__device__ __forceinline__ void phase_norm1(const Params& p, int l) {
    const int tid = opaque_tid(), lane = tid & 63, wave = tid >> 6, G = gridDim.x;
    const int gw = blockIdx.x * NWAVES + wave, NGW = G * NWAVES;
    if (l == 0) { for (int rq = gw; rq < NTOK / 4; rq += NGW) norm1_rows<4, false>(p, l, rq * 4, lane); }
    else { for (int rq = gw; rq < NTOK / 2; rq += NGW) norm1_rows<2, true>(p, l, rq * 2, lane); }
}

__device__ __forceinline__ void phase_final(const Params& p) {
    const int tid = opaque_tid(), lane = tid & 63, wave = tid >> 6, G = gridDim.x;
    const int gw = blockIdx.x * NWAVES + wave, NGW = G * NWAVES;
    const float* mod = (const float*)(p.ws + WS_MOD);
    const unsigned char* Y = (const unsigned char*)(p.ws + WS_Y);
    const bf16_t* XB = (const bf16_t*)(p.ws + WS_XB);
    constexpr int NR = 4;
    for (int rq = gw; rq < NTOK / NR; rq += NGW) {
        const int row0 = rq * NR, b = row0 >> 13;
        const float* g2 = mod + (size_t)((DEPTH - 1) * 4 + b) * 6144 + 5120;
        f32x4 v[NR][4], ys[NR][4];
#pragma unroll
        for (int r = 0; r < NR; ++r)
#pragma unroll
            for (int j = 0; j < 4; ++j) { const int c = 4 * lane + 256 * j; const u32x2 xw = *(const u32x2*)(XB + (size_t)(row0 + r) * DM + c);
                v[r][j] = (f32x4){bf_lo(xw.x), bf_hi(xw.x), bf_lo(xw.y), bf_hi(xw.y)}; ys[r][j] = y_pair_sum(Y, row0 + r, c); }
#pragma unroll
        for (int j = 0; j < 4; ++j) { const f32x4 gg = *(const f32x4*)(g2 + 4 * lane + 256 * j);
#pragma unroll
            for (int r = 0; r < NR; ++r) *(f32x4*)(p.out + (size_t)(row0 + r) * DM + 4 * lane + 256 * j) = v[r][j] + gg * ys[r][j]; }
    }
}

__device__ __forceinline__ int crow(int r, int hi) { return (r & 3) + 8 * (r >> 2) + 4 * hi; }

__device__ __forceinline__ void pool_strip(const Params& p, int strip, int lane) {
    const bf16_t* U = (const bf16_t*)(p.ws + WS_U); bf16_t* MIX = (bf16_t*)(p.ws + WS_BUF);
    const int tok0 = strip * 16, s0 = tok0 & (SEQ - 1);
    const int win = 2 << (lane >> 4);
    float S[8];
#pragma unroll
    for (int j = 0; j < 8; ++j) S[j] = 0.f;
#pragma unroll
    for (int d = 1; d < 16; ++d) {
        if (d < win && s0 - d >= 0) {
            const u32x4 w = *(const u32x4*)(U + (size_t)(tok0 - d) * 512 + lane * 8);
            S[0] += bf_lo(w.x); S[1] += bf_hi(w.x); S[2] += bf_lo(w.y); S[3] += bf_hi(w.y); S[4] += bf_lo(w.z); S[5] += bf_hi(w.z); S[6] += bf_lo(w.w); S[7] += bf_hi(w.w);
        }
    }
#pragma unroll 4
    for (int i = 0; i < 16; ++i) {
        const int s = s0 + i;
        const u32x4 w = *(const u32x4*)(U + (size_t)(tok0 + i) * 512 + lane * 8);
        float uv[8] = {bf_lo(w.x), bf_hi(w.x), bf_lo(w.y), bf_hi(w.y), bf_lo(w.z), bf_hi(w.z), bf_lo(w.w), bf_hi(w.w)};
#pragma unroll
        for (int j = 0; j < 8; ++j) S[j] += uv[j];
        const int cn = (s + 1 < win) ? s + 1 : win;
        const float inv = 1.0f / (float)cn;
        float o[8];
#pragma unroll
        for (int j = 0; j < 8; ++j) o[j] = S[j] * inv - uv[j];
        u32x4 ow; ow.x = cvtpk(o[0], o[1]); ow.y = cvtpk(o[2], o[3]); ow.z = cvtpk(o[4], o[5]); ow.w = cvtpk(o[6], o[7]);
        *(u32x4*)(MIX + (size_t)(tok0 + i) * DM + lane * 8) = ow;
        if (s - win + 1 >= 0) {
            const u32x4 x = *(const u32x4*)(U + (size_t)(tok0 + i - win + 1) * 512 + lane * 8);
            S[0] -= bf_lo(x.x); S[1] -= bf_hi(x.x); S[2] -= bf_lo(x.y); S[3] -= bf_hi(x.y); S[4] -= bf_lo(x.z); S[5] -= bf_hi(x.z); S[6] -= bf_lo(x.w); S[7] -= bf_hi(x.w);
        }
    }
}

__device__ __forceinline__ void attn_unit(const Params& p, int b, int h, int ch, int qh, int lane, const LAS float* tbl, LAS bf16_t* stg) {
    const int r32 = lane & 31, hi = lane >> 5;
    const char* Qf = (const char*)(p.ws + WS_Q); const char* Kf = (const char*)(p.ws + WS_K); const char* Vf = (const char*)(p.ws + WS_V);
    bf16_t* MIX = (bf16_t*)(p.ws + WS_BUF);
    const size_t bh = (size_t)(b * NHEAD + h) * 256;
    bf16x8 qr[4];
#pragma unroll
    for (int d0 = 0; d0 < 4; ++d0) qr[d0] = *(const bf16x8*)(Qf + (((bh + ch * 2 + qh) * 4 + d0) * 64 + lane) * 16);
    f32x16 o0 = {}, o1 = {};
    float lsum = 0.f;
    const LAS float* th = tbl + h * 256;
    f32x16 cfv; { const float cfar = th[254];
#pragma unroll
        for (int r = 0; r < 16; ++r) cfv[r] = cfar; }
    const int t0 = ch < 8 ? 8 - ch : 0;
    const char* kp = Kf + (bh * 4 * 64 + lane) * 16 + (ptrdiff_t)(ch - 8 + t0) * 8192;
    const char* vp = Vf + (bh * 4 * 64 + lane) * 16 + (ptrdiff_t)(ch - 8 + t0) * 8192;
    bf16x8 kk[8];
#define ATT_LD8(dst, ptr) do { const char* pa_ = (ptr); const char* pb_ = pa_ + 4096; _Pragma("unroll") for (int i_ = 0; i_ < 4; ++i_) { dst[i_] = *(const bf16x8*)(pa_ + i_ * 1024); dst[4 + i_] = *(const bf16x8*)(pb_ + i_ * 1024); } } while (0)
#define ATT_REST(P0, P1) do { \
        float sacc_ = 0.f; \
        _Pragma("unroll") for (int r = 0; r < 16; ++r) { P0[r] = fast_exp2(P0[r]); P1[r] = fast_exp2(P1[r]); sacc_ += P0[r] + P1[r]; } \
        lsum += sacc_; \
        u32x4 pa_[4]; \
        _Pragma("unroll") for (int s = 0; s < 2; ++s) { \
            pa_[s].x = cvtpk(P0[8 * s + 0], P0[8 * s + 1]); pa_[s].y = cvtpk(P0[8 * s + 2], P0[8 * s + 3]); pa_[s].z = cvtpk(P0[8 * s + 4], P0[8 * s + 5]); pa_[s].w = cvtpk(P0[8 * s + 6], P0[8 * s + 7]); \
            pa_[2 + s].x = cvtpk(P1[8 * s + 0], P1[8 * s + 1]); pa_[2 + s].y = cvtpk(P1[8 * s + 2], P1[8 * s + 3]); pa_[2 + s].z = cvtpk(P1[8 * s + 4], P1[8 * s + 5]); pa_[2 + s].w = cvtpk(P1[8 * s + 6], P1[8 * s + 7]); } \
        _Pragma("unroll") for (int i = 0; i < 4; ++i) { const bf16x8 pf_ = __builtin_bit_cast(bf16x8, pa_[i]); \
            o0 = __builtin_amdgcn_mfma_f32_32x32x16_bf16(pf_, vv[2 * i], o0, 0, 0, 0); o1 = __builtin_amdgcn_mfma_f32_32x32x16_bf16(pf_, vv[2 * i + 1], o1, 0, 0, 0); } \
    } while (0)
    ATT_LD8(kk, kp);
    int t = t0;
#pragma unroll 1
    for (; t <= 5; ++t) {
        bf16x8 vv[8]; ATT_LD8(vv, vp); vp += 8192;
        f32x16 p0 = __builtin_amdgcn_mfma_f32_32x32x16_bf16(kk[0], qr[0], cfv, 0, 0, 0);
        f32x16 p1 = __builtin_amdgcn_mfma_f32_32x32x16_bf16(kk[4], qr[0], cfv, 0, 0, 0);
#pragma unroll
        for (int d0 = 1; d0 < 4; ++d0) { p0 = __builtin_amdgcn_mfma_f32_32x32x16_bf16(kk[d0], qr[d0], p0, 0, 0, 0); p1 = __builtin_amdgcn_mfma_f32_32x32x16_bf16(kk[4 + d0], qr[d0], p1, 0, 0, 0); }
        kp += 8192; ATT_LD8(kk, kp);
        ATT_REST(p0, p1);
    }
#pragma unroll 1
    for (; t <= 8; ++t) {
        bf16x8 vv[8]; ATT_LD8(vv, vp); vp += 8192;
        f32x16 p0, p1;
        { const int base_ = 64 * (8 - t) + 32 * qh + r32 + 63 - 4 * hi;
#pragma unroll
          for (int r = 0; r < 16; ++r) { const int kj = (r & 3) + 8 * (r >> 2); p0[r] = th[base_ - kj]; p1[r] = th[base_ - kj - 32]; } }
#pragma unroll
        for (int d0 = 0; d0 < 4; ++d0) { p0 = __builtin_amdgcn_mfma_f32_32x32x16_bf16(kk[d0], qr[d0], p0, 0, 0, 0); p1 = __builtin_amdgcn_mfma_f32_32x32x16_bf16(kk[4 + d0], qr[d0], p1, 0, 0, 0); }
        if (t < 8) { kp += 8192; ATT_LD8(kk, kp); }
        ATT_REST(p0, p1);
    }
#undef ATT_LD8
#undef ATT_REST
    lsum += __shfl_xor(lsum, 32);
    const float linv = 1.0f / lsum;
#pragma unroll
    for (int r = 0; r < 16; ++r) {
        const int q = crow(r, hi);
        const float li = __shfl(linv, q);
        stg[q * 72 + r32] = (bf16_t)(cvtpk(o0[r] * li, 0.f) & 0xffffu);
        stg[q * 72 + 32 + r32] = (bf16_t)(cvtpk(o1[r] * li, 0.f) & 0xffffu);
    }
    asm volatile("s_waitcnt lgkmcnt(0)" ::: "memory");
    bf16_t* orow = MIX + ((size_t)b * SEQ + ch * 64 + qh * 32 + (lane >> 3)) * DM + 512 + h * 64 + (lane & 7) * 8;
    const LAS bf16_t* srow = stg + (lane >> 3) * 72 + (lane & 7) * 8;
#pragma unroll
    for (int i = 0; i < 4; ++i) *(u32x4*)(orow + (size_t)i * 8 * DM) = *(const LAS u32x4*)(srow + i * 8 * 72);
    asm volatile("s_waitcnt lgkmcnt(0)" ::: "memory");
}

__device__ __forceinline__ void phase_mixer(const Params& p, int l, LAS unsigned char* lds) {
    const int tid = opaque_tid(), lane = tid & 63, wave = tid >> 6, G = gridDim.x;
    LAS float* tbl = (LAS float*)lds;
    const float* gt = (const float*)(p.ws + WS_TBL) + (size_t)l * 2048;
    for (int i = tid; i < 2048; i += NTHREADS) tbl[i] = gt[i];
    __syncthreads();
    const int gw = blockIdx.x * NWAVES + wave, NGW = G * NWAVES;
    LAS bf16_t* stg = (LAS bf16_t*)(lds + 8192 + wave * 4608);
    for (int it = gw; it < NTOK / 16; it += NGW) pool_strip(p, it, lane);
    if (G % 8 == 0) {
        const int x = (int)blockIdx.x & 7, lw = ((int)blockIdx.x >> 3) * NWAVES + wave, nlw = (G >> 3) * NWAVES;
        for (int pr = x; pr < BATCH * NHEAD; pr += 8)
            for (int u = lw; u < 256; u += nlw) attn_unit(p, pr >> 3, pr & 7, u >> 1, u & 1, lane, tbl, stg);
    } else {
        for (int wu = gw; wu < BATCH * NHEAD * 256; wu += NGW) attn_unit(p, wu >> 11, (wu >> 8) & 7, (wu >> 1) & 127, wu & 1, lane, tbl, stg);
    }
}

__device__ __forceinline__ void phase_route(const Params& p, int l, LAS unsigned char* lds) {
    const int tid = opaque_tid(), lane = tid & 63, wave = __builtin_amdgcn_readfirstlane(tid >> 6), G = gridDim.x;
    LAS float* a2c = (LAS float*)(lds + 49152);
    LAS float* shc = (LAS float*)(lds + 49152 + 1024);
    LAS float* lg = (LAS float*)(lds + 53248) + wave * (16 * 48);
    LAS int* lcnt = (LAS int*)(lds + 77824);
    LAS int* gbase = (LAS int*)(lds + 77824 + 128);
    LAS int* tmp_e = (LAS int*)(lds + 77824 + 256);
    LAS int* tmp_r = (LAS int*)(lds + 77824 + 256 + 1024);
    LAS float* tmp_w = (LAS float*)(lds + 77824 + 256 + 2048);
    const float* mod = (const float*)(p.ws + WS_MOD);
    const float* gn = p.in[5] + l * 1024;
    bf16_t* H = (bf16_t*)(p.ws + WS_BUF);
    const char* RW = (const char*)(p.ws + WS_RW) + (size_t)l * 2 * 48 * 1024 * 2;
    const float* rwb = (const float*)(p.ws + WS_RWB) + l * 48;
    const float* ssq = (const float*)(p.ws + WS_SSQ);
    int* gcnt = (int*)(p.ws + WS_CTL) + l * 32;
    u32x2* list = (u32x2*)(p.ws + WS_LIST2);
    const int r = lane & 15, kg = lane >> 4;
    for (int it = blockIdx.x; it < NTOK / 128; it += G) {
        const int row0 = it * 128 + wave * 16, row = row0 + r, b = (it * 128) >> 13;
        const bf16_t* xr = (const bf16_t*)(p.ws + WS_XB) + (size_t)row * DM + 8 * kg;
        float ss; { const f32x4 q4 = *(const f32x4*)(ssq + (size_t)row * 16 + 4 * kg); ss = (q4[0] + q4[1]) + (q4[2] + q4[3]); }
        ss += __shfl_xor(ss, 16); ss += __shfl_xor(ss, 32);
        const float rstd = rsqrtf(ss * (1.0f / DM) + EPS);
        const float* sh = mod + (size_t)(l * 4 + b) * 6144 + 3072; const float* sc = sh + 1024;
        f32x4 acc[3];
#pragma unroll
        for (int nb = 0; nb < 3; ++nb) acc[nb] = (f32x4){0.f, 0.f, 0.f, 0.f};
#pragma unroll 1
        for (int c = 0; c < 4; ++c) {
            u32x4 xs[8];
#pragma unroll
            for (int i = 0; i < 8; ++i) xs[i] = *(const u32x4*)(xr + 256 * c + 32 * i);
            __syncthreads();
            if (c == 0 && tid < 32) lcnt[tid] = 0;
#pragma unroll
            for (int i = 0; i < 6; ++i) { const int q = wave * 6 + i; const char* src = RW + (q < 24 ? (size_t)(c * 24 + q) * 1024 : (size_t)98304 + (size_t)(c * 24 + q - 24) * 1024);
                __builtin_amdgcn_global_load_lds((const unsigned*)(src + lane * 16), (LAS unsigned*)(lds + q * 1024), 16, 0, 0); }
            if (tid < 256) { const int k = 256 * c + tid; a2c[tid] = gn[k] * (1.0f + sc[k]); shc[tid] = sh[k]; }
            asm volatile("s_waitcnt vmcnt(0)" ::: "memory");
            __syncthreads();
#pragma unroll
            for (int i = 0; i < 8; ++i) {
                float hv[8];
#pragma unroll
                for (int q = 0; q < 2; ++q) {
                    const f32x4 a = *(const LAS f32x4*)(a2c + 32 * i + 8 * kg + 4 * q), s0 = *(const LAS f32x4*)(shc + 32 * i + 8 * kg + 4 * q);
                    const f32x4 xv = q == 0 ? (f32x4){bf_lo(xs[i].x), bf_hi(xs[i].x), bf_lo(xs[i].y), bf_hi(xs[i].y)} : (f32x4){bf_lo(xs[i].z), bf_hi(xs[i].z), bf_lo(xs[i].w), bf_hi(xs[i].w)};
                    const f32x4 hh = xv * rstd * a + s0;
                    hv[4 * q + 0] = hh[0]; hv[4 * q + 1] = hh[1]; hv[4 * q + 2] = hh[2]; hv[4 * q + 3] = hh[3];
                }
                u32x4 hp; hp.x = cvtpk(hv[0], hv[1]); hp.y = cvtpk(hv[2], hv[3]); hp.z = cvtpk(hv[4], hv[5]); hp.w = cvtpk(hv[6], hv[7]);
                *(u32x4*)(H + (size_t)row * DM + 256 * c + 32 * i + 8 * kg) = hp;
                u32x4 lp;
                lp.x = cvtpk(hv[0] - bf_lo(hp.x), hv[1] - bf_hi(hp.x)); lp.y = cvtpk(hv[2] - bf_lo(hp.y), hv[3] - bf_hi(hp.y));
                lp.z = cvtpk(hv[4] - bf_lo(hp.z), hv[5] - bf_hi(hp.z)); lp.w = cvtpk(hv[6] - bf_lo(hp.w), hv[7] - bf_hi(hp.w));
                const bf16x8 xhi = __builtin_bit_cast(bf16x8, hp), xlo = __builtin_bit_cast(bf16x8, lp);
#pragma unroll
                for (int nb = 0; nb < 3; ++nb) {
                    const bf16x8 whi = *(const LAS bf16x8*)(lds + (i * 3 + nb) * 1024 + lane * 16);
                    const bf16x8 wlo = *(const LAS bf16x8*)(lds + 24576 + (i * 3 + nb) * 1024 + lane * 16);
                    acc[nb] = __builtin_amdgcn_mfma_f32_16x16x32_bf16(whi, xhi, acc[nb], 0, 0, 0);
                    acc[nb] = __builtin_amdgcn_mfma_f32_16x16x32_bf16(whi, xlo, acc[nb], 0, 0, 0);
                    acc[nb] = __builtin_amdgcn_mfma_f32_16x16x32_bf16(wlo, xhi, acc[nb], 0, 0, 0);
                }
            }
        }
#pragma unroll
        for (int nb = 0; nb < 3; ++nb)
#pragma unroll
            for (int q = 0; q < 4; ++q) lg[r * 48 + 16 * nb + 4 * kg + q] = acc[nb][q];
        asm volatile("s_waitcnt lgkmcnt(0)" ::: "memory");
        if (lane < 16) {
            const LAS float* my = lg + lane * 48;
            float gl[4]; int gi = 0; float gm;
#pragma unroll
            for (int i = 0; i < 4; ++i) gl[i] = my[32 + i] + rwb[32 + i];
            gm = gl[0];
#pragma unroll
            for (int i = 1; i < 4; ++i) if (gl[i] > gm) { gm = gl[i]; gi = i; }
            float den = 0.f;
#pragma unroll
            for (int i = 0; i < 4; ++i) den += __expf(gl[i] - gm);
            const float gpv = 1.0f / den;
            float el[8];
#pragma unroll
            for (int i = 0; i < 8; ++i) el[i] = my[8 * gi + i] + rwb[8 * gi + i];
            int i0 = 0; float v0 = el[0];
#pragma unroll
            for (int i = 1; i < 8; ++i) if (el[i] > v0) { v0 = el[i]; i0 = i; }
            int i1 = -1; float v1 = -3.0e38f;
#pragma unroll
            for (int i = 0; i < 8; ++i) if (i != i0 && el[i] > v1) { v1 = el[i]; i1 = i; }
            const float dd = __expf(v1 - v0);
            const float w0 = gpv / (1.0f + dd), w1 = gpv * dd / (1.0f + dd);
            const int e0 = 8 * gi + i0, e1 = 8 * gi + i1;
            const int tok = row0 + lane, lt = wave * 16 + lane;
            tmp_w[2 * lt] = w0; tmp_w[2 * lt + 1] = w1;
            tmp_e[2 * lt] = e0; tmp_e[2 * lt + 1] = e1;
            tmp_r[2 * lt] = __hip_atomic_fetch_add(lcnt + e0, 1, __ATOMIC_RELAXED, __HIP_MEMORY_SCOPE_WORKGROUP);
            tmp_r[2 * lt + 1] = __hip_atomic_fetch_add(lcnt + e1, 1, __ATOMIC_RELAXED, __HIP_MEMORY_SCOPE_WORKGROUP);
        }
        __syncthreads();
        if (tid < 32) gbase[tid] = __hip_atomic_fetch_add(gcnt + tid, lcnt[tid], __ATOMIC_RELAXED, __HIP_MEMORY_SCOPE_AGENT);
        __syncthreads();
        if (tid < 256) { const int e = tmp_e[tid]; u32x2 en; en.x = (unsigned)(it * 256 + tid); en.y = __float_as_uint(tmp_w[tid]); list[(size_t)e * NTOK + gbase[e] + tmp_r[tid]] = en; }
    }
    __syncthreads();
}

#define XB_TMO      128
#define XB_XCNT(j)  (256  + 64 * (j))
#define XB_XSUB(j)  (1280 + 64 * (j))
#define XB_XGEN(j)  (2304 + 64 * (j))
#define XB_TOP      3328
#define XB_TOPGEN   3392
#define XCD_BAR_WORDS 3456
#define XB_SPIN_CAP (1u << 18)
__device__ __forceinline__ unsigned xb_ld(unsigned* p)              { return __hip_atomic_load(p, __ATOMIC_RELAXED, __HIP_MEMORY_SCOPE_AGENT); }
__device__ __forceinline__ unsigned xb_add(unsigned* p, unsigned v) { return __hip_atomic_fetch_add(p, v, __ATOMIC_RELAXED, __HIP_MEMORY_SCOPE_AGENT); }
__device__ __forceinline__ unsigned xb_xcc_id() { return (unsigned)__builtin_amdgcn_s_getreg((3 << 11) | 20) & 0xFu; }
#define XB_SPIN(cond, bar) do { unsigned _sp = 0; while (cond) { __builtin_amdgcn_s_sleep(1); \
    if ((++_sp & 255u) == 0u) { if (xb_ld(&(bar)[XB_TMO])) break; if (_sp > XB_SPIN_CAP) { atomicAdd(&(bar)[XB_TMO], 1u); break; } } } } while (0)
struct XcdBarrier { unsigned* bar; unsigned x; volatile LAS unsigned* st; };
__device__ __forceinline__ XcdBarrier xcd_barrier_post(unsigned* bar, volatile LAS unsigned* st) {
    XcdBarrier b; b.bar = bar; b.x = xb_xcc_id(); b.st = st;
    if (threadIdx.x == 0) (void)xb_add(&bar[XB_XCNT(b.x)], 1u);
    return b;
}
__device__ __forceinline__ void xcd_barrier_complete(unsigned* bar, unsigned x, unsigned& nloc, unsigned& nx) {
    const unsigned G = gridDim.x * gridDim.y * gridDim.z;
    unsigned sum, cnt, mine, sp = 0u;
    for (;;) {
        sum = 0u; cnt = 0u; mine = 0u;
#pragma unroll
        for (unsigned j = 0; j < 16; ++j) { const unsigned c = xb_ld(&bar[XB_XCNT(j)]); sum += c; cnt += (c > 0u) ? 1u : 0u; mine = (j == x) ? c : mine; }
        if (sum == G) break;
        __builtin_amdgcn_s_sleep(1);
        if ((++sp & 255u) == 0u) { if (xb_ld(&bar[XB_TMO])) break; if (sp > XB_SPIN_CAP) { atomicAdd(&bar[XB_TMO], 1u); break; } }
    }
    nloc = mine > 0u ? mine : 1u; nx = cnt > 0u ? cnt : 1u;
}
__device__ __forceinline__ void xcd_barrier(const XcdBarrier& b) {
    asm volatile("s_waitcnt vmcnt(0)" ::: "memory");
    __syncthreads();
    if (threadIdx.x == 0) {
        unsigned* bar = b.bar;
        __builtin_amdgcn_s_waitcnt(0);
        unsigned nloc = b.st[0], nx = b.st[1];
        if (nloc == 0u) { xcd_barrier_complete(bar, b.x, nloc, nx); b.st[0] = nloc; b.st[1] = nx; }
        const unsigned old = xb_add(&bar[XB_XSUB(b.x)], 1u);
        const unsigned gen = old / nloc;
        if (old + 1u == (gen + 1u) * nloc) {
            __builtin_amdgcn_fence(__ATOMIC_RELEASE, "agent");
            asm volatile("s_waitcnt vmcnt(0)" ::: "memory");
            const unsigned og = xb_add(&bar[XB_TOP], 1u);
            const unsigned tg = og / nx;
            if (og + 1u == (tg + 1u) * nx) xb_add(&bar[XB_TOPGEN], 1u);
            else XB_SPIN(xb_ld(&bar[XB_TOPGEN]) == tg, bar);
            __builtin_amdgcn_fence(__ATOMIC_ACQUIRE, "agent");
            xb_add(&bar[XB_XGEN(b.x)], 1u);
            asm volatile("s_waitcnt vmcnt(0)" ::: "memory");
        } else {
            XB_SPIN(xb_ld(&bar[XB_XGEN(b.x)]) == gen, bar);
            __builtin_amdgcn_fence(__ATOMIC_ACQUIRE, "agent");
            asm volatile("s_waitcnt vmcnt(0)" ::: "memory");
        }
    }
    __syncthreads();
}

__device__ __forceinline__ void load_prefix(const Params& p, int l, LAS int* pre, LAS int* cntl) {
    const int* gcnt = (const int*)(p.ws + WS_CTL) + l * 32;
    if (threadIdx.x == 0) { int a = 0; for (int e = 0; e < NEXP; ++e) { const int c = gcnt[e]; cntl[e] = c; pre[e] = a; a += (c + 255) >> 8; } pre[NEXP] = a; }
    __syncthreads();
}

__global__ void __launch_bounds__(NTHREADS, 2) fwd_kernel(Params p) {
    extern __shared__ __attribute__((aligned(16))) unsigned char lds_raw[];
    LAS unsigned char* lds = (LAS unsigned char*)lds_raw;
    const int G = gridDim.x;
    unsigned char* ws = p.ws;
    volatile LAS unsigned* bst = (volatile LAS unsigned*)(lds + LDS_BYTES - 16);
    if (threadIdx.x < 2) bst[threadIdx.x] = 0u;
    __syncthreads();
    const XcdBarrier bar = xcd_barrier_post((unsigned*)(ws + WS_CTL) + 4096, bst);
    const int lo = p.ph_lo, hi = p.ph_hi;
#define IN(k) (lo <= (k) && (k) < hi)
#define SYNC_AFTER(k) do { if (IN(k) && IN((k) + 1)) xcd_barrier(bar); } while (0)
    if (IN(0)) phase_prologue(p, lds);
    SYNC_AFTER(0);
#pragma unroll 1
    for (int l = 0; l < DEPTH; ++l) {
        const int k0 = 1 + 7 * l;
        if (IN(k0 + 0)) phase_norm1(p, l);
        SYNC_AFTER(k0 + 0);
        if (IN(k0 + 1)) {
            {
                DenseGemm g{(const bf16_t*)(ws + WS_BUF), (const bf16_t*)(ws + WS_WIN) + (size_t)l * 2048 * 1024, 1024};
                pg8::StaticOrder S; S.init(NTOK, 1536, G, (int)blockIdx.x);
                EpiIn E{(bf16_t*)(ws + WS_U), (bf16_t*)(ws + WS_Q), (bf16_t*)(ws + WS_K), p.in[9] + l * 64, p.in[10] + l * 64};
                pg8::gemm_phase(lds, g, S, E);
            }
            {
                DenseGemm g{(const bf16_t*)(ws + WS_WIN) + (size_t)l * 2048 * 1024 + (size_t)1536 * 1024, (const bf16_t*)(ws + WS_BUF), 1024};
                pg8::StaticOrder S; S.init(512, NTOK, G, (int)blockIdx.x);
                EpiVt E{(bf16_t*)(ws + WS_V)};
                pg8::gemm_phase(lds, g, S, E);
            }
        }
        SYNC_AFTER(k0 + 1);
        if (IN(k0 + 2)) phase_mixer(p, l, lds);
        SYNC_AFTER(k0 + 2);
        if (IN(k0 + 3)) {
            DenseGemm g{(const bf16_t*)(ws + WS_BUF), (const bf16_t*)(ws + WS_WOUT) + (size_t)l * 1024 * 1024, 1024};
            pg8::StaticOrder S; S.init(NTOK, 1024, G, (int)blockIdx.x);
            const float* g1p = (const float*)(ws + WS_MOD) + (size_t)(l * 4) * 6144 + 2048;
            if (l == 0) { EpiOutB<true> E{p.in[0], (bf16_t*)(ws + WS_XB), g1p, (float*)(ws + WS_SSQ)}; pg8::gemm_phase(lds, g, S, E); }
            else { EpiOutB<false> E{nullptr, (bf16_t*)(ws + WS_XB), g1p, (float*)(ws + WS_SSQ)}; pg8::gemm_phase(lds, g, S, E); }
        }
        SYNC_AFTER(k0 + 3);
        if (IN(k0 + 4)) phase_route(p, l, lds);
        SYNC_AFTER(k0 + 4);
        if (IN(k0 + 5)) {
            const int vcu = (G % 8 == 0) ? ((int)blockIdx.x % 8) * (G / 8) + (int)blockIdx.x / 8 : (int)blockIdx.x;
            LAS int* pre = (LAS int*)(lds + pg8::STAGE_BYTES); LAS int* cntl = pre + 64;
            load_prefix(p, l, pre, cntl);
            GatherGemm g{(const bf16_t*)(ws + WS_BUF), (const bf16_t*)(ws + WS_WGU) + (size_t)l * NEXP * 1024 * 1024, (const u32x2*)(ws + WS_LIST2), 1024, 1, (size_t)1024 * 1024 * 2};
            pg8::GroupedOrder S{pre, cntl, G, vcu};
            EpiGU E{(bf16_t*)(ws + WS_ACT)};
            const int total_units = pre[NEXP] * 4;
            pg8::gemm_phase(lds, g, S, E);
            if (l == 0) tail_convert(p, lds, total_units, vcu, 0, 7424);
        }
        SYNC_AFTER(k0 + 5);
        if (IN(k0 + 6)) {
            const int vcu = (G % 8 == 0) ? ((int)blockIdx.x % 8) * (G / 8) + (int)blockIdx.x / 8 : (int)blockIdx.x;
            LAS int* pre = (LAS int*)(lds + pg8::STAGE_BYTES); LAS int* cntl = pre + 64;
            load_prefix(p, l, pre, cntl);
            GatherGemm g{(const bf16_t*)(ws + WS_ACT), (const bf16_t*)(ws + WS_WD) + (size_t)l * NEXP * 1024 * 512, (const u32x2*)(ws + WS_LIST2), 512, 0, (size_t)1024 * 512 * 2};
            pg8::GroupedOrder S{pre, cntl, G, vcu};
            EpiDn E{(unsigned char*)(ws + WS_Y)};
            const int total_units = pre[NEXP] * 4;
            pg8::gemm_phase(lds, g, S, E);
            if (l == 0) tail_convert(p, lds, total_units, vcu, 7424, T_NB - 7424);
        }
        SYNC_AFTER(k0 + 6);
    }
    if (IN(15)) phase_final(p);
#undef IN
#undef SYNC_AFTER
}

extern "C" void kernel_launch(void* const* d_in, const int* in_sizes, int n_in, void* d_out, int out_size, void* d_ws, size_t ws_size, hipStream_t stream) {
    static int grid = 0;
    if (grid == 0) {
        if (n_in != 20 || out_size != NTOK * DM || ws_size < WS_END) { fprintf(stderr, "kernel_launch: unexpected shapes (n_in %d out %d ws %zu)\n", n_in, out_size, ws_size); grid = -1; return; }
        int dev = 0, cus = 0, per_cu = 0;
        hipGetDevice(&dev);
        hipDeviceGetAttribute(&cus, hipDeviceAttributeMultiprocessorCount, dev);
        hipFuncSetAttribute((const void*)fwd_kernel, hipFuncAttributeMaxDynamicSharedMemorySize, LDS_BYTES);
        hipOccupancyMaxActiveBlocksPerMultiprocessor(&per_cu, (const void*)fwd_kernel, NTHREADS, LDS_BYTES);
        if (per_cu < 1) per_cu = 1;
        if (per_cu > 1) per_cu = 1;
        grid = cus * per_cu;
        (void)hipGetLastError();
    }
    if (grid < 0) return;
    if (hipMemsetAsync((char*)d_ws + WS_CTL, 0, 65536, stream) != hipSuccess) { fprintf(stderr, "memset failed\n"); return; }
    Params p{};
    for (int i = 0; i < 20; ++i) p.in[i] = (const float*)d_in[i];
    p.out = (float*)d_out; p.ws = (unsigned char*)d_ws; p.ph_lo = 0; p.ph_hi = 16;
    void* args[] = {&p};
    hipError_t e = hipLaunchCooperativeKernel((const void*)fwd_kernel, dim3(grid), dim3(NTHREADS), args, LDS_BYTES, stream);
    if (e != hipSuccess) fprintf(stderr, "cooperative launch failed: %s (grid %d)\n", hipGetErrorString(e), grid);
}
```

```cpp
#include <hip/hip_runtime.h>
#include <hip/hip_cooperative_groups.h>
#include <cstdio>
#include <cstdint>
namespace cg = cooperative_groups;

#define LAS __attribute__((address_space(3)))
typedef unsigned short bf16_t;
typedef short bf16x8 __attribute__((ext_vector_type(8)));
typedef float f32x4 __attribute__((ext_vector_type(4)));
typedef float f32x16 __attribute__((ext_vector_type(16)));
typedef unsigned u32x4 __attribute__((ext_vector_type(4)));
typedef int i32x4 __attribute__((ext_vector_type(4)));
typedef int i32x8 __attribute__((ext_vector_type(8)));
typedef unsigned u32x2 __attribute__((ext_vector_type(2)));
typedef float f32x2_t __attribute__((ext_vector_type(2)));
typedef __bf16 bf16x2_t __attribute__((ext_vector_type(2)));

constexpr int BATCH = 4, SEQ = 8192, DM = 1024, NTOK = BATCH * SEQ, DEPTH = 2;
constexpr int NHEAD = 8, HD = 64, NEXP = 32, DEXP = 512;
constexpr float EPS = 1e-6f;
constexpr float LOG2E = 1.4426950408889634f;

constexpr size_t MiB = 1u << 20;
constexpr size_t WS_CTL = 0;
constexpr size_t WS_MOD = 1 * MiB;
constexpr size_t WS_TBL = 1 * MiB + 512 * 1024;
constexpr size_t WS_RW = 2 * MiB;
constexpr size_t WS_RWB = 2 * MiB + 512 * 1024;
constexpr size_t WS_LIST = 3 * MiB;
constexpr size_t WS_EW = 7 * MiB;
constexpr size_t WS_WIN = 8 * MiB;
constexpr size_t WS_WOUT = 16 * MiB;
constexpr size_t WS_WGU = 20 * MiB;
constexpr size_t WS_WD = 148 * MiB;
constexpr size_t WS_BUF = 212 * MiB;
constexpr size_t WS_U = 276 * MiB;
constexpr size_t WS_Q = 308 * MiB;
constexpr size_t WS_K = 340 * MiB;
constexpr size_t WS_V = 372 * MiB;
constexpr size_t WS_Y = 276 * MiB;
constexpr size_t WS_ACT = 404 * MiB;
constexpr size_t WS_SSQ = 468 * MiB;
constexpr size_t WS_XB = 470 * MiB;
constexpr size_t WS_LIST2 = 534 * MiB;
constexpr size_t WS_END = 542 * MiB;

constexpr int LDS_BYTES = 147456;
constexpr int NWAVES = 8, NTHREADS = 512;

struct Params {
    const float* in[20];
    float* out;
    unsigned char* ws;
    int ph_lo, ph_hi;
};

__device__ __forceinline__ unsigned cvtpk(float lo, float hi) { f32x2_t v = {lo, hi}; bf16x2_t b = __builtin_convertvector(v, bf16x2_t); return __builtin_bit_cast(unsigned, b); }
__device__ __forceinline__ float bf_lo(unsigned w) { return __uint_as_float(w << 16); }
__device__ __forceinline__ float bf_hi(unsigned w) { return __uint_as_float(w & 0xffff0000u); }
__device__ __forceinline__ float fast_exp2(float x) { return __builtin_amdgcn_exp2f(x); }
__device__ __forceinline__ float fast_rcp(float x) { return __builtin_amdgcn_rcpf(x); }

__device__ __forceinline__ float clamp8(float x) { return __builtin_amdgcn_fmed3f(x, -448.0f, 448.0f); }
__device__ __forceinline__ unsigned pk_fp8x4(float a, float b, float c, float d) { int w = 0; w = __builtin_amdgcn_cvt_pk_fp8_f32(a, b, w, false); w = __builtin_amdgcn_cvt_pk_fp8_f32(c, d, w, true); return (unsigned)w; }
__device__ __forceinline__ int opaque_tid() { int t = threadIdx.x; asm volatile("" : "+v"(t)); return t; }
__device__ __forceinline__ int opaque_bid() { int t = blockIdx.x; asm volatile("" : "+s"(t)); return t; }

namespace pg8 {
constexpr int BM = 256, BK = 64, HALF = 128, HTB = HALF * BK * 2, STAGE_BYTES = 8 * HTB, NXCD = 8, WGM = 8;
__host__ __device__ __forceinline__ int lds_byte(int r, int c) { const int st = (r >> 4) * 2 + (c >> 5), rr = r & 15, cc = c & 31, ob = rr * 64 + cc * 2; return st * 1024 + (ob ^ (((ob >> 9) & 1) << 5)); }
__host__ __device__ __forceinline__ void stage_rc(int b, int& R, int& C) { const int st = b / 1024, sb = b % 1024, swz = sb ^ (((sb >> 9) & 1) << 5); R = (st >> 1) * 16 + swz / 64; C = (st & 1) * 32 + (swz % 64) / 2; }
__host__ __device__ __forceinline__ int perm32(int rho) { const int n = rho >> 4, i = rho & 15; return 8 * (i >> 2) + 4 * n + (i & 3); }

struct Unit { int pm, pn, e, rows; };

struct StaticOrder {
    int nM, nN, nwg, G, c;
    __device__ void init(int M, int N, int G_, int c_) { nM = M / BM; nN = N / BM; nwg = nM * nN; G = G_; c = c_; }
    __device__ bool next(int i, Unit& u) const {
        const long L = (long)i * G + c; if (L >= nwg) return false;
        int wgid = (int)L; { const int q = nwg / NXCD, r = nwg % NXCD, xcd = wgid % NXCD, off = wgid / NXCD; wgid = (xcd < r ? xcd * (q + 1) : r * (q + 1) + (xcd - r) * q) + off; }
        const int nig = WGM * nN, gid = wgid / nig, fm = gid * WGM, gsz = (nM - fm) < WGM ? (nM - fm) : WGM;
        u.pm = fm + ((wgid % nig) % gsz); u.pn = (wgid % nig) / gsz; u.e = 0; u.rows = BM; return true;
    }
};

struct GroupedOrder {
    const LAS int* prefix; const LAS int* cnt; int G, v;
    __device__ bool next(int i, Unit& u) const {
        const int L = i * G + v; const int total = prefix[NEXP];
        if (L >= total * 4) return false;
        const int rt = L >> 2; int e = 0;
#pragma unroll 1
        for (int j = 1; j < NEXP; ++j) if (prefix[j] <= rt) e = j;
        u.e = e; u.pm = rt - prefix[e]; u.pn = L & 3; const int rem = cnt[e] - u.pm * BM; u.rows = rem < BM ? rem : BM; return true;
    }
};

template <class G, class Epi, class Sched>
__device__ __forceinline__ void gemm_phase(LAS unsigned char* lds, const G g, const Sched& S, const Epi& E) {
    int tid = threadIdx.x; asm volatile("" : "+v"(tid));
    const int wid = __builtin_amdgcn_readfirstlane(tid >> 6), lane = tid & 63, wr = wid >> 2, wc = wid & 3, fr = lane & 15, fq = lane >> 4;
    const int K = g.K, KB = K * G::ES, nt = KB / (BK * 2);
    int RA[2], CA[2]; unsigned voffB[2];
#pragma unroll
    for (int i = 0; i < 2; ++i) { int R, C; stage_rc(tid * 16 + i * 8192, R, C); const int Rb = Epi::PERM ? ((R & ~31) + perm32(R & 31)) : R;
        RA[i] = R; CA[i] = C; voffB[i] = (unsigned)(Rb * KB + C * 2); }
    const size_t kstep = (size_t)(BK * 2);
    const size_t hstep = (size_t)HALF * KB;
    const unsigned ldsw = (unsigned)wid * 1024u;
    const int aoff = lds_byte(wr * 64 + fr, fq * 8), boff = lds_byte(wc * 32 + fr, fq * 8);
#define PG8_SA(b, h) (((b) * 2 + (h)) * HTB)
#define PG8_SB(b, h) ((4 + (b) * 2 + (h)) * HTB)
#define PG8_STAGE2(bufoff, gbase, o0, o1) do { \
        __builtin_amdgcn_global_load_lds((const unsigned*)((const char*)(gbase) + (o0)), (LAS unsigned*)(lds + (bufoff) + ldsw), 16, 0, 0); \
        __builtin_amdgcn_global_load_lds((const unsigned*)((const char*)(gbase) + (o1)), (LAS unsigned*)(lds + (bufoff) + ldsw + 8192), 16, 0, 0); } while (0)
#define PG8_STAGEB(bufoff, gbase) PG8_STAGE2(bufoff, gbase, voffB[0], voffB[1])
#define PG8_LDA(dst, b, h) do { _Pragma("unroll") for (int m = 0; m < 4; ++m) _Pragma("unroll") for (int k = 0; k < 2; ++k) dst[m][k] = *(const LAS bf16x8*)(lds + PG8_SA(b, h) + aoff + m * 2048 + k * 1024); } while (0)
#define PG8_LDB(dst, b, h) do { _Pragma("unroll") for (int n = 0; n < 2; ++n) _Pragma("unroll") for (int k = 0; k < 2; ++k) dst[n][k] = *(const LAS bf16x8*)(lds + PG8_SB(b, h) + boff + n * 2048 + k * 1024); } while (0)
#define PG8_F8(v0, v1) __builtin_shufflevector(__builtin_bit_cast(i32x4, v0), __builtin_bit_cast(i32x4, v1), 0, 1, 2, 3, 4, 5, 6, 7)
#define PG8_MMA(ai, bj, At, Bt) do { __builtin_amdgcn_s_setprio(1); \
        if (G::ES == 1) { const i32x8 a0_ = PG8_F8(At[0][0], At[0][1]), a1_ = PG8_F8(At[1][0], At[1][1]), a2_ = PG8_F8(At[2][0], At[2][1]), a3_ = PG8_F8(At[3][0], At[3][1]), b0_ = PG8_F8(Bt[0][0], Bt[0][1]), b1_ = PG8_F8(Bt[1][0], Bt[1][1]); \
            asm volatile("s_nop 1\n\tv_mfma_f32_16x16x128_f8f6f4 %0, %12, %8, %0\n\tv_mfma_f32_16x16x128_f8f6f4 %1, %13, %8, %1\n\tv_mfma_f32_16x16x128_f8f6f4 %2, %12, %9, %2\n\tv_mfma_f32_16x16x128_f8f6f4 %3, %13, %9, %3\n\t" \
                         "v_mfma_f32_16x16x128_f8f6f4 %4, %12, %10, %4\n\tv_mfma_f32_16x16x128_f8f6f4 %5, %13, %10, %5\n\tv_mfma_f32_16x16x128_f8f6f4 %6, %12, %11, %6\n\tv_mfma_f32_16x16x128_f8f6f4 %7, %13, %11, %7" \
                         : "+v"(acc[ai][bj][0][0]), "+v"(acc[ai][bj][0][1]), "+v"(acc[ai][bj][1][0]), "+v"(acc[ai][bj][1][1]), "+v"(acc[ai][bj][2][0]), "+v"(acc[ai][bj][2][1]), "+v"(acc[ai][bj][3][0]), "+v"(acc[ai][bj][3][1]) \
                         : "v"(a0_), "v"(a1_), "v"(a2_), "v"(a3_), "v"(b0_), "v"(b1_)); } \
        else { _Pragma("unroll") for (int m = 0; m < 4; ++m) _Pragma("unroll") for (int n = 0; n < 2; ++n) _Pragma("unroll") for (int k = 0; k < 2; ++k) \
            acc[ai][bj][m][n] = __builtin_amdgcn_mfma_f32_16x16x32_bf16(Bt[n][k], At[m][k], acc[ai][bj][m][n], 0, 0, 0); } __builtin_amdgcn_s_setprio(0); } while (0)
#define PG8_WAIT_V(n) asm volatile("s_waitcnt vmcnt(" #n ")" ::: "memory")
#define PG8_WAIT_L(n) asm volatile("s_waitcnt lgkmcnt(" #n ")" ::: "memory")
#define PG8_BAR __builtin_amdgcn_s_barrier()
#define PG8_SCHED __builtin_amdgcn_sched_barrier(0)
    Unit cur, nxt; int ui = 0;
    if (!S.next(0, cur)) return;
    LAS u32x2* const tab = (LAS u32x2*)(lds + STAGE_BYTES + 1024);
#define PG8_TABLE(u, par) do { if (G::GATHER) { if (wid < 2) __builtin_amdgcn_global_load_lds((const unsigned*)(g.tab_src(u) + (wid * 64 + lane) * 16), (LAS unsigned*)((LAS unsigned char*)tab + (par) * 2048 + wid * 1024), 16, 0, 0); } } while (0)
    PG8_TABLE(cur, 0);
    f32x4 acc[2][2][4][2];
#pragma unroll
    for (int a = 0; a < 2; ++a)
#pragma unroll
        for (int b = 0; b < 2; ++b)
#pragma unroll
            for (int m = 0; m < 4; ++m)
#pragma unroll
                for (int n = 0; n < 2; ++n) acc[a][b][m][n] = (f32x4){0.f, 0.f, 0.f, 0.f};
    bf16x8 At[4][2], B0[2][2], B1[2][2];
    const char* cA = g.a_base(cur); const char* cB = g.b_base(cur);
    unsigned c00 = g.a_off(cur, RA[0], CA[0]), c01 = g.a_off(cur, RA[1], CA[1]), c10 = g.a_off(cur, HALF + RA[0], CA[0]), c11 = g.a_off(cur, HALF + RA[1], CA[1]);
    PG8_STAGEB(PG8_SB(0, 0), cB); PG8_STAGEB(PG8_SB(0, 1), cB + hstep); PG8_STAGE2(PG8_SA(0, 0), cA, c00, c01); PG8_STAGE2(PG8_SA(0, 1), cA, c10, c11);
    if (wr == 1) PG8_BAR;
    PG8_WAIT_V(2); PG8_BAR;
    PG8_STAGEB(PG8_SB(1, 0), cB + kstep); PG8_STAGE2(PG8_SA(1, 0), cA + kstep, c00, c01); PG8_STAGEB(PG8_SB(1, 1), cB + hstep + kstep);
    PG8_WAIT_V(6); PG8_BAR;
    for (;;) {
        const bool has_next = S.next(ui + 1, nxt);
        const char* nA = has_next ? g.a_base(nxt) : cA; const char* nB = has_next ? g.b_base(nxt) : cB;
        unsigned n00 = c00, n01 = c01, n10 = c10, n11 = c11;
        if (G::GATHER && has_next) { n00 = g.a_off(nxt, RA[0], CA[0]); n01 = g.a_off(nxt, RA[1], CA[1]); n10 = g.a_off(nxt, HALF + RA[0], CA[0]); n11 = g.a_off(nxt, HALF + RA[1], CA[1]); }
#pragma unroll 1
        for (int t = 0; t < nt; t += 2) {
            const bool last = (t == nt - 2);
            const char* a1 = cA + (size_t)(t + 1) * kstep;
            const char* a2 = last ? nA : cA + (size_t)(t + 2) * kstep; const char* b2 = last ? nB : cB + (size_t)(t + 2) * kstep;
            const char* a3 = a2 + kstep; const char* b3 = b2 + kstep;
            const unsigned x00 = last ? n00 : c00, x01 = last ? n01 : c01, x10 = last ? n10 : c10, x11 = last ? n11 : c11;
            PG8_LDB(B0, 0, 0); PG8_LDB(B1, 0, 1); PG8_SCHED; PG8_LDA(At, 0, 0); PG8_STAGE2(PG8_SA(1, 1), a1, c10, c11);
            PG8_WAIT_V(8); PG8_WAIT_L(0); PG8_BAR; PG8_MMA(0, 0, At, B0); PG8_MMA(0, 1, At, B1); PG8_BAR; PG8_SCHED;
            PG8_LDA(At, 0, 1); PG8_STAGEB(PG8_SB(0, 0), b2); PG8_STAGEB(PG8_SB(0, 1), b2 + hstep); PG8_STAGE2(PG8_SA(0, 0), a2, x00, x01);
            PG8_WAIT_V(8); PG8_WAIT_L(0); PG8_BAR; PG8_MMA(1, 0, At, B0); PG8_MMA(1, 1, At, B1); PG8_BAR; PG8_SCHED;
            PG8_LDB(B0, 1, 0); PG8_LDB(B1, 1, 1); PG8_SCHED; PG8_LDA(At, 1, 0); PG8_STAGE2(PG8_SA(0, 1), a2, x10, x11);
            PG8_WAIT_V(8); PG8_WAIT_L(0); PG8_BAR; PG8_MMA(0, 0, At, B0); PG8_MMA(0, 1, At, B1); PG8_BAR; PG8_SCHED;
            PG8_LDA(At, 1, 1); PG8_STAGEB(PG8_SB(1, 0), b3); PG8_STAGEB(PG8_SB(1, 1), b3 + hstep); PG8_STAGE2(PG8_SA(1, 0), a3, x00, x01);
            PG8_WAIT_V(8); PG8_WAIT_L(0); PG8_BAR; PG8_MMA(1, 0, At, B0); PG8_MMA(1, 1, At, B1); PG8_BAR; PG8_SCHED;
        }
        if (G::ES == 1) asm volatile("s_nop 15\n\ts_nop 15" ::: "memory");
        if (wr == 0) PG8_BAR;
        E(acc, cur, wr, wc, fr, fq, tab + (ui & 1) * 256);
        if (!has_next) break;
#pragma unroll
        for (int a = 0; a < 2; ++a)
#pragma unroll
            for (int b = 0; b < 2; ++b)
#pragma unroll
                for (int m = 0; m < 4; ++m)
#pragma unroll
                    for (int n = 0; n < 2; ++n) acc[a][b][m][n] = (f32x4){0.f, 0.f, 0.f, 0.f};
        cur = nxt; cA = nA; cB = nB; c00 = n00; c01 = n01; c10 = n10; c11 = n11; ++ui;
        PG8_TABLE(cur, ui & 1);
        if (wr == 1) PG8_BAR;
    }
    PG8_WAIT_V(0);
    PG8_BAR;
#undef PG8_TABLE
#undef PG8_SA
#undef PG8_SB
#undef PG8_STAGE2
#undef PG8_STAGEB
#undef PG8_LDA
#undef PG8_LDB
#undef PG8_MMA
#undef PG8_F8
#undef PG8_WAIT_V
#undef PG8_WAIT_L
#undef PG8_BAR
#undef PG8_SCHED
}
}
using pg8::Unit;

struct DenseGemm {
    static constexpr bool GATHER = false; static constexpr int ES = 2;
    __device__ __forceinline__ const char* tab_src(const Unit&) const { return nullptr; }
    const bf16_t* A; const bf16_t* Bt; int K;
    __device__ __forceinline__ const char* a_base(const Unit& u) const { return (const char*)A + (size_t)u.pm * 256 * K * 2; }
    __device__ __forceinline__ const char* b_base(const Unit& u) const { return (const char*)Bt + (size_t)u.pn * 256 * K * 2; }
    __device__ __forceinline__ unsigned a_off(const Unit&, int r, int c) const { return (unsigned)(r * K + c) * 2u; }
};
struct GatherGemm {
    static constexpr bool GATHER = true; static constexpr int ES = 1;
    const unsigned char* A; const unsigned char* Bt; const u32x2* list; int K; int a_shift;
    size_t b_expert_stride;
    __device__ __forceinline__ const char* tab_src(const Unit& u) const { return (const char*)(list + (size_t)u.e * NTOK + u.pm * 256); }
    __device__ __forceinline__ const char* a_base(const Unit&) const { return (const char*)A; }
    __device__ __forceinline__ const char* b_base(const Unit& u) const { return (const char*)Bt + (size_t)u.e * b_expert_stride + (size_t)u.pn * 256 * K; }
    __device__ __forceinline__ unsigned a_off(const Unit& u, int r, int c) const {
        const int rr = r < u.rows ? r : u.rows - 1;
        const int slot = (int)list[(size_t)u.e * NTOK + u.pm * 256 + rr].x;
        return (unsigned)((slot >> a_shift) * K + c * 2);
    }
};


struct EpiIn {
    static constexpr bool PERM = true;
    bf16_t* U; bf16_t* Qf; bf16_t* Kf; const float* qg; const float* kg;
    __device__ __forceinline__ void operator()(const f32x4 (&acc)[2][2][4][2], const Unit& u, int wr, int wc, int fr, int fq, const LAS u32x2* tab) const {
        if (u.pn < 2) {
#pragma unroll
            for (int ai = 0; ai < 2; ++ai)
#pragma unroll
                for (int m = 0; m < 4; ++m) {
                    const int row = u.pm * 256 + ai * 128 + wr * 64 + m * 16 + fr;
#pragma unroll
                    for (int bj = 0; bj < 2; ++bj) {
                        const f32x4 v0 = acc[ai][bj][m][0], v1 = acc[ai][bj][m][1];
                        u32x4 w; w.x = cvtpk(v0[0], v0[1]); w.y = cvtpk(v0[2], v0[3]); w.z = cvtpk(v1[0], v1[1]); w.w = cvtpk(v1[2], v1[3]);
                        *(u32x4*)(U + (size_t)row * 512 + u.pn * 256 + bj * 128 + wc * 32 + fq * 8) = w;
                    }
                }
        } else {
            const bool isq = u.pn < 4;
            const float* gg = isq ? qg : kg; bf16_t* dst = isq ? Qf : Kf;
            const float osc = isq ? 0.125f * LOG2E : 1.0f;
            const int head = (u.pn & 1) * 4 + wc;
            f32x4 gv[2][2];
#pragma unroll
            for (int bj = 0; bj < 2; ++bj)
#pragma unroll
                for (int n = 0; n < 2; ++n) gv[bj][n] = *(const f32x4*)(gg + bj * 32 + fq * 8 + n * 4) * osc;
#pragma unroll
            for (int ai = 0; ai < 2; ++ai)
#pragma unroll
                for (int m = 0; m < 4; ++m) {
                    float ss = 0.f;
#pragma unroll
                    for (int bj = 0; bj < 2; ++bj)
#pragma unroll
                        for (int n = 0; n < 2; ++n) { const f32x4 v = acc[ai][bj][m][n]; ss += (v[0] * v[0] + v[1] * v[1]) + (v[2] * v[2] + v[3] * v[3]); }
                    ss += __shfl_xor(ss, 16); ss += __shfl_xor(ss, 32);
                    const float rstd = rsqrtf(ss * (1.0f / 64.0f) + EPS);
                    const int row = u.pm * 256 + ai * 128 + wr * 64 + m * 16 + fr;
                    const int b = row >> 13, s = row & (SEQ - 1), rb = s >> 5, r32 = s & 31;
#pragma unroll
                    for (int bj = 0; bj < 2; ++bj) {
                        const f32x4 v0 = acc[ai][bj][m][0] * rstd * gv[bj][0], v1 = acc[ai][bj][m][1] * rstd * gv[bj][1];
                        u32x4 w; w.x = cvtpk(v0[0], v0[1]); w.y = cvtpk(v0[2], v0[3]); w.z = cvtpk(v1[0], v1[1]); w.w = cvtpk(v1[2], v1[3]);
                        const int d0 = 2 * bj + (fq >> 1), hi = fq & 1;
                        const size_t piece = (((size_t)(b * NHEAD + head) * 256 + rb) * 4 + d0);
                        *(u32x4*)(dst + (piece * 64 + hi * 32 + r32) * 8) = w;
                    }
                }
        }
    }
};

struct EpiVt {
    static constexpr bool PERM = true;
    bf16_t* Vf;
    __device__ __forceinline__ void operator()(const f32x4 (&acc)[2][2][4][2], const Unit& u, int wr, int wc, int fr, int fq, const LAS u32x2* tab) const {
#pragma unroll
        for (int ai = 0; ai < 2; ++ai)
#pragma unroll
            for (int m = 0; m < 4; ++m) {
                const int hd = u.pm * 256 + ai * 128 + wr * 64 + m * 16 + fr;
                const int head = hd >> 6, dblk = (hd >> 5) & 1, dl = hd & 31;
#pragma unroll
                for (int bj = 0; bj < 2; ++bj) {
                    const int tok0 = u.pn * 256 + bj * 128 + wc * 32;
                    const int b = tok0 >> 13, kb = (tok0 & (SEQ - 1)) >> 5;
                    const size_t piece = ((((size_t)(b * NHEAD + head) * 256 + kb) * 2 + (fq >> 1)) * 2 + dblk);
#pragma unroll
                    for (int n = 0; n < 2; ++n) {
                        const f32x4 v = acc[ai][bj][m][n];
                        u32x2 w; w.x = cvtpk(v[0], v[1]); w.y = cvtpk(v[2], v[3]);
                        *(u32x2*)((char*)Vf + (piece * 64 + n * 32 + dl) * 16 + (fq & 1) * 8) = w;
                    }
                }
            }
    }
};

template <bool XF>
struct EpiOutB {
    static constexpr bool PERM = true;
    const float* xf; bf16_t* XB; const float* g1; float* ssq;
    __device__ __forceinline__ void operator()(const f32x4 (&acc)[2][2][4][2], const Unit& u, int wr, int wc, int fr, int fq, const LAS u32x2* tab) const {
        const int b = (u.pm * 256) >> 13;
        const int col0 = u.pn * 256 + wc * 32 + 8 * fq;
        f32x4 gv[2][2];
#pragma unroll
        for (int bj = 0; bj < 2; ++bj)
#pragma unroll
            for (int n = 0; n < 2; ++n) gv[bj][n] = *(const f32x4*)(g1 + (size_t)b * 6144 + col0 + bj * 128 + n * 4);
#pragma unroll
        for (int ai = 0; ai < 2; ++ai)
#pragma unroll
            for (int m = 0; m < 4; ++m) {
                const int row = u.pm * 256 + ai * 128 + wr * 64 + m * 16 + fr;
                const size_t off = (size_t)row * DM + col0;
                f32x4 xb[2][2];
                if (XF) {
#pragma unroll
                    for (int bj = 0; bj < 2; ++bj) { xb[bj][0] = *(const f32x4*)(xf + off + bj * 128); xb[bj][1] = *(const f32x4*)(xf + off + bj * 128 + 4); }
                } else {
#pragma unroll
                    for (int bj = 0; bj < 2; ++bj) { const u32x4 w = *(const u32x4*)(XB + off + bj * 128);
                        xb[bj][0] = (f32x4){bf_lo(w.x), bf_hi(w.x), bf_lo(w.y), bf_hi(w.y)}; xb[bj][1] = (f32x4){bf_lo(w.z), bf_hi(w.z), bf_lo(w.w), bf_hi(w.w)}; }
                }
                float ss = 0.f;
#pragma unroll
                for (int bj = 0; bj < 2; ++bj) {
                    const f32x4 x0 = xb[bj][0] + gv[bj][0] * acc[ai][bj][m][0], x1 = xb[bj][1] + gv[bj][1] * acc[ai][bj][m][1];
                    u32x4 w; w.x = cvtpk(x0[0], x0[1]); w.y = cvtpk(x0[2], x0[3]); w.z = cvtpk(x1[0], x1[1]); w.w = cvtpk(x1[2], x1[3]);
                    *(u32x4*)(XB + off + bj * 128) = w;
                    const float r0 = bf_lo(w.x), r1 = bf_hi(w.x), r2 = bf_lo(w.y), r3 = bf_hi(w.y), r4 = bf_lo(w.z), r5 = bf_hi(w.z), r6 = bf_lo(w.w), r7 = bf_hi(w.w);
                    ss += ((r0 * r0 + r1 * r1) + (r2 * r2 + r3 * r3)) + ((r4 * r4 + r5 * r5) + (r6 * r6 + r7 * r7));
                }
                ss += __shfl_xor(ss, 16); ss += __shfl_xor(ss, 32);
                if (fq == 0) ssq[(size_t)row * 16 + u.pn * 4 + wc] = ss;
            }
    }
};

struct EpiGU {
    static constexpr bool PERM = true;
    unsigned char* ACT;
    __device__ __forceinline__ void operator()(const f32x4 (&acc)[2][2][4][2], const Unit& u, int wr, int wc, int fr, int fq, const LAS u32x2* tab) const {
        constexpr float SI = 1.0f / 2048.0f;
#pragma unroll
        for (int ai = 0; ai < 2; ++ai)
#pragma unroll
            for (int m = 0; m < 4; ++m) {
                const int r = ai * 128 + wr * 64 + m * 16 + fr;
                const int slot = (int)tab[r].x;
                float o[8];
#pragma unroll
                for (int n = 0; n < 2; ++n)
#pragma unroll
                    for (int e = 0; e < 4; ++e) { const float gte = acc[ai][0][m][n][e] * SI, up = acc[ai][1][m][n][e] * (4.0f * SI);
                        o[n * 4 + e] = clamp8(gte * fast_rcp(1.0f + fast_exp2(-gte * LOG2E)) * up); }
                u32x2 w; w.x = pk_fp8x4(o[0], o[1], o[2], o[3]); w.y = pk_fp8x4(o[4], o[5], o[6], o[7]);
                if (r < u.rows) *(u32x2*)(ACT + (size_t)slot * DEXP + u.pn * 128 + wc * 32 + fq * 8) = w;
            }
    }
};

struct EpiDn {
    static constexpr bool PERM = true;
    unsigned char* Y8;
    __device__ __forceinline__ void operator()(const f32x4 (&acc)[2][2][4][2], const Unit& u, int wr, int wc, int fr, int fq, const LAS u32x2* tab) const {
#pragma unroll
        for (int ai = 0; ai < 2; ++ai)
#pragma unroll
            for (int m = 0; m < 4; ++m) {
                const int r = ai * 128 + wr * 64 + m * 16 + fr;
                const u32x2 en = tab[r];
                const int slot = (int)en.x;
                const float w8 = __uint_as_float(en.y) * (16.0f / 1024.0f);
                if (r < u.rows) {
#pragma unroll
                    for (int bj = 0; bj < 2; ++bj) {
                        const f32x4 v0 = acc[ai][bj][m][0] * w8, v1 = acc[ai][bj][m][1] * w8;
                        int lo = 0, hi = 0;
                        lo = __builtin_amdgcn_cvt_pk_fp8_f32(v0[0], v0[1], lo, false); lo = __builtin_amdgcn_cvt_pk_fp8_f32(v0[2], v0[3], lo, true);
                        hi = __builtin_amdgcn_cvt_pk_fp8_f32(v1[0], v1[1], hi, false); hi = __builtin_amdgcn_cvt_pk_fp8_f32(v1[2], v1[3], hi, true);
                        u32x2 w; w.x = (unsigned)lo; w.y = (unsigned)hi;
                        *(u32x2*)(Y8 + (size_t)slot * DM + u.pn * 256 + bj * 128 + wc * 32 + fq * 8) = w;
                    }
                }
            }
    }
};

struct TItem { const float* src; unsigned char* dst; int N, dstK, koff, k0, n0, map, f8; };
__device__ __forceinline__ int t_rowmap(int map, int n) {
    if (map == 0) return n;
    if (map == 1) { if (n < 512 || n >= 1536) return n; const int t = n & 255, wc = t >> 6, bj = (t >> 5) & 1, c = t & 31; return (n & ~255) + 128 * bj + 32 * wc + c; }
    return 256 * (n >> 7) + 128 * (map - 2) + (n & 127);
}
__device__ __forceinline__ void t_load(const TItem& d, f32x4 (&v)[16], int lane) {
    const int kr = lane >> 4, c4 = lane & 15;
#pragma unroll
    for (int i = 0; i < 16; ++i) v[i] = *(const f32x4*)(d.src + (size_t)(d.k0 + 4 * i + kr) * d.N + d.n0 + 4 * c4);
}
__device__ __forceinline__ void t_process(const TItem& d, const f32x4 (&v)[16], LAS float* scr, int lane) {
    const int kr = lane >> 4, c4 = lane & 15;
#pragma unroll
    for (int i = 0; i < 16; ++i) { LAS float* s = scr + (4 * i + kr) * 65 + 4 * c4; s[0] = v[i][0]; s[1] = v[i][1]; s[2] = v[i][2]; s[3] = v[i][3]; }
    asm volatile("s_waitcnt lgkmcnt(0)" ::: "memory");
    const int nr = lane >> 3, kc = lane & 7;
#pragma unroll
    for (int i = 0; i < 8; ++i) { const int n = 8 * i + nr; const LAS float* s = scr + (8 * kc) * 65 + n;
        const size_t eo = (size_t)t_rowmap(d.map, d.n0 + n) * d.dstK + d.koff + d.k0 + 8 * kc;
        if (d.f8) { u32x2 o; o.x = pk_fp8x4(s[0] * 256.0f, s[65] * 256.0f, s[2 * 65] * 256.0f, s[3 * 65] * 256.0f); o.y = pk_fp8x4(s[4 * 65] * 256.0f, s[5 * 65] * 256.0f, s[6 * 65] * 256.0f, s[7 * 65] * 256.0f);
            *(u32x2*)(d.dst + eo) = o; }
        else { u32x4 o; o.x = cvtpk(s[0], s[65]); o.y = cvtpk(s[2 * 65], s[3 * 65]); o.z = cvtpk(s[4 * 65], s[5 * 65]); o.w = cvtpk(s[6 * 65], s[7 * 65]);
            *(u32x4*)(d.dst + eo * 2) = o; } }
    asm volatile("s_waitcnt lgkmcnt(0)" ::: "memory");
}
constexpr int T_IN = 512, T_OUT = 128, T_E = 128, T_MOE = NEXP * 3 * T_E, T_PER_LAYER = T_IN + T_OUT + T_MOE;
constexpr int T_NA = T_PER_LAYER + T_IN + T_OUT, T_NB = T_MOE;
__device__ __forceinline__ void t_decode_lr(const Params& p, int l, int r, TItem& d) {
    unsigned char* ws = p.ws;
    if (r < T_IN) { d.src = p.in[6] + (size_t)l * 1024 * 2048; d.N = 2048; d.f8 = 0; d.dst = ws + WS_WIN + (size_t)l * 2048 * 1024 * 2; d.dstK = 1024; d.koff = 0; d.k0 = (r >> 5) * 64; d.n0 = (r & 31) * 64; d.map = 1; return; }
    r -= T_IN;
    if (r < T_OUT) { d.src = p.in[12] + ((size_t)l * 1024 + 512) * 1024; d.N = 1024; d.f8 = 0; d.dst = ws + WS_WOUT + (size_t)l * 1024 * 1024 * 2; d.dstK = 1024; d.koff = 512; d.k0 = (r >> 4) * 64; d.n0 = (r & 15) * 64; d.map = 0; return; }
    r -= T_OUT;
    const int e = r / (3 * T_E); int q = r % (3 * T_E);
    if (q < 2 * T_E) { const int up = q >= T_E; if (up) q -= T_E;
        d.src = p.in[up ? 18 : 17] + ((size_t)l * NEXP + e) * 1024 * 512; d.N = 512; d.f8 = 1; d.dst = ws + WS_WGU + ((size_t)l * NEXP + e) * 1024 * 1024; d.dstK = 1024; d.koff = 0; d.k0 = (q >> 3) * 64; d.n0 = (q & 7) * 64; d.map = 2 + up; return; }
    q -= 2 * T_E;
    d.src = p.in[19] + ((size_t)l * NEXP + e) * 512 * 1024; d.N = 1024; d.f8 = 1; d.dst = ws + WS_WD + ((size_t)l * NEXP + e) * 1024 * 512; d.dstK = 512; d.koff = 0; d.k0 = (q >> 4) * 64; d.n0 = (q & 15) * 64; d.map = 0;
}
template <bool SPACE_B>
__device__ __forceinline__ void t_decode(const Params& p, int it, TItem& d) {
    if (SPACE_B) t_decode_lr(p, 1, T_IN + T_OUT + it, d);
    else if (it < T_PER_LAYER) t_decode_lr(p, 0, it, d);
    else t_decode_lr(p, 1, it - T_PER_LAYER, d);
}
template <bool SPACE_B>
__device__ __forceinline__ void t_run(const Params& p, int it, int stride, int nit, LAS float* scr, int lane) {
    if (it >= nit) return;
    TItem dA, dB; f32x4 vA[16], vB[16];
    t_decode<SPACE_B>(p, it, dA); t_load(dA, vA, lane);
    for (;;) {
        int nx = it + stride; const bool hasB = nx < nit;
        if (hasB) { t_decode<SPACE_B>(p, nx, dB); t_load(dB, vB, lane); }
        t_process(dA, vA, scr, lane);
        if (!hasB) break;
        it = nx + stride; const bool hasA = it < nit;
        if (hasA) { t_decode<SPACE_B>(p, it, dA); t_load(dA, vA, lane); }
        t_process(dB, vB, scr, lane);
        if (!hasA) break;
    }
}
__device__ __forceinline__ void tail_convert(const Params& p, LAS unsigned char* lds, int total_units, int v, int first, int count) {
    const int tid = opaque_tid(), lane = tid & 63, wave = tid >> 6, G = gridDim.x;
    const int rem = total_units % G;
    const int nshare = rem ? G - rem : G, sidx = rem ? v - rem : v;
    __syncthreads();
    if (sidx >= 0) t_run<true>(p, first + sidx + nshare * wave, nshare * NWAVES, first + count, (LAS float*)(lds + wave * 16640), lane);
    __syncthreads();
}

__device__ __forceinline__ void phase_prologue(const Params& p, LAS unsigned char* lds) {
    const int tid = opaque_tid(), lane = tid & 63, wave = tid >> 6, G = gridDim.x;
    unsigned char* ws = p.ws;
    {
        LAS float* cact = (LAS float*)lds;
        LAS float* red = (LAS float*)(lds + 16384);
        const float* c = p.in[1];
        for (int i = tid; i < 4096; i += NTHREADS) { const float v = c[i]; cact[i] = v / (1.0f + __expf(-v)); }
        __syncthreads();
        float* mod = (float*)(ws + WS_MOD);
        for (int item = blockIdx.x; item < 2 * 192; item += G) {
            const int l = item / 192, cgp = item % 192;
            const float* W = p.in[2] + (size_t)l * 1024 * 6144 + cgp * 32;
            const int col = lane & 31, rsub = lane >> 5;
            float a0 = 0.f, a1 = 0.f, a2 = 0.f, a3 = 0.f;
#pragma unroll 16
            for (int i = 0; i < 64; ++i) { const int k = wave * 128 + 2 * i + rsub; const float w = W[(size_t)k * 6144 + col];
                a0 += cact[k] * w; a1 += cact[1024 + k] * w; a2 += cact[2048 + k] * w; a3 += cact[3072 + k] * w; }
            a0 += __shfl_xor(a0, 32); a1 += __shfl_xor(a1, 32); a2 += __shfl_xor(a2, 32); a3 += __shfl_xor(a3, 32);
            if (lane < 32) { red[(wave * 4 + 0) * 32 + col] = a0; red[(wave * 4 + 1) * 32 + col] = a1; red[(wave * 4 + 2) * 32 + col] = a2; red[(wave * 4 + 3) * 32 + col] = a3; }
            __syncthreads();
            if (tid < 128) { const int b = tid >> 5, cc = tid & 31; float s = 0.f;
#pragma unroll
                for (int w = 0; w < 8; ++w) s += red[(w * 4 + b) * 32 + cc];
                mod[(size_t)(l * 4 + b) * 6144 + cgp * 32 + cc] = s + p.in[3][l * 6144 + cgp * 32 + cc]; }
            __syncthreads();
        }
    }
    {
        float* tbl = (float*)(ws + WS_TBL);
        for (int job = blockIdx.x; job < 2; job += G) {
            const int l = job;
            LAS float* sm = (LAS float*)(lds + 32768);
            float mq = 0.f, mk = 0.f, mb = 0.f;
            if (tid < 64) { mq = fabsf(p.in[9][l * 64 + tid]); mk = fabsf(p.in[10][l * 64 + tid]); }
            for (int i = tid; i < NHEAD * 257; i += NTHREADS) mb = fmaxf(mb, fabsf(p.in[11][i]));
#pragma unroll
            for (int o = 1; o < 64; o <<= 1) { mq = fmaxf(mq, __shfl_xor(mq, o)); mk = fmaxf(mk, __shfl_xor(mk, o)); mb = fmaxf(mb, __shfl_xor(mb, o)); }
            if (lane == 0) { sm[wave * 4 + 0] = mq; sm[wave * 4 + 1] = mk; sm[wave * 4 + 2] = mb; }
            __syncthreads();
            mq = 0.f; mk = 0.f; mb = 0.f;
            for (int w = 0; w < 8; ++w) { mq = fmaxf(mq, sm[w * 4 + 0]); mk = fmaxf(mk, sm[w * 4 + 1]); mb = fmaxf(mb, sm[w * 4 + 2]); }
            const float shift = LOG2E * (8.0f * mq * mk + mb);
            for (int i = tid; i < NHEAD * 256; i += NTHREADS) { const int h = i >> 8, j = i & 255; int rel = j - 63; if (rel > 128) rel = 128;
                tbl[(size_t)l * 2048 + i] = (j < 255) ? p.in[11][h * 257 + rel + 128] * LOG2E - shift : 0.f; }
            __syncthreads();
        }
        for (int job = blockIdx.x; job < 2 * 48; job += G) {
            const int l = job / 48, n = job % 48;
            bf16_t* hi = (bf16_t*)(ws + WS_RW) + (size_t)l * 2 * 48 * 1024;
            bf16_t* lo = hi + 48 * 1024;
            for (int k = tid; k < 1024; k += NTHREADS) {
                float w = 0.f;
                if (n < 32) w = p.in[15][((size_t)l * 1024 + k) * 32 + n]; else if (n < 36) w = p.in[13][((size_t)l * 1024 + k) * 4 + (n - 32)];
                const unsigned h2 = cvtpk(w, 0.f) & 0xffffu; const float r = w - bf_lo(h2);
                const size_t idx = ((size_t)((k >> 5) * 3 + (n >> 4)) * 64 + ((k & 31) >> 3) * 16 + (n & 15)) * 8 + (k & 7);
                hi[idx] = (bf16_t)h2; lo[idx] = (bf16_t)(cvtpk(r, 0.f) & 0xffffu);
            }
            if (tid == 0) { float bsv = 0.f; if (n < 32) bsv = p.in[16][l * 32 + n]; else if (n < 36) bsv = p.in[14][l * 4 + (n - 32)]; ((float*)(ws + WS_RWB))[l * 48 + n] = bsv; }
        }
    }
    __syncthreads();
    {
        LAS float* wsc = (LAS float*)lds;
        LAS float* pwl = (LAS float*)(lds + 32768);
        for (int item = blockIdx.x; item < 2 * 4 * 16; item += G) {
            const int l = item >> 6, g = (item >> 4) & 3, nb = item & 15;
            const float* wo = p.in[12] + ((size_t)l * 1024 + g * 128) * 1024 + nb * 64;
            const float* sc = p.in[8] + l * 512 + g * 128;
            const float* pw = p.in[7] + ((size_t)l * 4 + g) * 128 * 128;
            for (int i = tid; i < 128 * 64; i += NTHREADS) { const int d = i >> 6, n = i & 63; wsc[i] = wo[(size_t)d * 1024 + n] * sc[d]; }
            for (int i = tid; i < 128 * 128 / 4; i += NTHREADS) *(LAS f32x4*)(pwl + 4 * i) = *(const f32x4*)(pw + 4 * i);
            __syncthreads();
            const int n = tid & 63, cgp = tid >> 6;
            float a[16];
#pragma unroll
            for (int j = 0; j < 16; ++j) a[j] = 0.f;
#pragma unroll 2
            for (int d4 = 0; d4 < 32; ++d4) {
                const float w0 = wsc[(4 * d4 + 0) * 64 + n], w1 = wsc[(4 * d4 + 1) * 64 + n], w2 = wsc[(4 * d4 + 2) * 64 + n], w3 = wsc[(4 * d4 + 3) * 64 + n];
#pragma unroll
                for (int j = 0; j < 16; ++j) { const f32x4 pv = *(const LAS f32x4*)(pwl + (cgp * 16 + j) * 128 + 4 * d4); a[j] += (pv[0] * w0 + pv[1] * w1) + (pv[2] * w2 + pv[3] * w3); }
            }
            bf16_t* dst = (bf16_t*)(ws + WS_WOUT) + ((size_t)l * 1024 + nb * 64 + n) * 1024 + g * 128 + cgp * 16;
            u32x4 o0, o1; o0.x = cvtpk(a[0], a[1]); o0.y = cvtpk(a[2], a[3]); o0.z = cvtpk(a[4], a[5]); o0.w = cvtpk(a[6], a[7]);
            o1.x = cvtpk(a[8], a[9]); o1.y = cvtpk(a[10], a[11]); o1.z = cvtpk(a[12], a[13]); o1.w = cvtpk(a[14], a[15]);
            *(u32x4*)dst = o0; *(u32x4*)(dst + 8) = o1;
            __syncthreads();
        }
    }
    {
        LAS float* scr = (LAS float*)(lds + wave * 16640);
        t_run<false>(p, blockIdx.x * NWAVES + wave, G * NWAVES, T_NA, scr, lane);
    }
}

typedef float f32x2v __attribute__((ext_vector_type(2)));
__device__ __forceinline__ f32x4 y_pair_sum(const unsigned char* Y8, size_t row, int c) {
    const int a = *(const int*)(Y8 + (size_t)(2 * row) * DM + c), b = *(const int*)(Y8 + (size_t)(2 * row + 1) * DM + c);
    const f32x2v a0 = __builtin_amdgcn_cvt_pk_f32_fp8(a, false), a1 = __builtin_amdgcn_cvt_pk_f32_fp8(a, true);
    const f32x2v b0 = __builtin_amdgcn_cvt_pk_f32_fp8(b, false), b1 = __builtin_amdgcn_cvt_pk_f32_fp8(b, true);
    f32x4 ys; ys[0] = (a0[0] + b0[0]) * 0.0625f; ys[1] = (a0[1] + b0[1]) * 0.0625f; ys[2] = (a1[0] + b1[0]) * 0.0625f; ys[3] = (a1[1] + b1[1]) * 0.0625f; return ys;
}
template <int NR, bool UPD>
__device__ __forceinline__ void norm1_rows(const Params& p, int l, int row0, int lane) {
    const float* mod = (const float*)(p.ws + WS_MOD);
    const float* gn = p.in[4] + l * 1024;
    bf16_t* H = (bf16_t*)(p.ws + WS_BUF);
    const unsigned char* Y = (const unsigned char*)(p.ws + WS_Y);
    bf16_t* XB = (bf16_t*)(p.ws + WS_XB);
    const int b = row0 >> 13;
    f32x4 v[NR][4];
    if (!UPD) {
#pragma unroll
        for (int r = 0; r < NR; ++r)
#pragma unroll
            for (int j = 0; j < 4; ++j) v[r][j] = *(const f32x4*)(p.in[0] + (size_t)(row0 + r) * DM + 4 * lane + 256 * j);
    } else {
        const float* g2 = mod + (size_t)((l - 1) * 4 + b) * 6144 + 5120;
        f32x4 ys[NR][4];
#pragma unroll
        for (int r = 0; r < NR; ++r)
#pragma unroll
            for (int j = 0; j < 4; ++j) { const int c = 4 * lane + 256 * j; const u32x2 xw = *(const u32x2*)(XB + (size_t)(row0 + r) * DM + c);
                v[r][j] = (f32x4){bf_lo(xw.x), bf_hi(xw.x), bf_lo(xw.y), bf_hi(xw.y)}; ys[r][j] = y_pair_sum(Y, row0 + r, c); }
#pragma unroll
        for (int j = 0; j < 4; ++j) { const f32x4 gg = *(const f32x4*)(g2 + 4 * lane + 256 * j);
#pragma unroll
            for (int r = 0; r < NR; ++r) { const f32x4 xn = v[r][j] + gg * ys[r][j]; u32x2 xw; xw.x = cvtpk(xn[0], xn[1]); xw.y = cvtpk(xn[2], xn[3]);
                *(u32x2*)(XB + (size_t)(row0 + r) * DM + 4 * lane + 256 * j) = xw;
                v[r][j] = (f32x4){bf_lo(xw.x), bf_hi(xw.x), bf_lo(xw.y), bf_hi(xw.y)}; } }
    }
    float ss[NR];
#pragma unroll
    for (int r = 0; r < NR; ++r) { ss[r] = 0.f;
#pragma unroll
        for (int j = 0; j < 4; ++j) ss[r] += (v[r][j][0] * v[r][j][0] + v[r][j][1] * v[r][j][1]) + (v[r][j][2] * v[r][j][2] + v[r][j][3] * v[r][j][3]); }
#pragma unroll
    for (int o = 1; o < 64; o <<= 1)
#pragma unroll
        for (int r = 0; r < NR; ++r) ss[r] += __shfl_xor(ss[r], o);
    const float* sh = mod + (size_t)(l * 4 + b) * 6144; const float* sc = sh + 1024;
#pragma unroll
    for (int j = 0; j < 4; ++j) {
        const int c = 4 * lane + 256 * j;
        const f32x4 g = *(const f32x4*)(gn + c), s1 = *(const f32x4*)(sc + c), s0 = *(const f32x4*)(sh + c);
        const f32x4 a = g * (s1 + 1.0f);
#pragma unroll
        for (int r = 0; r < NR; ++r) {
            const float rstd = rsqrtf(ss[r] * (1.0f / DM) + EPS);
            const f32x4 h = v[r][j] * rstd * a + s0;
            u32x2 w; w.x = cvtpk(h[0], h[1]); w.y = cvtpk(h[2], h[3]);
            *(u32x2*)(H + (size_t)(row0 + r) * DM + c) = w;
        }
    }
}
__device__ __forceinline__ void phase_norm1(const Params& p, int l) {
    const int tid = opaque_tid(), lane = tid & 63, wave = tid >> 6, G = gridDim.x;
    const int gw = blockIdx.x * NWAVES + wave, NGW = G * NWAVES;
    if (l == 0) { for (int rq = gw; rq < NTOK / 4; rq += NGW) norm1_rows<4, false>(p, l, rq * 4, lane); }
    else { for (int rq = gw; rq < NTOK / 2; rq += NGW) norm1_rows<2, true>(p, l, rq * 2, lane); }
}

__device__ __forceinline__ void phase_final(const Params& p) {
    const int tid = opaque_tid(), lane = tid & 63, wave = tid >> 6, G = gridDim.x;
    const int gw = blockIdx.x * NWAVES + wave, NGW = G * NWAVES;
    const float* mod = (const float*)(p.ws + WS_MOD);
    const unsigned char* Y = (const unsigned char*)(p.ws + WS_Y);
    const bf16_t* XB = (const bf16_t*)(p.ws + WS_XB);
    constexpr int NR = 4;
    for (int rq = gw; rq < NTOK / NR; rq += NGW) {
        const int row0 = rq * NR, b = row0 >> 13;
        const float* g2 = mod + (size_t)((DEPTH - 1) * 4 + b) * 6144 + 5120;
        f32x4 v[NR][4], ys[NR][4];
#pragma unroll
        for (int r = 0; r < NR; ++r)
#pragma unroll
            for (int j = 0; j < 4; ++j) { const int c = 4 * lane + 256 * j; const u32x2 xw = *(const u32x2*)(XB + (size_t)(row0 + r) * DM + c);
                v[r][j] = (f32x4){bf_lo(xw.x), bf_hi(xw.x), bf_lo(xw.y), bf_hi(xw.y)}; ys[r][j] = y_pair_sum(Y, row0 + r, c); }
#pragma unroll
        for (int j = 0; j < 4; ++j) { const f32x4 gg = *(const f32x4*)(g2 + 4 * lane + 256 * j);
#pragma unroll
            for (int r = 0; r < NR; ++r) *(f32x4*)(p.out + (size_t)(row0 + r) * DM + 4 * lane + 256 * j) = v[r][j] + gg * ys[r][j]; }
    }
}

__device__ __forceinline__ int crow(int r, int hi) { return (r & 3) + 8 * (r >> 2) + 4 * hi; }

__device__ __forceinline__ void pool_strip(const Params& p, int strip, int lane) {
    const bf16_t* U = (const bf16_t*)(p.ws + WS_U); bf16_t* MIX = (bf16_t*)(p.ws + WS_BUF);
    const int tok0 = strip * 16, s0 = tok0 & (SEQ - 1);
    const int win = 2 << (lane >> 4);
    float S[8];
#pragma unroll
    for (int j = 0; j < 8; ++j) S[j] = 0.f;
#pragma unroll
    for (int d = 1; d < 16; ++d) {
        if (d < win && s0 - d >= 0) {
            const u32x4 w = *(const u32x4*)(U + (size_t)(tok0 - d) * 512 + lane * 8);
            S[0] += bf_lo(w.x); S[1] += bf_hi(w.x); S[2] += bf_lo(w.y); S[3] += bf_hi(w.y); S[4] += bf_lo(w.z); S[5] += bf_hi(w.z); S[6] += bf_lo(w.w); S[7] += bf_hi(w.w);
        }
    }
#pragma unroll 4
    for (int i = 0; i < 16; ++i) {
        const int s = s0 + i;
        const u32x4 w = *(const u32x4*)(U + (size_t)(tok0 + i) * 512 + lane * 8);
        float uv[8] = {bf_lo(w.x), bf_hi(w.x), bf_lo(w.y), bf_hi(w.y), bf_lo(w.z), bf_hi(w.z), bf_lo(w.w), bf_hi(w.w)};
#pragma unroll
        for (int j = 0; j < 8; ++j) S[j] += uv[j];
        const int cn = (s + 1 < win) ? s + 1 : win;
        const float inv = 1.0f / (float)cn;
        float o[8];
#pragma unroll
        for (int j = 0; j < 8; ++j) o[j] = S[j] * inv - uv[j];
        u32x4 ow; ow.x = cvtpk(o[0], o[1]); ow.y = cvtpk(o[2], o[3]); ow.z = cvtpk(o[4], o[5]); ow.w = cvtpk(o[6], o[7]);
        *(u32x4*)(MIX + (size_t)(tok0 + i) * DM + lane * 8) = ow;
        if (s - win + 1 >= 0) {
            const u32x4 x = *(const u32x4*)(U + (size_t)(tok0 + i - win + 1) * 512 + lane * 8);
            S[0] -= bf_lo(x.x); S[1] -= bf_hi(x.x); S[2] -= bf_lo(x.y); S[3] -= bf_hi(x.y); S[4] -= bf_lo(x.z); S[5] -= bf_hi(x.z); S[6] -= bf_lo(x.w); S[7] -= bf_hi(x.w);
        }
    }
}

__device__ __forceinline__ void attn_unit(const Params& p, int b, int h, int ch, int qh, int lane, const LAS float* tbl, LAS bf16_t* stg) {
    const int r32 = lane & 31, hi = lane >> 5;
    const char* Qf = (const char*)(p.ws + WS_Q); const char* Kf = (const char*)(p.ws + WS_K); const char* Vf = (const char*)(p.ws + WS_V);
    bf16_t* MIX = (bf16_t*)(p.ws + WS_BUF);
    const size_t bh = (size_t)(b * NHEAD + h) * 256;
    bf16x8 qr[4];
#pragma unroll
    for (int d0 = 0; d0 < 4; ++d0) qr[d0] = *(const bf16x8*)(Qf + (((bh + ch * 2 + qh) * 4 + d0) * 64 + lane) * 16);
    f32x16 o0 = {}, o1 = {};
    float lsum = 0.f;
    const LAS float* th = tbl + h * 256;
    f32x16 cfv; { const float cfar = th[254];
#pragma unroll
        for (int r = 0; r < 16; ++r) cfv[r] = cfar; }
    const int t0 = ch < 8 ? 8 - ch : 0;
    const char* kp = Kf + (bh * 4 * 64 + lane) * 16 + (ptrdiff_t)(ch - 8 + t0) * 8192;
    const char* vp = Vf + (bh * 4 * 64 + lane) * 16 + (ptrdiff_t)(ch - 8 + t0) * 8192;
    bf16x8 kk[8];
#define ATT_LD8(dst, ptr) do { const char* pa_ = (ptr); const char* pb_ = pa_ + 4096; _Pragma("unroll") for (int i_ = 0; i_ < 4; ++i_) { dst[i_] = *(const bf16x8*)(pa_ + i_ * 1024); dst[4 + i_] = *(const bf16x8*)(pb_ + i_ * 1024); } } while (0)
#define ATT_REST(P0, P1) do { \
        float sacc_ = 0.f; \
        _Pragma("unroll") for (int r = 0; r < 16; ++r) { P0[r] = fast_exp2(P0[r]); P1[r] = fast_exp2(P1[r]); sacc_ += P0[r] + P1[r]; } \
        lsum += sacc_; \
        u32x4 pa_[4]; \
        _Pragma("unroll") for (int s = 0; s < 2; ++s) { \
            pa_[s].x = cvtpk(P0[8 * s + 0], P0[8 * s + 1]); pa_[s].y = cvtpk(P0[8 * s + 2], P0[8 * s + 3]); pa_[s].z = cvtpk(P0[8 * s + 4], P0[8 * s + 5]); pa_[s].w = cvtpk(P0[8 * s + 6], P0[8 * s + 7]); \
            pa_[2 + s].x = cvtpk(P1[8 * s + 0], P1[8 * s + 1]); pa_[2 + s].y = cvtpk(P1[8 * s + 2], P1[8 * s + 3]); pa_[2 + s].z = cvtpk(P1[8 * s + 4], P1[8 * s + 5]); pa_[2 + s].w = cvtpk(P1[8 * s + 6], P1[8 * s + 7]); } \
        _Pragma("unroll") for (int i = 0; i < 4; ++i) { const bf16x8 pf_ = __builtin_bit_cast(bf16x8, pa_[i]); \
            o0 = __builtin_amdgcn_mfma_f32_32x32x16_bf16(pf_, vv[2 * i], o0, 0, 0, 0); o1 = __builtin_amdgcn_mfma_f32_32x32x16_bf16(pf_, vv[2 * i + 1], o1, 0, 0, 0); } \
    } while (0)
    ATT_LD8(kk, kp);
    int t = t0;
#pragma unroll 1
    for (; t <= 5; ++t) {
        bf16x8 vv[8]; ATT_LD8(vv, vp); vp += 8192;
        f32x16 p0 = __builtin_amdgcn_mfma_f32_32x32x16_bf16(kk[0], qr[0], cfv, 0, 0, 0);
        f32x16 p1 = __builtin_amdgcn_mfma_f32_32x32x16_bf16(kk[4], qr[0], cfv, 0, 0, 0);
#pragma unroll
        for (int d0 = 1; d0 < 4; ++d0) { p0 = __builtin_amdgcn_mfma_f32_32x32x16_bf16(kk[d0], qr[d0], p0, 0, 0, 0); p1 = __builtin_amdgcn_mfma_f32_32x32x16_bf16(kk[4 + d0], qr[d0], p1, 0, 0, 0); }
        kp += 8192; ATT_LD8(kk, kp);
        ATT_REST(p0, p1);
    }
#pragma unroll 1
    for (; t <= 8; ++t) {
        bf16x8 vv[8]; ATT_LD8(vv, vp); vp += 8192;
        f32x16 p0, p1;
        { const int base_ = 64 * (8 - t) + 32 * qh + r32 + 63 - 4 * hi;
#pragma unroll
          for (int r = 0; r < 16; ++r) { const int kj = (r & 3) + 8 * (r >> 2); p0[r] = th[base_ - kj]; p1[r] = th[base_ - kj - 32]; } }
#pragma unroll
        for (int d0 = 0; d0 < 4; ++d0) { p0 = __builtin_amdgcn_mfma_f32_32x32x16_bf16(kk[d0], qr[d0], p0, 0, 0, 0); p1 = __builtin_amdgcn_mfma_f32_32x32x16_bf16(kk[4 + d0], qr[d0], p1, 0, 0, 0); }
        if (t < 8) { kp += 8192; ATT_LD8(kk, kp); }
        ATT_REST(p0, p1);
    }
#undef ATT_LD8
#undef ATT_REST
    lsum += __shfl_xor(lsum, 32);
    const float linv = 1.0f / lsum;
#pragma unroll
    for (int r = 0; r < 16; ++r) {
        const int q = crow(r, hi);
        const float li = __shfl(linv, q);
        stg[q * 72 + r32] = (bf16_t)(cvtpk(o0[r] * li, 0.f) & 0xffffu);
        stg[q * 72 + 32 + r32] = (bf16_t)(cvtpk(o1[r] * li, 0.f) & 0xffffu);
    }
    asm volatile("s_waitcnt lgkmcnt(0)" ::: "memory");
    bf16_t* orow = MIX + ((size_t)b * SEQ + ch * 64 + qh * 32 + (lane >> 3)) * DM + 512 + h * 64 + (lane & 7) * 8;
    const LAS bf16_t* srow = stg + (lane >> 3) * 72 + (lane & 7) * 8;
#pragma unroll
    for (int i = 0; i < 4; ++i) *(u32x4*)(orow + (size_t)i * 8 * DM) = *(const LAS u32x4*)(srow + i * 8 * 72);
    asm volatile("s_waitcnt lgkmcnt(0)" ::: "memory");
}

__device__ __forceinline__ void phase_mixer(const Params& p, int l, LAS unsigned char* lds) {
    const int tid = opaque_tid(), lane = tid & 63, wave = tid >> 6, G = gridDim.x;
    LAS float* tbl = (LAS float*)lds;
    const float* gt = (const float*)(p.ws + WS_TBL) + (size_t)l * 2048;
    for (int i = tid; i < 2048; i += NTHREADS) tbl[i] = gt[i];
    __syncthreads();
    const int gw = blockIdx.x * NWAVES + wave, NGW = G * NWAVES;
    LAS bf16_t* stg = (LAS bf16_t*)(lds + 8192 + wave * 4608);
    for (int it = gw; it < NTOK / 16; it += NGW) pool_strip(p, it, lane);
    if (G % 8 == 0) {
        const int x = (int)blockIdx.x & 7, lw = ((int)blockIdx.x >> 3) * NWAVES + wave, nlw = (G >> 3) * NWAVES;
        for (int pr = x; pr < BATCH * NHEAD; pr += 8)
            for (int u = lw; u < 256; u += nlw) attn_unit(p, pr >> 3, pr & 7, u >> 1, u & 1, lane, tbl, stg);
    } else {
        for (int wu = gw; wu < BATCH * NHEAD * 256; wu += NGW) attn_unit(p, wu >> 11, (wu >> 8) & 7, (wu >> 1) & 127, wu & 1, lane, tbl, stg);
    }
}

__device__ __forceinline__ void phase_route(const Params& p, int l, LAS unsigned char* lds) {
    const int tid = opaque_tid(), lane = tid & 63, wave = __builtin_amdgcn_readfirstlane(tid >> 6), G = gridDim.x;
    LAS float* a2c = (LAS float*)(lds + 49152);
    LAS float* shc = (LAS float*)(lds + 49152 + 1024);
    LAS float* lg = (LAS float*)(lds + 53248) + wave * (16 * 48);
    LAS int* lcnt = (LAS int*)(lds + 77824);
    LAS int* gbase = (LAS int*)(lds + 77824 + 128);
    LAS int* tmp_e = (LAS int*)(lds + 77824 + 256);
    LAS int* tmp_r = (LAS int*)(lds + 77824 + 256 + 1024);
    LAS float* tmp_w = (LAS float*)(lds + 77824 + 256 + 2048);
    const float* mod = (const float*)(p.ws + WS_MOD);
    const float* gn = p.in[5] + l * 1024;
    unsigned char* H8 = p.ws + WS_BUF;
    const char* RW = (const char*)(p.ws + WS_RW) + (size_t)l * 2 * 48 * 1024 * 2;
    const float* rwb = (const float*)(p.ws + WS_RWB) + l * 48;
    const float* ssq = (const float*)(p.ws + WS_SSQ);
    int* gcnt = (int*)(p.ws + WS_CTL) + l * 32;
    u32x2* list = (u32x2*)(p.ws + WS_LIST2);
    const int r = lane & 15, kg = lane >> 4;
    for (int it = blockIdx.x; it < NTOK / 128; it += G) {
        const int row0 = it * 128 + wave * 16, row = row0 + r, b = (it * 128) >> 13;
        const bf16_t* xr = (const bf16_t*)(p.ws + WS_XB) + (size_t)row * DM + 8 * kg;
        float ss; { const f32x4 q4 = *(const f32x4*)(ssq + (size_t)row * 16 + 4 * kg); ss = (q4[0] + q4[1]) + (q4[2] + q4[3]); }
        ss += __shfl_xor(ss, 16); ss += __shfl_xor(ss, 32);
        const float rstd = rsqrtf(ss * (1.0f / DM) + EPS);
        const float* sh = mod + (size_t)(l * 4 + b) * 6144 + 3072; const float* sc = sh + 1024;
        f32x4 acc[3];
#pragma unroll
        for (int nb = 0; nb < 3; ++nb) acc[nb] = (f32x4){0.f, 0.f, 0.f, 0.f};
#pragma unroll 1
        for (int c = 0; c < 4; ++c) {
            u32x4 xs[8];
#pragma unroll
            for (int i = 0; i < 8; ++i) xs[i] = *(const u32x4*)(xr + 256 * c + 32 * i);
            __syncthreads();
            if (c == 0 && tid < 32) lcnt[tid] = 0;
#pragma unroll
            for (int i = 0; i < 6; ++i) { const int q = wave * 6 + i; const char* src = RW + (q < 24 ? (size_t)(c * 24 + q) * 1024 : (size_t)98304 + (size_t)(c * 24 + q - 24) * 1024);
                __builtin_amdgcn_global_load_lds((const unsigned*)(src + lane * 16), (LAS unsigned*)(lds + q * 1024), 16, 0, 0); }
            if (tid < 256) { const int k = 256 * c + tid; a2c[tid] = gn[k] * (1.0f + sc[k]); shc[tid] = sh[k]; }
            asm volatile("s_waitcnt vmcnt(0)" ::: "memory");
            __syncthreads();
#pragma unroll
            for (int i = 0; i < 8; ++i) {
                float hv[8];
#pragma unroll
                for (int q = 0; q < 2; ++q) {
                    const f32x4 a = *(const LAS f32x4*)(a2c + 32 * i + 8 * kg + 4 * q), s0 = *(const LAS f32x4*)(shc + 32 * i + 8 * kg + 4 * q);
                    const f32x4 xv = q == 0 ? (f32x4){bf_lo(xs[i].x), bf_hi(xs[i].x), bf_lo(xs[i].y), bf_hi(xs[i].y)} : (f32x4){bf_lo(xs[i].z), bf_hi(xs[i].z), bf_lo(xs[i].w), bf_hi(xs[i].w)};
                    const f32x4 hh = xv * rstd * a + s0;
                    hv[4 * q + 0] = hh[0]; hv[4 * q + 1] = hh[1]; hv[4 * q + 2] = hh[2]; hv[4 * q + 3] = hh[3];
                }
                u32x4 hp; hp.x = cvtpk(hv[0], hv[1]); hp.y = cvtpk(hv[2], hv[3]); hp.z = cvtpk(hv[4], hv[5]); hp.w = cvtpk(hv[6], hv[7]);
                { u32x2 h8; h8.x = pk_fp8x4(clamp8(hv[0] * 8.0f), clamp8(hv[1] * 8.0f), clamp8(hv[2] * 8.0f), clamp8(hv[3] * 8.0f)); h8.y = pk_fp8x4(clamp8(hv[4] * 8.0f), clamp8(hv[5] * 8.0f), clamp8(hv[6] * 8.0f), clamp8(hv[7] * 8.0f));
                  *(u32x2*)(H8 + (size_t)row * DM + 256 * c + 32 * i + 8 * kg) = h8; }
                u32x4 lp;
                lp.x = cvtpk(hv[0] - bf_lo(hp.x), hv[1] - bf_hi(hp.x)); lp.y = cvtpk(hv[2] - bf_lo(hp.y), hv[3] - bf_hi(hp.y));
                lp.z = cvtpk(hv[4] - bf_lo(hp.z), hv[5] - bf_hi(hp.z)); lp.w = cvtpk(hv[6] - bf_lo(hp.w), hv[7] - bf_hi(hp.w));
                const bf16x8 xhi = __builtin_bit_cast(bf16x8, hp), xlo = __builtin_bit_cast(bf16x8, lp);
#pragma unroll
                for (int nb = 0; nb < 3; ++nb) {
                    const bf16x8 whi = *(const LAS bf16x8*)(lds + (i * 3 + nb) * 1024 + lane * 16);
                    const bf16x8 wlo = *(const LAS bf16x8*)(lds + 24576 + (i * 3 + nb) * 1024 + lane * 16);
                    acc[nb] = __builtin_amdgcn_mfma_f32_16x16x32_bf16(whi, xhi, acc[nb], 0, 0, 0);
                    acc[nb] = __builtin_amdgcn_mfma_f32_16x16x32_bf16(whi, xlo, acc[nb], 0, 0, 0);
                    acc[nb] = __builtin_amdgcn_mfma_f32_16x16x32_bf16(wlo, xhi, acc[nb], 0, 0, 0);
                }
            }
        }
#pragma unroll
        for (int nb = 0; nb < 3; ++nb)
#pragma unroll
            for (int q = 0; q < 4; ++q) lg[r * 48 + 16 * nb + 4 * kg + q] = acc[nb][q];
        asm volatile("s_waitcnt lgkmcnt(0)" ::: "memory");
        if (lane < 16) {
            const LAS float* my = lg + lane * 48;
            float gl[4]; int gi = 0; float gm;
#pragma unroll
            for (int i = 0; i < 4; ++i) gl[i] = my[32 + i] + rwb[32 + i];
            gm = gl[0];
#pragma unroll
            for (int i = 1; i < 4; ++i) if (gl[i] > gm) { gm = gl[i]; gi = i; }
            float den = 0.f;
#pragma unroll
            for (int i = 0; i < 4; ++i) den += __expf(gl[i] - gm);
            const float gpv = 1.0f / den;
            float el[8];
#pragma unroll
            for (int i = 0; i < 8; ++i) el[i] = my[8 * gi + i] + rwb[8 * gi + i];
            int i0 = 0; float v0 = el[0];
#pragma unroll
            for (int i = 1; i < 8; ++i) if (el[i] > v0) { v0 = el[i]; i0 = i; }
            int i1 = -1; float v1 = -3.0e38f;
#pragma unroll
            for (int i = 0; i < 8; ++i) if (i != i0 && el[i] > v1) { v1 = el[i]; i1 = i; }
            const float dd = __expf(v1 - v0);
            const float w0 = gpv / (1.0f + dd), w1 = gpv * dd / (1.0f + dd);
            const int e0 = 8 * gi + i0, e1 = 8 * gi + i1;
            const int tok = row0 + lane, lt = wave * 16 + lane;
            tmp_w[2 * lt] = w0; tmp_w[2 * lt + 1] = w1;
            tmp_e[2 * lt] = e0; tmp_e[2 * lt + 1] = e1;
            tmp_r[2 * lt] = __hip_atomic_fetch_add(lcnt + e0, 1, __ATOMIC_RELAXED, __HIP_MEMORY_SCOPE_WORKGROUP);
            tmp_r[2 * lt + 1] = __hip_atomic_fetch_add(lcnt + e1, 1, __ATOMIC_RELAXED, __HIP_MEMORY_SCOPE_WORKGROUP);
        }
        __syncthreads();
        if (tid < 32) gbase[tid] = __hip_atomic_fetch_add(gcnt + tid, lcnt[tid], __ATOMIC_RELAXED, __HIP_MEMORY_SCOPE_AGENT);
        __syncthreads();
        if (tid < 256) { const int e = tmp_e[tid]; u32x2 en; en.x = (unsigned)(it * 256 + tid); en.y = __float_as_uint(tmp_w[tid]); list[(size_t)e * NTOK + gbase[e] + tmp_r[tid]] = en; }
    }
    __syncthreads();
}

#define XB_TMO      128
#define XB_XCNT(j)  (256  + 64 * (j))
#define XB_XSUB(j)  (1280 + 64 * (j))
#define XB_XGEN(j)  (2304 + 64 * (j))
#define XB_TOP      3328
#define XB_TOPGEN   3392
#define XCD_BAR_WORDS 3456
#define XB_SPIN_CAP (1u << 18)
__device__ __forceinline__ unsigned xb_ld(unsigned* p)              { return __hip_atomic_load(p, __ATOMIC_RELAXED, __HIP_MEMORY_SCOPE_AGENT); }
__device__ __forceinline__ unsigned xb_add(unsigned* p, unsigned v) { return __hip_atomic_fetch_add(p, v, __ATOMIC_RELAXED, __HIP_MEMORY_SCOPE_AGENT); }
__device__ __forceinline__ unsigned xb_xcc_id() { return (unsigned)__builtin_amdgcn_s_getreg((3 << 11) | 20) & 0xFu; }
#define XB_SPIN(cond, bar) do { unsigned _sp = 0; while (cond) { __builtin_amdgcn_s_sleep(1); \
    if ((++_sp & 255u) == 0u) { if (xb_ld(&(bar)[XB_TMO])) break; if (_sp > XB_SPIN_CAP) { atomicAdd(&(bar)[XB_TMO], 1u); break; } } } } while (0)
struct XcdBarrier { unsigned* bar; unsigned x; volatile LAS unsigned* st; };
__device__ __forceinline__ XcdBarrier xcd_barrier_post(unsigned* bar, volatile LAS unsigned* st) {
    XcdBarrier b; b.bar = bar; b.x = xb_xcc_id(); b.st = st;
    if (threadIdx.x == 0) (void)xb_add(&bar[XB_XCNT(b.x)], 1u);
    return b;
}
__device__ __forceinline__ void xcd_barrier_complete(unsigned* bar, unsigned x, unsigned& nloc, unsigned& nx) {
    const unsigned G = gridDim.x * gridDim.y * gridDim.z;
    unsigned sum, cnt, mine, sp = 0u;
    for (;;) {
        sum = 0u; cnt = 0u; mine = 0u;
#pragma unroll
        for (unsigned j = 0; j < 16; ++j) { const unsigned c = xb_ld(&bar[XB_XCNT(j)]); sum += c; cnt += (c > 0u) ? 1u : 0u; mine = (j == x) ? c : mine; }
        if (sum == G) break;
        __builtin_amdgcn_s_sleep(1);
        if ((++sp & 255u) == 0u) { if (xb_ld(&bar[XB_TMO])) break; if (sp > XB_SPIN_CAP) { atomicAdd(&bar[XB_TMO], 1u); break; } }
    }
    nloc = mine > 0u ? mine : 1u; nx = cnt > 0u ? cnt : 1u;
}
__device__ __forceinline__ void xcd_barrier(const XcdBarrier& b) {
    asm volatile("s_waitcnt vmcnt(0)" ::: "memory");
    __syncthreads();
    if (threadIdx.x == 0) {
        unsigned* bar = b.bar;
        __builtin_amdgcn_s_waitcnt(0);
        unsigned nloc = b.st[0], nx = b.st[1];
        if (nloc == 0u) { xcd_barrier_complete(bar, b.x, nloc, nx); b.st[0] = nloc; b.st[1] = nx; }
        const unsigned old = xb_add(&bar[XB_XSUB(b.x)], 1u);
        const unsigned gen = old / nloc;
        if (old + 1u == (gen + 1u) * nloc) {
            __builtin_amdgcn_fence(__ATOMIC_RELEASE, "agent");
            asm volatile("s_waitcnt vmcnt(0)" ::: "memory");
            const unsigned og = xb_add(&bar[XB_TOP], 1u);
            const unsigned tg = og / nx;
            if (og + 1u == (tg + 1u) * nx) xb_add(&bar[XB_TOPGEN], 1u);
            else XB_SPIN(xb_ld(&bar[XB_TOPGEN]) == tg, bar);
            __builtin_amdgcn_fence(__ATOMIC_ACQUIRE, "agent");
            xb_add(&bar[XB_XGEN(b.x)], 1u);
            asm volatile("s_waitcnt vmcnt(0)" ::: "memory");
        } else {
            XB_SPIN(xb_ld(&bar[XB_XGEN(b.x)]) == gen, bar);
            __builtin_amdgcn_fence(__ATOMIC_ACQUIRE, "agent");
            asm volatile("s_waitcnt vmcnt(0)" ::: "memory");
        }
    }
    __syncthreads();
}

__device__ __forceinline__ void load_prefix(const Params& p, int l, LAS int* pre, LAS int* cntl) {
    const int* gcnt = (const int*)(p.ws + WS_CTL) + l * 32;
    if (threadIdx.x == 0) { int a = 0; for (int e = 0; e < NEXP; ++e) { const int c = gcnt[e]; cntl[e] = c; pre[e] = a; a += (c + 255) >> 8; } pre[NEXP] = a; }
    __syncthreads();
}

__global__ void __launch_bounds__(NTHREADS, 2) fwd_kernel(Params p) {
    extern __shared__ __attribute__((aligned(16))) unsigned char lds_raw[];
    LAS unsigned char* lds = (LAS unsigned char*)lds_raw;
    const int G = gridDim.x;
    unsigned char* ws = p.ws;
    volatile LAS unsigned* bst = (volatile LAS unsigned*)(lds + LDS_BYTES - 16);
    if (threadIdx.x < 2) bst[threadIdx.x] = 0u;
    __syncthreads();
    const XcdBarrier bar = xcd_barrier_post((unsigned*)(ws + WS_CTL) + 4096, bst);
    const int lo = p.ph_lo, hi = p.ph_hi;
#define IN(k) (lo <= (k) && (k) < hi)
#define SYNC_AFTER(k) do { if (IN(k) && IN((k) + 1)) xcd_barrier(bar); } while (0)
    if (IN(0)) phase_prologue(p, lds);
    SYNC_AFTER(0);
#pragma unroll 1
    for (int l = 0; l < DEPTH; ++l) {
        const int k0 = 1 + 7 * l;
        if (IN(k0 + 0)) phase_norm1(p, l);
        SYNC_AFTER(k0 + 0);
        if (IN(k0 + 1)) {
            {
                DenseGemm g{(const bf16_t*)(ws + WS_BUF), (const bf16_t*)(ws + WS_WIN) + (size_t)l * 2048 * 1024, 1024};
                pg8::StaticOrder S; S.init(NTOK, 1536, G, (int)blockIdx.x);
                EpiIn E{(bf16_t*)(ws + WS_U), (bf16_t*)(ws + WS_Q), (bf16_t*)(ws + WS_K), p.in[9] + l * 64, p.in[10] + l * 64};
                pg8::gemm_phase(lds, g, S, E);
            }
            {
                DenseGemm g{(const bf16_t*)(ws + WS_WIN) + (size_t)l * 2048 * 1024 + (size_t)1536 * 1024, (const bf16_t*)(ws + WS_BUF), 1024};
                pg8::StaticOrder S; S.init(512, NTOK, G, (int)blockIdx.x);
                EpiVt E{(bf16_t*)(ws + WS_V)};
                pg8::gemm_phase(lds, g, S, E);
            }
        }
        SYNC_AFTER(k0 + 1);
        if (IN(k0 + 2)) phase_mixer(p, l, lds);
        SYNC_AFTER(k0 + 2);
        if (IN(k0 + 3)) {
            DenseGemm g{(const bf16_t*)(ws + WS_BUF), (const bf16_t*)(ws + WS_WOUT) + (size_t)l * 1024 * 1024, 1024};
            pg8::StaticOrder S; S.init(NTOK, 1024, G, (int)blockIdx.x);
            const float* g1p = (const float*)(ws + WS_MOD) + (size_t)(l * 4) * 6144 + 2048;
            if (l == 0) { EpiOutB<true> E{p.in[0], (bf16_t*)(ws + WS_XB), g1p, (float*)(ws + WS_SSQ)}; pg8::gemm_phase(lds, g, S, E); }
            else { EpiOutB<false> E{nullptr, (bf16_t*)(ws + WS_XB), g1p, (float*)(ws + WS_SSQ)}; pg8::gemm_phase(lds, g, S, E); }
        }
        SYNC_AFTER(k0 + 3);
        if (IN(k0 + 4)) phase_route(p, l, lds);
        SYNC_AFTER(k0 + 4);
        if (IN(k0 + 5)) {
            const int vcu = (G % 8 == 0) ? ((int)blockIdx.x % 8) * (G / 8) + (int)blockIdx.x / 8 : (int)blockIdx.x;
            LAS int* pre = (LAS int*)(lds + pg8::STAGE_BYTES); LAS int* cntl = pre + 64;
            load_prefix(p, l, pre, cntl);
            GatherGemm g{ws + WS_BUF, ws + WS_WGU + (size_t)l * NEXP * 1024 * 1024, (const u32x2*)(ws + WS_LIST2), 1024, 1, (size_t)1024 * 1024};
            pg8::GroupedOrder S{pre, cntl, G, vcu};
            EpiGU E{ws + WS_ACT};
            const int total_units = pre[NEXP] * 4;
            pg8::gemm_phase(lds, g, S, E);
            if (l == 0) tail_convert(p, lds, total_units, vcu, 0, 7424);
        }
        SYNC_AFTER(k0 + 5);
        if (IN(k0 + 6)) {
            const int vcu = (G % 8 == 0) ? ((int)blockIdx.x % 8) * (G / 8) + (int)blockIdx.x / 8 : (int)blockIdx.x;
            LAS int* pre = (LAS int*)(lds + pg8::STAGE_BYTES); LAS int* cntl = pre + 64;
            load_prefix(p, l, pre, cntl);
            GatherGemm g{ws + WS_ACT, ws + WS_WD + (size_t)l * NEXP * 1024 * 512, (const u32x2*)(ws + WS_LIST2), 512, 0, (size_t)1024 * 512};
            pg8::GroupedOrder S{pre, cntl, G, vcu};
            EpiDn E{(unsigned char*)(ws + WS_Y)};
            const int total_units = pre[NEXP] * 4;
            pg8::gemm_phase(lds, g, S, E);
            if (l == 0) tail_convert(p, lds, total_units, vcu, 7424, T_NB - 7424);
        }
        SYNC_AFTER(k0 + 6);
    }
    if (IN(15)) phase_final(p);
#undef IN
#undef SYNC_AFTER
}

extern "C" void kernel_launch(void* const* d_in, const int* in_sizes, int n_in, void* d_out, int out_size, void* d_ws, size_t ws_size, hipStream_t stream) {
    static int grid = 0;
    if (grid == 0) {
        if (n_in != 20 || out_size != NTOK * DM || ws_size < WS_END) { fprintf(stderr, "kernel_launch: unexpected shapes (n_in %d out %d ws %zu)\n", n_in, out_size, ws_size); grid = -1; return; }
        int dev = 0, cus = 0, per_cu = 0;
        hipGetDevice(&dev);
        hipDeviceGetAttribute(&cus, hipDeviceAttributeMultiprocessorCount, dev);
        hipFuncSetAttribute((const void*)fwd_kernel, hipFuncAttributeMaxDynamicSharedMemorySize, LDS_BYTES);
        hipOccupancyMaxActiveBlocksPerMultiprocessor(&per_cu, (const void*)fwd_kernel, NTHREADS, LDS_BYTES);
        if (per_cu < 1) per_cu = 1;
        if (per_cu > 1) per_cu = 1;
        grid = cus * per_cu;
        (void)hipGetLastError();
    }
    if (grid < 0) return;
    if (hipMemsetAsync((char*)d_ws + WS_CTL, 0, 65536, stream) != hipSuccess) { fprintf(stderr, "memset failed\n"); return; }
    Params p{};
    for (int i = 0; i < 20; ++i) p.in[i] = (const float*)d_in[i];
    p.out = (float*)d_out; p.ws = (unsigned char*)d_ws; p.ph_lo = 0; p.ph_hi = 16;
    void* args[] = {&p};
    hipError_t e = hipLaunchCooperativeKernel((const void*)fwd_kernel, dim3(grid), dim3(NTHREADS), args, LDS_BYTES, stream);
    if (e != hipSuccess) fprintf(stderr, "cooperative launch failed: %s (grid %d)\n", hipGetErrorString(e), grid);
}
```

```cpp
#include <hip/hip_runtime.h>
#include <hip/hip_cooperative_groups.h>
#include <cstdio>
#include <cstdint>
namespace cg = cooperative_groups;

#define LAS __attribute__((address_space(3)))
typedef unsigned short bf16_t;
typedef short bf16x8 __attribute__((ext_vector_type(8)));
typedef float f32x4 __attribute__((ext_vector_type(4)));
typedef float f32x16 __attribute__((ext_vector_type(16)));
typedef unsigned u32x4 __attribute__((ext_vector_type(4)));
typedef int i32x4 __attribute__((ext_vector_type(4)));
typedef int i32x8 __attribute__((ext_vector_type(8)));
typedef unsigned u32x2 __attribute__((ext_vector_type(2)));
typedef float f32x2_t __attribute__((ext_vector_type(2)));
typedef __bf16 bf16x2_t __attribute__((ext_vector_type(2)));

constexpr int BATCH = 4, SEQ = 8192, DM = 1024, NTOK = BATCH * SEQ, DEPTH = 2;
constexpr int NHEAD = 8, HD = 64, NEXP = 32, DEXP = 512;
constexpr float EPS = 1e-6f;
constexpr float LOG2E = 1.4426950408889634f;

constexpr size_t MiB = 1u << 20;
constexpr size_t WS_CTL = 0;
constexpr size_t WS_MOD = 1 * MiB;
constexpr size_t WS_TBL = 1 * MiB + 512 * 1024;
constexpr size_t WS_RW = 2 * MiB;
constexpr size_t WS_RWB = 2 * MiB + 512 * 1024;
constexpr size_t WS_LIST = 3 * MiB;
constexpr size_t WS_EW = 7 * MiB;
constexpr size_t WS_WIN = 8 * MiB;
constexpr size_t WS_WOUT = 16 * MiB;
constexpr size_t WS_WGU = 20 * MiB;
constexpr size_t WS_WD = 148 * MiB;
constexpr size_t WS_BUF = 212 * MiB;
constexpr size_t WS_U = 276 * MiB;
constexpr size_t WS_Q = 308 * MiB;
constexpr size_t WS_K = 340 * MiB;
constexpr size_t WS_V = 372 * MiB;
constexpr size_t WS_Y = 276 * MiB;
constexpr size_t WS_ACT = 404 * MiB;
constexpr size_t WS_SSQ = 468 * MiB;
constexpr size_t WS_XB = 470 * MiB;
constexpr size_t WS_LIST2 = 534 * MiB;
constexpr size_t WS_END = 542 * MiB;

constexpr int LDS_BYTES = 147456;
constexpr int NWAVES = 8, NTHREADS = 512;

struct Params {
    const float* in[20];
    float* out;
    unsigned char* ws;
    int ph_lo, ph_hi;
};

__device__ __forceinline__ unsigned cvtpk(float lo, float hi) { f32x2_t v = {lo, hi}; bf16x2_t b = __builtin_convertvector(v, bf16x2_t); return __builtin_bit_cast(unsigned, b); }
__device__ __forceinline__ float bf_lo(unsigned w) { return __uint_as_float(w << 16); }
__device__ __forceinline__ float bf_hi(unsigned w) { return __uint_as_float(w & 0xffff0000u); }
__device__ __forceinline__ float fast_exp2(float x) { return __builtin_amdgcn_exp2f(x); }
__device__ __forceinline__ float fast_rcp(float x) { return __builtin_amdgcn_rcpf(x); }

__device__ __forceinline__ float clamp8(float x) { return __builtin_amdgcn_fmed3f(x, -448.0f, 448.0f); }
__device__ __forceinline__ unsigned pk_fp8x4(float a, float b, float c, float d) { int w = 0; w = __builtin_amdgcn_cvt_pk_fp8_f32(a, b, w, false); w = __builtin_amdgcn_cvt_pk_fp8_f32(c, d, w, true); return (unsigned)w; }
__device__ __forceinline__ int opaque_tid() { int t = threadIdx.x; asm volatile("" : "+v"(t)); return t; }
__device__ __forceinline__ int opaque_bid() { int t = blockIdx.x; asm volatile("" : "+s"(t)); return t; }

namespace pg8 {
constexpr int BM = 256, BK = 64, HALF = 128, HTB = HALF * BK * 2, STAGE_BYTES = 8 * HTB, NXCD = 8, WGM = 8;
__host__ __device__ __forceinline__ int lds_byte(int r, int c) { const int st = (r >> 4) * 2 + (c >> 5), rr = r & 15, cc = c & 31, ob = rr * 64 + cc * 2; return st * 1024 + (ob ^ (((ob >> 9) & 1) << 5)); }
__host__ __device__ __forceinline__ void stage_rc(int b, int& R, int& C) { const int st = b / 1024, sb = b % 1024, swz = sb ^ (((sb >> 9) & 1) << 5); R = (st >> 1) * 16 + swz / 64; C = (st & 1) * 32 + (swz % 64) / 2; }
__host__ __device__ __forceinline__ int perm32(int rho) { const int n = rho >> 4, i = rho & 15; return 8 * (i >> 2) + 4 * n + (i & 3); }

struct Unit { int pm, pn, e, rows; };

struct StaticOrder {
    int nM, nN, nwg, G, c;
    __device__ void init(int M, int N, int G_, int c_) { nM = M / BM; nN = N / BM; nwg = nM * nN; G = G_; c = c_; }
    __device__ bool next(int i, Unit& u) const {
        const long L = (long)i * G + c; if (L >= nwg) return false;
        int wgid = (int)L; { const int q = nwg / NXCD, r = nwg % NXCD, xcd = wgid % NXCD, off = wgid / NXCD; wgid = (xcd < r ? xcd * (q + 1) : r * (q + 1) + (xcd - r) * q) + off; }
        const int nig = WGM * nN, gid = wgid / nig, fm = gid * WGM, gsz = (nM - fm) < WGM ? (nM - fm) : WGM;
        u.pm = fm + ((wgid % nig) % gsz); u.pn = (wgid % nig) / gsz; u.e = 0; u.rows = BM; return true;
    }
};

struct GroupedOrder {
    const LAS int* prefix; const LAS int* cnt; int G, v;
    __device__ bool next(int i, Unit& u) const {
        const int L = i * G + v; const int total = prefix[NEXP];
        if (L >= total * 4) return false;
        const int rt = L >> 2; int e = 0;
#pragma unroll 1
        for (int j = 1; j < NEXP; ++j) if (prefix[j] <= rt) e = j;
        u.e = e; u.pm = rt - prefix[e]; u.pn = L & 3; const int rem = cnt[e] - u.pm * BM; u.rows = rem < BM ? rem : BM; return true;
    }
};

template <class G, class Epi, class Sched>
__device__ __forceinline__ void gemm_phase(LAS unsigned char* lds, const G g, const Sched& S, const Epi& E) {
    int tid = threadIdx.x; asm volatile("" : "+v"(tid));
    const int wid = __builtin_amdgcn_readfirstlane(tid >> 6), lane = tid & 63, wr = wid >> 2, wc = wid & 3, fr = lane & 15, fq = lane >> 4;
    const int K = g.K, KB = K * G::ES, nt = KB / (BK * 2);
    int RA[2], CA[2]; unsigned voffB[2];
#pragma unroll
    for (int i = 0; i < 2; ++i) { int R, C; stage_rc(tid * 16 + i * 8192, R, C); const int Rb = Epi::PERM ? ((R & ~31) + perm32(R & 31)) : R;
        RA[i] = R; CA[i] = C; voffB[i] = (unsigned)(Rb * KB + C * 2); }
    const size_t kstep = (size_t)(BK * 2);
    const size_t hstep = (size_t)HALF * KB;
    const unsigned ldsw = (unsigned)wid * 1024u;
    const int aoff = lds_byte(wr * 64 + fr, fq * 8), boff = lds_byte(wc * 32 + fr, fq * 8);
#define PG8_SA(b, h) (((b) * 2 + (h)) * HTB)
#define PG8_SB(b, h) ((4 + (b) * 2 + (h)) * HTB)
#define PG8_STAGE2(bufoff, gbase, o0, o1) do { \
        __builtin_amdgcn_global_load_lds((const unsigned*)((const char*)(gbase) + (o0)), (LAS unsigned*)(lds + (bufoff) + ldsw), 16, 0, 0); \
        __builtin_amdgcn_global_load_lds((const unsigned*)((const char*)(gbase) + (o1)), (LAS unsigned*)(lds + (bufoff) + ldsw + 8192), 16, 0, 0); } while (0)
#define PG8_STAGEB(bufoff, gbase) PG8_STAGE2(bufoff, gbase, voffB[0], voffB[1])
#define PG8_LDA(dst, b, h) do { _Pragma("unroll") for (int m = 0; m < 4; ++m) _Pragma("unroll") for (int k = 0; k < 2; ++k) dst[m][k] = *(const LAS bf16x8*)(lds + PG8_SA(b, h) + aoff + m * 2048 + k * 1024); } while (0)
#define PG8_LDB(dst, b, h) do { _Pragma("unroll") for (int n = 0; n < 2; ++n) _Pragma("unroll") for (int k = 0; k < 2; ++k) dst[n][k] = *(const LAS bf16x8*)(lds + PG8_SB(b, h) + boff + n * 2048 + k * 1024); } while (0)
#define PG8_F8(v0, v1) __builtin_shufflevector(__builtin_bit_cast(i32x4, v0), __builtin_bit_cast(i32x4, v1), 0, 1, 2, 3, 4, 5, 6, 7)
#define PG8_MMA(ai, bj, At, Bt) do { __builtin_amdgcn_s_setprio(1); \
        if (G::ES == 1) { const i32x8 a0_ = PG8_F8(At[0][0], At[0][1]), a1_ = PG8_F8(At[1][0], At[1][1]), a2_ = PG8_F8(At[2][0], At[2][1]), a3_ = PG8_F8(At[3][0], At[3][1]), b0_ = PG8_F8(Bt[0][0], Bt[0][1]), b1_ = PG8_F8(Bt[1][0], Bt[1][1]); \
            asm volatile("s_nop 1\n\tv_mfma_f32_16x16x128_f8f6f4 %0, %12, %8, %0\n\tv_mfma_f32_16x16x128_f8f6f4 %1, %13, %8, %1\n\tv_mfma_f32_16x16x128_f8f6f4 %2, %12, %9, %2\n\tv_mfma_f32_16x16x128_f8f6f4 %3, %13, %9, %3\n\t" \
                         "v_mfma_f32_16x16x128_f8f6f4 %4, %12, %10, %4\n\tv_mfma_f32_16x16x128_f8f6f4 %5, %13, %10, %5\n\tv_mfma_f32_16x16x128_f8f6f4 %6, %12, %11, %6\n\tv_mfma_f32_16x16x128_f8f6f4 %7, %13, %11, %7" \
                         : "+v"(acc[ai][bj][0][0]), "+v"(acc[ai][bj][0][1]), "+v"(acc[ai][bj][1][0]), "+v"(acc[ai][bj][1][1]), "+v"(acc[ai][bj][2][0]), "+v"(acc[ai][bj][2][1]), "+v"(acc[ai][bj][3][0]), "+v"(acc[ai][bj][3][1]) \
                         : "v"(a0_), "v"(a1_), "v"(a2_), "v"(a3_), "v"(b0_), "v"(b1_)); } \
        else { _Pragma("unroll") for (int m = 0; m < 4; ++m) _Pragma("unroll") for (int n = 0; n < 2; ++n) _Pragma("unroll") for (int k = 0; k < 2; ++k) \
            acc[ai][bj][m][n] = __builtin_amdgcn_mfma_f32_16x16x32_bf16(Bt[n][k], At[m][k], acc[ai][bj][m][n], 0, 0, 0); } __builtin_amdgcn_s_setprio(0); } while (0)
#define PG8_WAIT_V(n) asm volatile("s_waitcnt vmcnt(" #n ")" ::: "memory")
#define PG8_WAIT_L(n) asm volatile("s_waitcnt lgkmcnt(" #n ")" ::: "memory")
#define PG8_BAR __builtin_amdgcn_s_barrier()
#define PG8_SCHED __builtin_amdgcn_sched_barrier(0)
    Unit cur, nxt; int ui = 0;
    if (!S.next(0, cur)) return;
    LAS u32x2* const tab = (LAS u32x2*)(lds + STAGE_BYTES + 1024);
#define PG8_TABLE(u, par) do { if (G::GATHER) { if (wid < 2) __builtin_amdgcn_global_load_lds((const unsigned*)(g.tab_src(u) + (wid * 64 + lane) * 16), (LAS unsigned*)((LAS unsigned char*)tab + (par) * 2048 + wid * 1024), 16, 0, 0); } } while (0)
    PG8_TABLE(cur, 0);
    f32x4 acc[2][2][4][2];
#pragma unroll
    for (int a = 0; a < 2; ++a)
#pragma unroll
        for (int b = 0; b < 2; ++b)
#pragma unroll
            for (int m = 0; m < 4; ++m)
#pragma unroll
                for (int n = 0; n < 2; ++n) acc[a][b][m][n] = (f32x4){0.f, 0.f, 0.f, 0.f};
    bf16x8 At[4][2], B0[2][2], B1[2][2];
    const char* cA = g.a_base(cur); const char* cB = g.b_base(cur);
    unsigned c00 = g.a_off(cur, RA[0], CA[0]), c01 = g.a_off(cur, RA[1], CA[1]), c10 = g.a_off(cur, HALF + RA[0], CA[0]), c11 = g.a_off(cur, HALF + RA[1], CA[1]);
    PG8_STAGEB(PG8_SB(0, 0), cB); PG8_STAGEB(PG8_SB(0, 1), cB + hstep); PG8_STAGE2(PG8_SA(0, 0), cA, c00, c01); PG8_STAGE2(PG8_SA(0, 1), cA, c10, c11);
    if (wr == 1) PG8_BAR;
    PG8_WAIT_V(2); PG8_BAR;
    PG8_STAGEB(PG8_SB(1, 0), cB + kstep); PG8_STAGE2(PG8_SA(1, 0), cA + kstep, c00, c01); PG8_STAGEB(PG8_SB(1, 1), cB + hstep + kstep);
    PG8_WAIT_V(6); PG8_BAR;
    for (;;) {
        const bool has_next = S.next(ui + 1, nxt);
        const char* nA = has_next ? g.a_base(nxt) : cA; const char* nB = has_next ? g.b_base(nxt) : cB;
        unsigned n00 = c00, n01 = c01, n10 = c10, n11 = c11;
        if (G::GATHER && has_next) { n00 = g.a_off(nxt, RA[0], CA[0]); n01 = g.a_off(nxt, RA[1], CA[1]); n10 = g.a_off(nxt, HALF + RA[0], CA[0]); n11 = g.a_off(nxt, HALF + RA[1], CA[1]); }
#pragma unroll 1
        for (int t = 0; t < nt; t += 2) {
            const bool last = (t == nt - 2);
            const char* a1 = cA + (size_t)(t + 1) * kstep;
            const char* a2 = last ? nA : cA + (size_t)(t + 2) * kstep; const char* b2 = last ? nB : cB + (size_t)(t + 2) * kstep;
            const char* a3 = a2 + kstep; const char* b3 = b2 + kstep;
            const unsigned x00 = last ? n00 : c00, x01 = last ? n01 : c01, x10 = last ? n10 : c10, x11 = last ? n11 : c11;
            PG8_LDB(B0, 0, 0); PG8_LDB(B1, 0, 1); PG8_SCHED; PG8_LDA(At, 0, 0); PG8_STAGE2(PG8_SA(1, 1), a1, c10, c11);
            PG8_WAIT_V(8); PG8_WAIT_L(0); PG8_BAR; PG8_MMA(0, 0, At, B0); PG8_MMA(0, 1, At, B1); PG8_BAR; PG8_SCHED;
            PG8_LDA(At, 0, 1); PG8_STAGEB(PG8_SB(0, 0), b2); PG8_STAGEB(PG8_SB(0, 1), b2 + hstep); PG8_STAGE2(PG8_SA(0, 0), a2, x00, x01);
            PG8_WAIT_V(8); PG8_WAIT_L(0); PG8_BAR; PG8_MMA(1, 0, At, B0); PG8_MMA(1, 1, At, B1); PG8_BAR; PG8_SCHED;
            PG8_LDB(B0, 1, 0); PG8_LDB(B1, 1, 1); PG8_SCHED; PG8_LDA(At, 1, 0); PG8_STAGE2(PG8_SA(0, 1), a2, x10, x11);
            PG8_WAIT_V(8); PG8_WAIT_L(0); PG8_BAR; PG8_MMA(0, 0, At, B0); PG8_MMA(0, 1, At, B1); PG8_BAR; PG8_SCHED;
            PG8_LDA(At, 1, 1); PG8_STAGEB(PG8_SB(1, 0), b3); PG8_STAGEB(PG8_SB(1, 1), b3 + hstep); PG8_STAGE2(PG8_SA(1, 0), a3, x00, x01);
            PG8_WAIT_V(8); PG8_WAIT_L(0); PG8_BAR; PG8_MMA(1, 0, At, B0); PG8_MMA(1, 1, At, B1); PG8_BAR; PG8_SCHED;
        }
        if (G::ES == 1) asm volatile("s_nop 15\n\ts_nop 15" ::: "memory");
        if (wr == 0) PG8_BAR;
        E(acc, cur, wr, wc, fr, fq, tab + (ui & 1) * 256);
        if (!has_next) break;
#pragma unroll
        for (int a = 0; a < 2; ++a)
#pragma unroll
            for (int b = 0; b < 2; ++b)
#pragma unroll
                for (int m = 0; m < 4; ++m)
#pragma unroll
                    for (int n = 0; n < 2; ++n) acc[a][b][m][n] = (f32x4){0.f, 0.f, 0.f, 0.f};
        cur = nxt; cA = nA; cB = nB; c00 = n00; c01 = n01; c10 = n10; c11 = n11; ++ui;
        PG8_TABLE(cur, ui & 1);
        if (wr == 1) PG8_BAR;
    }
    PG8_WAIT_V(0);
    PG8_BAR;
#undef PG8_TABLE
#undef PG8_SA
#undef PG8_SB
#undef PG8_STAGE2
#undef PG8_STAGEB
#undef PG8_LDA
#undef PG8_LDB
#undef PG8_MMA
#undef PG8_F8
#undef PG8_WAIT_V
#undef PG8_WAIT_L
#undef PG8_BAR
#undef PG8_SCHED
}
}
using pg8::Unit;

template <int ES_>
struct DenseGemmT {
    static constexpr bool GATHER = false; static constexpr int ES = ES_;
    __device__ __forceinline__ const char* tab_src(const Unit&) const { return nullptr; }
    const void* A; const void* Bt; int K;
    __device__ __forceinline__ const char* a_base(const Unit& u) const { return (const char*)A + (size_t)u.pm * 256 * K * ES; }
    __device__ __forceinline__ const char* b_base(const Unit& u) const { return (const char*)Bt + (size_t)u.pn * 256 * K * ES; }
    __device__ __forceinline__ unsigned a_off(const Unit&, int r, int c) const { return (unsigned)(r * K * ES + c * 2); }
};
typedef DenseGemmT<2> DenseGemm;
typedef DenseGemmT<1> DenseGemm8;
struct GatherGemm {
    static constexpr bool GATHER = true; static constexpr int ES = 1;
    const unsigned char* A; const unsigned char* Bt; const u32x2* list; int K; int a_shift;
    size_t b_expert_stride;
    __device__ __forceinline__ const char* tab_src(const Unit& u) const { return (const char*)(list + (size_t)u.e * NTOK + u.pm * 256); }
    __device__ __forceinline__ const char* a_base(const Unit&) const { return (const char*)A; }
    __device__ __forceinline__ const char* b_base(const Unit& u) const { return (const char*)Bt + (size_t)u.e * b_expert_stride + (size_t)u.pn * 256 * K; }
    __device__ __forceinline__ unsigned a_off(const Unit& u, int r, int c) const {
        const int rr = r < u.rows ? r : u.rows - 1;
        const int slot = (int)list[(size_t)u.e * NTOK + u.pm * 256 + rr].x;
        return (unsigned)((slot >> a_shift) * K + c * 2);
    }
};


struct EpiIn {
    static constexpr bool PERM = true;
    bf16_t* U; bf16_t* Qf; bf16_t* Kf; const float* qg; const float* kg;
    __device__ __forceinline__ void operator()(const f32x4 (&acc)[2][2][4][2], const Unit& u, int wr, int wc, int fr, int fq, const LAS u32x2* tab) const {
        if (u.pn < 2) {
#pragma unroll
            for (int ai = 0; ai < 2; ++ai)
#pragma unroll
                for (int m = 0; m < 4; ++m) {
                    const int row = u.pm * 256 + ai * 128 + wr * 64 + m * 16 + fr;
#pragma unroll
                    for (int bj = 0; bj < 2; ++bj) {
                        const f32x4 v0 = acc[ai][bj][m][0], v1 = acc[ai][bj][m][1];
                        u32x4 w; w.x = cvtpk(v0[0], v0[1]); w.y = cvtpk(v0[2], v0[3]); w.z = cvtpk(v1[0], v1[1]); w.w = cvtpk(v1[2], v1[3]);
                        *(u32x4*)(U + (size_t)row * 512 + u.pn * 256 + bj * 128 + wc * 32 + fq * 8) = w;
                    }
                }
        } else {
            const bool isq = u.pn < 4;
            const float* gg = isq ? qg : kg; bf16_t* dst = isq ? Qf : Kf;
            const float osc = isq ? 0.125f * LOG2E : 1.0f;
            const int head = (u.pn & 1) * 4 + wc;
            f32x4 gv[2][2];
#pragma unroll
            for (int bj = 0; bj < 2; ++bj)
#pragma unroll
                for (int n = 0; n < 2; ++n) gv[bj][n] = *(const f32x4*)(gg + bj * 32 + fq * 8 + n * 4) * osc;
#pragma unroll
            for (int ai = 0; ai < 2; ++ai)
#pragma unroll
                for (int m = 0; m < 4; ++m) {
                    float ss = 0.f;
#pragma unroll
                    for (int bj = 0; bj < 2; ++bj)
#pragma unroll
                        for (int n = 0; n < 2; ++n) { const f32x4 v = acc[ai][bj][m][n]; ss += (v[0] * v[0] + v[1] * v[1]) + (v[2] * v[2] + v[3] * v[3]); }
                    ss += __shfl_xor(ss, 16); ss += __shfl_xor(ss, 32);
                    const float rstd = rsqrtf(ss * (1.0f / 64.0f) + EPS);
                    const int row = u.pm * 256 + ai * 128 + wr * 64 + m * 16 + fr;
                    const int b = row >> 13, s = row & (SEQ - 1), rb = s >> 5, r32 = s & 31;
#pragma unroll
                    for (int bj = 0; bj < 2; ++bj) {
                        const f32x4 v0 = acc[ai][bj][m][0] * rstd * gv[bj][0], v1 = acc[ai][bj][m][1] * rstd * gv[bj][1];
                        u32x4 w; w.x = cvtpk(v0[0], v0[1]); w.y = cvtpk(v0[2], v0[3]); w.z = cvtpk(v1[0], v1[1]); w.w = cvtpk(v1[2], v1[3]);
                        const int d0 = 2 * bj + (fq >> 1), hi = fq & 1;
                        const size_t piece = (((size_t)(b * NHEAD + head) * 256 + rb) * 4 + d0);
                        *(u32x4*)(dst + (piece * 64 + hi * 32 + r32) * 8) = w;
                    }
                }
        }
    }
};

struct EpiVt {
    static constexpr bool PERM = true;
    bf16_t* Vf;
    __device__ __forceinline__ void operator()(const f32x4 (&acc)[2][2][4][2], const Unit& u, int wr, int wc, int fr, int fq, const LAS u32x2* tab) const {
#pragma unroll
        for (int ai = 0; ai < 2; ++ai)
#pragma unroll
            for (int m = 0; m < 4; ++m) {
                const int hd = u.pm * 256 + ai * 128 + wr * 64 + m * 16 + fr;
                const int head = hd >> 6, dblk = (hd >> 5) & 1, dl = hd & 31;
#pragma unroll
                for (int bj = 0; bj < 2; ++bj) {
                    const int tok0 = u.pn * 256 + bj * 128 + wc * 32;
                    const int b = tok0 >> 13, kb = (tok0 & (SEQ - 1)) >> 5;
                    const size_t piece = ((((size_t)(b * NHEAD + head) * 256 + kb) * 2 + (fq >> 1)) * 2 + dblk);
#pragma unroll
                    for (int n = 0; n < 2; ++n) {
                        const f32x4 v = acc[ai][bj][m][n];
                        u32x2 w; w.x = cvtpk(v[0], v[1]); w.y = cvtpk(v[2], v[3]);
                        *(u32x2*)((char*)Vf + (piece * 64 + n * 32 + dl) * 16 + (fq & 1) * 8) = w;
                    }
                }
            }
    }
};

template <bool XF>
struct EpiOutB {
    static constexpr bool PERM = true;
    const float* xf; bf16_t* XB; const float* g1; float* ssq;
    __device__ __forceinline__ void operator()(const f32x4 (&acc)[2][2][4][2], const Unit& u, int wr, int wc, int fr, int fq, const LAS u32x2* tab) const {
        const int b = (u.pm * 256) >> 13;
        const int col0 = u.pn * 256 + wc * 32 + 8 * fq;
        f32x4 gv[2][2];
#pragma unroll
        for (int bj = 0; bj < 2; ++bj)
#pragma unroll
            for (int n = 0; n < 2; ++n) gv[bj][n] = *(const f32x4*)(g1 + (size_t)b * 6144 + col0 + bj * 128 + n * 4) * (1.0f / 4096.0f);
#pragma unroll
        for (int ai = 0; ai < 2; ++ai)
#pragma unroll
            for (int m = 0; m < 4; ++m) {
                const int row = u.pm * 256 + ai * 128 + wr * 64 + m * 16 + fr;
                const size_t off = (size_t)row * DM + col0;
                f32x4 xb[2][2];
                if (XF) {
#pragma unroll
                    for (int bj = 0; bj < 2; ++bj) { xb[bj][0] = *(const f32x4*)(xf + off + bj * 128); xb[bj][1] = *(const f32x4*)(xf + off + bj * 128 + 4); }
                } else {
#pragma unroll
                    for (int bj = 0; bj < 2; ++bj) { const u32x4 w = *(const u32x4*)(XB + off + bj * 128);
                        xb[bj][0] = (f32x4){bf_lo(w.x), bf_hi(w.x), bf_lo(w.y), bf_hi(w.y)}; xb[bj][1] = (f32x4){bf_lo(w.z), bf_hi(w.z), bf_lo(w.w), bf_hi(w.w)}; }
                }
                float ss = 0.f;
#pragma unroll
                for (int bj = 0; bj < 2; ++bj) {
                    const f32x4 x0 = xb[bj][0] + gv[bj][0] * acc[ai][bj][m][0], x1 = xb[bj][1] + gv[bj][1] * acc[ai][bj][m][1];
                    u32x4 w; w.x = cvtpk(x0[0], x0[1]); w.y = cvtpk(x0[2], x0[3]); w.z = cvtpk(x1[0], x1[1]); w.w = cvtpk(x1[2], x1[3]);
                    *(u32x4*)(XB + off + bj * 128) = w;
                    const float r0 = bf_lo(w.x), r1 = bf_hi(w.x), r2 = bf_lo(w.y), r3 = bf_hi(w.y), r4 = bf_lo(w.z), r5 = bf_hi(w.z), r6 = bf_lo(w.w), r7 = bf_hi(w.w);
                    ss += ((r0 * r0 + r1 * r1) + (r2 * r2 + r3 * r3)) + ((r4 * r4 + r5 * r5) + (r6 * r6 + r7 * r7));
                }
                ss += __shfl_xor(ss, 16); ss += __shfl_xor(ss, 32);
                if (fq == 0) ssq[(size_t)row * 16 + u.pn * 4 + wc] = ss;
            }
    }
};

struct EpiGU {
    static constexpr bool PERM = true;
    unsigned char* ACT;
    __device__ __forceinline__ void operator()(const f32x4 (&acc)[2][2][4][2], const Unit& u, int wr, int wc, int fr, int fq, const LAS u32x2* tab) const {
        constexpr float SI = 1.0f / 2048.0f;
#pragma unroll
        for (int ai = 0; ai < 2; ++ai)
#pragma unroll
            for (int m = 0; m < 4; ++m) {
                const int r = ai * 128 + wr * 64 + m * 16 + fr;
                const int slot = (int)tab[r].x;
                float o[8];
#pragma unroll
                for (int n = 0; n < 2; ++n)
#pragma unroll
                    for (int e = 0; e < 4; ++e) { const float gte = acc[ai][0][m][n][e] * SI, up = acc[ai][1][m][n][e] * (4.0f * SI);
                        o[n * 4 + e] = clamp8(gte * fast_rcp(1.0f + fast_exp2(-gte * LOG2E)) * up); }
                u32x2 w; w.x = pk_fp8x4(o[0], o[1], o[2], o[3]); w.y = pk_fp8x4(o[4], o[5], o[6], o[7]);
                if (r < u.rows) *(u32x2*)(ACT + (size_t)slot * DEXP + u.pn * 128 + wc * 32 + fq * 8) = w;
            }
    }
};

struct EpiDn {
    static constexpr bool PERM = true;
    unsigned char* Y8;
    __device__ __forceinline__ void operator()(const f32x4 (&acc)[2][2][4][2], const Unit& u, int wr, int wc, int fr, int fq, const LAS u32x2* tab) const {
#pragma unroll
        for (int ai = 0; ai < 2; ++ai)
#pragma unroll
            for (int m = 0; m < 4; ++m) {
                const int r = ai * 128 + wr * 64 + m * 16 + fr;
                const u32x2 en = tab[r];
                const int slot = (int)en.x;
                const float w8 = __uint_as_float(en.y) * (16.0f / 1024.0f);
                if (r < u.rows) {
#pragma unroll
                    for (int bj = 0; bj < 2; ++bj) {
                        const f32x4 v0 = acc[ai][bj][m][0] * w8, v1 = acc[ai][bj][m][1] * w8;
                        int lo = 0, hi = 0;
                        lo = __builtin_amdgcn_cvt_pk_fp8_f32(v0[0], v0[1], lo, false); lo = __builtin_amdgcn_cvt_pk_fp8_f32(v0[2], v0[3], lo, true);
                        hi = __builtin_amdgcn_cvt_pk_fp8_f32(v1[0], v1[1], hi, false); hi = __builtin_amdgcn_cvt_pk_fp8_f32(v1[2], v1[3], hi, true);
                        u32x2 w; w.x = (unsigned)lo; w.y = (unsigned)hi;
                        *(u32x2*)(Y8 + (size_t)slot * DM + u.pn * 256 + bj * 128 + wc * 32 + fq * 8) = w;
                    }
                }
            }
    }
};

struct TItem { const float* src; unsigned char* dst; int N, dstK, koff, k0, n0, map, f8; };
__device__ __forceinline__ int t_rowmap(int map, int n) {
    if (map == 0) return n;
    if (map == 1) { if (n < 512 || n >= 1536) return n; const int t = n & 255, wc = t >> 6, bj = (t >> 5) & 1, c = t & 31; return (n & ~255) + 128 * bj + 32 * wc + c; }
    return 256 * (n >> 7) + 128 * (map - 2) + (n & 127);
}
__device__ __forceinline__ void t_load(const TItem& d, f32x4 (&v)[16], int lane) {
    const int kr = lane >> 4, c4 = lane & 15;
#pragma unroll
    for (int i = 0; i < 16; ++i) v[i] = *(const f32x4*)(d.src + (size_t)(d.k0 + 4 * i + kr) * d.N + d.n0 + 4 * c4);
}
__device__ __forceinline__ void t_process(const TItem& d, const f32x4 (&v)[16], LAS float* scr, int lane) {
    const int kr = lane >> 4, c4 = lane & 15;
#pragma unroll
    for (int i = 0; i < 16; ++i) { LAS float* s = scr + (4 * i + kr) * 65 + 4 * c4; s[0] = v[i][0]; s[1] = v[i][1]; s[2] = v[i][2]; s[3] = v[i][3]; }
    asm volatile("s_waitcnt lgkmcnt(0)" ::: "memory");
    const int nr = lane >> 3, kc = lane & 7;
#pragma unroll
    for (int i = 0; i < 8; ++i) { const int n = 8 * i + nr; const LAS float* s = scr + (8 * kc) * 65 + n;
        const size_t eo = (size_t)t_rowmap(d.map, d.n0 + n) * d.dstK + d.koff + d.k0 + 8 * kc;
        if (d.f8) { u32x2 o; o.x = pk_fp8x4(s[0] * 256.0f, s[65] * 256.0f, s[2 * 65] * 256.0f, s[3 * 65] * 256.0f); o.y = pk_fp8x4(s[4 * 65] * 256.0f, s[5 * 65] * 256.0f, s[6 * 65] * 256.0f, s[7 * 65] * 256.0f);
            *(u32x2*)(d.dst + eo) = o; }
        else { u32x4 o; o.x = cvtpk(s[0], s[65]); o.y = cvtpk(s[2 * 65], s[3 * 65]); o.z = cvtpk(s[4 * 65], s[5 * 65]); o.w = cvtpk(s[6 * 65], s[7 * 65]);
            *(u32x4*)(d.dst + eo * 2) = o; } }
    asm volatile("s_waitcnt lgkmcnt(0)" ::: "memory");
}
constexpr int T_IN = 512, T_OUT = 128, T_E = 128, T_MOE = NEXP * 3 * T_E, T_PER_LAYER = T_IN + T_OUT + T_MOE;
constexpr int T_NA = T_PER_LAYER + T_IN + T_OUT, T_NB = T_MOE;
__device__ __forceinline__ void t_decode_lr(const Params& p, int l, int r, TItem& d) {
    unsigned char* ws = p.ws;
    if (r < T_IN) { d.src = p.in[6] + (size_t)l * 1024 * 2048; d.N = 2048; d.f8 = 0; d.dst = ws + WS_WIN + (size_t)l * 2048 * 1024 * 2; d.dstK = 1024; d.koff = 0; d.k0 = (r >> 5) * 64; d.n0 = (r & 31) * 64; d.map = 1; return; }
    r -= T_IN;
    if (r < T_OUT) { d.src = p.in[12] + ((size_t)l * 1024 + 512) * 1024; d.N = 1024; d.f8 = 1; d.dst = ws + WS_WOUT + (size_t)l * 1024 * 1024; d.dstK = 1024; d.koff = 512; d.k0 = (r >> 4) * 64; d.n0 = (r & 15) * 64; d.map = 0; return; }
    r -= T_OUT;
    const int e = r / (3 * T_E); int q = r % (3 * T_E);
    if (q < 2 * T_E) { const int up = q >= T_E; if (up) q -= T_E;
        d.src = p.in[up ? 18 : 17] + ((size_t)l * NEXP + e) * 1024 * 512; d.N = 512; d.f8 = 1; d.dst = ws + WS_WGU + ((size_t)l * NEXP + e) * 1024 * 1024; d.dstK = 1024; d.koff = 0; d.k0 = (q >> 3) * 64; d.n0 = (q & 7) * 64; d.map = 2 + up; return; }
    q -= 2 * T_E;
    d.src = p.in[19] + ((size_t)l * NEXP + e) * 512 * 1024; d.N = 1024; d.f8 = 1; d.dst = ws + WS_WD + ((size_t)l * NEXP + e) * 1024 * 512; d.dstK = 512; d.koff = 0; d.k0 = (q >> 4) * 64; d.n0 = (q & 15) * 64; d.map = 0;
}
template <bool SPACE_B>
__device__ __forceinline__ void t_decode(const Params& p, int it, TItem& d) {
    if (SPACE_B) t_decode_lr(p, 1, T_IN + T_OUT + it, d);
    else if (it < T_PER_LAYER) t_decode_lr(p, 0, it, d);
    else t_decode_lr(p, 1, it - T_PER_LAYER, d);
}
template <bool SPACE_B>
__device__ __forceinline__ void t_run(const Params& p, int it, int stride, int nit, LAS float* scr, int lane) {
    if (it >= nit) return;
    TItem dA, dB; f32x4 vA[16], vB[16];
    t_decode<SPACE_B>(p, it, dA); t_load(dA, vA, lane);
    for (;;) {
        int nx = it + stride; const bool hasB = nx < nit;
        if (hasB) { t_decode<SPACE_B>(p, nx, dB); t_load(dB, vB, lane); }
        t_process(dA, vA, scr, lane);
        if (!hasB) break;
        it = nx + stride; const bool hasA = it < nit;
        if (hasA) { t_decode<SPACE_B>(p, it, dA); t_load(dA, vA, lane); }
        t_process(dB, vB, scr, lane);
        if (!hasA) break;
    }
}
__device__ __forceinline__ void tail_convert(const Params& p, LAS unsigned char* lds, int total_units, int v, int first, int count) {
    const int tid = opaque_tid(), lane = tid & 63, wave = tid >> 6, G = gridDim.x;
    const int rem = total_units % G;
    const int nshare = rem ? G - rem : G, sidx = rem ? v - rem : v;
    __syncthreads();
    if (sidx >= 0) t_run<true>(p, first + sidx + nshare * wave, nshare * NWAVES, first + count, (LAS float*)(lds + wave * 16640), lane);
    __syncthreads();
}

__device__ __forceinline__ void phase_prologue(const Params& p, LAS unsigned char* lds) {
    const int tid = opaque_tid(), lane = tid & 63, wave = tid >> 6, G = gridDim.x;
    unsigned char* ws = p.ws;
    {
        LAS float* cact = (LAS float*)lds;
        LAS float* red = (LAS float*)(lds + 16384);
        const float* c = p.in[1];
        for (int i = tid; i < 4096; i += NTHREADS) { const float v = c[i]; cact[i] = v / (1.0f + __expf(-v)); }
        __syncthreads();
        float* mod = (float*)(ws + WS_MOD);
        for (int item = blockIdx.x; item < 2 * 192; item += G) {
            const int l = item / 192, cgp = item % 192;
            const float* W = p.in[2] + (size_t)l * 1024 * 6144 + cgp * 32;
            const int col = lane & 31, rsub = lane >> 5;
            float a0 = 0.f, a1 = 0.f, a2 = 0.f, a3 = 0.f;
#pragma unroll 16
            for (int i = 0; i < 64; ++i) { const int k = wave * 128 + 2 * i + rsub; const float w = W[(size_t)k * 6144 + col];
                a0 += cact[k] * w; a1 += cact[1024 + k] * w; a2 += cact[2048 + k] * w; a3 += cact[3072 + k] * w; }
            a0 += __shfl_xor(a0, 32); a1 += __shfl_xor(a1, 32); a2 += __shfl_xor(a2, 32); a3 += __shfl_xor(a3, 32);
            if (lane < 32) { red[(wave * 4 + 0) * 32 + col] = a0; red[(wave * 4 + 1) * 32 + col] = a1; red[(wave * 4 + 2) * 32 + col] = a2; red[(wave * 4 + 3) * 32 + col] = a3; }
            __syncthreads();
            if (tid < 128) { const int b = tid >> 5, cc = tid & 31; float s = 0.f;
#pragma unroll
                for (int w = 0; w < 8; ++w) s += red[(w * 4 + b) * 32 + cc];
                mod[(size_t)(l * 4 + b) * 6144 + cgp * 32 + cc] = s + p.in[3][l * 6144 + cgp * 32 + cc]; }
            __syncthreads();
        }
    }
    {
        float* tbl = (float*)(ws + WS_TBL);
        for (int job = blockIdx.x; job < 2; job += G) {
            const int l = job;
            LAS float* sm = (LAS float*)(lds + 32768);
            float mq = 0.f, mk = 0.f, mb = 0.f;
            if (tid < 64) { mq = fabsf(p.in[9][l * 64 + tid]); mk = fabsf(p.in[10][l * 64 + tid]); }
            for (int i = tid; i < NHEAD * 257; i += NTHREADS) mb = fmaxf(mb, fabsf(p.in[11][i]));
#pragma unroll
            for (int o = 1; o < 64; o <<= 1) { mq = fmaxf(mq, __shfl_xor(mq, o)); mk = fmaxf(mk, __shfl_xor(mk, o)); mb = fmaxf(mb, __shfl_xor(mb, o)); }
            if (lane == 0) { sm[wave * 4 + 0] = mq; sm[wave * 4 + 1] = mk; sm[wave * 4 + 2] = mb; }
            __syncthreads();
            mq = 0.f; mk = 0.f; mb = 0.f;
            for (int w = 0; w < 8; ++w) { mq = fmaxf(mq, sm[w * 4 + 0]); mk = fmaxf(mk, sm[w * 4 + 1]); mb = fmaxf(mb, sm[w * 4 + 2]); }
            const float shift = LOG2E * (8.0f * mq * mk + mb);
            for (int i = tid; i < NHEAD * 256; i += NTHREADS) { const int h = i >> 8, j = i & 255; int rel = j - 63; if (rel > 128) rel = 128;
                tbl[(size_t)l * 2048 + i] = (j < 255) ? p.in[11][h * 257 + rel + 128] * LOG2E - shift : 0.f; }
            __syncthreads();
        }
        for (int job = blockIdx.x; job < 2 * 48; job += G) {
            const int l = job / 48, n = job % 48;
            bf16_t* hi = (bf16_t*)(ws + WS_RW) + (size_t)l * 2 * 48 * 1024;
            bf16_t* lo = hi + 48 * 1024;
            for (int k = tid; k < 1024; k += NTHREADS) {
                float w = 0.f;
                if (n < 32) w = p.in[15][((size_t)l * 1024 + k) * 32 + n]; else if (n < 36) w = p.in[13][((size_t)l * 1024 + k) * 4 + (n - 32)];
                const unsigned h2 = cvtpk(w, 0.f) & 0xffffu; const float r = w - bf_lo(h2);
                const size_t idx = ((size_t)((k >> 5) * 3 + (n >> 4)) * 64 + ((k & 31) >> 3) * 16 + (n & 15)) * 8 + (k & 7);
                hi[idx] = (bf16_t)h2; lo[idx] = (bf16_t)(cvtpk(r, 0.f) & 0xffffu);
            }
            if (tid == 0) { float bsv = 0.f; if (n < 32) bsv = p.in[16][l * 32 + n]; else if (n < 36) bsv = p.in[14][l * 4 + (n - 32)]; ((float*)(ws + WS_RWB))[l * 48 + n] = bsv; }
        }
    }
    __syncthreads();
    {
        LAS float* wsc = (LAS float*)lds;
        LAS float* pwl = (LAS float*)(lds + 32768);
        for (int item = blockIdx.x; item < 2 * 4 * 16; item += G) {
            const int l = item >> 6, g = (item >> 4) & 3, nb = item & 15;
            const float* wo = p.in[12] + ((size_t)l * 1024 + g * 128) * 1024 + nb * 64;
            const float* sc = p.in[8] + l * 512 + g * 128;
            const float* pw = p.in[7] + ((size_t)l * 4 + g) * 128 * 128;
            for (int i = tid; i < 128 * 64; i += NTHREADS) { const int d = i >> 6, n = i & 63; wsc[i] = wo[(size_t)d * 1024 + n] * sc[d]; }
            for (int i = tid; i < 128 * 128 / 4; i += NTHREADS) *(LAS f32x4*)(pwl + 4 * i) = *(const f32x4*)(pw + 4 * i);
            __syncthreads();
            const int n = tid & 63, cgp = tid >> 6;
            float a[16];
#pragma unroll
            for (int j = 0; j < 16; ++j) a[j] = 0.f;
#pragma unroll 2
            for (int d4 = 0; d4 < 32; ++d4) {
                const float w0 = wsc[(4 * d4 + 0) * 64 + n], w1 = wsc[(4 * d4 + 1) * 64 + n], w2 = wsc[(4 * d4 + 2) * 64 + n], w3 = wsc[(4 * d4 + 3) * 64 + n];
#pragma unroll
                for (int j = 0; j < 16; ++j) { const f32x4 pv = *(const LAS f32x4*)(pwl + (cgp * 16 + j) * 128 + 4 * d4); a[j] += (pv[0] * w0 + pv[1] * w1) + (pv[2] * w2 + pv[3] * w3); }
            }
            unsigned char* dst = ws + WS_WOUT + ((size_t)l * 1024 + nb * 64 + n) * 1024 + g * 128 + cgp * 16;
#pragma unroll
            for (int j = 0; j < 16; ++j) a[j] *= 256.0f;
            u32x4 o0; o0.x = pk_fp8x4(a[0], a[1], a[2], a[3]); o0.y = pk_fp8x4(a[4], a[5], a[6], a[7]); o0.z = pk_fp8x4(a[8], a[9], a[10], a[11]); o0.w = pk_fp8x4(a[12], a[13], a[14], a[15]);
            *(u32x4*)dst = o0;
            __syncthreads();
        }
    }
    {
        LAS float* scr = (LAS float*)(lds + wave * 16640);
        t_run<false>(p, blockIdx.x * NWAVES + wave, G * NWAVES, T_NA, scr, lane);
    }
}

typedef float f32x2v __attribute__((ext_vector_type(2)));
__device__ __forceinline__ f32x4 y_pair_sum(const unsigned char* Y8, size_t row, int c) {
    const int a = *(const int*)(Y8 + (size_t)(2 * row) * DM + c), b = *(const int*)(Y8 + (size_t)(2 * row + 1) * DM + c);
    const f32x2v a0 = __builtin_amdgcn_cvt_pk_f32_fp8(a, false), a1 = __builtin_amdgcn_cvt_pk_f32_fp8(a, true);
    const f32x2v b0 = __builtin_amdgcn_cvt_pk_f32_fp8(b, false), b1 = __builtin_amdgcn_cvt_pk_f32_fp8(b, true);
    f32x4 ys; ys[0] = (a0[0] + b0[0]) * 0.0625f; ys[1] = (a0[1] + b0[1]) * 0.0625f; ys[2] = (a1[0] + b1[0]) * 0.0625f; ys[3] = (a1[1] + b1[1]) * 0.0625f; return ys;
}
template <int NR, bool UPD>
__device__ __forceinline__ void norm1_rows(const Params& p, int l, int row0, int lane) {
    const float* mod = (const float*)(p.ws + WS_MOD);
    const float* gn = p.in[4] + l * 1024;
    bf16_t* H = (bf16_t*)(p.ws + WS_BUF);
    const unsigned char* Y = (const unsigned char*)(p.ws + WS_Y);
    bf16_t* XB = (bf16_t*)(p.ws + WS_XB);
    const int b = row0 >> 13;
    f32x4 v[NR][4];
    if (!UPD) {
#pragma unroll
        for (int r = 0; r < NR; ++r)
#pragma unroll
            for (int j = 0; j < 4; ++j) v[r][j] = *(const f32x4*)(p.in[0] + (size_t)(row0 + r) * DM + 4 * lane + 256 * j);
    } else {
        const float* g2 = mod + (size_t)((l - 1) * 4 + b) * 6144 + 5120;
        f32x4 ys[NR][4];
#pragma unroll
        for (int r = 0; r < NR; ++r)
#pragma unroll
            for (int j = 0; j < 4; ++j) { const int c = 4 * lane + 256 * j; const u32x2 xw = *(const u32x2*)(XB + (size_t)(row0 + r) * DM + c);
                v[r][j] = (f32x4){bf_lo(xw.x), bf_hi(xw.x), bf_lo(xw.y), bf_hi(xw.y)}; ys[r][j] = y_pair_sum(Y, row0 + r, c); }
#pragma unroll
        for (int j = 0; j < 4; ++j) { const f32x4 gg = *(const f32x4*)(g2 + 4 * lane + 256 * j);
#pragma unroll
            for (int r = 0; r < NR; ++r) { const f32x4 xn = v[r][j] + gg * ys[r][j]; u32x2 xw; xw.x = cvtpk(xn[0], xn[1]); xw.y = cvtpk(xn[2], xn[3]);
                *(u32x2*)(XB + (size_t)(row0 + r) * DM + 4 * lane + 256 * j) = xw;
                v[r][j] = (f32x4){bf_lo(xw.x), bf_hi(xw.x), bf_lo(xw.y), bf_hi(xw.y)}; } }
    }
    float ss[NR];
#pragma unroll
    for (int r = 0; r < NR; ++r) { ss[r] = 0.f;
#pragma unroll
        for (int j = 0; j < 4; ++j) ss[r] += (v[r][j][0] * v[r][j][0] + v[r][j][1] * v[r][j][1]) + (v[r][j][2] * v[r][j][2] + v[r][j][3] * v[r][j][3]); }
#pragma unroll
    for (int o = 1; o < 64; o <<= 1)
#pragma unroll
        for (int r = 0; r < NR; ++r) ss[r] += __shfl_xor(ss[r], o);
    const float* sh = mod + (size_t)(l * 4 + b) * 6144; const float* sc = sh + 1024;
#pragma unroll
    for (int j = 0; j < 4; ++j) {
        const int c = 4 * lane + 256 * j;
        const f32x4 g = *(const f32x4*)(gn + c), s1 = *(const f32x4*)(sc + c), s0 = *(const f32x4*)(sh + c);
        const f32x4 a = g * (s1 + 1.0f);
#pragma unroll
        for (int r = 0; r < NR; ++r) {
            const float rstd = rsqrtf(ss[r] * (1.0f / DM) + EPS);
            const f32x4 h = v[r][j] * rstd * a + s0;
            u32x2 w; w.x = cvtpk(h[0], h[1]); w.y = cvtpk(h[2], h[3]);
            *(u32x2*)(H + (size_t)(row0 + r) * DM + c) = w;
        }
    }
}
__device__ __forceinline__ void phase_norm1(const Params& p, int l) {
    const int tid = opaque_tid(), lane = tid & 63, wave = tid >> 6, G = gridDim.x;
    const int gw = blockIdx.x * NWAVES + wave, NGW = G * NWAVES;
    if (l == 0) { for (int rq = gw; rq < NTOK / 4; rq += NGW) norm1_rows<4, false>(p, l, rq * 4, lane); }
    else { for (int rq = gw; rq < NTOK / 2; rq += NGW) norm1_rows<2, true>(p, l, rq * 2, lane); }
}

__device__ __forceinline__ void phase_final(const Params& p) {
    const int tid = opaque_tid(), lane = tid & 63, wave = tid >> 6, G = gridDim.x;
    const int gw = blockIdx.x * NWAVES + wave, NGW = G * NWAVES;
    const float* mod = (const float*)(p.ws + WS_MOD);
    const unsigned char* Y = (const unsigned char*)(p.ws + WS_Y);
    const bf16_t* XB = (const bf16_t*)(p.ws + WS_XB);
    constexpr int NR = 4;
    for (int rq = gw; rq < NTOK / NR; rq += NGW) {
        const int row0 = rq * NR, b = row0 >> 13;
        const float* g2 = mod + (size_t)((DEPTH - 1) * 4 + b) * 6144 + 5120;
        f32x4 v[NR][4], ys[NR][4];
#pragma unroll
        for (int r = 0; r < NR; ++r)
#pragma unroll
            for (int j = 0; j < 4; ++j) { const int c = 4 * lane + 256 * j; const u32x2 xw = *(const u32x2*)(XB + (size_t)(row0 + r) * DM + c);
                v[r][j] = (f32x4){bf_lo(xw.x), bf_hi(xw.x), bf_lo(xw.y), bf_hi(xw.y)}; ys[r][j] = y_pair_sum(Y, row0 + r, c); }
#pragma unroll
        for (int j = 0; j < 4; ++j) { const f32x4 gg = *(const f32x4*)(g2 + 4 * lane + 256 * j);
#pragma unroll
            for (int r = 0; r < NR; ++r) *(f32x4*)(p.out + (size_t)(row0 + r) * DM + 4 * lane + 256 * j) = v[r][j] + gg * ys[r][j]; }
    }
}

__device__ __forceinline__ int crow(int r, int hi) { return (r & 3) + 8 * (r >> 2) + 4 * hi; }

__device__ __forceinline__ void pool_strip(const Params& p, int strip, int lane) {
    const bf16_t* U = (const bf16_t*)(p.ws + WS_U); unsigned char* MIX = p.ws + WS_BUF;
    const int tok0 = strip * 16, s0 = tok0 & (SEQ - 1);
    const int win = 2 << (lane >> 4);
    float S[8];
#pragma unroll
    for (int j = 0; j < 8; ++j) S[j] = 0.f;
#pragma unroll
    for (int d = 1; d < 16; ++d) {
        if (d < win && s0 - d >= 0) {
            const u32x4 w = *(const u32x4*)(U + (size_t)(tok0 - d) * 512 + lane * 8);
            S[0] += bf_lo(w.x); S[1] += bf_hi(w.x); S[2] += bf_lo(w.y); S[3] += bf_hi(w.y); S[4] += bf_lo(w.z); S[5] += bf_hi(w.z); S[6] += bf_lo(w.w); S[7] += bf_hi(w.w);
        }
    }
#pragma unroll 4
    for (int i = 0; i < 16; ++i) {
        const int s = s0 + i;
        const u32x4 w = *(const u32x4*)(U + (size_t)(tok0 + i) * 512 + lane * 8);
        float uv[8] = {bf_lo(w.x), bf_hi(w.x), bf_lo(w.y), bf_hi(w.y), bf_lo(w.z), bf_hi(w.z), bf_lo(w.w), bf_hi(w.w)};
#pragma unroll
        for (int j = 0; j < 8; ++j) S[j] += uv[j];
        const int cn = (s + 1 < win) ? s + 1 : win;
        const float inv = 1.0f / (float)cn;
        float o[8];
#pragma unroll
        for (int j = 0; j < 8; ++j) o[j] = clamp8((S[j] * inv - uv[j]) * 16.0f);
        u32x2 ow; ow.x = pk_fp8x4(o[0], o[1], o[2], o[3]); ow.y = pk_fp8x4(o[4], o[5], o[6], o[7]);
        *(u32x2*)(MIX + (size_t)(tok0 + i) * DM + lane * 8) = ow;
        if (s - win + 1 >= 0) {
            const u32x4 x = *(const u32x4*)(U + (size_t)(tok0 + i - win + 1) * 512 + lane * 8);
            S[0] -= bf_lo(x.x); S[1] -= bf_hi(x.x); S[2] -= bf_lo(x.y); S[3] -= bf_hi(x.y); S[4] -= bf_lo(x.z); S[5] -= bf_hi(x.z); S[6] -= bf_lo(x.w); S[7] -= bf_hi(x.w);
        }
    }
}

__device__ __forceinline__ void attn_unit(const Params& p, int b, int h, int ch, int qh, int lane, const LAS float* tbl, LAS unsigned char* stg) {
    const int r32 = lane & 31, hi = lane >> 5;
    const char* Qf = (const char*)(p.ws + WS_Q); const char* Kf = (const char*)(p.ws + WS_K); const char* Vf = (const char*)(p.ws + WS_V);
    unsigned char* MIX = p.ws + WS_BUF;
    const size_t bh = (size_t)(b * NHEAD + h) * 256;
    bf16x8 qr[4];
#pragma unroll
    for (int d0 = 0; d0 < 4; ++d0) qr[d0] = *(const bf16x8*)(Qf + (((bh + ch * 2 + qh) * 4 + d0) * 64 + lane) * 16);
    f32x16 o0 = {}, o1 = {};
    float lsum = 0.f;
    const LAS float* th = tbl + h * 256;
    f32x16 cfv; { const float cfar = th[254];
#pragma unroll
        for (int r = 0; r < 16; ++r) cfv[r] = cfar; }
    const int t0 = ch < 8 ? 8 - ch : 0;
    const char* kp = Kf + (bh * 4 * 64 + lane) * 16 + (ptrdiff_t)(ch - 8 + t0) * 8192;
    const char* vp = Vf + (bh * 4 * 64 + lane) * 16 + (ptrdiff_t)(ch - 8 + t0) * 8192;
    bf16x8 kk[8];
#define ATT_LD8(dst, ptr) do { const char* pa_ = (ptr); const char* pb_ = pa_ + 4096; _Pragma("unroll") for (int i_ = 0; i_ < 4; ++i_) { dst[i_] = *(const bf16x8*)(pa_ + i_ * 1024); dst[4 + i_] = *(const bf16x8*)(pb_ + i_ * 1024); } } while (0)
#define ATT_REST(P0, P1) do { \
        float sacc_ = 0.f; \
        _Pragma("unroll") for (int r = 0; r < 16; ++r) { P0[r] = fast_exp2(P0[r]); P1[r] = fast_exp2(P1[r]); sacc_ += P0[r] + P1[r]; } \
        lsum += sacc_; \
        u32x4 pa_[4]; \
        _Pragma("unroll") for (int s = 0; s < 2; ++s) { \
            pa_[s].x = cvtpk(P0[8 * s + 0], P0[8 * s + 1]); pa_[s].y = cvtpk(P0[8 * s + 2], P0[8 * s + 3]); pa_[s].z = cvtpk(P0[8 * s + 4], P0[8 * s + 5]); pa_[s].w = cvtpk(P0[8 * s + 6], P0[8 * s + 7]); \
            pa_[2 + s].x = cvtpk(P1[8 * s + 0], P1[8 * s + 1]); pa_[2 + s].y = cvtpk(P1[8 * s + 2], P1[8 * s + 3]); pa_[2 + s].z = cvtpk(P1[8 * s + 4], P1[8 * s + 5]); pa_[2 + s].w = cvtpk(P1[8 * s + 6], P1[8 * s + 7]); } \
        _Pragma("unroll") for (int i = 0; i < 4; ++i) { const bf16x8 pf_ = __builtin_bit_cast(bf16x8, pa_[i]); \
            o0 = __builtin_amdgcn_mfma_f32_32x32x16_bf16(pf_, vv[2 * i], o0, 0, 0, 0); o1 = __builtin_amdgcn_mfma_f32_32x32x16_bf16(pf_, vv[2 * i + 1], o1, 0, 0, 0); } \
    } while (0)
    ATT_LD8(kk, kp);
    int t = t0;
#pragma unroll 1
    for (; t <= 5; ++t) {
        bf16x8 vv[8]; ATT_LD8(vv, vp); vp += 8192;
        f32x16 p0 = __builtin_amdgcn_mfma_f32_32x32x16_bf16(kk[0], qr[0], cfv, 0, 0, 0);
        f32x16 p1 = __builtin_amdgcn_mfma_f32_32x32x16_bf16(kk[4], qr[0], cfv, 0, 0, 0);
#pragma unroll
        for (int d0 = 1; d0 < 4; ++d0) { p0 = __builtin_amdgcn_mfma_f32_32x32x16_bf16(kk[d0], qr[d0], p0, 0, 0, 0); p1 = __builtin_amdgcn_mfma_f32_32x32x16_bf16(kk[4 + d0], qr[d0], p1, 0, 0, 0); }
        kp += 8192; ATT_LD8(kk, kp);
        ATT_REST(p0, p1);
    }
#pragma unroll 1
    for (; t <= 8; ++t) {
        bf16x8 vv[8]; ATT_LD8(vv, vp); vp += 8192;
        f32x16 p0, p1;
        { const int base_ = 64 * (8 - t) + 32 * qh + r32 + 63 - 4 * hi;
#pragma unroll
          for (int r = 0; r < 16; ++r) { const int kj = (r & 3) + 8 * (r >> 2); p0[r] = th[base_ - kj]; p1[r] = th[base_ - kj - 32]; } }
#pragma unroll
        for (int d0 = 0; d0 < 4; ++d0) { p0 = __builtin_amdgcn_mfma_f32_32x32x16_bf16(kk[d0], qr[d0], p0, 0, 0, 0); p1 = __builtin_amdgcn_mfma_f32_32x32x16_bf16(kk[4 + d0], qr[d0], p1, 0, 0, 0); }
        if (t < 8) { kp += 8192; ATT_LD8(kk, kp); }
        ATT_REST(p0, p1);
    }
#undef ATT_LD8
#undef ATT_REST
    lsum += __shfl_xor(lsum, 32);
    const float linv = 1.0f / lsum;
#pragma unroll
    for (int r = 0; r < 16; ++r) {
        const int q = crow(r, hi);
        const float li = __shfl(linv, q) * 16.0f;
        const unsigned w = pk_fp8x4(clamp8(o0[r] * li), clamp8(o1[r] * li), 0.f, 0.f);
        stg[q * 80 + r32] = (unsigned char)(w & 0xffu);
        stg[q * 80 + 32 + r32] = (unsigned char)((w >> 8) & 0xffu);
    }
    asm volatile("s_waitcnt lgkmcnt(0)" ::: "memory");
    unsigned char* orow = MIX + ((size_t)b * SEQ + ch * 64 + qh * 32 + (lane >> 2)) * DM + 512 + h * 64 + (lane & 3) * 16;
    const LAS unsigned char* srow = stg + (lane >> 2) * 80 + (lane & 3) * 16;
#pragma unroll
    for (int i = 0; i < 2; ++i) *(u32x4*)(orow + (size_t)i * 16 * DM) = *(const LAS u32x4*)(srow + i * 16 * 80);
    asm volatile("s_waitcnt lgkmcnt(0)" ::: "memory");
}

__device__ __forceinline__ void phase_mixer(const Params& p, int l, LAS unsigned char* lds) {
    const int tid = opaque_tid(), lane = tid & 63, wave = tid >> 6, G = gridDim.x;
    LAS float* tbl = (LAS float*)lds;
    const float* gt = (const float*)(p.ws + WS_TBL) + (size_t)l * 2048;
    for (int i = tid; i < 2048; i += NTHREADS) tbl[i] = gt[i];
    __syncthreads();
    const int gw = blockIdx.x * NWAVES + wave, NGW = G * NWAVES;
    LAS unsigned char* stg = lds + 8192 + wave * 4608;
    for (int it = gw; it < NTOK / 16; it += NGW) pool_strip(p, it, lane);
    if (G % 8 == 0) {
        const int x = (int)blockIdx.x & 7, lw = ((int)blockIdx.x >> 3) * NWAVES + wave, nlw = (G >> 3) * NWAVES;
        for (int pr = x; pr < BATCH * NHEAD; pr += 8)
            for (int u = lw; u < 256; u += nlw) attn_unit(p, pr >> 3, pr & 7, u >> 1, u & 1, lane, tbl, stg);
    } else {
        for (int wu = gw; wu < BATCH * NHEAD * 256; wu += NGW) attn_unit(p, wu >> 11, (wu >> 8) & 7, (wu >> 1) & 127, wu & 1, lane, tbl, stg);
    }
}

__device__ __forceinline__ void phase_route(const Params& p, int l, LAS unsigned char* lds) {
    const int tid = opaque_tid(), lane = tid & 63, wave = __builtin_amdgcn_readfirstlane(tid >> 6), G = gridDim.x;
    LAS float* a2c = (LAS float*)(lds + 49152);
    LAS float* shc = (LAS float*)(lds + 49152 + 1024);
    LAS float* lg = (LAS float*)(lds + 53248) + wave * (16 * 48);
    LAS int* lcnt = (LAS int*)(lds + 77824);
    LAS int* gbase = (LAS int*)(lds + 77824 + 128);
    LAS int* tmp_e = (LAS int*)(lds + 77824 + 256);
    LAS int* tmp_r = (LAS int*)(lds + 77824 + 256 + 1024);
    LAS float* tmp_w = (LAS float*)(lds + 77824 + 256 + 2048);
    const float* mod = (const float*)(p.ws + WS_MOD);
    const float* gn = p.in[5] + l * 1024;
    unsigned char* H8 = p.ws + WS_BUF;
    const char* RW = (const char*)(p.ws + WS_RW) + (size_t)l * 2 * 48 * 1024 * 2;
    const float* rwb = (const float*)(p.ws + WS_RWB) + l * 48;
    const float* ssq = (const float*)(p.ws + WS_SSQ);
    int* gcnt = (int*)(p.ws + WS_CTL) + l * 32;
    u32x2* list = (u32x2*)(p.ws + WS_LIST2);
    const int r = lane & 15, kg = lane >> 4;
    for (int it = blockIdx.x; it < NTOK / 128; it += G) {
        const int row0 = it * 128 + wave * 16, row = row0 + r, b = (it * 128) >> 13;
        const bf16_t* xr = (const bf16_t*)(p.ws + WS_XB) + (size_t)row * DM + 8 * kg;
        float ss; { const f32x4 q4 = *(const f32x4*)(ssq + (size_t)row * 16 + 4 * kg); ss = (q4[0] + q4[1]) + (q4[2] + q4[3]); }
        ss += __shfl_xor(ss, 16); ss += __shfl_xor(ss, 32);
        const float rstd = rsqrtf(ss * (1.0f / DM) + EPS);
        const float* sh = mod + (size_t)(l * 4 + b) * 6144 + 3072; const float* sc = sh + 1024;
        f32x4 acc[3];
#pragma unroll
        for (int nb = 0; nb < 3; ++nb) acc[nb] = (f32x4){0.f, 0.f, 0.f, 0.f};
#pragma unroll 1
        for (int c = 0; c < 4; ++c) {
            u32x4 xs[8];
#pragma unroll
            for (int i = 0; i < 8; ++i) xs[i] = *(const u32x4*)(xr + 256 * c + 32 * i);
            __syncthreads();
            if (c == 0 && tid < 32) lcnt[tid] = 0;
#pragma unroll
            for (int i = 0; i < 6; ++i) { const int q = wave * 6 + i; const char* src = RW + (q < 24 ? (size_t)(c * 24 + q) * 1024 : (size_t)98304 + (size_t)(c * 24 + q - 24) * 1024);
                __builtin_amdgcn_global_load_lds((const unsigned*)(src + lane * 16), (LAS unsigned*)(lds + q * 1024), 16, 0, 0); }
            if (tid < 256) { const int k = 256 * c + tid; a2c[tid] = gn[k] * (1.0f + sc[k]); shc[tid] = sh[k]; }
            asm volatile("s_waitcnt vmcnt(0)" ::: "memory");
            __syncthreads();
#pragma unroll
            for (int i = 0; i < 8; ++i) {
                float hv[8];
#pragma unroll
                for (int q = 0; q < 2; ++q) {
                    const f32x4 a = *(const LAS f32x4*)(a2c + 32 * i + 8 * kg + 4 * q), s0 = *(const LAS f32x4*)(shc + 32 * i + 8 * kg + 4 * q);
                    const f32x4 xv = q == 0 ? (f32x4){bf_lo(xs[i].x), bf_hi(xs[i].x), bf_lo(xs[i].y), bf_hi(xs[i].y)} : (f32x4){bf_lo(xs[i].z), bf_hi(xs[i].z), bf_lo(xs[i].w), bf_hi(xs[i].w)};
                    const f32x4 hh = xv * rstd * a + s0;
                    hv[4 * q + 0] = hh[0]; hv[4 * q + 1] = hh[1]; hv[4 * q + 2] = hh[2]; hv[4 * q + 3] = hh[3];
                }
                u32x4 hp; hp.x = cvtpk(hv[0], hv[1]); hp.y = cvtpk(hv[2], hv[3]); hp.z = cvtpk(hv[4], hv[5]); hp.w = cvtpk(hv[6], hv[7]);
                { u32x2 h8; h8.x = pk_fp8x4(clamp8(hv[0] * 8.0f), clamp8(hv[1] * 8.0f), clamp8(hv[2] * 8.0f), clamp8(hv[3] * 8.0f)); h8.y = pk_fp8x4(clamp8(hv[4] * 8.0f), clamp8(hv[5] * 8.0f), clamp8(hv[6] * 8.0f), clamp8(hv[7] * 8.0f));
                  *(u32x2*)(H8 + (size_t)row * DM + 256 * c + 32 * i + 8 * kg) = h8; }
                u32x4 lp;
                lp.x = cvtpk(hv[0] - bf_lo(hp.x), hv[1] - bf_hi(hp.x)); lp.y = cvtpk(hv[2] - bf_lo(hp.y), hv[3] - bf_hi(hp.y));
                lp.z = cvtpk(hv[4] - bf_lo(hp.z), hv[5] - bf_hi(hp.z)); lp.w = cvtpk(hv[6] - bf_lo(hp.w), hv[7] - bf_hi(hp.w));
                const bf16x8 xhi = __builtin_bit_cast(bf16x8, hp), xlo = __builtin_bit_cast(bf16x8, lp);
#pragma unroll
                for (int nb = 0; nb < 3; ++nb) {
                    const bf16x8 whi = *(const LAS bf16x8*)(lds + (i * 3 + nb) * 1024 + lane * 16);
                    const bf16x8 wlo = *(const LAS bf16x8*)(lds + 24576 + (i * 3 + nb) * 1024 + lane * 16);
                    acc[nb] = __builtin_amdgcn_mfma_f32_16x16x32_bf16(whi, xhi, acc[nb], 0, 0, 0);
                    acc[nb] = __builtin_amdgcn_mfma_f32_16x16x32_bf16(whi, xlo, acc[nb], 0, 0, 0);
                    acc[nb] = __builtin_amdgcn_mfma_f32_16x16x32_bf16(wlo, xhi, acc[nb], 0, 0, 0);
                }
            }
        }
#pragma unroll
        for (int nb = 0; nb < 3; ++nb)
#pragma unroll
            for (int q = 0; q < 4; ++q) lg[r * 48 + 16 * nb + 4 * kg + q] = acc[nb][q];
        asm volatile("s_waitcnt lgkmcnt(0)" ::: "memory");
        if (lane < 16) {
            const LAS float* my = lg + lane * 48;
            float gl[4]; int gi = 0; float gm;
#pragma unroll
            for (int i = 0; i < 4; ++i) gl[i] = my[32 + i] + rwb[32 + i];
            gm = gl[0];
#pragma unroll
            for (int i = 1; i < 4; ++i) if (gl[i] > gm) { gm = gl[i]; gi = i; }
            float den = 0.f;
#pragma unroll
            for (int i = 0; i < 4; ++i) den += __expf(gl[i] - gm);
            const float gpv = 1.0f / den;
            float el[8];
#pragma unroll
            for (int i = 0; i < 8; ++i) el[i] = my[8 * gi + i] + rwb[8 * gi + i];
            int i0 = 0; float v0 = el[0];
#pragma unroll
            for (int i = 1; i < 8; ++i) if (el[i] > v0) { v0 = el[i]; i0 = i; }
            int i1 = -1; float v1 = -3.0e38f;
#pragma unroll
            for (int i = 0; i < 8; ++i) if (i != i0 && el[i] > v1) { v1 = el[i]; i1 = i; }
            const float dd = __expf(v1 - v0);
            const float w0 = gpv / (1.0f + dd), w1 = gpv * dd / (1.0f + dd);
            const int e0 = 8 * gi + i0, e1 = 8 * gi + i1;
            const int tok = row0 + lane, lt = wave * 16 + lane;
            tmp_w[2 * lt] = w0; tmp_w[2 * lt + 1] = w1;
            tmp_e[2 * lt] = e0; tmp_e[2 * lt + 1] = e1;
            tmp_r[2 * lt] = __hip_atomic_fetch_add(lcnt + e0, 1, __ATOMIC_RELAXED, __HIP_MEMORY_SCOPE_WORKGROUP);
            tmp_r[2 * lt + 1] = __hip_atomic_fetch_add(lcnt + e1, 1, __ATOMIC_RELAXED, __HIP_MEMORY_SCOPE_WORKGROUP);
        }
        __syncthreads();
        if (tid < 32) gbase[tid] = __hip_atomic_fetch_add(gcnt + tid, lcnt[tid], __ATOMIC_RELAXED, __HIP_MEMORY_SCOPE_AGENT);
        __syncthreads();
        if (tid < 256) { const int e = tmp_e[tid]; u32x2 en; en.x = (unsigned)(it * 256 + tid); en.y = __float_as_uint(tmp_w[tid]); list[(size_t)e * NTOK + gbase[e] + tmp_r[tid]] = en; }
    }
    __syncthreads();
}

#define XB_TMO      128
#define XB_XCNT(j)  (256  + 64 * (j))
#define XB_XSUB(j)  (1280 + 64 * (j))
#define XB_XGEN(j)  (2304 + 64 * (j))
#define XB_TOP      3328
#define XB_TOPGEN   3392
#define XCD_BAR_WORDS 3456
#define XB_SPIN_CAP (1u << 18)
__device__ __forceinline__ unsigned xb_ld(unsigned* p)              { return __hip_atomic_load(p, __ATOMIC_RELAXED, __HIP_MEMORY_SCOPE_AGENT); }
__device__ __forceinline__ unsigned xb_add(unsigned* p, unsigned v) { return __hip_atomic_fetch_add(p, v, __ATOMIC_RELAXED, __HIP_MEMORY_SCOPE_AGENT); }
__device__ __forceinline__ unsigned xb_xcc_id() { return (unsigned)__builtin_amdgcn_s_getreg((3 << 11) | 20) & 0xFu; }
#define XB_SPIN(cond, bar) do { unsigned _sp = 0; while (cond) { __builtin_amdgcn_s_sleep(1); \
    if ((++_sp & 255u) == 0u) { if (xb_ld(&(bar)[XB_TMO])) break; if (_sp > XB_SPIN_CAP) { atomicAdd(&(bar)[XB_TMO], 1u); break; } } } } while (0)
struct XcdBarrier { unsigned* bar; unsigned x; volatile LAS unsigned* st; };
__device__ __forceinline__ XcdBarrier xcd_barrier_post(unsigned* bar, volatile LAS unsigned* st) {
    XcdBarrier b; b.bar = bar; b.x = xb_xcc_id(); b.st = st;
    if (threadIdx.x == 0) (void)xb_add(&bar[XB_XCNT(b.x)], 1u);
    return b;
}
__device__ __forceinline__ void xcd_barrier_complete(unsigned* bar, unsigned x, unsigned& nloc, unsigned& nx) {
    const unsigned G = gridDim.x * gridDim.y * gridDim.z;
    unsigned sum, cnt, mine, sp = 0u;
    for (;;) {
        sum = 0u; cnt = 0u; mine = 0u;
#pragma unroll
        for (unsigned j = 0; j < 16; ++j) { const unsigned c = xb_ld(&bar[XB_XCNT(j)]); sum += c; cnt += (c > 0u) ? 1u : 0u; mine = (j == x) ? c : mine; }
        if (sum == G) break;
        __builtin_amdgcn_s_sleep(1);
        if ((++sp & 255u) == 0u) { if (xb_ld(&bar[XB_TMO])) break; if (sp > XB_SPIN_CAP) { atomicAdd(&bar[XB_TMO], 1u); break; } }
    }
    nloc = mine > 0u ? mine : 1u; nx = cnt > 0u ? cnt : 1u;
}
__device__ __forceinline__ void xcd_barrier(const XcdBarrier& b) {
    asm volatile("s_waitcnt vmcnt(0)" ::: "memory");
    __syncthreads();
    if (threadIdx.x == 0) {
        unsigned* bar = b.bar;
        __builtin_amdgcn_s_waitcnt(0);
        unsigned nloc = b.st[0], nx = b.st[1];
        if (nloc == 0u) { xcd_barrier_complete(bar, b.x, nloc, nx); b.st[0] = nloc; b.st[1] = nx; }
        const unsigned old = xb_add(&bar[XB_XSUB(b.x)], 1u);
        const unsigned gen = old / nloc;
        if (old + 1u == (gen + 1u) * nloc) {
            __builtin_amdgcn_fence(__ATOMIC_RELEASE, "agent");
            asm volatile("s_waitcnt vmcnt(0)" ::: "memory");
            const unsigned og = xb_add(&bar[XB_TOP], 1u);
            const unsigned tg = og / nx;
            if (og + 1u == (tg + 1u) * nx) xb_add(&bar[XB_TOPGEN], 1u);
            else XB_SPIN(xb_ld(&bar[XB_TOPGEN]) == tg, bar);
            __builtin_amdgcn_fence(__ATOMIC_ACQUIRE, "agent");
            xb_add(&bar[XB_XGEN(b.x)], 1u);
            asm volatile("s_waitcnt vmcnt(0)" ::: "memory");
        } else {
            XB_SPIN(xb_ld(&bar[XB_XGEN(b.x)]) == gen, bar);
            __builtin_amdgcn_fence(__ATOMIC_ACQUIRE, "agent");
            asm volatile("s_waitcnt vmcnt(0)" ::: "memory");
        }
    }
    __syncthreads();
}

__device__ __forceinline__ void load_prefix(const Params& p, int l, LAS int* pre, LAS int* cntl) {
    const int* gcnt = (const int*)(p.ws + WS_CTL) + l * 32;
    if (threadIdx.x == 0) { int a = 0; for (int e = 0; e < NEXP; ++e) { const int c = gcnt[e]; cntl[e] = c; pre[e] = a; a += (c + 255) >> 8; } pre[NEXP] = a; }
    __syncthreads();
}

__global__ void __launch_bounds__(NTHREADS, 2) fwd_kernel(Params p) {
    extern __shared__ __attribute__((aligned(16))) unsigned char lds_raw[];
    LAS unsigned char* lds = (LAS unsigned char*)lds_raw;
    const int G = gridDim.x;
    unsigned char* ws = p.ws;
    volatile LAS unsigned* bst = (volatile LAS unsigned*)(lds + LDS_BYTES - 16);
    if (threadIdx.x < 2) bst[threadIdx.x] = 0u;
    __syncthreads();
    const XcdBarrier bar = xcd_barrier_post((unsigned*)(ws + WS_CTL) + 4096, bst);
    const int lo = p.ph_lo, hi = p.ph_hi;
#define IN(k) (lo <= (k) && (k) < hi)
#define SYNC_AFTER(k) do { if (IN(k) && IN((k) + 1)) xcd_barrier(bar); } while (0)
    if (IN(0)) phase_prologue(p, lds);
    SYNC_AFTER(0);
#pragma unroll 1
    for (int l = 0; l < DEPTH; ++l) {
        const int k0 = 1 + 7 * l;
        if (IN(k0 + 0)) phase_norm1(p, l);
        SYNC_AFTER(k0 + 0);
        if (IN(k0 + 1)) {
            {
                DenseGemm g{(const bf16_t*)(ws + WS_BUF), (const bf16_t*)(ws + WS_WIN) + (size_t)l * 2048 * 1024, 1024};
                pg8::StaticOrder S; S.init(NTOK, 1536, G, (int)blockIdx.x);
                EpiIn E{(bf16_t*)(ws + WS_U), (bf16_t*)(ws + WS_Q), (bf16_t*)(ws + WS_K), p.in[9] + l * 64, p.in[10] + l * 64};
                pg8::gemm_phase(lds, g, S, E);
            }
            {
                DenseGemm g{(const bf16_t*)(ws + WS_WIN) + (size_t)l * 2048 * 1024 + (size_t)1536 * 1024, (const bf16_t*)(ws + WS_BUF), 1024};
                pg8::StaticOrder S; S.init(512, NTOK, G, (int)blockIdx.x);
                EpiVt E{(bf16_t*)(ws + WS_V)};
                pg8::gemm_phase(lds, g, S, E);
            }
        }
        SYNC_AFTER(k0 + 1);
        if (IN(k0 + 2)) phase_mixer(p, l, lds);
        SYNC_AFTER(k0 + 2);
        if (IN(k0 + 3)) {
            DenseGemm8 g{ws + WS_BUF, ws + WS_WOUT + (size_t)l * 1024 * 1024, 1024};
            pg8::StaticOrder S; S.init(NTOK, 1024, G, (int)blockIdx.x);
            const float* g1p = (const float*)(ws + WS_MOD) + (size_t)(l * 4) * 6144 + 2048;
            if (l == 0) { EpiOutB<true> E{p.in[0], (bf16_t*)(ws + WS_XB), g1p, (float*)(ws + WS_SSQ)}; pg8::gemm_phase(lds, g, S, E); }
            else { EpiOutB<false> E{nullptr, (bf16_t*)(ws + WS_XB), g1p, (float*)(ws + WS_SSQ)}; pg8::gemm_phase(lds, g, S, E); }
        }
        SYNC_AFTER(k0 + 3);
        if (IN(k0 + 4)) phase_route(p, l, lds);
        SYNC_AFTER(k0 + 4);
        if (IN(k0 + 5)) {
            const int vcu = (G % 8 == 0) ? ((int)blockIdx.x % 8) * (G / 8) + (int)blockIdx.x / 8 : (int)blockIdx.x;
            LAS int* pre = (LAS int*)(lds + pg8::STAGE_BYTES); LAS int* cntl = pre + 64;
            load_prefix(p, l, pre, cntl);
            GatherGemm g{ws + WS_BUF, ws + WS_WGU + (size_t)l * NEXP * 1024 * 1024, (const u32x2*)(ws + WS_LIST2), 1024, 1, (size_t)1024 * 1024};
            pg8::GroupedOrder S{pre, cntl, G, vcu};
            EpiGU E{ws + WS_ACT};
            const int total_units = pre[NEXP] * 4;
            pg8::gemm_phase(lds, g, S, E);
            if (l == 0) tail_convert(p, lds, total_units, vcu, 0, 7424);
        }
        SYNC_AFTER(k0 + 5);
        if (IN(k0 + 6)) {
            const int vcu = (G % 8 == 0) ? ((int)blockIdx.x % 8) * (G / 8) + (int)blockIdx.x / 8 : (int)blockIdx.x;
            LAS int* pre = (LAS int*)(lds + pg8::STAGE_BYTES); LAS int* cntl = pre + 64;
            load_prefix(p, l, pre, cntl);
            GatherGemm g{ws + WS_ACT, ws + WS_WD + (size_t)l * NEXP * 1024 * 512, (const u32x2*)(ws + WS_LIST2), 512, 0, (size_t)1024 * 512};
            pg8::GroupedOrder S{pre, cntl, G, vcu};
            EpiDn E{(unsigned char*)(ws + WS_Y)};
            const int total_units = pre[NEXP] * 4;
            pg8::gemm_phase(lds, g, S, E);
            if (l == 0) tail_convert(p, lds, total_units, vcu, 7424, T_NB - 7424);
        }
        SYNC_AFTER(k0 + 6);
    }
    if (IN(15)) phase_final(p);
#undef IN
#undef SYNC_AFTER
}

extern "C" void kernel_launch(void* const* d_in, const int* in_sizes, int n_in, void* d_out, int out_size, void* d_ws, size_t ws_size, hipStream_t stream) {
    static int grid = 0;
    if (grid == 0) {
        if (n_in != 20 || out_size != NTOK * DM || ws_size < WS_END) { fprintf(stderr, "kernel_launch: unexpected shapes (n_in %d out %d ws %zu)\n", n_in, out_size, ws_size); grid = -1; return; }
        int dev = 0, cus = 0, per_cu = 0;
        hipGetDevice(&dev);
        hipDeviceGetAttribute(&cus, hipDeviceAttributeMultiprocessorCount, dev);
        hipFuncSetAttribute((const void*)fwd_kernel, hipFuncAttributeMaxDynamicSharedMemorySize, LDS_BYTES);
        hipOccupancyMaxActiveBlocksPerMultiprocessor(&per_cu, (const void*)fwd_kernel, NTHREADS, LDS_BYTES);
        if (per_cu < 1) per_cu = 1;
        if (per_cu > 1) per_cu = 1;
        grid = cus * per_cu;
        (void)hipGetLastError();
    }
    if (grid < 0) return;
    if (hipMemsetAsync((char*)d_ws + WS_CTL, 0, 65536, stream) != hipSuccess) { fprintf(stderr, "memset failed\n"); return; }
    Params p{};
    for (int i = 0; i < 20; ++i) p.in[i] = (const float*)d_in[i];
    p.out = (float*)d_out; p.ws = (unsigned char*)d_ws; p.ph_lo = 0; p.ph_hi = 16;
    void* args[] = {&p};
    hipError_t e = hipLaunchCooperativeKernel((const void*)fwd_kernel, dim3(grid), dim3(NTHREADS), args, LDS_BYTES, stream);
    if (e != hipSuccess) fprintf(stderr, "cooperative launch failed: %s (grid %d)\n", hipGetErrorString(e), grid);
}
```

```cpp
#include <hip/hip_runtime.h>
#include <hip/hip_cooperative_groups.h>
#include <cstdio>
#include <cstdint>
namespace cg = cooperative_groups;

#define LAS __attribute__((address_space(3)))
typedef unsigned short bf16_t;
typedef short bf16x8 __attribute__((ext_vector_type(8)));
typedef float f32x4 __attribute__((ext_vector_type(4)));
typedef float f32x16 __attribute__((ext_vector_type(16)));
typedef unsigned u32x4 __attribute__((ext_vector_type(4)));
typedef int i32x4 __attribute__((ext_vector_type(4)));
typedef int i32x8 __attribute__((ext_vector_type(8)));
typedef unsigned u32x2 __attribute__((ext_vector_type(2)));
typedef float f32x2_t __attribute__((ext_vector_type(2)));
typedef __bf16 bf16x2_t __attribute__((ext_vector_type(2)));

constexpr int BATCH = 4, SEQ = 8192, DM = 1024, NTOK = BATCH * SEQ, DEPTH = 2;
constexpr int NHEAD = 8, HD = 64, NEXP = 32, DEXP = 512;
constexpr float EPS = 1e-6f;
constexpr float LOG2E = 1.4426950408889634f;

constexpr size_t MiB = 1u << 20;
constexpr size_t WS_CTL = 0;
constexpr size_t WS_MOD = 1 * MiB;
constexpr size_t WS_TBL = 1 * MiB + 512 * 1024;
constexpr size_t WS_RW = 2 * MiB;
constexpr size_t WS_RWB = 2 * MiB + 512 * 1024;
constexpr size_t WS_LIST = 3 * MiB;
constexpr size_t WS_EW = 7 * MiB;
constexpr size_t WS_WIN = 8 * MiB;
constexpr size_t WS_WOUT = 16 * MiB;
constexpr size_t WS_WGU = 20 * MiB;
constexpr size_t WS_WD = 148 * MiB;
constexpr size_t WS_BUF = 212 * MiB;
constexpr size_t WS_U = 276 * MiB;
constexpr size_t WS_Q = 308 * MiB;
constexpr size_t WS_K = 340 * MiB;
constexpr size_t WS_V = 372 * MiB;
constexpr size_t WS_Y = 276 * MiB;
constexpr size_t WS_ACT = 404 * MiB;
constexpr size_t WS_SSQ = 468 * MiB;
constexpr size_t WS_XB = 470 * MiB;
constexpr size_t WS_LIST2 = 534 * MiB;
constexpr size_t WS_RS = 542 * MiB;
constexpr size_t WS_CS = 543 * MiB;
constexpr size_t WS_END = 544 * MiB;

constexpr int LDS_BYTES = 147456;
constexpr int NWAVES = 8, NTHREADS = 512;

struct Params {
    const float* in[20];
    float* out;
    unsigned char* ws;
    int ph_lo, ph_hi;
};

__device__ __forceinline__ unsigned cvtpk(float lo, float hi) { f32x2_t v = {lo, hi}; bf16x2_t b = __builtin_convertvector(v, bf16x2_t); return __builtin_bit_cast(unsigned, b); }
__device__ __forceinline__ float bf_lo(unsigned w) { return __uint_as_float(w << 16); }
__device__ __forceinline__ float bf_hi(unsigned w) { return __uint_as_float(w & 0xffff0000u); }
__device__ __forceinline__ float fast_exp2(float x) { return __builtin_amdgcn_exp2f(x); }
__device__ __forceinline__ float fast_rcp(float x) { return __builtin_amdgcn_rcpf(x); }

__device__ __forceinline__ float clamp8(float x) { return __builtin_amdgcn_fmed3f(x, -448.0f, 448.0f); }
__device__ __forceinline__ unsigned pk_fp8x4(float a, float b, float c, float d) { int w = 0; w = __builtin_amdgcn_cvt_pk_fp8_f32(a, b, w, false); w = __builtin_amdgcn_cvt_pk_fp8_f32(c, d, w, true); return (unsigned)w; }
__device__ __forceinline__ unsigned pk_i8x4(float a, float b, float c, float d) {
    const unsigned ua = __float_as_uint(a + 12582912.0f), ub = __float_as_uint(b + 12582912.0f), uc = __float_as_uint(c + 12582912.0f), ud = __float_as_uint(d + 12582912.0f);
    return __builtin_amdgcn_perm(__builtin_amdgcn_perm(ud, uc, 0x0c0c0400u), __builtin_amdgcn_perm(ub, ua, 0x0c0c0400u), 0x05040100u);
}
__device__ __forceinline__ f32x4 i2f(const f32x4& a) { return __builtin_convertvector(__builtin_bit_cast(i32x4, a), f32x4); }
__device__ __forceinline__ int opaque_tid() { int t = threadIdx.x; asm volatile("" : "+v"(t)); return t; }
__device__ __forceinline__ int opaque_bid() { int t = blockIdx.x; asm volatile("" : "+s"(t)); return t; }

namespace pg8 {
constexpr int BM = 256, BK = 64, HALF = 128, HTB = HALF * BK * 2, STAGE_BYTES = 8 * HTB, NXCD = 8, WGM = 8;
__host__ __device__ __forceinline__ int lds_byte(int r, int c) { const int st = (r >> 4) * 2 + (c >> 5), rr = r & 15, cc = c & 31, ob = rr * 64 + cc * 2; return st * 1024 + (ob ^ (((ob >> 9) & 1) << 5)); }
__host__ __device__ __forceinline__ void stage_rc(int b, int& R, int& C) { const int st = b / 1024, sb = b % 1024, swz = sb ^ (((sb >> 9) & 1) << 5); R = (st >> 1) * 16 + swz / 64; C = (st & 1) * 32 + (swz % 64) / 2; }
__host__ __device__ __forceinline__ int perm32(int rho) { const int n = rho >> 4, i = rho & 15; return 8 * (i >> 2) + 4 * n + (i & 3); }

struct Unit { int pm, pn, e, rows; };

struct StaticOrder {
    int nM, nN, nwg, G, c;
    __device__ void init(int M, int N, int G_, int c_) { nM = M / BM; nN = N / BM; nwg = nM * nN; G = G_; c = c_; }
    __device__ bool next(int i, Unit& u) const {
        const long L = (long)i * G + c; if (L >= nwg) return false;
        int wgid = (int)L; { const int q = nwg / NXCD, r = nwg % NXCD, xcd = wgid % NXCD, off = wgid / NXCD; wgid = (xcd < r ? xcd * (q + 1) : r * (q + 1) + (xcd - r) * q) + off; }
        const int nig = WGM * nN, gid = wgid / nig, fm = gid * WGM, gsz = (nM - fm) < WGM ? (nM - fm) : WGM;
        u.pm = fm + ((wgid % nig) % gsz); u.pn = (wgid % nig) / gsz; u.e = 0; u.rows = BM; return true;
    }
};

struct GroupedOrder {
    const LAS int* prefix; const LAS int* cnt; int G, v;
    __device__ bool next(int i, Unit& u) const {
        const int L = i * G + v; const int total = prefix[NEXP];
        if (L >= total * 4) return false;
        const int rt = L >> 2; int e = 0;
#pragma unroll 1
        for (int j = 1; j < NEXP; ++j) if (prefix[j] <= rt) e = j;
        u.e = e; u.pm = rt - prefix[e]; u.pn = L & 3; const int rem = cnt[e] - u.pm * BM; u.rows = rem < BM ? rem : BM; return true;
    }
};

template <class G, class Epi, class Sched>
__device__ __forceinline__ void gemm_phase(LAS unsigned char* lds, const G g, const Sched& S, const Epi& E) {
    int tid = threadIdx.x; asm volatile("" : "+v"(tid));
    const int wid = __builtin_amdgcn_readfirstlane(tid >> 6), lane = tid & 63, wr = wid >> 2, wc = wid & 3, fr = lane & 15, fq = lane >> 4;
    const int K = g.K, KB = K * G::ES, nt = KB / (BK * 2);
    int RA[2], CA[2]; unsigned voffB[2];
#pragma unroll
    for (int i = 0; i < 2; ++i) { int R, C; stage_rc(tid * 16 + i * 8192, R, C); const int Rb = Epi::PERM ? ((R & ~31) + perm32(R & 31)) : R;
        RA[i] = R; CA[i] = C; voffB[i] = (unsigned)(Rb * KB + C * 2); }
    const size_t kstep = (size_t)(BK * 2);
    const size_t hstep = (size_t)HALF * KB;
    const unsigned ldsw = (unsigned)wid * 1024u;
    const int aoff = lds_byte(wr * 64 + fr, fq * 8), boff = lds_byte(wc * 32 + fr, fq * 8);
#define PG8_SA(b, h) (((b) * 2 + (h)) * HTB)
#define PG8_SB(b, h) ((4 + (b) * 2 + (h)) * HTB)
#define PG8_STAGE2(bufoff, gbase, o0, o1) do { \
        __builtin_amdgcn_global_load_lds((const unsigned*)((const char*)(gbase) + (o0)), (LAS unsigned*)(lds + (bufoff) + ldsw), 16, 0, 0); \
        __builtin_amdgcn_global_load_lds((const unsigned*)((const char*)(gbase) + (o1)), (LAS unsigned*)(lds + (bufoff) + ldsw + 8192), 16, 0, 0); } while (0)
#define PG8_STAGEB(bufoff, gbase) PG8_STAGE2(bufoff, gbase, voffB[0], voffB[1])
#define PG8_LDA(dst, b, h) do { _Pragma("unroll") for (int m = 0; m < 4; ++m) _Pragma("unroll") for (int k = 0; k < 2; ++k) dst[m][k] = *(const LAS bf16x8*)(lds + PG8_SA(b, h) + aoff + m * 2048 + k * 1024); } while (0)
#define PG8_LDB(dst, b, h) do { _Pragma("unroll") for (int n = 0; n < 2; ++n) _Pragma("unroll") for (int k = 0; k < 2; ++k) dst[n][k] = *(const LAS bf16x8*)(lds + PG8_SB(b, h) + boff + n * 2048 + k * 1024); } while (0)
#define PG8_F8(v0, v1) __builtin_shufflevector(__builtin_bit_cast(i32x4, v0), __builtin_bit_cast(i32x4, v1), 0, 1, 2, 3, 4, 5, 6, 7)
#define PG8_MMA(ai, bj, At, Bt) do { __builtin_amdgcn_s_setprio(1); \
        if (G::MODE == 1) { const i32x8 a0_ = PG8_F8(At[0][0], At[0][1]), a1_ = PG8_F8(At[1][0], At[1][1]), a2_ = PG8_F8(At[2][0], At[2][1]), a3_ = PG8_F8(At[3][0], At[3][1]), b0_ = PG8_F8(Bt[0][0], Bt[0][1]), b1_ = PG8_F8(Bt[1][0], Bt[1][1]); \
            asm volatile("s_nop 1\n\tv_mfma_f32_16x16x128_f8f6f4 %0, %12, %8, %0\n\tv_mfma_f32_16x16x128_f8f6f4 %1, %13, %8, %1\n\tv_mfma_f32_16x16x128_f8f6f4 %2, %12, %9, %2\n\tv_mfma_f32_16x16x128_f8f6f4 %3, %13, %9, %3\n\t" \
                         "v_mfma_f32_16x16x128_f8f6f4 %4, %12, %10, %4\n\tv_mfma_f32_16x16x128_f8f6f4 %5, %13, %10, %5\n\tv_mfma_f32_16x16x128_f8f6f4 %6, %12, %11, %6\n\tv_mfma_f32_16x16x128_f8f6f4 %7, %13, %11, %7" \
                         : "+v"(acc[ai][bj][0][0]), "+v"(acc[ai][bj][0][1]), "+v"(acc[ai][bj][1][0]), "+v"(acc[ai][bj][1][1]), "+v"(acc[ai][bj][2][0]), "+v"(acc[ai][bj][2][1]), "+v"(acc[ai][bj][3][0]), "+v"(acc[ai][bj][3][1]) \
                         : "v"(a0_), "v"(a1_), "v"(a2_), "v"(a3_), "v"(b0_), "v"(b1_)); } \
        else if (G::MODE == 2) { _Pragma("unroll") for (int m = 0; m < 4; ++m) _Pragma("unroll") for (int n = 0; n < 2; ++n) _Pragma("unroll") for (int k = 0; k < 2; ++k) \
            acc[ai][bj][m][n] = __builtin_bit_cast(f32x4, __builtin_amdgcn_mfma_i32_16x16x64_i8(__builtin_bit_cast(i32x4, Bt[n][k]), __builtin_bit_cast(i32x4, At[m][k]), __builtin_bit_cast(i32x4, acc[ai][bj][m][n]), 0, 0, 0)); } \
        else { _Pragma("unroll") for (int m = 0; m < 4; ++m) _Pragma("unroll") for (int n = 0; n < 2; ++n) _Pragma("unroll") for (int k = 0; k < 2; ++k) \
            acc[ai][bj][m][n] = __builtin_amdgcn_mfma_f32_16x16x32_bf16(Bt[n][k], At[m][k], acc[ai][bj][m][n], 0, 0, 0); } __builtin_amdgcn_s_setprio(0); } while (0)
#define PG8_WAIT_V(n) asm volatile("s_waitcnt vmcnt(" #n ")" ::: "memory")
#define PG8_WAIT_L(n) asm volatile("s_waitcnt lgkmcnt(" #n ")" ::: "memory")
#define PG8_BAR __builtin_amdgcn_s_barrier()
#define PG8_SCHED __builtin_amdgcn_sched_barrier(0)
    Unit cur, nxt; int ui = 0;
    if (!S.next(0, cur)) return;
    LAS u32x2* const tab = (LAS u32x2*)(lds + STAGE_BYTES + 1024);
#define PG8_TABLE(u, par) do { if (G::TABLE) { if (wid < 2) __builtin_amdgcn_global_load_lds((const unsigned*)(g.tab_src(u, wid) + lane * 16), (LAS unsigned*)((LAS unsigned char*)tab + (par) * 2048 + wid * 1024), 16, 0, 0); } } while (0)
    PG8_TABLE(cur, 0);
    f32x4 acc[2][2][4][2];
#pragma unroll
    for (int a = 0; a < 2; ++a)
#pragma unroll
        for (int b = 0; b < 2; ++b)
#pragma unroll
            for (int m = 0; m < 4; ++m)
#pragma unroll
                for (int n = 0; n < 2; ++n) acc[a][b][m][n] = (f32x4){0.f, 0.f, 0.f, 0.f};
    bf16x8 At[4][2], B0[2][2], B1[2][2];
    const char* cA = g.a_base(cur); const char* cB = g.b_base(cur);
    unsigned c00 = g.a_off(cur, RA[0], CA[0]), c01 = g.a_off(cur, RA[1], CA[1]), c10 = g.a_off(cur, HALF + RA[0], CA[0]), c11 = g.a_off(cur, HALF + RA[1], CA[1]);
    PG8_STAGEB(PG8_SB(0, 0), cB); PG8_STAGEB(PG8_SB(0, 1), cB + hstep); PG8_STAGE2(PG8_SA(0, 0), cA, c00, c01); PG8_STAGE2(PG8_SA(0, 1), cA, c10, c11);
    if (wr == 1) PG8_BAR;
    PG8_WAIT_V(2); PG8_BAR;
    PG8_STAGEB(PG8_SB(1, 0), cB + kstep); PG8_STAGE2(PG8_SA(1, 0), cA + kstep, c00, c01); PG8_STAGEB(PG8_SB(1, 1), cB + hstep + kstep);
    PG8_WAIT_V(6); PG8_BAR;
    for (;;) {
        const bool has_next = S.next(ui + 1, nxt);
        const char* nA = has_next ? g.a_base(nxt) : cA; const char* nB = has_next ? g.b_base(nxt) : cB;
        unsigned n00 = c00, n01 = c01, n10 = c10, n11 = c11;
        if (G::GATHER && has_next) { n00 = g.a_off(nxt, RA[0], CA[0]); n01 = g.a_off(nxt, RA[1], CA[1]); n10 = g.a_off(nxt, HALF + RA[0], CA[0]); n11 = g.a_off(nxt, HALF + RA[1], CA[1]); }
#pragma unroll 1
        for (int t = 0; t < nt; t += 2) {
            const bool last = (t == nt - 2);
            const char* a1 = cA + (size_t)(t + 1) * kstep;
            const char* a2 = last ? nA : cA + (size_t)(t + 2) * kstep; const char* b2 = last ? nB : cB + (size_t)(t + 2) * kstep;
            const char* a3 = a2 + kstep; const char* b3 = b2 + kstep;
            const unsigned x00 = last ? n00 : c00, x01 = last ? n01 : c01, x10 = last ? n10 : c10, x11 = last ? n11 : c11;
            PG8_LDB(B0, 0, 0); PG8_LDB(B1, 0, 1); PG8_SCHED; PG8_LDA(At, 0, 0); PG8_STAGE2(PG8_SA(1, 1), a1, c10, c11);
            PG8_WAIT_V(8); PG8_WAIT_L(0); PG8_BAR; PG8_MMA(0, 0, At, B0); PG8_MMA(0, 1, At, B1); PG8_BAR; PG8_SCHED;
            PG8_LDA(At, 0, 1); PG8_STAGEB(PG8_SB(0, 0), b2); PG8_STAGEB(PG8_SB(0, 1), b2 + hstep); PG8_STAGE2(PG8_SA(0, 0), a2, x00, x01);
            PG8_WAIT_V(8); PG8_WAIT_L(0); PG8_BAR; PG8_MMA(1, 0, At, B0); PG8_MMA(1, 1, At, B1); PG8_BAR; PG8_SCHED;
            PG8_LDB(B0, 1, 0); PG8_LDB(B1, 1, 1); PG8_SCHED; PG8_LDA(At, 1, 0); PG8_STAGE2(PG8_SA(0, 1), a2, x10, x11);
            PG8_WAIT_V(8); PG8_WAIT_L(0); PG8_BAR; PG8_MMA(0, 0, At, B0); PG8_MMA(0, 1, At, B1); PG8_BAR; PG8_SCHED;
            PG8_LDA(At, 1, 1); PG8_STAGEB(PG8_SB(1, 0), b3); PG8_STAGEB(PG8_SB(1, 1), b3 + hstep); PG8_STAGE2(PG8_SA(1, 0), a3, x00, x01);
            PG8_WAIT_V(8); PG8_WAIT_L(0); PG8_BAR; PG8_MMA(1, 0, At, B0); PG8_MMA(1, 1, At, B1); PG8_BAR; PG8_SCHED;
        }
        if (G::MODE == 1) asm volatile("s_nop 15\n\ts_nop 15" ::: "memory");
        if (wr == 0) PG8_BAR;
        E(acc, cur, wr, wc, fr, fq, tab + (ui & 1) * 256);
        if (!has_next) break;
#pragma unroll
        for (int a = 0; a < 2; ++a)
#pragma unroll
            for (int b = 0; b < 2; ++b)
#pragma unroll
                for (int m = 0; m < 4; ++m)
#pragma unroll
                    for (int n = 0; n < 2; ++n) acc[a][b][m][n] = (f32x4){0.f, 0.f, 0.f, 0.f};
        cur = nxt; cA = nA; cB = nB; c00 = n00; c01 = n01; c10 = n10; c11 = n11; ++ui;
        PG8_TABLE(cur, ui & 1);
        if (wr == 1) PG8_BAR;
    }
    PG8_WAIT_V(0);
    PG8_BAR;
#undef PG8_TABLE
#undef PG8_SA
#undef PG8_SB
#undef PG8_STAGE2
#undef PG8_STAGEB
#undef PG8_LDA
#undef PG8_LDB
#undef PG8_MMA
#undef PG8_F8
#undef PG8_WAIT_V
#undef PG8_WAIT_L
#undef PG8_BAR
#undef PG8_SCHED
}
}
using pg8::Unit;

template <int MODE_>
struct DenseGemmT {
    static constexpr bool GATHER = false, TABLE = MODE_ == 2; static constexpr int MODE = MODE_, ES = MODE_ == 0 ? 2 : 1;
    const void* A; const void* Bt; int K; const float* sA; const float* sB;
    __device__ __forceinline__ const char* tab_src(const Unit& u, int w) const { return (const char*)(w == 0 ? sA + u.pm * 256 : sB + u.pn * 256); }
    __device__ __forceinline__ const char* a_base(const Unit& u) const { return (const char*)A + (size_t)u.pm * 256 * K * ES; }
    __device__ __forceinline__ const char* b_base(const Unit& u) const { return (const char*)Bt + (size_t)u.pn * 256 * K * ES; }
    __device__ __forceinline__ unsigned a_off(const Unit&, int r, int c) const { return (unsigned)(r * K * ES + c * 2); }
};
typedef DenseGemmT<0> DenseGemm;
typedef DenseGemmT<2> DenseGemmI8;
struct GatherGemm {
    static constexpr bool GATHER = true, TABLE = true; static constexpr int MODE = 1, ES = 1;
    const unsigned char* A; const unsigned char* Bt; const u32x2* list; int K; int a_shift;
    size_t b_expert_stride;
    __device__ __forceinline__ const char* tab_src(const Unit& u, int w) const { return (const char*)(list + (size_t)u.e * NTOK + u.pm * 256) + w * 1024; }
    __device__ __forceinline__ const char* a_base(const Unit&) const { return (const char*)A; }
    __device__ __forceinline__ const char* b_base(const Unit& u) const { return (const char*)Bt + (size_t)u.e * b_expert_stride + (size_t)u.pn * 256 * K; }
    __device__ __forceinline__ unsigned a_off(const Unit& u, int r, int c) const {
        const int rr = r < u.rows ? r : u.rows - 1;
        const int slot = (int)list[(size_t)u.e * NTOK + u.pm * 256 + rr].x;
        return (unsigned)((slot >> a_shift) * K + c * 2);
    }
};


struct EpiIn {
    static constexpr bool PERM = true;
    bf16_t* U; bf16_t* Qf; bf16_t* Kf; const float* qg; const float* kg;
    __device__ __forceinline__ void operator()(const f32x4 (&acc)[2][2][4][2], const Unit& u, int wr, int wc, int fr, int fq, const LAS u32x2* tab) const {
        const LAS float* tf = (const LAS float*)tab;
        const int cix = 256 + wc * 32 + fq * 8;
        if (u.pn < 2) {
#pragma unroll
            for (int ai = 0; ai < 2; ++ai)
#pragma unroll
                for (int m = 0; m < 4; ++m) {
                    int z = 0; asm volatile("" : "+v"(z));
                    const int r = ai * 128 + wr * 64 + m * 16 + fr;
                    const float rr = tf[r + z];
                    const int row = u.pm * 256 + r;
#pragma unroll
                    for (int bj = 0; bj < 2; ++bj) {
                        const f32x4 c0 = *(const LAS f32x4*)(tf + cix + bj * 128 + z), c1 = *(const LAS f32x4*)(tf + cix + bj * 128 + 4 + z);
                        const f32x4 v0 = i2f(acc[ai][bj][m][0]) * c0 * rr, v1 = i2f(acc[ai][bj][m][1]) * c1 * rr;
                        u32x4 w; w.x = cvtpk(v0[0], v0[1]); w.y = cvtpk(v0[2], v0[3]); w.z = cvtpk(v1[0], v1[1]); w.w = cvtpk(v1[2], v1[3]);
                        *(u32x4*)(U + (size_t)row * 512 + u.pn * 256 + bj * 128 + wc * 32 + fq * 8) = w;
                    }
                }
        } else {
            const bool isq = u.pn < 4;
            const float* gg = isq ? qg : kg; bf16_t* dst = isq ? Qf : Kf;
            const float osc = isq ? 0.125f * LOG2E : 1.0f;
            const int head = (u.pn & 1) * 4 + wc;
            f32x4 gv[2][2];
#pragma unroll
            for (int bj = 0; bj < 2; ++bj)
#pragma unroll
                for (int n = 0; n < 2; ++n) gv[bj][n] = *(const f32x4*)(gg + bj * 32 + fq * 8 + n * 4) * osc;
#pragma unroll
            for (int ai = 0; ai < 2; ++ai)
#pragma unroll
                for (int m = 0; m < 4; ++m) {
                    int z = 0; asm volatile("" : "+v"(z));
                    const int r = ai * 128 + wr * 64 + m * 16 + fr;
                    const float rr = tf[r + z];
                    f32x4 val[2][2];
                    float ss = 0.f;
#pragma unroll
                    for (int bj = 0; bj < 2; ++bj)
#pragma unroll
                        for (int n = 0; n < 2; ++n) { const f32x4 v = i2f(acc[ai][bj][m][n]) * *(const LAS f32x4*)(tf + cix + bj * 128 + n * 4 + z); val[bj][n] = v; ss += (v[0] * v[0] + v[1] * v[1]) + (v[2] * v[2] + v[3] * v[3]); }
                    ss += __shfl_xor(ss, 16); ss += __shfl_xor(ss, 32);
                    const float rstd = rsqrtf(ss * (rr * rr) * (1.0f / 64.0f) + EPS) * rr;
                    const int row = u.pm * 256 + r;
                    const int b = row >> 13, s = row & (SEQ - 1), rb = s >> 5, r32 = s & 31;
#pragma unroll
                    for (int bj = 0; bj < 2; ++bj) {
                        const f32x4 v0 = val[bj][0] * rstd * gv[bj][0], v1 = val[bj][1] * rstd * gv[bj][1];
                        u32x4 w; w.x = cvtpk(v0[0], v0[1]); w.y = cvtpk(v0[2], v0[3]); w.z = cvtpk(v1[0], v1[1]); w.w = cvtpk(v1[2], v1[3]);
                        const int d0 = 2 * bj + (fq >> 1), hi = fq & 1;
                        const size_t piece = (((size_t)(b * NHEAD + head) * 256 + rb) * 4 + d0);
                        *(u32x4*)(dst + (piece * 64 + hi * 32 + r32) * 8) = w;
                    }
                }
        }
    }
};

struct EpiVt {
    static constexpr bool PERM = true;
    bf16_t* Vf;
    __device__ __forceinline__ void operator()(const f32x4 (&acc)[2][2][4][2], const Unit& u, int wr, int wc, int fr, int fq, const LAS u32x2* tab) const {
        const LAS float* tf = (const LAS float*)tab;
        f32x4 rv[2][2];
#pragma unroll
        for (int bj = 0; bj < 2; ++bj)
#pragma unroll
            for (int n = 0; n < 2; ++n) rv[bj][n] = *(const LAS f32x4*)(tf + 256 + bj * 128 + wc * 32 + fq * 8 + n * 4);
#pragma unroll
        for (int ai = 0; ai < 2; ++ai)
#pragma unroll
            for (int m = 0; m < 4; ++m) {
                const int r = ai * 128 + wr * 64 + m * 16 + fr;
                const float cc = tf[r];
                const int hd = u.pm * 256 + r;
                const int head = hd >> 6, dblk = (hd >> 5) & 1, dl = hd & 31;
#pragma unroll
                for (int bj = 0; bj < 2; ++bj) {
                    const int tok0 = u.pn * 256 + bj * 128 + wc * 32;
                    const int b = tok0 >> 13, kb = (tok0 & (SEQ - 1)) >> 5;
                    const size_t piece = ((((size_t)(b * NHEAD + head) * 256 + kb) * 2 + (fq >> 1)) * 2 + dblk);
#pragma unroll
                    for (int n = 0; n < 2; ++n) {
                        const f32x4 v = i2f(acc[ai][bj][m][n]) * rv[bj][n] * cc;
                        u32x2 w; w.x = cvtpk(v[0], v[1]); w.y = cvtpk(v[2], v[3]);
                        *(u32x2*)((char*)Vf + (piece * 64 + n * 32 + dl) * 16 + (fq & 1) * 8) = w;
                    }
                }
            }
    }
};

template <bool XF>
struct EpiOutB {
    static constexpr bool PERM = true;
    const float* xf; bf16_t* XB; const float* g1; float* ssq;
    __device__ __forceinline__ void operator()(const f32x4 (&acc)[2][2][4][2], const Unit& u, int wr, int wc, int fr, int fq, const LAS u32x2* tab) const {
        const int b = (u.pm * 256) >> 13;
        const int col0 = u.pn * 256 + wc * 32 + 8 * fq;
        f32x4 gv[2][2];
#pragma unroll
        for (int bj = 0; bj < 2; ++bj)
#pragma unroll
            for (int n = 0; n < 2; ++n) gv[bj][n] = *(const f32x4*)(g1 + (size_t)b * 6144 + col0 + bj * 128 + n * 4);
#pragma unroll
        for (int ai = 0; ai < 2; ++ai)
#pragma unroll
            for (int m = 0; m < 4; ++m) {
                const int row = u.pm * 256 + ai * 128 + wr * 64 + m * 16 + fr;
                const size_t off = (size_t)row * DM + col0;
                f32x4 xb[2][2];
                if (XF) {
#pragma unroll
                    for (int bj = 0; bj < 2; ++bj) { xb[bj][0] = *(const f32x4*)(xf + off + bj * 128); xb[bj][1] = *(const f32x4*)(xf + off + bj * 128 + 4); }
                } else {
#pragma unroll
                    for (int bj = 0; bj < 2; ++bj) { const u32x4 w = *(const u32x4*)(XB + off + bj * 128);
                        xb[bj][0] = (f32x4){bf_lo(w.x), bf_hi(w.x), bf_lo(w.y), bf_hi(w.y)}; xb[bj][1] = (f32x4){bf_lo(w.z), bf_hi(w.z), bf_lo(w.w), bf_hi(w.w)}; }
                }
                float ss = 0.f;
#pragma unroll
                for (int bj = 0; bj < 2; ++bj) {
                    const f32x4 x0 = xb[bj][0] + gv[bj][0] * acc[ai][bj][m][0], x1 = xb[bj][1] + gv[bj][1] * acc[ai][bj][m][1];
                    u32x4 w; w.x = cvtpk(x0[0], x0[1]); w.y = cvtpk(x0[2], x0[3]); w.z = cvtpk(x1[0], x1[1]); w.w = cvtpk(x1[2], x1[3]);
                    *(u32x4*)(XB + off + bj * 128) = w;
                    const float r0 = bf_lo(w.x), r1 = bf_hi(w.x), r2 = bf_lo(w.y), r3 = bf_hi(w.y), r4 = bf_lo(w.z), r5 = bf_hi(w.z), r6 = bf_lo(w.w), r7 = bf_hi(w.w);
                    ss += ((r0 * r0 + r1 * r1) + (r2 * r2 + r3 * r3)) + ((r4 * r4 + r5 * r5) + (r6 * r6 + r7 * r7));
                }
                ss += __shfl_xor(ss, 16); ss += __shfl_xor(ss, 32);
                if (fq == 0) ssq[(size_t)row * 16 + u.pn * 4 + wc] = ss;
            }
    }
};

struct EpiGU {
    static constexpr bool PERM = true;
    unsigned char* ACT;
    __device__ __forceinline__ void operator()(const f32x4 (&acc)[2][2][4][2], const Unit& u, int wr, int wc, int fr, int fq, const LAS u32x2* tab) const {
        constexpr float SI = 1.0f / 2048.0f;
#pragma unroll
        for (int ai = 0; ai < 2; ++ai)
#pragma unroll
            for (int m = 0; m < 4; ++m) {
                const int r = ai * 128 + wr * 64 + m * 16 + fr;
                const int slot = (int)tab[r].x;
                float o[8];
#pragma unroll
                for (int n = 0; n < 2; ++n)
#pragma unroll
                    for (int e = 0; e < 4; ++e) { const float gte = acc[ai][0][m][n][e] * SI, up = acc[ai][1][m][n][e] * (4.0f * SI);
                        o[n * 4 + e] = clamp8(gte * fast_rcp(1.0f + fast_exp2(-gte * LOG2E)) * up); }
                u32x2 w; w.x = pk_fp8x4(o[0], o[1], o[2], o[3]); w.y = pk_fp8x4(o[4], o[5], o[6], o[7]);
                if (r < u.rows) *(u32x2*)(ACT + (size_t)slot * DEXP + u.pn * 128 + wc * 32 + fq * 8) = w;
            }
    }
};

struct EpiDn {
    static constexpr bool PERM = true;
    unsigned char* Y8;
    __device__ __forceinline__ void operator()(const f32x4 (&acc)[2][2][4][2], const Unit& u, int wr, int wc, int fr, int fq, const LAS u32x2* tab) const {
#pragma unroll
        for (int ai = 0; ai < 2; ++ai)
#pragma unroll
            for (int m = 0; m < 4; ++m) {
                const int r = ai * 128 + wr * 64 + m * 16 + fr;
                const u32x2 en = tab[r];
                const int slot = (int)en.x;
                const float w8 = __uint_as_float(en.y) * (16.0f / 1024.0f);
                if (r < u.rows) {
#pragma unroll
                    for (int bj = 0; bj < 2; ++bj) {
                        const f32x4 v0 = acc[ai][bj][m][0] * w8, v1 = acc[ai][bj][m][1] * w8;
                        int lo = 0, hi = 0;
                        lo = __builtin_amdgcn_cvt_pk_fp8_f32(v0[0], v0[1], lo, false); lo = __builtin_amdgcn_cvt_pk_fp8_f32(v0[2], v0[3], lo, true);
                        hi = __builtin_amdgcn_cvt_pk_fp8_f32(v1[0], v1[1], hi, false); hi = __builtin_amdgcn_cvt_pk_fp8_f32(v1[2], v1[3], hi, true);
                        u32x2 w; w.x = (unsigned)lo; w.y = (unsigned)hi;
                        *(u32x2*)(Y8 + (size_t)slot * DM + u.pn * 256 + bj * 128 + wc * 32 + fq * 8) = w;
                    }
                }
            }
    }
};

struct TItem { const float* src; unsigned char* dst; int N, dstK, koff, k0, n0, map, f8; };
__device__ __forceinline__ int t_rowmap(int map, int n) {
    if (map == 0) return n;
    if (map == 1) { if (n < 512 || n >= 1536) return n; const int t = n & 255, wc = t >> 6, bj = (t >> 5) & 1, c = t & 31; return (n & ~255) + 128 * bj + 32 * wc + c; }
    return 256 * (n >> 7) + 128 * (map - 2) + (n & 127);
}
__device__ __forceinline__ void t_load(const TItem& d, f32x4 (&v)[16], int lane) {
    const int kr = lane >> 4, c4 = lane & 15;
#pragma unroll
    for (int i = 0; i < 16; ++i) v[i] = *(const f32x4*)(d.src + (size_t)(d.k0 + 4 * i + kr) * d.N + d.n0 + 4 * c4);
}
__device__ __forceinline__ void t_process(const TItem& d, const f32x4 (&v)[16], LAS float* scr, int lane) {
    const int kr = lane >> 4, c4 = lane & 15;
#pragma unroll
    for (int i = 0; i < 16; ++i) { LAS float* s = scr + (4 * i + kr) * 65 + 4 * c4; s[0] = v[i][0]; s[1] = v[i][1]; s[2] = v[i][2]; s[3] = v[i][3]; }
    asm volatile("s_waitcnt lgkmcnt(0)" ::: "memory");
    const int nr = lane >> 3, kc = lane & 7;
#pragma unroll
    for (int i = 0; i < 8; ++i) { const int n = 8 * i + nr; const LAS float* s = scr + (8 * kc) * 65 + n;
        const size_t eo = (size_t)t_rowmap(d.map, d.n0 + n) * d.dstK + d.koff + d.k0 + 8 * kc;
        if (d.f8 == 2) { u32x2 o; o.x = pk_i8x4(s[0], s[65], s[2 * 65], s[3 * 65]); o.y = pk_i8x4(s[4 * 65], s[5 * 65], s[6 * 65], s[7 * 65]); *(u32x2*)(d.dst + eo) = o; }
        else if (d.f8) { u32x2 o; o.x = pk_fp8x4(s[0] * 256.0f, s[65] * 256.0f, s[2 * 65] * 256.0f, s[3 * 65] * 256.0f); o.y = pk_fp8x4(s[4 * 65] * 256.0f, s[5 * 65] * 256.0f, s[6 * 65] * 256.0f, s[7 * 65] * 256.0f);
            *(u32x2*)(d.dst + eo) = o; }
        else { u32x4 o; o.x = cvtpk(s[0], s[65]); o.y = cvtpk(s[2 * 65], s[3 * 65]); o.z = cvtpk(s[4 * 65], s[5 * 65]); o.w = cvtpk(s[6 * 65], s[7 * 65]);
            *(u32x4*)(d.dst + eo * 2) = o; } }
    asm volatile("s_waitcnt lgkmcnt(0)" ::: "memory");
}
constexpr int T_IN = 0, T_OUT = 128, T_E = 128, T_MOE = NEXP * 3 * T_E, T_PER_LAYER = T_IN + T_OUT + T_MOE;
constexpr int T_NA = T_PER_LAYER + T_IN + T_OUT, T_NB = T_MOE;
__device__ __forceinline__ void t_decode_lr(const Params& p, int l, int r, TItem& d) {
    unsigned char* ws = p.ws;
    if (r < T_IN) { d.src = p.in[6] + (size_t)l * 1024 * 2048; d.N = 2048; d.f8 = 0; d.dst = ws + WS_WIN + (size_t)l * 2048 * 1024 * 2; d.dstK = 1024; d.koff = 0; d.k0 = (r >> 5) * 64; d.n0 = (r & 31) * 64; d.map = 1; return; }
    r -= T_IN;
    if (r < T_OUT) { d.src = p.in[12] + ((size_t)l * 1024 + 512) * 1024; d.N = 1024; d.f8 = 0; d.dst = ws + WS_WOUT + (size_t)l * 1024 * 1024 * 2; d.dstK = 1024; d.koff = 512; d.k0 = (r >> 4) * 64; d.n0 = (r & 15) * 64; d.map = 0; return; }
    r -= T_OUT;
    const int e = r / (3 * T_E); int q = r % (3 * T_E);
    if (q < 2 * T_E) { const int up = q >= T_E; if (up) q -= T_E;
        d.src = p.in[up ? 18 : 17] + ((size_t)l * NEXP + e) * 1024 * 512; d.N = 512; d.f8 = 1; d.dst = ws + WS_WGU + ((size_t)l * NEXP + e) * 1024 * 1024; d.dstK = 1024; d.koff = 0; d.k0 = (q >> 3) * 64; d.n0 = (q & 7) * 64; d.map = 2 + up; return; }
    q -= 2 * T_E;
    d.src = p.in[19] + ((size_t)l * NEXP + e) * 512 * 1024; d.N = 1024; d.f8 = 1; d.dst = ws + WS_WD + ((size_t)l * NEXP + e) * 1024 * 512; d.dstK = 512; d.koff = 0; d.k0 = (q >> 4) * 64; d.n0 = (q & 15) * 64; d.map = 0;
}
template <bool SPACE_B>
__device__ __forceinline__ void t_decode(const Params& p, int it, TItem& d) {
    if (SPACE_B) t_decode_lr(p, 1, T_IN + T_OUT + it, d);
    else if (it < T_PER_LAYER) t_decode_lr(p, 0, it, d);
    else t_decode_lr(p, 1, it - T_PER_LAYER, d);
}
template <bool SPACE_B>
__device__ __forceinline__ void t_run(const Params& p, int it, int stride, int nit, LAS float* scr, int lane) {
    if (it >= nit) return;
    TItem dA, dB; f32x4 vA[16], vB[16];
    t_decode<SPACE_B>(p, it, dA); t_load(dA, vA, lane);
    for (;;) {
        int nx = it + stride; const bool hasB = nx < nit;
        if (hasB) { t_decode<SPACE_B>(p, nx, dB); t_load(dB, vB, lane); }
        t_process(dA, vA, scr, lane);
        if (!hasB) break;
        it = nx + stride; const bool hasA = it < nit;
        if (hasA) { t_decode<SPACE_B>(p, it, dA); t_load(dA, vA, lane); }
        t_process(dB, vB, scr, lane);
        if (!hasA) break;
    }
}
__device__ __forceinline__ void tail_convert(const Params& p, LAS unsigned char* lds, int total_units, int v, int first, int count) {
    const int tid = opaque_tid(), lane = tid & 63, wave = tid >> 6, G = gridDim.x;
    const int rem = total_units % G;
    const int nshare = rem ? G - rem : G, sidx = rem ? v - rem : v;
    __syncthreads();
    if (sidx >= 0) t_run<true>(p, first + sidx + nshare * wave, nshare * NWAVES, first + count, (LAS float*)(lds + wave * 16640), lane);
    __syncthreads();
}

__device__ __forceinline__ void phase_prologue(const Params& p, LAS unsigned char* lds) {
    const int tid = opaque_tid(), lane = tid & 63, wave = tid >> 6, G = gridDim.x;
    unsigned char* ws = p.ws;
    {
        LAS float* cact = (LAS float*)lds;
        LAS float* red = (LAS float*)(lds + 16384);
        const float* c = p.in[1];
        for (int i = tid; i < 4096; i += NTHREADS) { const float v = c[i]; cact[i] = v / (1.0f + __expf(-v)); }
        __syncthreads();
        float* mod = (float*)(ws + WS_MOD);
        for (int item = blockIdx.x; item < 2 * 192; item += G) {
            const int l = item / 192, cgp = item % 192;
            const float* W = p.in[2] + (size_t)l * 1024 * 6144 + cgp * 32;
            const int col = lane & 31, rsub = lane >> 5;
            float a0 = 0.f, a1 = 0.f, a2 = 0.f, a3 = 0.f;
#pragma unroll 16
            for (int i = 0; i < 64; ++i) { const int k = wave * 128 + 2 * i + rsub; const float w = W[(size_t)k * 6144 + col];
                a0 += cact[k] * w; a1 += cact[1024 + k] * w; a2 += cact[2048 + k] * w; a3 += cact[3072 + k] * w; }
            a0 += __shfl_xor(a0, 32); a1 += __shfl_xor(a1, 32); a2 += __shfl_xor(a2, 32); a3 += __shfl_xor(a3, 32);
            if (lane < 32) { red[(wave * 4 + 0) * 32 + col] = a0; red[(wave * 4 + 1) * 32 + col] = a1; red[(wave * 4 + 2) * 32 + col] = a2; red[(wave * 4 + 3) * 32 + col] = a3; }
            __syncthreads();
            if (tid < 128) { const int b = tid >> 5, cc = tid & 31; float s = 0.f;
#pragma unroll
                for (int w = 0; w < 8; ++w) s += red[(w * 4 + b) * 32 + cc];
                mod[(size_t)(l * 4 + b) * 6144 + cgp * 32 + cc] = s + p.in[3][l * 6144 + cgp * 32 + cc]; }
            __syncthreads();
        }
    }
    {
        float* tbl = (float*)(ws + WS_TBL);
        for (int job = blockIdx.x; job < 2; job += G) {
            const int l = job;
            LAS float* sm = (LAS float*)(lds + 32768);
            float mq = 0.f, mk = 0.f, mb = 0.f;
            if (tid < 64) { mq = fabsf(p.in[9][l * 64 + tid]); mk = fabsf(p.in[10][l * 64 + tid]); }
            for (int i = tid; i < NHEAD * 257; i += NTHREADS) mb = fmaxf(mb, fabsf(p.in[11][i]));
#pragma unroll
            for (int o = 1; o < 64; o <<= 1) { mq = fmaxf(mq, __shfl_xor(mq, o)); mk = fmaxf(mk, __shfl_xor(mk, o)); mb = fmaxf(mb, __shfl_xor(mb, o)); }
            if (lane == 0) { sm[wave * 4 + 0] = mq; sm[wave * 4 + 1] = mk; sm[wave * 4 + 2] = mb; }
            __syncthreads();
            mq = 0.f; mk = 0.f; mb = 0.f;
            for (int w = 0; w < 8; ++w) { mq = fmaxf(mq, sm[w * 4 + 0]); mk = fmaxf(mk, sm[w * 4 + 1]); mb = fmaxf(mb, sm[w * 4 + 2]); }
            const float shift = LOG2E * (8.0f * mq * mk + mb);
            for (int i = tid; i < NHEAD * 256; i += NTHREADS) { const int h = i >> 8, j = i & 255; int rel = j - 63; if (rel > 128) rel = 128;
                tbl[(size_t)l * 2048 + i] = (j < 255) ? p.in[11][h * 257 + rel + 128] * LOG2E - shift : 0.f; }
            __syncthreads();
        }
        for (int job = blockIdx.x; job < 2 * 48; job += G) {
            const int l = job / 48, n = job % 48;
            bf16_t* hi = (bf16_t*)(ws + WS_RW) + (size_t)l * 2 * 48 * 1024;
            bf16_t* lo = hi + 48 * 1024;
            for (int k = tid; k < 1024; k += NTHREADS) {
                float w = 0.f;
                if (n < 32) w = p.in[15][((size_t)l * 1024 + k) * 32 + n]; else if (n < 36) w = p.in[13][((size_t)l * 1024 + k) * 4 + (n - 32)];
                const unsigned h2 = cvtpk(w, 0.f) & 0xffffu; const float r = w - bf_lo(h2);
                const size_t idx = ((size_t)((k >> 5) * 3 + (n >> 4)) * 64 + ((k & 31) >> 3) * 16 + (n & 15)) * 8 + (k & 7);
                hi[idx] = (bf16_t)h2; lo[idx] = (bf16_t)(cvtpk(r, 0.f) & 0xffffu);
            }
            if (tid == 0) { float bsv = 0.f; if (n < 32) bsv = p.in[16][l * 32 + n]; else if (n < 36) bsv = p.in[14][l * 4 + (n - 32)]; ((float*)(ws + WS_RWB))[l * 48 + n] = bsv; }
        }
    }
    __syncthreads();
    {
        LAS float* wsc = (LAS float*)lds;
        LAS float* pwl = (LAS float*)(lds + 32768);
        for (int item = blockIdx.x; item < 2 * 4 * 16; item += G) {
            const int l = item >> 6, g = (item >> 4) & 3, nb = item & 15;
            const float* wo = p.in[12] + ((size_t)l * 1024 + g * 128) * 1024 + nb * 64;
            const float* sc = p.in[8] + l * 512 + g * 128;
            const float* pw = p.in[7] + ((size_t)l * 4 + g) * 128 * 128;
            for (int i = tid; i < 128 * 64; i += NTHREADS) { const int d = i >> 6, n = i & 63; wsc[i] = wo[(size_t)d * 1024 + n] * sc[d]; }
            for (int i = tid; i < 128 * 128 / 4; i += NTHREADS) *(LAS f32x4*)(pwl + 4 * i) = *(const f32x4*)(pw + 4 * i);
            __syncthreads();
            const int n = tid & 63, cgp = tid >> 6;
            float a[16];
#pragma unroll
            for (int j = 0; j < 16; ++j) a[j] = 0.f;
#pragma unroll 2
            for (int d4 = 0; d4 < 32; ++d4) {
                const float w0 = wsc[(4 * d4 + 0) * 64 + n], w1 = wsc[(4 * d4 + 1) * 64 + n], w2 = wsc[(4 * d4 + 2) * 64 + n], w3 = wsc[(4 * d4 + 3) * 64 + n];
#pragma unroll
                for (int j = 0; j < 16; ++j) { const f32x4 pv = *(const LAS f32x4*)(pwl + (cgp * 16 + j) * 128 + 4 * d4); a[j] += (pv[0] * w0 + pv[1] * w1) + (pv[2] * w2 + pv[3] * w3); }
            }
            bf16_t* dst = (bf16_t*)(ws + WS_WOUT) + ((size_t)l * 1024 + nb * 64 + n) * 1024 + g * 128 + cgp * 16;
            u32x4 o0, o1; o0.x = cvtpk(a[0], a[1]); o0.y = cvtpk(a[2], a[3]); o0.z = cvtpk(a[4], a[5]); o0.w = cvtpk(a[6], a[7]);
            o1.x = cvtpk(a[8], a[9]); o1.y = cvtpk(a[10], a[11]); o1.z = cvtpk(a[12], a[13]); o1.w = cvtpk(a[14], a[15]);
            *(u32x4*)dst = o0; *(u32x4*)(dst + 8) = o1;
            __syncthreads();
        }
    }
    {
        LAS float* scr = (LAS float*)(lds + wave * 16640);
        LAS float* wmax = (LAS float*)(lds + 8 * 16640);
        LAS float* winv = wmax + 512;
        for (int item = blockIdx.x; item < 2 * 32; item += G) {
            const int l = item >> 5, n0 = (item & 31) * 64;
            TItem d0, d1;
            d0.src = p.in[6] + (size_t)l * 1024 * 2048; d0.N = 2048; d0.f8 = 2; d0.dst = ws + WS_WIN + (size_t)l * 2048 * 1024; d0.dstK = 1024; d0.koff = 0; d0.k0 = wave * 128; d0.n0 = n0; d0.map = 1;
            d1 = d0; d1.k0 = wave * 128 + 64;
            f32x4 v0[16], v1[16];
            t_load(d0, v0, lane); t_load(d1, v1, lane);
            f32x4 cm = {0.f, 0.f, 0.f, 0.f};
#pragma unroll
            for (int i = 0; i < 16; ++i)
#pragma unroll
                for (int e = 0; e < 4; ++e) cm[e] = fmaxf(cm[e], fmaxf(fabsf(v0[i][e]), fabsf(v1[i][e])));
#pragma unroll
            for (int e = 0; e < 4; ++e) { cm[e] = fmaxf(cm[e], __shfl_xor(cm[e], 16)); cm[e] = fmaxf(cm[e], __shfl_xor(cm[e], 32)); }
            if (lane < 16) *(LAS f32x4*)(wmax + wave * 64 + 4 * lane) = cm;
            __syncthreads();
            if (tid < 64) { float m = 0.f;
#pragma unroll
                for (int w = 0; w < 8; ++w) m = fmaxf(m, wmax[w * 64 + tid]);
                winv[tid] = m > 0.f ? 127.0f / m : 0.f;
                ((float*)(ws + WS_CS))[l * 2048 + t_rowmap(1, n0 + tid)] = m * (1.0f / 127.0f); }
            __syncthreads();
            const f32x4 iv = *(const LAS f32x4*)(winv + 4 * (lane & 15));
#pragma unroll
            for (int i = 0; i < 16; ++i) { v0[i] *= iv; v1[i] *= iv; }
            t_process(d0, v0, scr, lane); t_process(d1, v1, scr, lane);
            __syncthreads();
        }
    }
    {
        LAS float* scr = (LAS float*)(lds + wave * 16640);
        t_run<false>(p, blockIdx.x * NWAVES + wave, G * NWAVES, T_NA, scr, lane);
    }
}

typedef float f32x2v __attribute__((ext_vector_type(2)));
__device__ __forceinline__ f32x4 y_pair_sum(const unsigned char* Y8, size_t row, int c) {
    const int a = *(const int*)(Y8 + (size_t)(2 * row) * DM + c), b = *(const int*)(Y8 + (size_t)(2 * row + 1) * DM + c);
    const f32x2v a0 = __builtin_amdgcn_cvt_pk_f32_fp8(a, false), a1 = __builtin_amdgcn_cvt_pk_f32_fp8(a, true);
    const f32x2v b0 = __builtin_amdgcn_cvt_pk_f32_fp8(b, false), b1 = __builtin_amdgcn_cvt_pk_f32_fp8(b, true);
    f32x4 ys; ys[0] = (a0[0] + b0[0]) * 0.0625f; ys[1] = (a0[1] + b0[1]) * 0.0625f; ys[2] = (a1[0] + b1[0]) * 0.0625f; ys[3] = (a1[1] + b1[1]) * 0.0625f; return ys;
}
template <int NR, bool UPD>
__device__ __forceinline__ void norm1_rows(const Params& p, int l, int row0, int lane) {
    const float* mod = (const float*)(p.ws + WS_MOD);
    const float* gn = p.in[4] + l * 1024;
    unsigned char* H8 = p.ws + WS_BUF;
    const unsigned char* Y = (const unsigned char*)(p.ws + WS_Y);
    bf16_t* XB = (bf16_t*)(p.ws + WS_XB);
    const int b = row0 >> 13;
    f32x4 v[NR][4];
    if (!UPD) {
#pragma unroll
        for (int r = 0; r < NR; ++r)
#pragma unroll
            for (int j = 0; j < 4; ++j) v[r][j] = *(const f32x4*)(p.in[0] + (size_t)(row0 + r) * DM + 4 * lane + 256 * j);
    } else {
        const float* g2 = mod + (size_t)((l - 1) * 4 + b) * 6144 + 5120;
        f32x4 ys[NR][4];
#pragma unroll
        for (int r = 0; r < NR; ++r)
#pragma unroll
            for (int j = 0; j < 4; ++j) { const int c = 4 * lane + 256 * j; const u32x2 xw = *(const u32x2*)(XB + (size_t)(row0 + r) * DM + c);
                v[r][j] = (f32x4){bf_lo(xw.x), bf_hi(xw.x), bf_lo(xw.y), bf_hi(xw.y)}; ys[r][j] = y_pair_sum(Y, row0 + r, c); }
#pragma unroll
        for (int j = 0; j < 4; ++j) { const f32x4 gg = *(const f32x4*)(g2 + 4 * lane + 256 * j);
#pragma unroll
            for (int r = 0; r < NR; ++r) { const f32x4 xn = v[r][j] + gg * ys[r][j]; u32x2 xw; xw.x = cvtpk(xn[0], xn[1]); xw.y = cvtpk(xn[2], xn[3]);
                *(u32x2*)(XB + (size_t)(row0 + r) * DM + 4 * lane + 256 * j) = xw;
                v[r][j] = (f32x4){bf_lo(xw.x), bf_hi(xw.x), bf_lo(xw.y), bf_hi(xw.y)}; } }
    }
    float ss[NR];
#pragma unroll
    for (int r = 0; r < NR; ++r) { ss[r] = 0.f;
#pragma unroll
        for (int j = 0; j < 4; ++j) ss[r] += (v[r][j][0] * v[r][j][0] + v[r][j][1] * v[r][j][1]) + (v[r][j][2] * v[r][j][2] + v[r][j][3] * v[r][j][3]); }
#pragma unroll
    for (int o = 1; o < 64; o <<= 1)
#pragma unroll
        for (int r = 0; r < NR; ++r) ss[r] += __shfl_xor(ss[r], o);
    const float* sh = mod + (size_t)(l * 4 + b) * 6144; const float* sc = sh + 1024;
    float rstd[NR], mx[NR];
#pragma unroll
    for (int r = 0; r < NR; ++r) { rstd[r] = rsqrtf(ss[r] * (1.0f / DM) + EPS); mx[r] = 0.f; }
#pragma unroll
    for (int j = 0; j < 4; ++j) {
        const int c = 4 * lane + 256 * j;
        const f32x4 g = *(const f32x4*)(gn + c), s1 = *(const f32x4*)(sc + c), s0 = *(const f32x4*)(sh + c);
        const f32x4 a = g * (s1 + 1.0f);
#pragma unroll
        for (int r = 0; r < NR; ++r) {
            const f32x4 h = v[r][j] * rstd[r] * a + s0;
            v[r][j] = h;
            mx[r] = fmaxf(mx[r], fmaxf(fmaxf(fabsf(h[0]), fabsf(h[1])), fmaxf(fabsf(h[2]), fabsf(h[3]))));
        }
    }
#pragma unroll
    for (int o = 1; o < 64; o <<= 1)
#pragma unroll
        for (int r = 0; r < NR; ++r) mx[r] = fmaxf(mx[r], __shfl_xor(mx[r], o));
    float* RS = (float*)(p.ws + WS_RS);
#pragma unroll
    for (int r = 0; r < NR; ++r) {
        const float inv = mx[r] > 0.f ? 127.0f / mx[r] : 0.f;
        if (lane == 0) RS[row0 + r] = mx[r] * (1.0f / 127.0f);
#pragma unroll
        for (int j = 0; j < 4; ++j) { const f32x4 q = v[r][j] * inv; *(unsigned*)(H8 + (size_t)(row0 + r) * DM + 4 * lane + 256 * j) = pk_i8x4(q[0], q[1], q[2], q[3]); }
    }
}
__device__ __forceinline__ void phase_norm1(const Params& p, int l) {
    const int tid = opaque_tid(), lane = tid & 63, wave = tid >> 6, G = gridDim.x;
    const int gw = blockIdx.x * NWAVES + wave, NGW = G * NWAVES;
    if (l == 0) { for (int rq = gw; rq < NTOK / 4; rq += NGW) norm1_rows<4, false>(p, l, rq * 4, lane); }
    else { for (int rq = gw; rq < NTOK / 2; rq += NGW) norm1_rows<2, true>(p, l, rq * 2, lane); }
}

__device__ __forceinline__ void phase_final(const Params& p) {
    const int tid = opaque_tid(), lane = tid & 63, wave = tid >> 6, G = gridDim.x;
    const int gw = blockIdx.x * NWAVES + wave, NGW = G * NWAVES;
    const float* mod = (const float*)(p.ws + WS_MOD);
    const unsigned char* Y = (const unsigned char*)(p.ws + WS_Y);
    const bf16_t* XB = (const bf16_t*)(p.ws + WS_XB);
    constexpr int NR = 4;
    for (int rq = gw; rq < NTOK / NR; rq += NGW) {
        const int row0 = rq * NR, b = row0 >> 13;
        const float* g2 = mod + (size_t)((DEPTH - 1) * 4 + b) * 6144 + 5120;
        f32x4 v[NR][4], ys[NR][4];
#pragma unroll
        for (int r = 0; r < NR; ++r)
#pragma unroll
            for (int j = 0; j < 4; ++j) { const int c = 4 * lane + 256 * j; const u32x2 xw = *(const u32x2*)(XB + (size_t)(row0 + r) * DM + c);
                v[r][j] = (f32x4){bf_lo(xw.x), bf_hi(xw.x), bf_lo(xw.y), bf_hi(xw.y)}; ys[r][j] = y_pair_sum(Y, row0 + r, c); }
#pragma unroll
        for (int j = 0; j < 4; ++j) { const f32x4 gg = *(const f32x4*)(g2 + 4 * lane + 256 * j);
#pragma unroll
            for (int r = 0; r < NR; ++r) *(f32x4*)(p.out + (size_t)(row0 + r) * DM + 4 * lane + 256 * j) = v[r][j] + gg * ys[r][j]; }
    }
}

__device__ __forceinline__ int crow(int r, int hi) { return (r & 3) + 8 * (r >> 2) + 4 * hi; }

__device__ __forceinline__ void pool_strip(const Params& p, int strip, int lane) {
    const bf16_t* U = (const bf16_t*)(p.ws + WS_U); bf16_t* MIX = (bf16_t*)(p.ws + WS_BUF);
    const int tok0 = strip * 16, s0 = tok0 & (SEQ - 1);
    const int win = 2 << (lane >> 4);
    float S[8];
#pragma unroll
    for (int j = 0; j < 8; ++j) S[j] = 0.f;
#pragma unroll
    for (int d = 1; d < 16; ++d) {
        if (d < win && s0 - d >= 0) {
            const u32x4 w = *(const u32x4*)(U + (size_t)(tok0 - d) * 512 + lane * 8);
            S[0] += bf_lo(w.x); S[1] += bf_hi(w.x); S[2] += bf_lo(w.y); S[3] += bf_hi(w.y); S[4] += bf_lo(w.z); S[5] += bf_hi(w.z); S[6] += bf_lo(w.w); S[7] += bf_hi(w.w);
        }
    }
#pragma unroll 4
    for (int i = 0; i < 16; ++i) {
        const int s = s0 + i;
        const u32x4 w = *(const u32x4*)(U + (size_t)(tok0 + i) * 512 + lane * 8);
        float uv[8] = {bf_lo(w.x), bf_hi(w.x), bf_lo(w.y), bf_hi(w.y), bf_lo(w.z), bf_hi(w.z), bf_lo(w.w), bf_hi(w.w)};
#pragma unroll
        for (int j = 0; j < 8; ++j) S[j] += uv[j];
        const int cn = (s + 1 < win) ? s + 1 : win;
        const float inv = 1.0f / (float)cn;
        float o[8];
#pragma unroll
        for (int j = 0; j < 8; ++j) o[j] = S[j] * inv - uv[j];
        u32x4 ow; ow.x = cvtpk(o[0], o[1]); ow.y = cvtpk(o[2], o[3]); ow.z = cvtpk(o[4], o[5]); ow.w = cvtpk(o[6], o[7]);
        *(u32x4*)(MIX + (size_t)(tok0 + i) * DM + lane * 8) = ow;
        if (s - win + 1 >= 0) {
            const u32x4 x = *(const u32x4*)(U + (size_t)(tok0 + i - win + 1) * 512 + lane * 8);
            S[0] -= bf_lo(x.x); S[1] -= bf_hi(x.x); S[2] -= bf_lo(x.y); S[3] -= bf_hi(x.y); S[4] -= bf_lo(x.z); S[5] -= bf_hi(x.z); S[6] -= bf_lo(x.w); S[7] -= bf_hi(x.w);
        }
    }
}

__device__ __forceinline__ void attn_unit(const Params& p, int b, int h, int ch, int qh, int lane, const LAS float* tbl, LAS bf16_t* stg) {
    const int r32 = lane & 31, hi = lane >> 5;
    const char* Qf = (const char*)(p.ws + WS_Q); const char* Kf = (const char*)(p.ws + WS_K); const char* Vf = (const char*)(p.ws + WS_V);
    bf16_t* MIX = (bf16_t*)(p.ws + WS_BUF);
    const size_t bh = (size_t)(b * NHEAD + h) * 256;
    bf16x8 qr[4];
#pragma unroll
    for (int d0 = 0; d0 < 4; ++d0) qr[d0] = *(const bf16x8*)(Qf + (((bh + ch * 2 + qh) * 4 + d0) * 64 + lane) * 16);
    f32x16 o0 = {}, o1 = {};
    float lsum = 0.f;
    const LAS float* th = tbl + h * 256;
    f32x16 cfv; { const float cfar = th[254];
#pragma unroll
        for (int r = 0; r < 16; ++r) cfv[r] = cfar; }
    const int t0 = ch < 8 ? 8 - ch : 0;
    const char* kp = Kf + (bh * 4 * 64 + lane) * 16 + (ptrdiff_t)(ch - 8 + t0) * 8192;
    const char* vp = Vf + (bh * 4 * 64 + lane) * 16 + (ptrdiff_t)(ch - 8 + t0) * 8192;
    bf16x8 kk[8];
#define ATT_LD8(dst, ptr) do { const char* pa_ = (ptr); const char* pb_ = pa_ + 4096; _Pragma("unroll") for (int i_ = 0; i_ < 4; ++i_) { dst[i_] = *(const bf16x8*)(pa_ + i_ * 1024); dst[4 + i_] = *(const bf16x8*)(pb_ + i_ * 1024); } } while (0)
#define ATT_REST(P0, P1) do { \
        float sacc_ = 0.f; \
        _Pragma("unroll") for (int r = 0; r < 16; ++r) { P0[r] = fast_exp2(P0[r]); P1[r] = fast_exp2(P1[r]); sacc_ += P0[r] + P1[r]; } \
        lsum += sacc_; \
        u32x4 pa_[4]; \
        _Pragma("unroll") for (int s = 0; s < 2; ++s) { \
            pa_[s].x = cvtpk(P0[8 * s + 0], P0[8 * s + 1]); pa_[s].y = cvtpk(P0[8 * s + 2], P0[8 * s + 3]); pa_[s].z = cvtpk(P0[8 * s + 4], P0[8 * s + 5]); pa_[s].w = cvtpk(P0[8 * s + 6], P0[8 * s + 7]); \
            pa_[2 + s].x = cvtpk(P1[8 * s + 0], P1[8 * s + 1]); pa_[2 + s].y = cvtpk(P1[8 * s + 2], P1[8 * s + 3]); pa_[2 + s].z = cvtpk(P1[8 * s + 4], P1[8 * s + 5]); pa_[2 + s].w = cvtpk(P1[8 * s + 6], P1[8 * s + 7]); } \
        _Pragma("unroll") for (int i = 0; i < 4; ++i) { const bf16x8 pf_ = __builtin_bit_cast(bf16x8, pa_[i]); \
            o0 = __builtin_amdgcn_mfma_f32_32x32x16_bf16(pf_, vv[2 * i], o0, 0, 0, 0); o1 = __builtin_amdgcn_mfma_f32_32x32x16_bf16(pf_, vv[2 * i + 1], o1, 0, 0, 0); } \
    } while (0)
    ATT_LD8(kk, kp);
    int t = t0;
#pragma unroll 1
    for (; t <= 5; ++t) {
        bf16x8 vv[8]; ATT_LD8(vv, vp); vp += 8192;
        f32x16 p0 = __builtin_amdgcn_mfma_f32_32x32x16_bf16(kk[0], qr[0], cfv, 0, 0, 0);
        f32x16 p1 = __builtin_amdgcn_mfma_f32_32x32x16_bf16(kk[4], qr[0], cfv, 0, 0, 0);
#pragma unroll
        for (int d0 = 1; d0 < 4; ++d0) { p0 = __builtin_amdgcn_mfma_f32_32x32x16_bf16(kk[d0], qr[d0], p0, 0, 0, 0); p1 = __builtin_amdgcn_mfma_f32_32x32x16_bf16(kk[4 + d0], qr[d0], p1, 0, 0, 0); }
        kp += 8192; ATT_LD8(kk, kp);
        ATT_REST(p0, p1);
    }
#pragma unroll 1
    for (; t <= 8; ++t) {
        bf16x8 vv[8]; ATT_LD8(vv, vp); vp += 8192;
        f32x16 p0, p1;
        { const int base_ = 64 * (8 - t) + 32 * qh + r32 + 63 - 4 * hi;
#pragma unroll
          for (int r = 0; r < 16; ++r) { const int kj = (r & 3) + 8 * (r >> 2); p0[r] = th[base_ - kj]; p1[r] = th[base_ - kj - 32]; } }
#pragma unroll
        for (int d0 = 0; d0 < 4; ++d0) { p0 = __builtin_amdgcn_mfma_f32_32x32x16_bf16(kk[d0], qr[d0], p0, 0, 0, 0); p1 = __builtin_amdgcn_mfma_f32_32x32x16_bf16(kk[4 + d0], qr[d0], p1, 0, 0, 0); }
        if (t < 8) { kp += 8192; ATT_LD8(kk, kp); }
        ATT_REST(p0, p1);
    }
#undef ATT_LD8
#undef ATT_REST
    lsum += __shfl_xor(lsum, 32);
    const float linv = 1.0f / lsum;
#pragma unroll
    for (int r = 0; r < 16; ++r) {
        const int q = crow(r, hi);
        const float li = __shfl(linv, q);
        stg[q * 72 + r32] = (bf16_t)(cvtpk(o0[r] * li, 0.f) & 0xffffu);
        stg[q * 72 + 32 + r32] = (bf16_t)(cvtpk(o1[r] * li, 0.f) & 0xffffu);
    }
    asm volatile("s_waitcnt lgkmcnt(0)" ::: "memory");
    bf16_t* orow = MIX + ((size_t)b * SEQ + ch * 64 + qh * 32 + (lane >> 3)) * DM + 512 + h * 64 + (lane & 7) * 8;
    const LAS bf16_t* srow = stg + (lane >> 3) * 72 + (lane & 7) * 8;
#pragma unroll
    for (int i = 0; i < 4; ++i) *(u32x4*)(orow + (size_t)i * 8 * DM) = *(const LAS u32x4*)(srow + i * 8 * 72);
    asm volatile("s_waitcnt lgkmcnt(0)" ::: "memory");
}

__device__ __forceinline__ void phase_mixer(const Params& p, int l, LAS unsigned char* lds) {
    const int tid = opaque_tid(), lane = tid & 63, wave = tid >> 6, G = gridDim.x;
    LAS float* tbl = (LAS float*)lds;
    const float* gt = (const float*)(p.ws + WS_TBL) + (size_t)l * 2048;
    for (int i = tid; i < 2048; i += NTHREADS) tbl[i] = gt[i];
    __syncthreads();
    const int gw = blockIdx.x * NWAVES + wave, NGW = G * NWAVES;
    LAS bf16_t* stg = (LAS bf16_t*)(lds + 8192 + wave * 4608);
    for (int it = gw; it < NTOK / 16; it += NGW) pool_strip(p, it, lane);
    if (G % 8 == 0) {
        const int x = (int)blockIdx.x & 7, lw = ((int)blockIdx.x >> 3) * NWAVES + wave, nlw = (G >> 3) * NWAVES;
        for (int pr = x; pr < BATCH * NHEAD; pr += 8)
            for (int u = lw; u < 256; u += nlw) attn_unit(p, pr >> 3, pr & 7, u >> 1, u & 1, lane, tbl, stg);
    } else {
        for (int wu = gw; wu < BATCH * NHEAD * 256; wu += NGW) attn_unit(p, wu >> 11, (wu >> 8) & 7, (wu >> 1) & 127, wu & 1, lane, tbl, stg);
    }
}

__device__ __forceinline__ void phase_route(const Params& p, int l, LAS unsigned char* lds) {
    const int tid = opaque_tid(), lane = tid & 63, wave = __builtin_amdgcn_readfirstlane(tid >> 6), G = gridDim.x;
    LAS float* a2c = (LAS float*)(lds + 49152);
    LAS float* shc = (LAS float*)(lds + 49152 + 1024);
    LAS float* lg = (LAS float*)(lds + 53248) + wave * (16 * 48);
    LAS int* lcnt = (LAS int*)(lds + 77824);
    LAS int* gbase = (LAS int*)(lds + 77824 + 128);
    LAS int* tmp_e = (LAS int*)(lds + 77824 + 256);
    LAS int* tmp_r = (LAS int*)(lds + 77824 + 256 + 1024);
    LAS float* tmp_w = (LAS float*)(lds + 77824 + 256 + 2048);
    const float* mod = (const float*)(p.ws + WS_MOD);
    const float* gn = p.in[5] + l * 1024;
    unsigned char* H8 = p.ws + WS_BUF;
    const char* RW = (const char*)(p.ws + WS_RW) + (size_t)l * 2 * 48 * 1024 * 2;
    const float* rwb = (const float*)(p.ws + WS_RWB) + l * 48;
    const float* ssq = (const float*)(p.ws + WS_SSQ);
    int* gcnt = (int*)(p.ws + WS_CTL) + l * 32;
    u32x2* list = (u32x2*)(p.ws + WS_LIST2);
    const int r = lane & 15, kg = lane >> 4;
    for (int it = blockIdx.x; it < NTOK / 128; it += G) {
        const int row0 = it * 128 + wave * 16, row = row0 + r, b = (it * 128) >> 13;
        const bf16_t* xr = (const bf16_t*)(p.ws + WS_XB) + (size_t)row * DM + 8 * kg;
        float ss; { const f32x4 q4 = *(const f32x4*)(ssq + (size_t)row * 16 + 4 * kg); ss = (q4[0] + q4[1]) + (q4[2] + q4[3]); }
        ss += __shfl_xor(ss, 16); ss += __shfl_xor(ss, 32);
        const float rstd = rsqrtf(ss * (1.0f / DM) + EPS);
        const float* sh = mod + (size_t)(l * 4 + b) * 6144 + 3072; const float* sc = sh + 1024;
        f32x4 acc[3];
#pragma unroll
        for (int nb = 0; nb < 3; ++nb) acc[nb] = (f32x4){0.f, 0.f, 0.f, 0.f};
#pragma unroll 1
        for (int c = 0; c < 4; ++c) {
            u32x4 xs[8];
#pragma unroll
            for (int i = 0; i < 8; ++i) xs[i] = *(const u32x4*)(xr + 256 * c + 32 * i);
            __syncthreads();
            if (c == 0 && tid < 32) lcnt[tid] = 0;
#pragma unroll
            for (int i = 0; i < 6; ++i) { const int q = wave * 6 + i; const char* src = RW + (q < 24 ? (size_t)(c * 24 + q) * 1024 : (size_t)98304 + (size_t)(c * 24 + q - 24) * 1024);
                __builtin_amdgcn_global_load_lds((const unsigned*)(src + lane * 16), (LAS unsigned*)(lds + q * 1024), 16, 0, 0); }
            if (tid < 256) { const int k = 256 * c + tid; a2c[tid] = gn[k] * (1.0f + sc[k]); shc[tid] = sh[k]; }
            asm volatile("s_waitcnt vmcnt(0)" ::: "memory");
            __syncthreads();
#pragma unroll
            for (int i = 0; i < 8; ++i) {
                float hv[8];
#pragma unroll
                for (int q = 0; q < 2; ++q) {
                    const f32x4 a = *(const LAS f32x4*)(a2c + 32 * i + 8 * kg + 4 * q), s0 = *(const LAS f32x4*)(shc + 32 * i + 8 * kg + 4 * q);
                    const f32x4 xv = q == 0 ? (f32x4){bf_lo(xs[i].x), bf_hi(xs[i].x), bf_lo(xs[i].y), bf_hi(xs[i].y)} : (f32x4){bf_lo(xs[i].z), bf_hi(xs[i].z), bf_lo(xs[i].w), bf_hi(xs[i].w)};
                    const f32x4 hh = xv * rstd * a + s0;
                    hv[4 * q + 0] = hh[0]; hv[4 * q + 1] = hh[1]; hv[4 * q + 2] = hh[2]; hv[4 * q + 3] = hh[3];
                }
                u32x4 hp; hp.x = cvtpk(hv[0], hv[1]); hp.y = cvtpk(hv[2], hv[3]); hp.z = cvtpk(hv[4], hv[5]); hp.w = cvtpk(hv[6], hv[7]);
                { u32x2 h8; h8.x = pk_fp8x4(clamp8(hv[0] * 8.0f), clamp8(hv[1] * 8.0f), clamp8(hv[2] * 8.0f), clamp8(hv[3] * 8.0f)); h8.y = pk_fp8x4(clamp8(hv[4] * 8.0f), clamp8(hv[5] * 8.0f), clamp8(hv[6] * 8.0f), clamp8(hv[7] * 8.0f));
                  *(u32x2*)(H8 + (size_t)row * DM + 256 * c + 32 * i + 8 * kg) = h8; }
                u32x4 lp;
                lp.x = cvtpk(hv[0] - bf_lo(hp.x), hv[1] - bf_hi(hp.x)); lp.y = cvtpk(hv[2] - bf_lo(hp.y), hv[3] - bf_hi(hp.y));
                lp.z = cvtpk(hv[4] - bf_lo(hp.z), hv[5] - bf_hi(hp.z)); lp.w = cvtpk(hv[6] - bf_lo(hp.w), hv[7] - bf_hi(hp.w));
                const bf16x8 xhi = __builtin_bit_cast(bf16x8, hp), xlo = __builtin_bit_cast(bf16x8, lp);
#pragma unroll
                for (int nb = 0; nb < 3; ++nb) {
                    const bf16x8 whi = *(const LAS bf16x8*)(lds + (i * 3 + nb) * 1024 + lane * 16);
                    const bf16x8 wlo = *(const LAS bf16x8*)(lds + 24576 + (i * 3 + nb) * 1024 + lane * 16);
                    acc[nb] = __builtin_amdgcn_mfma_f32_16x16x32_bf16(whi, xhi, acc[nb], 0, 0, 0);
                    acc[nb] = __builtin_amdgcn_mfma_f32_16x16x32_bf16(whi, xlo, acc[nb], 0, 0, 0);
                    acc[nb] = __builtin_amdgcn_mfma_f32_16x16x32_bf16(wlo, xhi, acc[nb], 0, 0, 0);
                }
            }
        }
#pragma unroll
        for (int nb = 0; nb < 3; ++nb)
#pragma unroll
            for (int q = 0; q < 4; ++q) lg[r * 48 + 16 * nb + 4 * kg + q] = acc[nb][q];
        asm volatile("s_waitcnt lgkmcnt(0)" ::: "memory");
        if (lane < 16) {
            const LAS float* my = lg + lane * 48;
            float gl[4]; int gi = 0; float gm;
#pragma unroll
            for (int i = 0; i < 4; ++i) gl[i] = my[32 + i] + rwb[32 + i];
            gm = gl[0];
#pragma unroll
            for (int i = 1; i < 4; ++i) if (gl[i] > gm) { gm = gl[i]; gi = i; }
            float den = 0.f;
#pragma unroll
            for (int i = 0; i < 4; ++i) den += __expf(gl[i] - gm);
            const float gpv = 1.0f / den;
            float el[8];
#pragma unroll
            for (int i = 0; i < 8; ++i) el[i] = my[8 * gi + i] + rwb[8 * gi + i];
            int i0 = 0; float v0 = el[0];
#pragma unroll
            for (int i = 1; i < 8; ++i) if (el[i] > v0) { v0 = el[i]; i0 = i; }
            int i1 = -1; float v1 = -3.0e38f;
#pragma unroll
            for (int i = 0; i < 8; ++i) if (i != i0 && el[i] > v1) { v1 = el[i]; i1 = i; }
            const float dd = __expf(v1 - v0);
            const float w0 = gpv / (1.0f + dd), w1 = gpv * dd / (1.0f + dd);
            const int e0 = 8 * gi + i0, e1 = 8 * gi + i1;
            const int tok = row0 + lane, lt = wave * 16 + lane;
            tmp_w[2 * lt] = w0; tmp_w[2 * lt + 1] = w1;
            tmp_e[2 * lt] = e0; tmp_e[2 * lt + 1] = e1;
            tmp_r[2 * lt] = __hip_atomic_fetch_add(lcnt + e0, 1, __ATOMIC_RELAXED, __HIP_MEMORY_SCOPE_WORKGROUP);
            tmp_r[2 * lt + 1] = __hip_atomic_fetch_add(lcnt + e1, 1, __ATOMIC_RELAXED, __HIP_MEMORY_SCOPE_WORKGROUP);
        }
        __syncthreads();
        if (tid < 32) gbase[tid] = __hip_atomic_fetch_add(gcnt + tid, lcnt[tid], __ATOMIC_RELAXED, __HIP_MEMORY_SCOPE_AGENT);
        __syncthreads();
        if (tid < 256) { const int e = tmp_e[tid]; u32x2 en; en.x = (unsigned)(it * 256 + tid); en.y = __float_as_uint(tmp_w[tid]); list[(size_t)e * NTOK + gbase[e] + tmp_r[tid]] = en; }
    }
    __syncthreads();
}

#define XB_TMO      128
#define XB_XCNT(j)  (256  + 64 * (j))
#define XB_XSUB(j)  (1280 + 64 * (j))
#define XB_XGEN(j)  (2304 + 64 * (j))
#define XB_TOP      3328
#define XB_TOPGEN   3392
#define XCD_BAR_WORDS 3456
#define XB_SPIN_CAP (1u << 18)
__device__ __forceinline__ unsigned xb_ld(unsigned* p)              { return __hip_atomic_load(p, __ATOMIC_RELAXED, __HIP_MEMORY_SCOPE_AGENT); }
__device__ __forceinline__ unsigned xb_add(unsigned* p, unsigned v) { return __hip_atomic_fetch_add(p, v, __ATOMIC_RELAXED, __HIP_MEMORY_SCOPE_AGENT); }
__device__ __forceinline__ unsigned xb_xcc_id() { return (unsigned)__builtin_amdgcn_s_getreg((3 << 11) | 20) & 0xFu; }
#define XB_SPIN(cond, bar) do { unsigned _sp = 0; while (cond) { __builtin_amdgcn_s_sleep(1); \
    if ((++_sp & 255u) == 0u) { if (xb_ld(&(bar)[XB_TMO])) break; if (_sp > XB_SPIN_CAP) { atomicAdd(&(bar)[XB_TMO], 1u); break; } } } } while (0)
struct XcdBarrier { unsigned* bar; unsigned x; volatile LAS unsigned* st; };
__device__ __forceinline__ XcdBarrier xcd_barrier_post(unsigned* bar, volatile LAS unsigned* st) {
    XcdBarrier b; b.bar = bar; b.x = xb_xcc_id(); b.st = st;
    if (threadIdx.x == 0) (void)xb_add(&bar[XB_XCNT(b.x)], 1u);
    return b;
}
__device__ __forceinline__ void xcd_barrier_complete(unsigned* bar, unsigned x, unsigned& nloc, unsigned& nx) {
    const unsigned G = gridDim.x * gridDim.y * gridDim.z;
    unsigned sum, cnt, mine, sp = 0u;
    for (;;) {
        sum = 0u; cnt = 0u; mine = 0u;
#pragma unroll
        for (unsigned j = 0; j < 16; ++j) { const unsigned c = xb_ld(&bar[XB_XCNT(j)]); sum += c; cnt += (c > 0u) ? 1u : 0u; mine = (j == x) ? c : mine; }
        if (sum == G) break;
        __builtin_amdgcn_s_sleep(1);
        if ((++sp & 255u) == 0u) { if (xb_ld(&bar[XB_TMO])) break; if (sp > XB_SPIN_CAP) { atomicAdd(&bar[XB_TMO], 1u); break; } }
    }
    nloc = mine > 0u ? mine : 1u; nx = cnt > 0u ? cnt : 1u;
}
__device__ __forceinline__ void xcd_barrier(const XcdBarrier& b) {
    asm volatile("s_waitcnt vmcnt(0)" ::: "memory");
    __syncthreads();
    if (threadIdx.x == 0) {
        unsigned* bar = b.bar;
        __builtin_amdgcn_s_waitcnt(0);
        unsigned nloc = b.st[0], nx = b.st[1];
        if (nloc == 0u) { xcd_barrier_complete(bar, b.x, nloc, nx); b.st[0] = nloc; b.st[1] = nx; }
        const unsigned old = xb_add(&bar[XB_XSUB(b.x)], 1u);
        const unsigned gen = old / nloc;
        if (old + 1u == (gen + 1u) * nloc) {
            __builtin_amdgcn_fence(__ATOMIC_RELEASE, "agent");
            asm volatile("s_waitcnt vmcnt(0)" ::: "memory");
            const unsigned og = xb_add(&bar[XB_TOP], 1u);
            const unsigned tg = og / nx;
            if (og + 1u == (tg + 1u) * nx) xb_add(&bar[XB_TOPGEN], 1u);
            else XB_SPIN(xb_ld(&bar[XB_TOPGEN]) == tg, bar);
            __builtin_amdgcn_fence(__ATOMIC_ACQUIRE, "agent");
            xb_add(&bar[XB_XGEN(b.x)], 1u);
            asm volatile("s_waitcnt vmcnt(0)" ::: "memory");
        } else {
            XB_SPIN(xb_ld(&bar[XB_XGEN(b.x)]) == gen, bar);
            __builtin_amdgcn_fence(__ATOMIC_ACQUIRE, "agent");
            asm volatile("s_waitcnt vmcnt(0)" ::: "memory");
        }
    }
    __syncthreads();
}

__device__ __forceinline__ void load_params(Params& q, const Params& p) {
#if defined(__HIP_DEVICE_COMPILE__)
    const unsigned long long a = (unsigned long long)__builtin_amdgcn_kernarg_segment_ptr();
    unsigned alo = __builtin_amdgcn_readfirstlane((unsigned)a), ahi = __builtin_amdgcn_readfirstlane((unsigned)(a >> 32));
    asm volatile("" : "+s"(alo), "+s"(ahi));
    q = *(const __attribute__((address_space(4))) Params*)(((unsigned long long)ahi << 32) | alo);
#else
    q = p;
#endif
}
__device__ __forceinline__ void load_prefix(const Params& p, int l, LAS int* pre, LAS int* cntl) {
    const int* gcnt = (const int*)(p.ws + WS_CTL) + l * 32;
    if (threadIdx.x == 0) { int a = 0; for (int e = 0; e < NEXP; ++e) { const int c = gcnt[e]; cntl[e] = c; pre[e] = a; a += (c + 255) >> 8; } pre[NEXP] = a; }
    __syncthreads();
}

__global__ void __launch_bounds__(NTHREADS, 2) fwd_kernel(Params p) {
    extern __shared__ __attribute__((aligned(16))) unsigned char lds_raw[];
    LAS unsigned char* lds = (LAS unsigned char*)lds_raw;
    const int G = gridDim.x;
    unsigned char* ws = p.ws;
    volatile LAS unsigned* bst = (volatile LAS unsigned*)(lds + LDS_BYTES - 16);
    if (threadIdx.x < 2) bst[threadIdx.x] = 0u;
    __syncthreads();
    const XcdBarrier bar = xcd_barrier_post((unsigned*)(ws + WS_CTL) + 4096, bst);
    const int lo = p.ph_lo, hi = p.ph_hi;
#define IN(k) (lo <= (k) && (k) < hi)
#define SYNC_AFTER(k) do { if (IN(k) && IN((k) + 1)) xcd_barrier(bar); } while (0)
    if (IN(0)) { Params q; load_params(q, p); phase_prologue(q, lds); }
    SYNC_AFTER(0);
#pragma unroll 1
    for (int l = 0; l < DEPTH; ++l) {
        const int k0 = 1 + 7 * l;
        if (IN(k0 + 0)) { Params q; load_params(q, p); phase_norm1(q, l); }
        SYNC_AFTER(k0 + 0);
        if (IN(k0 + 1)) {
            Params q; load_params(q, p); unsigned char* ws = q.ws;
            {
                DenseGemmI8 g{ws + WS_BUF, ws + WS_WIN + (size_t)l * 2048 * 1024, 1024, (const float*)(ws + WS_RS), (const float*)(ws + WS_CS) + l * 2048};
                pg8::StaticOrder S; S.init(NTOK, 1536, G, (int)blockIdx.x);
                EpiIn E{(bf16_t*)(ws + WS_U), (bf16_t*)(ws + WS_Q), (bf16_t*)(ws + WS_K), q.in[9] + l * 64, q.in[10] + l * 64};
                pg8::gemm_phase(lds, g, S, E);
            }
            {
                DenseGemmI8 g{ws + WS_WIN + (size_t)l * 2048 * 1024 + (size_t)1536 * 1024, ws + WS_BUF, 1024, (const float*)(ws + WS_CS) + l * 2048 + 1536, (const float*)(ws + WS_RS)};
                pg8::StaticOrder S; S.init(512, NTOK, G, (int)blockIdx.x);
                EpiVt E{(bf16_t*)(ws + WS_V)};
                pg8::gemm_phase(lds, g, S, E);
            }
        }
        SYNC_AFTER(k0 + 1);
        if (IN(k0 + 2)) { Params q; load_params(q, p); phase_mixer(q, l, lds); }
        SYNC_AFTER(k0 + 2);
        if (IN(k0 + 3)) {
            Params q; load_params(q, p); unsigned char* ws = q.ws;
            DenseGemm g{(const bf16_t*)(ws + WS_BUF), (const bf16_t*)(ws + WS_WOUT) + (size_t)l * 1024 * 1024, 1024, nullptr, nullptr};
            pg8::StaticOrder S; S.init(NTOK, 1024, G, (int)blockIdx.x);
            const float* g1p = (const float*)(ws + WS_MOD) + (size_t)(l * 4) * 6144 + 2048;
            if (l == 0) { EpiOutB<true> E{q.in[0], (bf16_t*)(ws + WS_XB), g1p, (float*)(ws + WS_SSQ)}; pg8::gemm_phase(lds, g, S, E); }
            else { EpiOutB<false> E{nullptr, (bf16_t*)(ws + WS_XB), g1p, (float*)(ws + WS_SSQ)}; pg8::gemm_phase(lds, g, S, E); }
        }
        SYNC_AFTER(k0 + 3);
        if (IN(k0 + 4)) { Params q; load_params(q, p); phase_route(q, l, lds); }
        SYNC_AFTER(k0 + 4);
        if (IN(k0 + 5)) {
            Params q; load_params(q, p); unsigned char* ws = q.ws;
            const int vcu = (G % 8 == 0) ? ((int)blockIdx.x % 8) * (G / 8) + (int)blockIdx.x / 8 : (int)blockIdx.x;
            LAS int* pre = (LAS int*)(lds + pg8::STAGE_BYTES); LAS int* cntl = pre + 64;
            load_prefix(q, l, pre, cntl);
            GatherGemm g{ws + WS_BUF, ws + WS_WGU + (size_t)l * NEXP * 1024 * 1024, (const u32x2*)(ws + WS_LIST2), 1024, 1, (size_t)1024 * 1024};
            pg8::GroupedOrder S{pre, cntl, G, vcu};
            EpiGU E{ws + WS_ACT};
            const int total_units = pre[NEXP] * 4;
            pg8::gemm_phase(lds, g, S, E);
            if (l == 0) tail_convert(q, lds, total_units, vcu, 0, 7424);
        }
        SYNC_AFTER(k0 + 5);
        if (IN(k0 + 6)) {
            Params q; load_params(q, p); unsigned char* ws = q.ws;
            const int vcu = (G % 8 == 0) ? ((int)blockIdx.x % 8) * (G / 8) + (int)blockIdx.x / 8 : (int)blockIdx.x;
            LAS int* pre = (LAS int*)(lds + pg8::STAGE_BYTES); LAS int* cntl = pre + 64;
            load_prefix(q, l, pre, cntl);
            GatherGemm g{ws + WS_ACT, ws + WS_WD + (size_t)l * NEXP * 1024 * 512, (const u32x2*)(ws + WS_LIST2), 512, 0, (size_t)1024 * 512};
            pg8::GroupedOrder S{pre, cntl, G, vcu};
            EpiDn E{(unsigned char*)(ws + WS_Y)};
            const int total_units = pre[NEXP] * 4;
            pg8::gemm_phase(lds, g, S, E);
            if (l == 0) tail_convert(q, lds, total_units, vcu, 7424, T_NB - 7424);
        }
        SYNC_AFTER(k0 + 6);
    }
    if (IN(15)) { Params q; load_params(q, p); phase_final(q); }
#undef IN
#undef SYNC_AFTER
}

extern "C" void kernel_launch(void* const* d_in, const int* in_sizes, int n_in, void* d_out, int out_size, void* d_ws, size_t ws_size, hipStream_t stream) {
    static int grid = 0;
    if (grid == 0) {
        if (n_in != 20 || out_size != NTOK * DM || ws_size < WS_END) { fprintf(stderr, "kernel_launch: unexpected shapes (n_in %d out %d ws %zu)\n", n_in, out_size, ws_size); grid = -1; return; }
        int dev = 0, cus = 0, per_cu = 0;
        hipGetDevice(&dev);
        hipDeviceGetAttribute(&cus, hipDeviceAttributeMultiprocessorCount, dev);
        hipFuncSetAttribute((const void*)fwd_kernel, hipFuncAttributeMaxDynamicSharedMemorySize, LDS_BYTES);
        hipOccupancyMaxActiveBlocksPerMultiprocessor(&per_cu, (const void*)fwd_kernel, NTHREADS, LDS_BYTES);
        if (per_cu < 1) per_cu = 1;
        if (per_cu > 1) per_cu = 1;
        grid = cus * per_cu;
        (void)hipGetLastError();
    }
    if (grid < 0) return;
    if (hipMemsetAsync((char*)d_ws + WS_CTL, 0, 65536, stream) != hipSuccess) { fprintf(stderr, "memset failed\n"); return; }
    Params p{};
    for (int i = 0; i < 20; ++i) p.in[i] = (const float*)d_in[i];
    p.out = (float*)d_out; p.ws = (unsigned char*)d_ws; p.ph_lo = 0; p.ph_hi = 16;
    void* args[] = {&p};
    hipError_t e = hipLaunchCooperativeKernel((const void*)fwd_kernel, dim3(grid), dim3(NTHREADS), args, LDS_BYTES, stream);
    if (e != hipSuccess) fprintf(stderr, "cooperative launch failed: %s (grid %d)\n", hipGetErrorString(e), grid);
}
```

```cpp
#include <hip/hip_runtime.h>
#include <hip/hip_cooperative_groups.h>
#include <cstdio>
#include <cstdint>
namespace cg = cooperative_groups;

#define LAS __attribute__((address_space(3)))
typedef unsigned short bf16_t;
typedef short bf16x8 __attribute__((ext_vector_type(8)));
typedef float f32x4 __attribute__((ext_vector_type(4)));
typedef float f32x16 __attribute__((ext_vector_type(16)));
typedef unsigned u32x4 __attribute__((ext_vector_type(4)));
typedef int i32x4 __attribute__((ext_vector_type(4)));
typedef int i32x8 __attribute__((ext_vector_type(8)));
typedef unsigned u32x2 __attribute__((ext_vector_type(2)));
typedef float f32x2_t __attribute__((ext_vector_type(2)));
typedef __bf16 bf16x2_t __attribute__((ext_vector_type(2)));

constexpr int BATCH = 4, SEQ = 8192, DM = 1024, NTOK = BATCH * SEQ, DEPTH = 2;
constexpr int NHEAD = 8, HD = 64, NEXP = 32, DEXP = 512;
constexpr float EPS = 1e-6f;
constexpr float LOG2E = 1.4426950408889634f;

constexpr size_t MiB = 1u << 20;
constexpr size_t WS_CTL = 0;
constexpr size_t WS_MOD = 1 * MiB;
constexpr size_t WS_TBL = 1 * MiB + 512 * 1024;
constexpr size_t WS_RW = 2 * MiB;
constexpr size_t WS_RWB = 2 * MiB + 512 * 1024;
constexpr size_t WS_LIST = 3 * MiB;
constexpr size_t WS_EW = 7 * MiB;
constexpr size_t WS_WIN = 8 * MiB;
constexpr size_t WS_WOUT = 16 * MiB;
constexpr size_t WS_WGU = 20 * MiB;
constexpr size_t WS_WD = 148 * MiB;
constexpr size_t WS_BUF = 212 * MiB;
constexpr size_t WS_U = 276 * MiB;
constexpr size_t WS_Q = 308 * MiB;
constexpr size_t WS_K = 340 * MiB;
constexpr size_t WS_V = 372 * MiB;
constexpr size_t WS_Y = 276 * MiB;
constexpr size_t WS_ACT = 404 * MiB;
constexpr size_t WS_SSQ = 468 * MiB;
constexpr size_t WS_XB = 470 * MiB;
constexpr size_t WS_LIST2 = 534 * MiB;
constexpr size_t WS_RS = 542 * MiB;
constexpr size_t WS_CS = 543 * MiB;
constexpr size_t WS_END = 544 * MiB;

constexpr int LDS_BYTES = 163840;
constexpr int NWAVES = 8, NTHREADS = 512;

struct Params {
    const float* in[20];
    float* out;
    unsigned char* ws;
    int ph_lo, ph_hi;
};

__device__ __forceinline__ unsigned cvtpk(float lo, float hi) { f32x2_t v = {lo, hi}; bf16x2_t b = __builtin_convertvector(v, bf16x2_t); return __builtin_bit_cast(unsigned, b); }
__device__ __forceinline__ float bf_lo(unsigned w) { return __uint_as_float(w << 16); }
__device__ __forceinline__ float bf_hi(unsigned w) { return __uint_as_float(w & 0xffff0000u); }
__device__ __forceinline__ float fast_exp2(float x) { return __builtin_amdgcn_exp2f(x); }
__device__ __forceinline__ float fast_rcp(float x) { return __builtin_amdgcn_rcpf(x); }

__device__ __forceinline__ float clamp8(float x) { return __builtin_amdgcn_fmed3f(x, -448.0f, 448.0f); }
__device__ __forceinline__ unsigned pk_fp8x4(float a, float b, float c, float d) { int w = 0; w = __builtin_amdgcn_cvt_pk_fp8_f32(a, b, w, false); w = __builtin_amdgcn_cvt_pk_fp8_f32(c, d, w, true); return (unsigned)w; }
__device__ __forceinline__ unsigned pk_i8x4(float a, float b, float c, float d) {
    const unsigned ua = __float_as_uint(a + 12582912.0f), ub = __float_as_uint(b + 12582912.0f), uc = __float_as_uint(c + 12582912.0f), ud = __float_as_uint(d + 12582912.0f);
    return __builtin_amdgcn_perm(__builtin_amdgcn_perm(ud, uc, 0x0c0c0400u), __builtin_amdgcn_perm(ub, ua, 0x0c0c0400u), 0x05040100u);
}
__device__ __forceinline__ f32x4 i2f(const f32x4& a) { return __builtin_convertvector(__builtin_bit_cast(i32x4, a), f32x4); }
__device__ __forceinline__ float shx(float v, int k, int lane) { return __int_as_float(__builtin_amdgcn_ds_bpermute((lane ^ k) << 2, __float_as_int(v))); }
__device__ __forceinline__ unsigned bpx(unsigned v, int src_lane) { return (unsigned)__builtin_amdgcn_ds_bpermute(src_lane << 2, (int)v); }
__device__ __forceinline__ int opaque_tid() { int t = threadIdx.x; asm volatile("" : "+v"(t)); return t; }
__device__ __forceinline__ int opaque_bid() { int t = blockIdx.x; asm volatile("" : "+s"(t)); return t; }

namespace pg8 {
constexpr int BM = 256, BK = 64, HALF = 128, HTB = HALF * BK * 2, STAGE_BYTES = 8 * HTB, NXCD = 8, WGM = 8;
__host__ __device__ __forceinline__ int lds_byte(int r, int c) { const int st = (r >> 4) * 2 + (c >> 5), rr = r & 15, cc = c & 31, ob = rr * 64 + cc * 2; return st * 1024 + (ob ^ (((ob >> 9) & 1) << 5)); }
__host__ __device__ __forceinline__ void stage_rc(unsigned b, int& R, int& C) { const unsigned st = b >> 10, sb = b & 1023u, swz = sb ^ (((sb >> 9) & 1u) << 5); R = (int)((st >> 1) * 16u + (swz >> 6)); C = (int)((st & 1u) * 32u + ((swz & 63u) >> 1)); }
__host__ __device__ __forceinline__ int perm32(int rho) { const int n = rho >> 4, i = rho & 15; return 8 * (i >> 2) + 4 * n + (i & 3); }

struct Unit { int pm, pn, e, rows; };

struct StaticOrder {
    int nM, nN, nwg, G, c;
    __device__ void init(int M, int N, int G_, int c_) { nM = M / BM; nN = N / BM; nwg = nM * nN; G = G_; c = c_; }
    __device__ bool next(int i, Unit& u) const {
        const long L = (long)i * G + c; if (L >= nwg) return false;
        int wgid = (int)L; { const int q = nwg / NXCD, r = nwg % NXCD, xcd = wgid % NXCD, off = wgid / NXCD; wgid = (xcd < r ? xcd * (q + 1) : r * (q + 1) + (xcd - r) * q) + off; }
        const int nig = WGM * nN, gid = wgid / nig, fm = gid * WGM, gsz = (nM - fm) < WGM ? (nM - fm) : WGM;
        u.pm = fm + ((wgid % nig) % gsz); u.pn = (wgid % nig) / gsz; u.e = 0; u.rows = BM; return true;
    }
};

struct GroupedOrder {
    const LAS int* prefix; const LAS int* cnt; int G, v;
    __device__ bool next(int i, Unit& u) const {
        const int L = i * G + v; const int total = prefix[NEXP];
        if (L >= total * 4) return false;
        const int rt = L >> 2; int e = 0;
#pragma unroll 1
        for (int j = 1; j < NEXP; ++j) if (prefix[j] <= rt) e = j;
        u.e = e; u.pm = rt - prefix[e]; u.pn = L & 3; const int rem = cnt[e] - u.pm * BM; u.rows = rem < BM ? rem : BM; return true;
    }
};

template <class G, class Epi, class Sched>
__device__ __forceinline__ void gemm_phase(LAS unsigned char* lds, const G g, const Sched& S, const Epi& E) {
    int tid = threadIdx.x; asm volatile("" : "+v"(tid));
    const int wid = __builtin_amdgcn_readfirstlane(tid >> 6), lane = tid & 63, wr = wid >> 2, wc = wid & 3, fr = lane & 15, fq = lane >> 4;
    const int K = g.K, KB = K * G::ES, nt = KB / (BK * 2);
    unsigned voffB[2];
#pragma unroll
    for (int i = 0; i < 2; ++i) { int R, C; stage_rc(tid * 16 + i * 8192, R, C); const int Rb = Epi::PERM ? ((R & ~31) + perm32(R & 31)) : R;
        voffB[i] = (unsigned)(Rb * KB + C * 2); }
#define PG8_AOFF(u, i, h) ({ int t_ = tid; asm volatile("" : "+v"(t_)); int R_, C_; stage_rc((unsigned)t_ * 16u + (i) * 8192u, R_, C_); g.a_off(u, (h) * HALF + R_, C_); })
    const size_t kstep = (size_t)(BK * 2);
    const size_t hstep = (size_t)HALF * KB;
    const unsigned ldsw = (unsigned)wid * 1024u;
    const int aoff = lds_byte(wr * 64 + fr, fq * 8), boff = lds_byte(wc * 32 + fr, fq * 8);
#define PG8_SA(b, h) (((b) * 2 + (h)) * HTB)
#define PG8_SB(b, h) ((4 + (b) * 2 + (h)) * HTB)
#define PG8_STAGE2(bufoff, gbase, o0, o1) do { \
        __builtin_amdgcn_global_load_lds((const unsigned*)((const char*)(gbase) + (o0)), (LAS unsigned*)(lds + (bufoff) + ldsw), 16, 0, 0); \
        __builtin_amdgcn_global_load_lds((const unsigned*)((const char*)(gbase) + (o1)), (LAS unsigned*)(lds + (bufoff) + ldsw + 8192), 16, 0, 0); } while (0)
#define PG8_STAGEB(bufoff, gbase) PG8_STAGE2(bufoff, gbase, voffB[0], voffB[1])
#define PG8_LDA(dst, b, h) do { _Pragma("unroll") for (int m = 0; m < 4; ++m) _Pragma("unroll") for (int k = 0; k < 2; ++k) dst[m][k] = *(const LAS bf16x8*)(lds + PG8_SA(b, h) + aoff + m * 2048 + k * 1024); } while (0)
#define PG8_LDB(dst, b, h) do { _Pragma("unroll") for (int n = 0; n < 2; ++n) _Pragma("unroll") for (int k = 0; k < 2; ++k) dst[n][k] = *(const LAS bf16x8*)(lds + PG8_SB(b, h) + boff + n * 2048 + k * 1024); } while (0)
#define PG8_F8(v0, v1) __builtin_shufflevector(__builtin_bit_cast(i32x4, v0), __builtin_bit_cast(i32x4, v1), 0, 1, 2, 3, 4, 5, 6, 7)
#define PG8_MMA(ai, bj, At, Bt) do { __builtin_amdgcn_s_setprio(1); \
        if (G::MODE == 1) { const i32x8 a0_ = PG8_F8(At[0][0], At[0][1]), a1_ = PG8_F8(At[1][0], At[1][1]), a2_ = PG8_F8(At[2][0], At[2][1]), a3_ = PG8_F8(At[3][0], At[3][1]), b0_ = PG8_F8(Bt[0][0], Bt[0][1]), b1_ = PG8_F8(Bt[1][0], Bt[1][1]); \
            asm volatile("s_nop 1\n\tv_mfma_f32_16x16x128_f8f6f4 %0, %12, %8, %0\n\tv_mfma_f32_16x16x128_f8f6f4 %1, %13, %8, %1\n\tv_mfma_f32_16x16x128_f8f6f4 %2, %12, %9, %2\n\tv_mfma_f32_16x16x128_f8f6f4 %3, %13, %9, %3\n\t" \
                         "v_mfma_f32_16x16x128_f8f6f4 %4, %12, %10, %4\n\tv_mfma_f32_16x16x128_f8f6f4 %5, %13, %10, %5\n\tv_mfma_f32_16x16x128_f8f6f4 %6, %12, %11, %6\n\tv_mfma_f32_16x16x128_f8f6f4 %7, %13, %11, %7" \
                         : "+v"(acc[ai][bj][0][0]), "+v"(acc[ai][bj][0][1]), "+v"(acc[ai][bj][1][0]), "+v"(acc[ai][bj][1][1]), "+v"(acc[ai][bj][2][0]), "+v"(acc[ai][bj][2][1]), "+v"(acc[ai][bj][3][0]), "+v"(acc[ai][bj][3][1]) \
                         : "v"(a0_), "v"(a1_), "v"(a2_), "v"(a3_), "v"(b0_), "v"(b1_)); } \
        else if (G::MODE == 2) { _Pragma("unroll") for (int m = 0; m < 4; ++m) _Pragma("unroll") for (int n = 0; n < 2; ++n) _Pragma("unroll") for (int k = 0; k < 2; ++k) \
            acc[ai][bj][m][n] = __builtin_bit_cast(f32x4, __builtin_amdgcn_mfma_i32_16x16x64_i8(__builtin_bit_cast(i32x4, Bt[n][k]), __builtin_bit_cast(i32x4, At[m][k]), __builtin_bit_cast(i32x4, acc[ai][bj][m][n]), 0, 0, 0)); } \
        else { _Pragma("unroll") for (int m = 0; m < 4; ++m) _Pragma("unroll") for (int n = 0; n < 2; ++n) _Pragma("unroll") for (int k = 0; k < 2; ++k) \
            acc[ai][bj][m][n] = __builtin_amdgcn_mfma_f32_16x16x32_bf16(Bt[n][k], At[m][k], acc[ai][bj][m][n], 0, 0, 0); } __builtin_amdgcn_s_setprio(0); } while (0)
#define PG8_WAIT_V(n) asm volatile("s_waitcnt vmcnt(" #n ")" ::: "memory")
#define PG8_WAIT_L(n) asm volatile("s_waitcnt lgkmcnt(" #n ")" ::: "memory")
#define PG8_BAR __builtin_amdgcn_s_barrier()
#define PG8_SCHED __builtin_amdgcn_sched_barrier(0)
    Unit cur, nxt; int ui = 0;
    if (!S.next(0, cur)) return;
    LAS u32x2* const tab = (LAS u32x2*)(lds + STAGE_BYTES + 1024);
#define PG8_TABLE(u, par) do { if (G::TABLE) { if (wid < 2) { const unsigned long long ts_ = (unsigned long long)g.tab_src(u, wid); \
        const char* tb_ = (const char*)(((unsigned long long)(unsigned)__builtin_amdgcn_readfirstlane((int)(ts_ >> 32)) << 32) | (unsigned)__builtin_amdgcn_readfirstlane((int)ts_));     \
        unsigned lo_ = (unsigned)lane * 16u; asm volatile("" : "+v"(lo_));     \
        __builtin_amdgcn_global_load_lds((const unsigned*)(tb_ + lo_), (LAS unsigned*)((LAS unsigned char*)tab + (par) * 2048 + wid * 1024), 16, 0, 0); } } } while (0)
    PG8_TABLE(cur, 0);
    f32x4 acc[2][2][4][2];
#pragma unroll
    for (int a = 0; a < 2; ++a)
#pragma unroll
        for (int b = 0; b < 2; ++b)
#pragma unroll
            for (int m = 0; m < 4; ++m)
#pragma unroll
                for (int n = 0; n < 2; ++n) acc[a][b][m][n] = (f32x4){0.f, 0.f, 0.f, 0.f};
    bf16x8 At[4][2], B0[2][2], B1[2][2];
    const char* cA = g.a_base(cur); const char* cB = g.b_base(cur);
    unsigned c00 = PG8_AOFF(cur, 0, 0), c01 = PG8_AOFF(cur, 1, 0), c10 = PG8_AOFF(cur, 0, 1), c11 = PG8_AOFF(cur, 1, 1);
    PG8_STAGEB(PG8_SB(0, 0), cB); PG8_STAGEB(PG8_SB(0, 1), cB + hstep); PG8_STAGE2(PG8_SA(0, 0), cA, c00, c01); PG8_STAGE2(PG8_SA(0, 1), cA, c10, c11);
    if (wr == 1) PG8_BAR;
    PG8_WAIT_V(2); PG8_BAR;
    PG8_STAGEB(PG8_SB(1, 0), cB + kstep); PG8_STAGE2(PG8_SA(1, 0), cA + kstep, c00, c01); PG8_STAGEB(PG8_SB(1, 1), cB + hstep + kstep);
    PG8_WAIT_V(6); PG8_BAR;
    for (;;) {
        const bool has_next = S.next(ui + 1, nxt);
        const char* nA = has_next ? g.a_base(nxt) : cA; const char* nB = has_next ? g.b_base(nxt) : cB;
        unsigned n00 = c00, n01 = c01, n10 = c10, n11 = c11;
        if (G::GATHER && has_next) { n00 = PG8_AOFF(nxt, 0, 0); n01 = PG8_AOFF(nxt, 1, 0); n10 = PG8_AOFF(nxt, 0, 1); n11 = PG8_AOFF(nxt, 1, 1); }
#pragma unroll 1
        for (int t = 0; t < nt; t += 2) {
            const bool last = (t == nt - 2);
            const char* a1 = cA + (size_t)(t + 1) * kstep;
            const char* a2 = last ? nA : cA + (size_t)(t + 2) * kstep; const char* b2 = last ? nB : cB + (size_t)(t + 2) * kstep;
            const char* a3 = a2 + kstep; const char* b3 = b2 + kstep;
            const unsigned x00 = last ? n00 : c00, x01 = last ? n01 : c01, x10 = last ? n10 : c10, x11 = last ? n11 : c11;
            PG8_LDB(B0, 0, 0); PG8_LDB(B1, 0, 1); PG8_SCHED; PG8_LDA(At, 0, 0); PG8_STAGE2(PG8_SA(1, 1), a1, c10, c11);
            PG8_WAIT_V(8); PG8_WAIT_L(0); PG8_BAR; PG8_MMA(0, 0, At, B0); PG8_MMA(0, 1, At, B1); PG8_BAR; PG8_SCHED;
            PG8_LDA(At, 0, 1); PG8_STAGEB(PG8_SB(0, 0), b2); PG8_STAGEB(PG8_SB(0, 1), b2 + hstep); PG8_STAGE2(PG8_SA(0, 0), a2, x00, x01);
            PG8_WAIT_V(8); PG8_WAIT_L(0); PG8_BAR; PG8_MMA(1, 0, At, B0); PG8_MMA(1, 1, At, B1); PG8_BAR; PG8_SCHED;
            PG8_LDB(B0, 1, 0); PG8_LDB(B1, 1, 1); PG8_SCHED; PG8_LDA(At, 1, 0); PG8_STAGE2(PG8_SA(0, 1), a2, x10, x11);
            PG8_WAIT_V(8); PG8_WAIT_L(0); PG8_BAR; PG8_MMA(0, 0, At, B0); PG8_MMA(0, 1, At, B1); PG8_BAR; PG8_SCHED;
            PG8_LDA(At, 1, 1); PG8_STAGEB(PG8_SB(1, 0), b3); PG8_STAGEB(PG8_SB(1, 1), b3 + hstep); PG8_STAGE2(PG8_SA(1, 0), a3, x00, x01);
            PG8_WAIT_V(8); PG8_WAIT_L(0); PG8_BAR; PG8_MMA(1, 0, At, B0); PG8_MMA(1, 1, At, B1); PG8_BAR; PG8_SCHED;
        }
        if (G::MODE == 1) asm volatile("s_nop 15\n\ts_nop 15" ::: "memory");
        if (wr == 0) PG8_BAR;
        E(acc, cur, wr, wc, fr, fq, tab + (ui & 1) * 256);
        if (!has_next) break;
#pragma unroll
        for (int a = 0; a < 2; ++a)
#pragma unroll
            for (int b = 0; b < 2; ++b)
#pragma unroll
                for (int m = 0; m < 4; ++m)
#pragma unroll
                    for (int n = 0; n < 2; ++n) acc[a][b][m][n] = (f32x4){0.f, 0.f, 0.f, 0.f};
        cur = nxt; cA = nA; cB = nB; c00 = n00; c01 = n01; c10 = n10; c11 = n11; ++ui;
        PG8_TABLE(cur, ui & 1);
        if (wr == 1) PG8_BAR;
    }
    PG8_WAIT_V(0);
    PG8_BAR;
#undef PG8_TABLE
#undef PG8_AOFF
#undef PG8_SA
#undef PG8_SB
#undef PG8_STAGE2
#undef PG8_STAGEB
#undef PG8_LDA
#undef PG8_LDB
#undef PG8_MMA
#undef PG8_F8
#undef PG8_WAIT_V
#undef PG8_WAIT_L
#undef PG8_BAR
#undef PG8_SCHED
}
}
using pg8::Unit;

template <int MODE_>
struct DenseGemmT {
    static constexpr bool GATHER = false, TABLE = MODE_ == 2; static constexpr int MODE = MODE_, ES = MODE_ == 0 ? 2 : 1;
    const void* A; const void* Bt; int K; const float* sA; const float* sB;
    __device__ __forceinline__ const char* tab_src(const Unit& u, int w) const { return (const char*)(w == 0 ? sA + u.pm * 256 : sB + u.pn * 256); }
    __device__ __forceinline__ const char* a_base(const Unit& u) const { return (const char*)A + (size_t)u.pm * 256 * K * ES; }
    __device__ __forceinline__ const char* b_base(const Unit& u) const { return (const char*)Bt + (size_t)u.pn * 256 * K * ES; }
    __device__ __forceinline__ unsigned a_off(const Unit&, int r, int c) const { return (unsigned)(r * K * ES + c * 2); }
};
typedef DenseGemmT<0> DenseGemm;
typedef DenseGemmT<2> DenseGemmI8;
typedef DenseGemmT<1> DenseGemm8;
struct GatherGemm {
    static constexpr bool GATHER = true, TABLE = true; static constexpr int MODE = 1, ES = 1;
    const unsigned char* A; const unsigned char* Bt; const u32x2* list; int K; int a_shift;
    size_t b_expert_stride;
    __device__ __forceinline__ const char* tab_src(const Unit& u, int w) const { return (const char*)(list + (size_t)u.e * NTOK + u.pm * 256) + w * 1024; }
    __device__ __forceinline__ const char* a_base(const Unit&) const { return (const char*)A; }
    __device__ __forceinline__ const char* b_base(const Unit& u) const { return (const char*)Bt + (size_t)u.e * b_expert_stride + (size_t)u.pn * 256 * K; }
    __device__ __forceinline__ unsigned a_off(const Unit& u, int r, int c) const {
        const int rr = r < u.rows ? r : u.rows - 1;
        const int slot = (int)list[(size_t)u.e * NTOK + u.pm * 256 + rr].x;
        return (unsigned)((slot >> a_shift) * K + c * 2);
    }
};


struct EpiIn {
    static constexpr bool PERM = true;
    bf16_t* U; bf16_t* Qf; bf16_t* Kf; const LAS float* gl;
    __device__ __forceinline__ void operator()(const f32x4 (&acc)[2][2][4][2], const Unit& u, int wr, int wc, int fr, int fq, const LAS u32x2* tab) const {
        const LAS float* tf = (const LAS float*)tab;
        const int cix = 256 + wc * 32 + fq * 8;
        if (u.pn < 2) {
#pragma unroll
            for (int ai = 0; ai < 2; ++ai)
#pragma unroll
                for (int m = 0; m < 4; ++m) {
                    int z = 0; asm volatile("" : "+v"(z));
                    const int r = ai * 128 + wr * 64 + m * 16 + fr;
                    const float rr = tf[r + z];
                    const int row = u.pm * 256 + r;
#pragma unroll
                    for (int bj = 0; bj < 2; ++bj) {
                        const f32x4 c0 = *(const LAS f32x4*)(tf + cix + bj * 128 + z), c1 = *(const LAS f32x4*)(tf + cix + bj * 128 + 4 + z);
                        const f32x4 v0 = i2f(acc[ai][bj][m][0]) * c0 * rr, v1 = i2f(acc[ai][bj][m][1]) * c1 * rr;
                        u32x4 w; w.x = cvtpk(v0[0], v0[1]); w.y = cvtpk(v0[2], v0[3]); w.z = cvtpk(v1[0], v1[1]); w.w = cvtpk(v1[2], v1[3]);
                        *(u32x4*)(U + (size_t)row * 512 + u.pn * 256 + bj * 128 + wc * 32 + fq * 8) = w;
                    }
                }
        } else {
            const bool isq = u.pn < 4;
            bf16_t* dst = isq ? Qf : Kf;
            const LAS float* gg = gl + (isq ? 0 : 64) + fq * 8;
            const int head = (u.pn & 1) * 4 + wc;
#pragma unroll
            for (int ai = 0; ai < 2; ++ai)
#pragma unroll
                for (int m = 0; m < 4; ++m) {
                    int z = 0; asm volatile("" : "+v"(z));
                    const int r = ai * 128 + wr * 64 + m * 16 + fr;
                    const float rr = tf[r + z];
                    f32x4 val[2][2];
                    float ss = 0.f;
#pragma unroll
                    for (int bj = 0; bj < 2; ++bj)
#pragma unroll
                        for (int n = 0; n < 2; ++n) { const f32x4 v = i2f(acc[ai][bj][m][n]) * *(const LAS f32x4*)(tf + cix + bj * 128 + n * 4 + z); val[bj][n] = v; ss += (v[0] * v[0] + v[1] * v[1]) + (v[2] * v[2] + v[3] * v[3]); }
                    ss += shx(ss, 16, fq * 16 + fr); ss += shx(ss, 32, fq * 16 + fr);
                    const float rstd = rsqrtf(ss * (rr * rr) * (1.0f / 64.0f) + EPS) * rr;
                    const int row = u.pm * 256 + r;
                    const int b = row >> 13, s = row & (SEQ - 1), rb = s >> 5, r32 = s & 31;
#pragma unroll
                    for (int bj = 0; bj < 2; ++bj) {
                        const f32x4 v0 = val[bj][0] * rstd * *(const LAS f32x4*)(gg + bj * 32 + z), v1 = val[bj][1] * rstd * *(const LAS f32x4*)(gg + bj * 32 + 4 + z);
                        u32x4 w; w.x = cvtpk(v0[0], v0[1]); w.y = cvtpk(v0[2], v0[3]); w.z = cvtpk(v1[0], v1[1]); w.w = cvtpk(v1[2], v1[3]);
                        const int d0 = 2 * bj + (fq >> 1), hi = fq & 1;
                        const size_t piece = (((size_t)(b * NHEAD + head) * 256 + rb) * 4 + d0);
                        *(u32x4*)(dst + (piece * 64 + hi * 32 + r32) * 8) = w;
                    }
                }
        }
    }
};

struct EpiVt {
    static constexpr bool PERM = true;
    bf16_t* Vf;
    __device__ __forceinline__ void operator()(const f32x4 (&acc)[2][2][4][2], const Unit& u, int wr, int wc, int fr, int fq, const LAS u32x2* tab) const {
        const LAS float* tf = (const LAS float*)tab;
        f32x4 rv[2][2];
#pragma unroll
        for (int bj = 0; bj < 2; ++bj)
#pragma unroll
            for (int n = 0; n < 2; ++n) rv[bj][n] = *(const LAS f32x4*)(tf + 256 + bj * 128 + wc * 32 + fq * 8 + n * 4);
#pragma unroll
        for (int ai = 0; ai < 2; ++ai)
#pragma unroll
            for (int m = 0; m < 4; ++m) {
                const int r = ai * 128 + wr * 64 + m * 16 + fr;
                const float cc = tf[r];
                const int hd = u.pm * 256 + r;
                const int head = hd >> 6, dblk = (hd >> 5) & 1, dl = hd & 31;
#pragma unroll
                for (int bj = 0; bj < 2; ++bj) {
                    const int tok0 = u.pn * 256 + bj * 128 + wc * 32;
                    const int b = tok0 >> 13, kb = (tok0 & (SEQ - 1)) >> 5;
                    const size_t piece = ((((size_t)(b * NHEAD + head) * 256 + kb) * 2 + (fq >> 1)) * 2 + dblk);
                    u32x2 w[2];
#pragma unroll
                    for (int n = 0; n < 2; ++n) { const f32x4 v = i2f(acc[ai][bj][m][n]) * rv[bj][n] * cc; w[n].x = cvtpk(v[0], v[1]); w[n].y = cvtpk(v[2], v[3]); }
                    const int odd = fq & 1, partner = (fq ^ 1) * 16 + fr;
                    const u32x2 snd = odd ? w[0] : w[1];
                    u32x2 rcv; rcv.x = bpx(snd.x, partner); rcv.y = bpx(snd.y, partner);
                    u32x4 o4; if (odd) { o4.x = rcv.x; o4.y = rcv.y; o4.z = w[1].x; o4.w = w[1].y; } else { o4.x = w[0].x; o4.y = w[0].y; o4.z = rcv.x; o4.w = rcv.y; }
                    *(u32x4*)((char*)Vf + (piece * 64 + odd * 32 + dl) * 16) = o4;
                }
            }
    }
};

template <bool XF>
struct EpiOutB {
    static constexpr bool PERM = true;
    const float* xf; bf16_t* XB; const float* g1; float* ssq;
    __device__ __forceinline__ void operator()(const f32x4 (&acc)[2][2][4][2], const Unit& u, int wr, int wc, int fr, int fq, const LAS u32x2* tab) const {
        const int b = (u.pm * 256) >> 13;
        const int col0 = u.pn * 256 + wc * 32 + 8 * fq;
        f32x4 gv[2][2];
#pragma unroll
        for (int bj = 0; bj < 2; ++bj)
#pragma unroll
            for (int n = 0; n < 2; ++n) gv[bj][n] = *(const f32x4*)(g1 + (size_t)b * 6144 + col0 + bj * 128 + n * 4) * (1.0f / 4096.0f);
        float keep = 0.f;
#pragma unroll
        for (int ai = 0; ai < 2; ++ai)
#pragma unroll
            for (int m = 0; m < 4; ++m) {
                const int row = u.pm * 256 + ai * 128 + wr * 64 + m * 16 + fr;
                const size_t off = (size_t)row * DM + col0;
                f32x4 xb[2][2];
                if (XF) {
#pragma unroll
                    for (int bj = 0; bj < 2; ++bj) { xb[bj][0] = *(const f32x4*)(xf + off + bj * 128); xb[bj][1] = *(const f32x4*)(xf + off + bj * 128 + 4); }
                } else {
#pragma unroll
                    for (int bj = 0; bj < 2; ++bj) { const u32x4 w = *(const u32x4*)(XB + off + bj * 128);
                        xb[bj][0] = (f32x4){bf_lo(w.x), bf_hi(w.x), bf_lo(w.y), bf_hi(w.y)}; xb[bj][1] = (f32x4){bf_lo(w.z), bf_hi(w.z), bf_lo(w.w), bf_hi(w.w)}; }
                }
                float ss = 0.f;
#pragma unroll
                for (int bj = 0; bj < 2; ++bj) {
                    const f32x4 x0 = xb[bj][0] + gv[bj][0] * acc[ai][bj][m][0], x1 = xb[bj][1] + gv[bj][1] * acc[ai][bj][m][1];
                    u32x4 w; w.x = cvtpk(x0[0], x0[1]); w.y = cvtpk(x0[2], x0[3]); w.z = cvtpk(x1[0], x1[1]); w.w = cvtpk(x1[2], x1[3]);
                    *(u32x4*)(XB + off + bj * 128) = w;
                    const float r0 = bf_lo(w.x), r1 = bf_hi(w.x), r2 = bf_lo(w.y), r3 = bf_hi(w.y), r4 = bf_lo(w.z), r5 = bf_hi(w.z), r6 = bf_lo(w.w), r7 = bf_hi(w.w);
                    ss += ((r0 * r0 + r1 * r1) + (r2 * r2 + r3 * r3)) + ((r4 * r4 + r5 * r5) + (r6 * r6 + r7 * r7));
                }
                ss += shx(ss, 16, fq * 16 + fr); ss += shx(ss, 32, fq * 16 + fr);
                if (fq == m) keep = ss;
                if (m == 3) ssq[(size_t)(u.pn * 4 + wc) * NTOK + u.pm * 256 + ai * 128 + wr * 64 + fq * 16 + fr] = keep;
            }
    }
};

struct EpiGU {
    static constexpr bool PERM = true;
    unsigned char* ACT;
    __device__ __forceinline__ void operator()(const f32x4 (&acc)[2][2][4][2], const Unit& u, int wr, int wc, int fr, int fq, const LAS u32x2* tab) const {
        constexpr float SI = 1.0f / 2048.0f;
        const int odd = fq & 1, partner = (fq ^ 1) * 16 + fr;
#pragma unroll
        for (int ai = 0; ai < 2; ++ai)
#pragma unroll
            for (int mp = 0; mp < 2; ++mp) {
                u32x2 w[2];
#pragma unroll
                for (int h = 0; h < 2; ++h) {
                    const int m = 2 * mp + h;
                    float o[8];
#pragma unroll
                    for (int n = 0; n < 2; ++n)
#pragma unroll
                        for (int e = 0; e < 4; ++e) { const float gte = acc[ai][0][m][n][e] * SI, up = acc[ai][1][m][n][e] * (4.0f * SI);
                            o[n * 4 + e] = clamp8(gte * fast_rcp(1.0f + fast_exp2(-gte * LOG2E)) * up); }
                    w[h].x = pk_fp8x4(o[0], o[1], o[2], o[3]); w[h].y = pk_fp8x4(o[4], o[5], o[6], o[7]);
                }
                const u32x2 snd = odd ? w[0] : w[1];
                u32x2 rcv; rcv.x = bpx(snd.x, partner); rcv.y = bpx(snd.y, partner);
                const int r = ai * 128 + wr * 64 + (2 * mp + odd) * 16 + fr;
                const int slot = (int)tab[r].x;
                u32x4 o4; if (odd) { o4.x = rcv.x; o4.y = rcv.y; o4.z = w[1].x; o4.w = w[1].y; } else { o4.x = w[0].x; o4.y = w[0].y; o4.z = rcv.x; o4.w = rcv.y; }
                if (r < u.rows) *(u32x4*)(ACT + (size_t)slot * DEXP + u.pn * 128 + wc * 32 + (fq & 2) * 8) = o4;
            }
    }
};

struct EpiDn {
    static constexpr bool PERM = true;
    unsigned char* Y8;
    __device__ __forceinline__ void operator()(const f32x4 (&acc)[2][2][4][2], const Unit& u, int wr, int wc, int fr, int fq, const LAS u32x2* tab) const {
        const int odd = fq & 1, partner = (fq ^ 1) * 16 + fr;
#pragma unroll
        for (int ai = 0; ai < 2; ++ai)
#pragma unroll
            for (int m = 0; m < 4; ++m) {
                const int r = ai * 128 + wr * 64 + m * 16 + fr;
                const u32x2 en = tab[r];
                const int slot = (int)en.x;
                const float w8 = __uint_as_float(en.y) * (16.0f / 1024.0f);
                u32x2 w[2];
#pragma unroll
                for (int bj = 0; bj < 2; ++bj) {
                    const f32x4 v0 = acc[ai][bj][m][0] * w8, v1 = acc[ai][bj][m][1] * w8;
                    w[bj].x = pk_fp8x4(v0[0], v0[1], v0[2], v0[3]); w[bj].y = pk_fp8x4(v1[0], v1[1], v1[2], v1[3]);
                }
                const u32x2 snd = odd ? w[0] : w[1];
                u32x2 rcv; rcv.x = bpx(snd.x, partner); rcv.y = bpx(snd.y, partner);
                u32x4 o4; if (odd) { o4.x = rcv.x; o4.y = rcv.y; o4.z = w[1].x; o4.w = w[1].y; } else { o4.x = w[0].x; o4.y = w[0].y; o4.z = rcv.x; o4.w = rcv.y; }
                if (r < u.rows) *(u32x4*)(Y8 + (size_t)slot * DM + u.pn * 256 + odd * 128 + wc * 32 + (fq & 2) * 8) = o4;
            }
    }
};

struct TItem { const float* src; unsigned char* dst; int N, dstK, koff, k0, n0, map, f8; };
__device__ __forceinline__ int t_rowmap(int map, int n) {
    if (map == 0) return n;
    if (map == 1) { if (n < 512 || n >= 1536) return n; const int t = n & 255, wc = t >> 6, bj = (t >> 5) & 1, c = t & 31; return (n & ~255) + 128 * bj + 32 * wc + c; }
    return 256 * (n >> 7) + 128 * (map - 2) + (n & 127);
}
__device__ __forceinline__ void t_load(const TItem& d, f32x4 (&v)[16], int lane) {
    const int kr = lane >> 4, c4 = lane & 15;
#pragma unroll
    for (int i = 0; i < 16; ++i) v[i] = *(const f32x4*)(d.src + (size_t)(d.k0 + 4 * i + kr) * d.N + d.n0 + 4 * c4);
}
__device__ __forceinline__ void t_process(const TItem& d, const f32x4 (&v)[16], LAS float* scr, int lane) {
    const int kr = lane >> 4, c4 = lane & 15;
#pragma unroll
    for (int i = 0; i < 16; ++i) { LAS float* s = scr + (4 * i + kr) * 65 + 4 * c4; s[0] = v[i][0]; s[1] = v[i][1]; s[2] = v[i][2]; s[3] = v[i][3]; }
    asm volatile("s_waitcnt lgkmcnt(0)" ::: "memory");
    if (d.f8) {
        const int nr = lane >> 2, kc = lane & 3;
#pragma unroll
        for (int i = 0; i < 4; ++i) { const int n = 16 * i + nr; const LAS float* s = scr + (16 * kc) * 65 + n;
            const size_t eo = (size_t)t_rowmap(d.map, d.n0 + n) * d.dstK + d.koff + d.k0 + 16 * kc;
            u32x4 o;
            if (d.f8 == 2) { o.x = pk_i8x4(s[0], s[65], s[2 * 65], s[3 * 65]); o.y = pk_i8x4(s[4 * 65], s[5 * 65], s[6 * 65], s[7 * 65]);
                o.z = pk_i8x4(s[8 * 65], s[9 * 65], s[10 * 65], s[11 * 65]); o.w = pk_i8x4(s[12 * 65], s[13 * 65], s[14 * 65], s[15 * 65]); }
            else { o.x = pk_fp8x4(s[0] * 256.0f, s[65] * 256.0f, s[2 * 65] * 256.0f, s[3 * 65] * 256.0f); o.y = pk_fp8x4(s[4 * 65] * 256.0f, s[5 * 65] * 256.0f, s[6 * 65] * 256.0f, s[7 * 65] * 256.0f);
                o.z = pk_fp8x4(s[8 * 65] * 256.0f, s[9 * 65] * 256.0f, s[10 * 65] * 256.0f, s[11 * 65] * 256.0f); o.w = pk_fp8x4(s[12 * 65] * 256.0f, s[13 * 65] * 256.0f, s[14 * 65] * 256.0f, s[15 * 65] * 256.0f); }
            *(u32x4*)(d.dst + eo) = o; }
    } else {
        const int nr = lane >> 3, kc = lane & 7;
#pragma unroll
        for (int i = 0; i < 8; ++i) { const int n = 8 * i + nr; const LAS float* s = scr + (8 * kc) * 65 + n;
            const size_t eo = (size_t)t_rowmap(d.map, d.n0 + n) * d.dstK + d.koff + d.k0 + 8 * kc;
            u32x4 o; o.x = cvtpk(s[0], s[65]); o.y = cvtpk(s[2 * 65], s[3 * 65]); o.z = cvtpk(s[4 * 65], s[5 * 65]); o.w = cvtpk(s[6 * 65], s[7 * 65]);
            *(u32x4*)(d.dst + eo * 2) = o; }
    }
    asm volatile("s_waitcnt lgkmcnt(0)" ::: "memory");
}
constexpr int T_OUT = 128, T_GU = NEXP * 256, T_DN = NEXP * 128;
constexpr int SIDE_GU0 = 2048, SIDE_CC_GU = 160, SIDE_CC_DN = 90;
constexpr int T_NA = 2 * T_OUT + T_GU, T_NB = T_DN + T_GU + T_DN;
__device__ __forceinline__ void t_item_out(const Params& p, int l, int r, TItem& d) {
    d.src = p.in[12] + ((size_t)l * 1024 + 512) * 1024; d.N = 1024; d.f8 = 1; d.dst = p.ws + WS_WOUT + (size_t)l * 1024 * 1024; d.dstK = 1024; d.koff = 512; d.k0 = (r >> 4) * 64; d.n0 = (r & 15) * 64; d.map = 0;
}
__device__ __forceinline__ void t_item_gu(const Params& p, int l, int j, TItem& d) {
    const int e = j >> 8; int q = j & 255; const int up = q >> 7; q &= 127;
    d.src = (up ? p.in[18] : p.in[17]) + ((size_t)l * NEXP + e) * 1024 * 512; d.N = 512; d.f8 = 1; d.dst = p.ws + WS_WGU + ((size_t)l * NEXP + e) * 1024 * 1024; d.dstK = 1024; d.koff = 0; d.k0 = (q >> 3) * 64; d.n0 = (q & 7) * 64; d.map = 2 + up;
}
__device__ __forceinline__ void t_item_dn(const Params& p, int l, int j, TItem& d) {
    const int e = j >> 7, q = j & 127;
    d.src = p.in[19] + ((size_t)l * NEXP + e) * 512 * 1024; d.N = 1024; d.f8 = 1; d.dst = p.ws + WS_WD + ((size_t)l * NEXP + e) * 1024 * 512; d.dstK = 512; d.koff = 0; d.k0 = (q >> 4) * 64; d.n0 = (q & 15) * 64; d.map = 0;
}
template <bool SPACE_B>
__device__ __forceinline__ void t_decode(const Params& p, int it, TItem& d) {
    if (SPACE_B) { if (it < T_DN) t_item_dn(p, 0, it, d); else if (it < T_DN + T_GU) t_item_gu(p, 1, it - T_DN, d); else t_item_dn(p, 1, it - T_DN - T_GU, d); }
    else { if (it < T_OUT) t_item_out(p, 0, it, d); else if (it < 2 * T_OUT) t_item_out(p, 1, it - T_OUT, d); else t_item_gu(p, 0, it - 2 * T_OUT, d); }
}
template <bool SPACE_B>
__device__ __forceinline__ void t_run(const Params& p, int it, int stride, int nit, LAS float* scr, int lane) {
    if (it >= nit) return;
    TItem dA, dB; f32x4 vA[16], vB[16];
    t_decode<SPACE_B>(p, it, dA); t_load(dA, vA, lane);
    for (;;) {
        int nx = it + stride; const bool hasB = nx < nit;
        if (hasB) { t_decode<SPACE_B>(p, nx, dB); t_load(dB, vB, lane); }
        t_process(dA, vA, scr, lane);
        if (!hasB) break;
        it = nx + stride; const bool hasA = it < nit;
        if (hasA) { t_decode<SPACE_B>(p, it, dA); t_load(dA, vA, lane); }
        t_process(dB, vB, scr, lane);
        if (!hasA) break;
    }
}
struct SidePlan { int gp, v, nconv, cidx; bool conv; };
__device__ __forceinline__ SidePlan side_plan(int total_units, int count) {
    const int G = gridDim.x, bid = blockIdx.x;
    SidePlan s; s.gp = G; s.v = (G % 8 == 0) ? (bid % 8) * (G / 8) + bid / 8 : bid; s.nconv = 0; s.cidx = 0; s.conv = false;
    if (G % 8 == 0 && count > 0 && total_units > 0) {
        const int rounds = (total_units + G - 1) / G, need = (total_units + rounds - 1) / rounds;
        const int cpx = (G - need) / 8, per = G / 8 - cpx;
        if (cpx > 0) { s.gp = 8 * per; s.nconv = 8 * cpx; s.conv = bid / 8 >= per; s.v = (bid % 8) * per + bid / 8; s.cidx = (bid / 8 - per) * 8 + bid % 8; }
    }
    return s;
}
__device__ __forceinline__ void side_convert(const Params& p, LAS unsigned char* lds, const LAS int* pre, int first, int count, int cc) {
    const int tid = opaque_tid(), lane = tid & 63, wave = tid >> 6, G = gridDim.x;
    const SidePlan s = side_plan(pre[NEXP] * 4, count);
    int p1 = s.nconv * cc; if (p1 > count) p1 = count;
    __syncthreads();
    LAS float* scr = (LAS float*)(lds + wave * 16640);
    if (s.conv) t_run<true>(p, first + s.cidx + s.nconv * wave, s.nconv * NWAVES, first + p1, scr, lane);
    t_run<true>(p, first + p1 + (int)blockIdx.x + G * wave, G * NWAVES, first + count, scr, lane);
    __syncthreads();
}

__device__ __forceinline__ void phase_prologue(const Params& p, LAS unsigned char* lds) {
    const int tid = opaque_tid(), lane = tid & 63, wave = tid >> 6, G = gridDim.x;
    unsigned char* ws = p.ws;
    {
        LAS float* cact = (LAS float*)lds;
        LAS float* red = (LAS float*)(lds + 16384);
        const float* c = p.in[1];
        for (int i = tid; i < 4096; i += NTHREADS) { const float v = c[i]; cact[i] = v / (1.0f + __expf(-v)); }
        __syncthreads();
        float* mod = (float*)(ws + WS_MOD);
        for (int item = blockIdx.x; item < 2 * 192; item += G) {
            const int l = item / 192, cgp = item % 192;
            const float* W = p.in[2] + (size_t)l * 1024 * 6144 + cgp * 32;
            const int c4 = lane & 7, rr = lane >> 3;
            f32x4 wv[16];
#pragma unroll
            for (int i = 0; i < 16; ++i) wv[i] = *(const f32x4*)(W + (size_t)(wave * 128 + 8 * i + rr) * 6144 + 4 * c4);
            f32x4 a[4];
#pragma unroll
            for (int bb = 0; bb < 4; ++bb) a[bb] = (f32x4){0.f, 0.f, 0.f, 0.f};
#pragma unroll
            for (int i = 0; i < 16; ++i) { const int k = wave * 128 + 8 * i + rr;
#pragma unroll
                for (int bb = 0; bb < 4; ++bb) a[bb] += wv[i] * cact[bb * 1024 + k]; }
#pragma unroll
            for (int bb = 0; bb < 4; ++bb)
#pragma unroll
                for (int e = 0; e < 4; ++e) { float s = a[bb][e]; s += shx(s, 8, lane); s += shx(s, 16, lane); s += shx(s, 32, lane); a[bb][e] = s; }
            if (lane < 8) {
#pragma unroll
                for (int bb = 0; bb < 4; ++bb) *(LAS f32x4*)(red + (wave * 4 + bb) * 32 + 4 * c4) = a[bb];
            }
            __syncthreads();
            if (tid < 128) { const int b = tid >> 5, cc = tid & 31; float s = 0.f;
#pragma unroll
                for (int w = 0; w < 8; ++w) s += red[(w * 4 + b) * 32 + cc];
                mod[(size_t)(l * 4 + b) * 6144 + cgp * 32 + cc] = s + p.in[3][l * 6144 + cgp * 32 + cc]; }
            __syncthreads();
        }
    }
    {
        float* tbl = (float*)(ws + WS_TBL);
        for (int job = blockIdx.x; job < 2; job += G) {
            const int l = job;
            LAS float* sm = (LAS float*)(lds + 32768);
            float mq = 0.f, mk = 0.f, mb = 0.f;
            if (tid < 64) { mq = fabsf(p.in[9][l * 64 + tid]); mk = fabsf(p.in[10][l * 64 + tid]); }
            for (int i = tid; i < NHEAD * 257; i += NTHREADS) mb = fmaxf(mb, fabsf(p.in[11][i]));
#pragma unroll
            for (int o = 1; o < 64; o <<= 1) { mq = fmaxf(mq, shx(mq, o, lane)); mk = fmaxf(mk, shx(mk, o, lane)); mb = fmaxf(mb, shx(mb, o, lane)); }
            if (lane == 0) { sm[wave * 4 + 0] = mq; sm[wave * 4 + 1] = mk; sm[wave * 4 + 2] = mb; }
            __syncthreads();
            mq = 0.f; mk = 0.f; mb = 0.f;
            for (int w = 0; w < 8; ++w) { mq = fmaxf(mq, sm[w * 4 + 0]); mk = fmaxf(mk, sm[w * 4 + 1]); mb = fmaxf(mb, sm[w * 4 + 2]); }
            const float shift = LOG2E * (8.0f * mq * mk + mb);
            for (int i = tid; i < NHEAD * 256; i += NTHREADS) { const int h = i >> 8, j = i & 255; int rel = j - 63; if (rel > 128) rel = 128;
                tbl[(size_t)l * 2048 + i] = (j < 255) ? p.in[11][h * 257 + rel + 128] * LOG2E - shift : 0.f; }
            __syncthreads();
        }
        for (int job = blockIdx.x; job < 2 * 48; job += G) {
            const int l = job / 48, n = job % 48;
            bf16_t* hi = (bf16_t*)(ws + WS_RW) + (size_t)l * 2 * 48 * 1024;
            bf16_t* lo = hi + 48 * 1024;
            for (int k = tid; k < 1024; k += NTHREADS) {
                float w = 0.f;
                if (n < 32) w = p.in[15][((size_t)l * 1024 + k) * 32 + n]; else if (n < 36) w = p.in[13][((size_t)l * 1024 + k) * 4 + (n - 32)];
                const unsigned h2 = cvtpk(w, 0.f) & 0xffffu; const float r = w - bf_lo(h2);
                const size_t idx = ((size_t)((k >> 5) * 3 + (n >> 4)) * 64 + ((k & 31) >> 3) * 16 + (n & 15)) * 8 + (k & 7);
                hi[idx] = (bf16_t)h2; lo[idx] = (bf16_t)(cvtpk(r, 0.f) & 0xffffu);
            }
            if (tid == 0) { float bsv = 0.f; if (n < 32) bsv = p.in[16][l * 32 + n]; else if (n < 36) bsv = p.in[14][l * 4 + (n - 32)]; ((float*)(ws + WS_RWB))[l * 48 + n] = bsv; }
        }
    }
    __syncthreads();
    {
        LAS float* wsc = (LAS float*)lds;
        LAS float* pwl = (LAS float*)(lds + 32768);
        for (int item = blockIdx.x; item < 2 * 4 * 16; item += G) {
            const int l = item >> 6, g = (item >> 4) & 3, nb = item & 15;
            const float* wo = p.in[12] + ((size_t)l * 1024 + g * 128) * 1024 + nb * 64;
            const float* sc = p.in[8] + l * 512 + g * 128;
            const float* pw = p.in[7] + ((size_t)l * 4 + g) * 128 * 128;
            for (int i = tid; i < 128 * 64; i += NTHREADS) { const int d = i >> 6, n = i & 63; wsc[i] = wo[(size_t)d * 1024 + n] * sc[d]; }
            for (int i = tid; i < 128 * 128 / 4; i += NTHREADS) *(LAS f32x4*)(pwl + 4 * i) = *(const f32x4*)(pw + 4 * i);
            __syncthreads();
            const int n = tid & 63, cgp = tid >> 6;
            float a[16];
#pragma unroll
            for (int j = 0; j < 16; ++j) a[j] = 0.f;
#pragma unroll 2
            for (int d4 = 0; d4 < 32; ++d4) {
                const float w0 = wsc[(4 * d4 + 0) * 64 + n], w1 = wsc[(4 * d4 + 1) * 64 + n], w2 = wsc[(4 * d4 + 2) * 64 + n], w3 = wsc[(4 * d4 + 3) * 64 + n];
#pragma unroll
                for (int j = 0; j < 16; ++j) { const f32x4 pv = *(const LAS f32x4*)(pwl + (cgp * 16 + j) * 128 + 4 * d4); a[j] += (pv[0] * w0 + pv[1] * w1) + (pv[2] * w2 + pv[3] * w3); }
            }
            unsigned char* dst = ws + WS_WOUT + ((size_t)l * 1024 + nb * 64 + n) * 1024 + g * 128 + cgp * 16;
#pragma unroll
            for (int j = 0; j < 16; ++j) a[j] *= 256.0f;
            u32x4 o0; o0.x = pk_fp8x4(a[0], a[1], a[2], a[3]); o0.y = pk_fp8x4(a[4], a[5], a[6], a[7]); o0.z = pk_fp8x4(a[8], a[9], a[10], a[11]); o0.w = pk_fp8x4(a[12], a[13], a[14], a[15]);
            *(u32x4*)dst = o0;
            __syncthreads();
        }
    }
    {
        LAS float* scr = (LAS float*)(lds + wave * 16640);
        LAS float* wmax = (LAS float*)(lds + 8 * 16640);
        LAS float* winv = wmax + 512;
        for (int item = blockIdx.x; item < 2 * 32; item += G) {
            const int l = item >> 5, n0 = (item & 31) * 64;
            TItem d0, d1;
            d0.src = p.in[6] + (size_t)l * 1024 * 2048; d0.N = 2048; d0.f8 = 2; d0.dst = ws + WS_WIN + (size_t)l * 2048 * 1024; d0.dstK = 1024; d0.koff = 0; d0.k0 = wave * 128; d0.n0 = n0; d0.map = 1;
            d1 = d0; d1.k0 = wave * 128 + 64;
            f32x4 v0[16], v1[16];
            t_load(d0, v0, lane); t_load(d1, v1, lane);
            f32x4 cm = {0.f, 0.f, 0.f, 0.f};
#pragma unroll
            for (int i = 0; i < 16; ++i)
#pragma unroll
                for (int e = 0; e < 4; ++e) cm[e] = fmaxf(cm[e], fmaxf(fabsf(v0[i][e]), fabsf(v1[i][e])));
#pragma unroll
            for (int e = 0; e < 4; ++e) { cm[e] = fmaxf(cm[e], shx(cm[e], 16, lane)); cm[e] = fmaxf(cm[e], shx(cm[e], 32, lane)); }
            if (lane < 16) *(LAS f32x4*)(wmax + wave * 64 + 4 * lane) = cm;
            __syncthreads();
            if (tid < 64) { float m = 0.f;
#pragma unroll
                for (int w = 0; w < 8; ++w) m = fmaxf(m, wmax[w * 64 + tid]);
                winv[tid] = m > 0.f ? 127.0f / m : 0.f;
                ((float*)(ws + WS_CS))[l * 2048 + t_rowmap(1, n0 + tid)] = m * (1.0f / 127.0f); }
            __syncthreads();
            const f32x4 iv = *(const LAS f32x4*)(winv + 4 * (lane & 15));
#pragma unroll
            for (int i = 0; i < 16; ++i) { v0[i] *= iv; v1[i] *= iv; }
            t_process(d0, v0, scr, lane); t_process(d1, v1, scr, lane);
            __syncthreads();
        }
    }
    {
        LAS float* scr = (LAS float*)(lds + wave * 16640);
        t_run<false>(p, blockIdx.x * NWAVES + wave, G * NWAVES, T_NA, scr, lane);
    }
}

typedef float f32x2v __attribute__((ext_vector_type(2)));
__device__ __forceinline__ f32x4 y_pair4(unsigned a, unsigned b) {
    const f32x2v a0 = __builtin_amdgcn_cvt_pk_f32_fp8((int)a, false), a1 = __builtin_amdgcn_cvt_pk_f32_fp8((int)a, true);
    const f32x2v b0 = __builtin_amdgcn_cvt_pk_f32_fp8((int)b, false), b1 = __builtin_amdgcn_cvt_pk_f32_fp8((int)b, true);
    f32x4 ys; ys[0] = (a0[0] + b0[0]) * 0.0625f; ys[1] = (a0[1] + b0[1]) * 0.0625f; ys[2] = (a1[0] + b1[0]) * 0.0625f; ys[3] = (a1[1] + b1[1]) * 0.0625f; return ys;
}
__device__ __forceinline__ void bf8_to_f32(const u32x4& w, f32x4& lo, f32x4& hi) { lo = (f32x4){bf_lo(w.x), bf_hi(w.x), bf_lo(w.y), bf_hi(w.y)}; hi = (f32x4){bf_lo(w.z), bf_hi(w.z), bf_lo(w.w), bf_hi(w.w)}; }
template <int NR, bool UPD> struct N1Raw { f32x4 xf[UPD ? 1 : NR][4]; u32x4 xw[UPD ? NR : 1][2], ya[UPD ? NR : 1], yb[UPD ? NR : 1]; };
template <int NR, bool UPD>
__device__ __forceinline__ void n1_load(const Params& p, N1Raw<NR, UPD>& R, int row0, int lane) {
    const int c0 = 16 * lane;
    if (!UPD) {
#pragma unroll
        for (int r = 0; r < NR; ++r)
#pragma unroll
            for (int j = 0; j < 4; ++j) R.xf[r][j] = *(const f32x4*)(p.in[0] + (size_t)(row0 + r) * DM + c0 + 4 * j);
    } else {
        const unsigned char* Y = (const unsigned char*)(p.ws + WS_Y);
        const bf16_t* XB = (const bf16_t*)(p.ws + WS_XB);
#pragma unroll
        for (int r = 0; r < NR; ++r) {
            R.xw[r][0] = *(const u32x4*)(XB + (size_t)(row0 + r) * DM + c0); R.xw[r][1] = *(const u32x4*)(XB + (size_t)(row0 + r) * DM + c0 + 8);
            R.ya[r] = *(const u32x4*)(Y + (size_t)(2 * (row0 + r)) * DM + c0); R.yb[r] = *(const u32x4*)(Y + (size_t)(2 * (row0 + r) + 1) * DM + c0);
        }
    }
}
template <int NR, bool UPD>
__device__ __forceinline__ void n1_process(const Params& p, const N1Raw<NR, UPD>& R, int l, int row0, int lane) {
    const float* mod = (const float*)(p.ws + WS_MOD);
    const float* gn = p.in[4] + l * 1024;
    unsigned char* H8 = p.ws + WS_BUF;
    bf16_t* XB = (bf16_t*)(p.ws + WS_XB);
    const int b = row0 >> 13, c0 = 16 * lane;
    f32x4 v[NR][4];
    if (!UPD) {
#pragma unroll
        for (int r = 0; r < NR; ++r)
#pragma unroll
            for (int j = 0; j < 4; ++j) v[r][j] = R.xf[r][j];
    } else {
        const float* g2 = mod + (size_t)((l - 1) * 4 + b) * 6144 + 5120;
        f32x4 gg[4];
#pragma unroll
        for (int j = 0; j < 4; ++j) gg[j] = *(const f32x4*)(g2 + c0 + 4 * j);
#pragma unroll
        for (int r = 0; r < NR; ++r) {
            bf8_to_f32(R.xw[r][0], v[r][0], v[r][1]); bf8_to_f32(R.xw[r][1], v[r][2], v[r][3]);
            u32x4 o[2];
#pragma unroll
            for (int j = 0; j < 4; ++j) {
                const f32x4 xn = v[r][j] + gg[j] * y_pair4(R.ya[r][j], R.yb[r][j]);
                const unsigned w0 = cvtpk(xn[0], xn[1]), w1 = cvtpk(xn[2], xn[3]);
                if (j & 1) { o[j >> 1].z = w0; o[j >> 1].w = w1; } else { o[j >> 1].x = w0; o[j >> 1].y = w1; }
                v[r][j] = (f32x4){bf_lo(w0), bf_hi(w0), bf_lo(w1), bf_hi(w1)};
            }
            *(u32x4*)(XB + (size_t)(row0 + r) * DM + c0) = o[0]; *(u32x4*)(XB + (size_t)(row0 + r) * DM + c0 + 8) = o[1];
        }
    }
    float ss[NR];
#pragma unroll
    for (int r = 0; r < NR; ++r) { ss[r] = 0.f;
#pragma unroll
        for (int j = 0; j < 4; ++j) ss[r] += (v[r][j][0] * v[r][j][0] + v[r][j][1] * v[r][j][1]) + (v[r][j][2] * v[r][j][2] + v[r][j][3] * v[r][j][3]); }
#pragma unroll
    for (int o = 1; o < 64; o <<= 1)
#pragma unroll
        for (int r = 0; r < NR; ++r) ss[r] += shx(ss[r], o, lane);
    const float* sh = mod + (size_t)(l * 4 + b) * 6144; const float* sc = sh + 1024;
    float rstd[NR], mx[NR];
#pragma unroll
    for (int r = 0; r < NR; ++r) { rstd[r] = rsqrtf(ss[r] * (1.0f / DM) + EPS); mx[r] = 0.f; }
#pragma unroll
    for (int j = 0; j < 4; ++j) {
        const int c = c0 + 4 * j;
        const f32x4 g = *(const f32x4*)(gn + c), s1 = *(const f32x4*)(sc + c), s0 = *(const f32x4*)(sh + c);
        const f32x4 a = g * (s1 + 1.0f);
#pragma unroll
        for (int r = 0; r < NR; ++r) {
            const f32x4 h = v[r][j] * rstd[r] * a + s0;
            v[r][j] = h;
            mx[r] = fmaxf(mx[r], fmaxf(fmaxf(fabsf(h[0]), fabsf(h[1])), fmaxf(fabsf(h[2]), fabsf(h[3]))));
        }
    }
#pragma unroll
    for (int o = 1; o < 64; o <<= 1)
#pragma unroll
        for (int r = 0; r < NR; ++r) mx[r] = fmaxf(mx[r], shx(mx[r], o, lane));
    float* RS = (float*)(p.ws + WS_RS);
#pragma unroll
    for (int r = 0; r < NR; ++r) {
        const float inv = mx[r] > 0.f ? 127.0f / mx[r] : 0.f;
        if (lane == 0) RS[row0 + r] = mx[r] * (1.0f / 127.0f);
        u32x4 q8;
        { const f32x4 q = v[r][0] * inv; q8.x = pk_i8x4(q[0], q[1], q[2], q[3]); } { const f32x4 q = v[r][1] * inv; q8.y = pk_i8x4(q[0], q[1], q[2], q[3]); }
        { const f32x4 q = v[r][2] * inv; q8.z = pk_i8x4(q[0], q[1], q[2], q[3]); } { const f32x4 q = v[r][3] * inv; q8.w = pk_i8x4(q[0], q[1], q[2], q[3]); }
        *(u32x4*)(H8 + (size_t)(row0 + r) * DM + c0) = q8;
    }
}
template <int NR, bool UPD>
__device__ __forceinline__ void n1_run(const Params& p, int l, int gw, int NGW, int lane) {
    constexpr int N = NTOK / NR;
    int rq = gw; if (rq >= N) return;
    N1Raw<NR, UPD> A, B;
    n1_load<NR, UPD>(p, A, rq * NR, lane);
    for (;;) {
        const int nx = rq + NGW; const bool hb = nx < N;
        if (hb) n1_load<NR, UPD>(p, B, nx * NR, lane);
        n1_process<NR, UPD>(p, A, l, rq * NR, lane);
        if (!hb) break;
        rq = nx + NGW; const bool ha = rq < N;
        if (ha) n1_load<NR, UPD>(p, A, rq * NR, lane);
        n1_process<NR, UPD>(p, B, l, nx * NR, lane);
        if (!ha) break;
    }
}
__device__ __forceinline__ void phase_norm1(const Params& p, int l) {
    const int tid = opaque_tid(), lane = tid & 63, wave = tid >> 6, G = gridDim.x;
    const int gw = blockIdx.x * NWAVES + wave, NGW = G * NWAVES;
    if (l == 0) n1_run<4, false>(p, l, gw, NGW, lane); else n1_run<2, true>(p, l, gw, NGW, lane);
}

struct FinRaw { u32x4 xw[4][2], ya[4], yb[4]; };
__device__ __forceinline__ void fin_load(const Params& p, FinRaw& R, int row0, int lane) {
    const unsigned char* Y = (const unsigned char*)(p.ws + WS_Y);
    const bf16_t* XB = (const bf16_t*)(p.ws + WS_XB);
    const int c0 = 16 * lane;
#pragma unroll
    for (int r = 0; r < 4; ++r) {
        R.xw[r][0] = *(const u32x4*)(XB + (size_t)(row0 + r) * DM + c0); R.xw[r][1] = *(const u32x4*)(XB + (size_t)(row0 + r) * DM + c0 + 8);
        R.ya[r] = *(const u32x4*)(Y + (size_t)(2 * (row0 + r)) * DM + c0); R.yb[r] = *(const u32x4*)(Y + (size_t)(2 * (row0 + r) + 1) * DM + c0);
    }
}
__device__ __forceinline__ void fin_process(const Params& p, const FinRaw& R, int row0, int lane, LAS float* scr) {
    const float* mod = (const float*)(p.ws + WS_MOD);
    const int b = row0 >> 13, c0 = 16 * lane;
    const float* g2 = mod + (size_t)((DEPTH - 1) * 4 + b) * 6144 + 5120;
    f32x4 gg[4];
#pragma unroll
    for (int j = 0; j < 4; ++j) gg[j] = *(const f32x4*)(g2 + c0 + 4 * j);
#pragma unroll
    for (int r = 0; r < 4; ++r) {
        f32x4 v[4];
        bf8_to_f32(R.xw[r][0], v[0], v[1]); bf8_to_f32(R.xw[r][1], v[2], v[3]);
#pragma unroll
        for (int j = 0; j < 4; ++j) *(LAS f32x4*)(scr + r * 1024 + c0 + 4 * j) = v[j] + gg[j] * y_pair4(R.ya[r][j], R.yb[r][j]);
    }
    asm volatile("s_waitcnt lgkmcnt(0)" ::: "memory");
#pragma unroll
    for (int r = 0; r < 4; ++r)
#pragma unroll
        for (int s = 0; s < 4; ++s) *(f32x4*)(p.out + (size_t)(row0 + r) * DM + 256 * s + 4 * lane) = *(const LAS f32x4*)(scr + r * 1024 + 256 * s + 4 * lane);
    asm volatile("s_waitcnt lgkmcnt(0)" ::: "memory");
}
__device__ __forceinline__ void phase_final(const Params& p, LAS unsigned char* lds) {
    const int tid = opaque_tid(), lane = tid & 63, wave = tid >> 6, G = gridDim.x;
    const int gw = blockIdx.x * NWAVES + wave, NGW = G * NWAVES;
    constexpr int N = NTOK / 4;
    int rq = gw; if (rq >= N) return;
    FinRaw A, B;
    LAS float* scr = (LAS float*)(lds + wave * 16384);
    fin_load(p, A, rq * 4, lane);
    for (;;) {
        const int nx = rq + NGW; const bool hb = nx < N;
        if (hb) fin_load(p, B, nx * 4, lane);
        fin_process(p, A, rq * 4, lane, scr);
        if (!hb) break;
        rq = nx + NGW; const bool ha = rq < N;
        if (ha) fin_load(p, A, rq * 4, lane);
        fin_process(p, B, nx * 4, lane, scr);
        if (!ha) break;
    }
}

__device__ __forceinline__ int crow(int r, int hi) { return (r & 3) + 8 * (r >> 2) + 4 * hi; }

__device__ __forceinline__ void acc8(float (&S)[8], const u32x4& w, float sg) {
    S[0] += sg * bf_lo(w.x); S[1] += sg * bf_hi(w.x); S[2] += sg * bf_lo(w.y); S[3] += sg * bf_hi(w.y); S[4] += sg * bf_lo(w.z); S[5] += sg * bf_hi(w.z); S[6] += sg * bf_lo(w.w); S[7] += sg * bf_hi(w.w);
}
__device__ __forceinline__ void pool_strip(const Params& p, int strip, int lane) {
    const bf16_t* U = (const bf16_t*)(p.ws + WS_U); unsigned char* MIX = p.ws + WS_BUF;
    const int tok0 = strip * 16, s0 = tok0 & (SEQ - 1);
    const int g = lane >> 4, win = 2 << g;
    u32x4 w[31];
#pragma unroll
    for (int d = 0; d < 31; ++d) { w[d] = (u32x4){0u, 0u, 0u, 0u}; if (d >= 15 || s0 > 0) w[d] = *(const u32x4*)(U + (size_t)(tok0 - 15 + d) * 512 + lane * 8); }
    float S[8];
#pragma unroll
    for (int j = 0; j < 8; ++j) S[j] = 0.f;
#pragma unroll
    for (int k = 1; k < 16; ++k) acc8(S, w[15 - k], (k < win) ? 1.0f : 0.0f);
#pragma unroll
    for (int i = 0; i < 16; ++i) {
        const int s = s0 + i;
        const u32x4 x = w[15 + i];
        float uv[8] = {bf_lo(x.x), bf_hi(x.x), bf_lo(x.y), bf_hi(x.y), bf_lo(x.z), bf_hi(x.z), bf_lo(x.w), bf_hi(x.w)};
#pragma unroll
        for (int j = 0; j < 8; ++j) S[j] += uv[j];
        const int cn = (s + 1 < win) ? s + 1 : win;
        const float inv = 1.0f / (float)cn;
        float o[8];
#pragma unroll
        for (int j = 0; j < 8; ++j) o[j] = clamp8((S[j] * inv - uv[j]) * 16.0f);
        u32x2 ow; ow.x = pk_fp8x4(o[0], o[1], o[2], o[3]); ow.y = pk_fp8x4(o[4], o[5], o[6], o[7]);
        *(u32x2*)(MIX + (size_t)(tok0 + i) * DM + lane * 8) = ow;
        const u32x4 l0 = w[15 + i - 1], l1 = (i + 12 >= 0) ? w[15 + i - 3 < 0 ? 0 : 15 + i - 3] : l0, l2 = w[15 + i - 7 < 0 ? 0 : 15 + i - 7], l3 = w[15 + i - 15 < 0 ? 0 : 15 + i - 15];
        u32x4 lv;
        lv.x = g == 0 ? l0.x : g == 1 ? l1.x : g == 2 ? l2.x : l3.x; lv.y = g == 0 ? l0.y : g == 1 ? l1.y : g == 2 ? l2.y : l3.y;
        lv.z = g == 0 ? l0.z : g == 1 ? l1.z : g == 2 ? l2.z : l3.z; lv.w = g == 0 ? l0.w : g == 1 ? l1.w : g == 2 ? l2.w : l3.w;
        acc8(S, lv, -1.0f);
    }
}

__device__ __forceinline__ void attn_unit(const Params& p, int b, int h, int ch, int qh, int lane, const LAS float* tbl, LAS unsigned char* stg) {
    const int r32 = lane & 31, hi = lane >> 5;
    const char* Qf = (const char*)(p.ws + WS_Q); const char* Kf = (const char*)(p.ws + WS_K); const char* Vf = (const char*)(p.ws + WS_V);
    unsigned char* MIX = p.ws + WS_BUF;
    const size_t bh = (size_t)(b * NHEAD + h) * 256;
    bf16x8 qr[4];
#pragma unroll
    for (int d0 = 0; d0 < 4; ++d0) qr[d0] = *(const bf16x8*)(Qf + (((bh + ch * 2 + qh) * 4 + d0) * 64 + lane) * 16);
    f32x16 o0 = {}, o1 = {};
    float lsum = 0.f;
    const LAS float* th = tbl + h * 256;
    f32x16 cfv; { const float cfar = th[254];
#pragma unroll
        for (int r = 0; r < 16; ++r) cfv[r] = cfar; }
    const int t0 = ch < 8 ? 8 - ch : 0;
    const char* kp = Kf + (bh * 4 * 64 + lane) * 16 + (ptrdiff_t)(ch - 8 + t0) * 8192;
    const char* vp = Vf + (bh * 4 * 64 + lane) * 16 + (ptrdiff_t)(ch - 8 + t0) * 8192;
    bf16x8 kk[8];
#define ATT_LD8(dst, ptr) do { const char* pa_ = (ptr); const char* pb_ = pa_ + 4096; _Pragma("unroll") for (int i_ = 0; i_ < 4; ++i_) { dst[i_] = *(const bf16x8*)(pa_ + i_ * 1024); dst[4 + i_] = *(const bf16x8*)(pb_ + i_ * 1024); } } while (0)
#define ATT_REST(P0, P1) do { \
        float sacc_ = 0.f; \
        _Pragma("unroll") for (int r = 0; r < 16; ++r) { P0[r] = fast_exp2(P0[r]); P1[r] = fast_exp2(P1[r]); sacc_ += P0[r] + P1[r]; } \
        lsum += sacc_; \
        u32x4 pa_[4]; \
        _Pragma("unroll") for (int s = 0; s < 2; ++s) { \
            pa_[s].x = cvtpk(P0[8 * s + 0], P0[8 * s + 1]); pa_[s].y = cvtpk(P0[8 * s + 2], P0[8 * s + 3]); pa_[s].z = cvtpk(P0[8 * s + 4], P0[8 * s + 5]); pa_[s].w = cvtpk(P0[8 * s + 6], P0[8 * s + 7]); \
            pa_[2 + s].x = cvtpk(P1[8 * s + 0], P1[8 * s + 1]); pa_[2 + s].y = cvtpk(P1[8 * s + 2], P1[8 * s + 3]); pa_[2 + s].z = cvtpk(P1[8 * s + 4], P1[8 * s + 5]); pa_[2 + s].w = cvtpk(P1[8 * s + 6], P1[8 * s + 7]); } \
        _Pragma("unroll") for (int i = 0; i < 4; ++i) { const bf16x8 pf_ = __builtin_bit_cast(bf16x8, pa_[i]); \
            o0 = __builtin_amdgcn_mfma_f32_32x32x16_bf16(pf_, vv[2 * i], o0, 0, 0, 0); o1 = __builtin_amdgcn_mfma_f32_32x32x16_bf16(pf_, vv[2 * i + 1], o1, 0, 0, 0); } \
    } while (0)
    ATT_LD8(kk, kp);
    int t = t0;
#pragma unroll 1
    for (; t <= 5; ++t) {
        bf16x8 vv[8]; ATT_LD8(vv, vp); vp += 8192;
        f32x16 p0 = __builtin_amdgcn_mfma_f32_32x32x16_bf16(kk[0], qr[0], cfv, 0, 0, 0);
        f32x16 p1 = __builtin_amdgcn_mfma_f32_32x32x16_bf16(kk[4], qr[0], cfv, 0, 0, 0);
#pragma unroll
        for (int d0 = 1; d0 < 4; ++d0) { p0 = __builtin_amdgcn_mfma_f32_32x32x16_bf16(kk[d0], qr[d0], p0, 0, 0, 0); p1 = __builtin_amdgcn_mfma_f32_32x32x16_bf16(kk[4 + d0], qr[d0], p1, 0, 0, 0); }
        kp += 8192; ATT_LD8(kk, kp);
        ATT_REST(p0, p1);
    }
#pragma unroll 1
    for (; t <= 8; ++t) {
        bf16x8 vv[8]; ATT_LD8(vv, vp); vp += 8192;
        f32x16 p0, p1;
        { const int base_ = 64 * (8 - t) + 32 * qh + r32 + 63 - 4 * hi;
#pragma unroll
          for (int r = 0; r < 16; ++r) { const int kj = (r & 3) + 8 * (r >> 2); p0[r] = th[base_ - kj]; p1[r] = th[base_ - kj - 32]; } }
#pragma unroll
        for (int d0 = 0; d0 < 4; ++d0) { p0 = __builtin_amdgcn_mfma_f32_32x32x16_bf16(kk[d0], qr[d0], p0, 0, 0, 0); p1 = __builtin_amdgcn_mfma_f32_32x32x16_bf16(kk[4 + d0], qr[d0], p1, 0, 0, 0); }
        if (t < 8) { kp += 8192; ATT_LD8(kk, kp); }
        ATT_REST(p0, p1);
    }
#undef ATT_LD8
#undef ATT_REST
    lsum += shx(lsum, 32, lane);
    const float linv = 1.0f / lsum;
#pragma unroll
    for (int r = 0; r < 16; ++r) {
        const int q = crow(r, hi);
        const float li = __int_as_float(__builtin_amdgcn_ds_bpermute(q << 2, __float_as_int(linv))) * 16.0f;
        const unsigned w = pk_fp8x4(clamp8(o0[r] * li), clamp8(o1[r] * li), 0.f, 0.f);
        stg[q * 80 + r32] = (unsigned char)(w & 0xffu);
        stg[q * 80 + 32 + r32] = (unsigned char)((w >> 8) & 0xffu);
    }
    asm volatile("s_waitcnt lgkmcnt(0)" ::: "memory");
    unsigned char* orow = MIX + ((size_t)b * SEQ + ch * 64 + qh * 32 + (lane >> 2)) * DM + 512 + h * 64 + (lane & 3) * 16;
    const LAS unsigned char* srow = stg + (lane >> 2) * 80 + (lane & 3) * 16;
#pragma unroll
    for (int i = 0; i < 2; ++i) *(u32x4*)(orow + (size_t)i * 16 * DM) = *(const LAS u32x4*)(srow + i * 16 * 80);
    asm volatile("s_waitcnt lgkmcnt(0)" ::: "memory");
}

__device__ __forceinline__ void phase_mixer(const Params& p, int l, LAS unsigned char* lds) {
    const int tid = opaque_tid(), lane = tid & 63, wave = tid >> 6, G = gridDim.x;
    LAS float* tbl = (LAS float*)lds;
    const float* gt = (const float*)(p.ws + WS_TBL) + (size_t)l * 2048;
    for (int i = tid; i < 2048; i += NTHREADS) tbl[i] = gt[i];
    __syncthreads();
    const int gw = blockIdx.x * NWAVES + wave, NGW = G * NWAVES;
    LAS unsigned char* stg = lds + 8192 + wave * 4608;
    for (int it = gw; it < NTOK / 16; it += NGW) pool_strip(p, it, lane);
    if (G % 8 == 0) {
        const int x = (int)blockIdx.x & 7, lw = ((int)blockIdx.x >> 3) * NWAVES + wave, nlw = (G >> 3) * NWAVES;
        for (int pr = x; pr < BATCH * NHEAD; pr += 8)
            for (int u = lw; u < 256; u += nlw) attn_unit(p, pr >> 3, pr & 7, u >> 1, u & 1, lane, tbl, stg);
    } else {
        for (int wu = gw; wu < BATCH * NHEAD * 256; wu += NGW) attn_unit(p, wu >> 11, (wu >> 8) & 7, (wu >> 1) & 127, wu & 1, lane, tbl, stg);
    }
}

__device__ __forceinline__ void phase_route(const Params& p, int l, LAS unsigned char* lds) {
    const int tid = opaque_tid(), lane = tid & 63, wave = __builtin_amdgcn_readfirstlane(tid >> 6), G = gridDim.x;
    LAS float* a2c = (LAS float*)(lds + 49152);
    LAS float* shc = (LAS float*)(lds + 49152 + 1024);
    LAS float* lg = (LAS float*)(lds + 53248) + wave * (16 * 48);
    LAS int* lcnt = (LAS int*)(lds + 77824);
    LAS int* gbase = (LAS int*)(lds + 77824 + 128);
    LAS int* tmp_e = (LAS int*)(lds + 77824 + 256);
    LAS int* tmp_r = (LAS int*)(lds + 77824 + 256 + 1024);
    LAS float* tmp_w = (LAS float*)(lds + 77824 + 256 + 2048);
    const float* mod = (const float*)(p.ws + WS_MOD);
    const float* gn = p.in[5] + l * 1024;
    unsigned char* H8 = p.ws + WS_BUF;
    const char* RW = (const char*)(p.ws + WS_RW) + (size_t)l * 2 * 48 * 1024 * 2;
    const float* rwb = (const float*)(p.ws + WS_RWB) + l * 48;
    const float* ssq = (const float*)(p.ws + WS_SSQ);
    int* gcnt = (int*)(p.ws + WS_CTL) + l * 32;
    u32x2* list = (u32x2*)(p.ws + WS_LIST2);
    const int r = lane & 15, kg = lane >> 4;
    for (int it = blockIdx.x; it < NTOK / 128; it += G) {
        const int row0 = it * 128 + wave * 16, row = row0 + r, b = (it * 128) >> 13;
        const bf16_t* xr = (const bf16_t*)(p.ws + WS_XB) + (size_t)row * DM + 8 * kg;
        float ss; { const float* sq = ssq + (size_t)(4 * kg) * NTOK + row; ss = (sq[0] + sq[NTOK]) + (sq[2 * (size_t)NTOK] + sq[3 * (size_t)NTOK]); }
        ss += shx(ss, 16, lane); ss += shx(ss, 32, lane);
        const float rstd = rsqrtf(ss * (1.0f / DM) + EPS);
        const float* sh = mod + (size_t)(l * 4 + b) * 6144 + 3072; const float* sc = sh + 1024;
        f32x4 acc[3];
#pragma unroll
        for (int nb = 0; nb < 3; ++nb) acc[nb] = (f32x4){0.f, 0.f, 0.f, 0.f};
        u32x4 xsb[2][8];
#pragma unroll
        for (int i = 0; i < 8; ++i) xsb[0][i] = *(const u32x4*)(xr + 32 * i);
#pragma unroll
        for (int c = 0; c < 4; ++c) {
            __syncthreads();
            if (c == 0 && tid < 32) lcnt[tid] = 0;
#pragma unroll
            for (int i = 0; i < 6; ++i) { const int q = wave * 6 + i; const char* src = RW + (q < 24 ? (size_t)(c * 24 + q) * 1024 : (size_t)98304 + (size_t)(c * 24 + q - 24) * 1024);
                __builtin_amdgcn_global_load_lds((const unsigned*)(src + lane * 16), (LAS unsigned*)(lds + q * 1024), 16, 0, 0); }
            if (tid < 256) { const int k = 256 * c + tid; a2c[tid] = gn[k] * (1.0f + sc[k]); shc[tid] = sh[k]; }
            asm volatile("s_waitcnt vmcnt(0) lgkmcnt(0)" : "+v"(xsb[c & 1][0]), "+v"(xsb[c & 1][1]), "+v"(xsb[c & 1][2]), "+v"(xsb[c & 1][3]), "+v"(xsb[c & 1][4]), "+v"(xsb[c & 1][5]), "+v"(xsb[c & 1][6]), "+v"(xsb[c & 1][7]) :: "memory");
            if (c < 3) {
#pragma unroll
                for (int i = 0; i < 8; ++i) xsb[(c + 1) & 1][i] = *(const u32x4*)(xr + 256 * (c + 1) + 32 * i);
            }
            __builtin_amdgcn_s_barrier();
            const u32x4 (&xs)[8] = xsb[c & 1];
#pragma unroll
            for (int i = 0; i < 8; ++i) {
                float hv[8];
#pragma unroll
                for (int q = 0; q < 2; ++q) {
                    const f32x4 a = *(const LAS f32x4*)(a2c + 32 * i + 8 * kg + 4 * q), s0 = *(const LAS f32x4*)(shc + 32 * i + 8 * kg + 4 * q);
                    const f32x4 xv = q == 0 ? (f32x4){bf_lo(xs[i].x), bf_hi(xs[i].x), bf_lo(xs[i].y), bf_hi(xs[i].y)} : (f32x4){bf_lo(xs[i].z), bf_hi(xs[i].z), bf_lo(xs[i].w), bf_hi(xs[i].w)};
                    const f32x4 hh = xv * rstd * a + s0;
                    hv[4 * q + 0] = hh[0]; hv[4 * q + 1] = hh[1]; hv[4 * q + 2] = hh[2]; hv[4 * q + 3] = hh[3];
                }
                u32x4 hp; hp.x = cvtpk(hv[0], hv[1]); hp.y = cvtpk(hv[2], hv[3]); hp.z = cvtpk(hv[4], hv[5]); hp.w = cvtpk(hv[6], hv[7]);
                { u32x2 h8; h8.x = pk_fp8x4(clamp8(hv[0] * 8.0f), clamp8(hv[1] * 8.0f), clamp8(hv[2] * 8.0f), clamp8(hv[3] * 8.0f)); h8.y = pk_fp8x4(clamp8(hv[4] * 8.0f), clamp8(hv[5] * 8.0f), clamp8(hv[6] * 8.0f), clamp8(hv[7] * 8.0f));
                  *(u32x2*)(H8 + (size_t)row * DM + 256 * c + 32 * i + 8 * kg) = h8; }
                u32x4 lp;
                lp.x = cvtpk(hv[0] - bf_lo(hp.x), hv[1] - bf_hi(hp.x)); lp.y = cvtpk(hv[2] - bf_lo(hp.y), hv[3] - bf_hi(hp.y));
                lp.z = cvtpk(hv[4] - bf_lo(hp.z), hv[5] - bf_hi(hp.z)); lp.w = cvtpk(hv[6] - bf_lo(hp.w), hv[7] - bf_hi(hp.w));
                const bf16x8 xhi = __builtin_bit_cast(bf16x8, hp), xlo = __builtin_bit_cast(bf16x8, lp);
#pragma unroll
                for (int nb = 0; nb < 3; ++nb) {
                    const bf16x8 whi = *(const LAS bf16x8*)(lds + (i * 3 + nb) * 1024 + lane * 16);
                    const bf16x8 wlo = *(const LAS bf16x8*)(lds + 24576 + (i * 3 + nb) * 1024 + lane * 16);
                    acc[nb] = __builtin_amdgcn_mfma_f32_16x16x32_bf16(whi, xhi, acc[nb], 0, 0, 0);
                    acc[nb] = __builtin_amdgcn_mfma_f32_16x16x32_bf16(whi, xlo, acc[nb], 0, 0, 0);
                    acc[nb] = __builtin_amdgcn_mfma_f32_16x16x32_bf16(wlo, xhi, acc[nb], 0, 0, 0);
                }
            }
        }
#pragma unroll
        for (int nb = 0; nb < 3; ++nb)
#pragma unroll
            for (int q = 0; q < 4; ++q) lg[r * 48 + 16 * nb + 4 * kg + q] = acc[nb][q];
        asm volatile("s_waitcnt lgkmcnt(0)" ::: "memory");
        if (lane < 16) {
            const LAS float* my = lg + lane * 48;
            float gl[4]; int gi = 0; float gm;
#pragma unroll
            for (int i = 0; i < 4; ++i) gl[i] = my[32 + i] + rwb[32 + i];
            gm = gl[0];
#pragma unroll
            for (int i = 1; i < 4; ++i) if (gl[i] > gm) { gm = gl[i]; gi = i; }
            float den = 0.f;
#pragma unroll
            for (int i = 0; i < 4; ++i) den += __expf(gl[i] - gm);
            const float gpv = 1.0f / den;
            float el[8];
#pragma unroll
            for (int i = 0; i < 8; ++i) el[i] = my[8 * gi + i] + rwb[8 * gi + i];
            int i0 = 0; float v0 = el[0];
#pragma unroll
            for (int i = 1; i < 8; ++i) if (el[i] > v0) { v0 = el[i]; i0 = i; }
            int i1 = -1; float v1 = -3.0e38f;
#pragma unroll
            for (int i = 0; i < 8; ++i) if (i != i0 && el[i] > v1) { v1 = el[i]; i1 = i; }
            const float dd = __expf(v1 - v0);
            const float w0 = gpv / (1.0f + dd), w1 = gpv * dd / (1.0f + dd);
            const int e0 = 8 * gi + i0, e1 = 8 * gi + i1;
            const int tok = row0 + lane, lt = wave * 16 + lane;
            tmp_w[2 * lt] = w0; tmp_w[2 * lt + 1] = w1;
            tmp_e[2 * lt] = e0; tmp_e[2 * lt + 1] = e1;
            tmp_r[2 * lt] = __hip_atomic_fetch_add(lcnt + e0, 1, __ATOMIC_RELAXED, __HIP_MEMORY_SCOPE_WORKGROUP);
            tmp_r[2 * lt + 1] = __hip_atomic_fetch_add(lcnt + e1, 1, __ATOMIC_RELAXED, __HIP_MEMORY_SCOPE_WORKGROUP);
        }
        __syncthreads();
        if (tid < 32) gbase[tid] = __hip_atomic_fetch_add(gcnt + tid, lcnt[tid], __ATOMIC_RELAXED, __HIP_MEMORY_SCOPE_AGENT);
        __syncthreads();
        if (tid < 256) { const int e = tmp_e[tid]; u32x2 en; en.x = (unsigned)(it * 256 + tid); en.y = __float_as_uint(tmp_w[tid]); list[(size_t)e * NTOK + gbase[e] + tmp_r[tid]] = en; }
    }
    __syncthreads();
}

#define XB_TMO      128
#define XB_XCNT(j)  (256  + 64 * (j))
#define XB_XSUB(j)  (1280 + 64 * (j))
#define XB_XGEN(j)  (2304 + 64 * (j))
#define XB_TOP      3328
#define XB_TOPGEN   3392
#define XCD_BAR_WORDS 3456
#define XB_SPIN_CAP (1u << 18)
__device__ __forceinline__ unsigned xb_ld(unsigned* p)              { return __hip_atomic_load(p, __ATOMIC_RELAXED, __HIP_MEMORY_SCOPE_AGENT); }
__device__ __forceinline__ unsigned xb_add(unsigned* p, unsigned v) { return __hip_atomic_fetch_add(p, v, __ATOMIC_RELAXED, __HIP_MEMORY_SCOPE_AGENT); }
__device__ __forceinline__ unsigned xb_xcc_id() { return (unsigned)__builtin_amdgcn_s_getreg((3 << 11) | 20) & 0xFu; }
#define XB_SPIN(cond, bar) do { unsigned _sp = 0; while (cond) { __builtin_amdgcn_s_sleep(1); \
    if ((++_sp & 255u) == 0u) { if (xb_ld(&(bar)[XB_TMO])) break; if (_sp > XB_SPIN_CAP) { atomicAdd(&(bar)[XB_TMO], 1u); break; } } } } while (0)
struct XcdBarrier { unsigned* bar; unsigned x; volatile LAS unsigned* st; };
__device__ __forceinline__ XcdBarrier xcd_barrier_post(unsigned* bar, volatile LAS unsigned* st) {
    XcdBarrier b; b.bar = bar; b.x = xb_xcc_id(); b.st = st;
    if (threadIdx.x == 0) (void)xb_add(&bar[XB_XCNT(b.x)], 1u);
    return b;
}
__device__ __forceinline__ void xcd_barrier_complete(unsigned* bar, unsigned x, unsigned& nloc, unsigned& nx) {
    const unsigned G = gridDim.x * gridDim.y * gridDim.z;
    unsigned sum, cnt, mine, sp = 0u;
    for (;;) {
        sum = 0u; cnt = 0u; mine = 0u;
#pragma unroll
        for (unsigned j = 0; j < 16; ++j) { const unsigned c = xb_ld(&bar[XB_XCNT(j)]); sum += c; cnt += (c > 0u) ? 1u : 0u; mine = (j == x) ? c : mine; }
        if (sum == G) break;
        __builtin_amdgcn_s_sleep(1);
        if ((++sp & 255u) == 0u) { if (xb_ld(&bar[XB_TMO])) break; if (sp > XB_SPIN_CAP) { atomicAdd(&bar[XB_TMO], 1u); break; } }
    }
    nloc = mine > 0u ? mine : 1u; nx = cnt > 0u ? cnt : 1u;
}
__device__ __forceinline__ void xcd_barrier(const XcdBarrier& b) {
    asm volatile("s_waitcnt vmcnt(0)" ::: "memory");
    __syncthreads();
    if (threadIdx.x == 0) {
        unsigned* bar = b.bar;
        __builtin_amdgcn_s_waitcnt(0);
        unsigned nloc = b.st[0], nx = b.st[1];
        if (nloc == 0u) { xcd_barrier_complete(bar, b.x, nloc, nx); b.st[0] = nloc; b.st[1] = nx; }
        const unsigned old = xb_add(&bar[XB_XSUB(b.x)], 1u);
        const unsigned gen = old / nloc;
        if (old + 1u == (gen + 1u) * nloc) {
            __builtin_amdgcn_fence(__ATOMIC_RELEASE, "agent");
            asm volatile("s_waitcnt vmcnt(0)" ::: "memory");
            const unsigned og = xb_add(&bar[XB_TOP], 1u);
            const unsigned tg = og / nx;
            if (og + 1u == (tg + 1u) * nx) xb_add(&bar[XB_TOPGEN], 1u);
            else XB_SPIN(xb_ld(&bar[XB_TOPGEN]) == tg, bar);
            __builtin_amdgcn_fence(__ATOMIC_ACQUIRE, "agent");
            xb_add(&bar[XB_XGEN(b.x)], 1u);
            asm volatile("s_waitcnt vmcnt(0)" ::: "memory");
        } else {
            XB_SPIN(xb_ld(&bar[XB_XGEN(b.x)]) == gen, bar);
            __builtin_amdgcn_fence(__ATOMIC_ACQUIRE, "agent");
            asm volatile("s_waitcnt vmcnt(0)" ::: "memory");
        }
    }
    __syncthreads();
}

__device__ __forceinline__ void load_params(Params& q, const Params& p) {
#if defined(__HIP_DEVICE_COMPILE__)
    const unsigned long long a = (unsigned long long)__builtin_amdgcn_kernarg_segment_ptr();
    unsigned alo = __builtin_amdgcn_readfirstlane((unsigned)a), ahi = __builtin_amdgcn_readfirstlane((unsigned)(a >> 32));
    asm volatile("" : "+s"(alo), "+s"(ahi));
    q = *(const __attribute__((address_space(4))) Params*)(((unsigned long long)ahi << 32) | alo);
#else
    q = p;
#endif
}
__device__ __forceinline__ void load_prefix(const Params& p, int l, LAS int* pre, LAS int* cntl) {
    const int* gcnt = (const int*)(p.ws + WS_CTL) + l * 32;
    const int tid = opaque_tid();
    if (tid < 64) {
        const int c = tid < NEXP ? gcnt[tid] : 0;
        const int t0 = (c + 255) >> 8;
        int t = t0;
#pragma unroll
        for (int o = 1; o < 32; o <<= 1) { const int v = __builtin_amdgcn_ds_bpermute(((tid - o) & 63) << 2, t); if (tid >= o) t += v; }
        if (tid < NEXP) { cntl[tid] = c; pre[tid] = t - t0; }
        if (tid == NEXP - 1) pre[NEXP] = t;
    }
    __syncthreads();
}

__global__ void __launch_bounds__(NTHREADS, 2) fwd_kernel(Params p) {
    extern __shared__ __attribute__((aligned(16))) unsigned char lds_raw[];
    LAS unsigned char* lds = (LAS unsigned char*)lds_raw;
    const int G = gridDim.x;
    unsigned char* ws = p.ws;
    volatile LAS unsigned* bst = (volatile LAS unsigned*)(lds + LDS_BYTES - 16);
    if (threadIdx.x < 2) bst[threadIdx.x] = 0u;
    __syncthreads();
    const XcdBarrier bar = xcd_barrier_post((unsigned*)(ws + WS_CTL) + 4096, bst);
    const int lo = p.ph_lo, hi = p.ph_hi;
#define IN(k) (lo <= (k) && (k) < hi)
#define SYNC_AFTER(k) do { if (IN(k) && IN((k) + 1)) xcd_barrier(bar); } while (0)
#define PROBE_REL (-1)
#define PROBE_BEGIN(j) unsigned long long pt0_ = 0; if (PROBE_REL == (j)) pt0_ = __builtin_amdgcn_s_memrealtime();
#define PROBE_END(j) if (PROBE_REL == (j)) { if (blockIdx.x == 0 && threadIdx.x == 0) { const unsigned long long t1_ = __builtin_amdgcn_s_memrealtime(); const unsigned long long dt_ = t1_ - pt0_; \
        while (__builtin_amdgcn_s_memrealtime() - t1_ < dt_) __builtin_amdgcn_s_sleep(8); } xcd_barrier(bar); }
    { PROBE_BEGIN(7)
    if (IN(0)) { Params q; load_params(q, p); phase_prologue(q, lds); }
    SYNC_AFTER(0);
    PROBE_END(7) }
#pragma unroll 1
    for (int l = 0; l < DEPTH; ++l) {
        const int k0 = 1 + 7 * l;
        { PROBE_BEGIN(0)
        if (IN(k0 + 0)) { Params q; load_params(q, p); phase_norm1(q, l); }
        SYNC_AFTER(k0 + 0);
        PROBE_END(0) }
        { PROBE_BEGIN(1)
        if (IN(k0 + 1)) {
            Params q; load_params(q, p); unsigned char* ws = q.ws;
            {
                DenseGemmI8 g{ws + WS_BUF, ws + WS_WIN + (size_t)l * 2048 * 1024, 1024, (const float*)(ws + WS_RS), (const float*)(ws + WS_CS) + l * 2048};
                pg8::StaticOrder S; S.init(NTOK, 1536, G, (int)blockIdx.x);
                LAS float* gl = (LAS float*)(lds + pg8::STAGE_BYTES + 5120);
                { const int t_ = opaque_tid(); if (t_ < 128) gl[t_] = t_ < 64 ? q.in[9][l * 64 + t_] * (0.125f * LOG2E) : q.in[10][l * 64 + t_ - 64]; __syncthreads(); }
                EpiIn E{(bf16_t*)(ws + WS_U), (bf16_t*)(ws + WS_Q), (bf16_t*)(ws + WS_K), gl};
                pg8::gemm_phase(lds, g, S, E);
            }
            {
                DenseGemmI8 g{ws + WS_WIN + (size_t)l * 2048 * 1024 + (size_t)1536 * 1024, ws + WS_BUF, 1024, (const float*)(ws + WS_CS) + l * 2048 + 1536, (const float*)(ws + WS_RS)};
                pg8::StaticOrder S; S.init(512, NTOK, G, (int)blockIdx.x);
                EpiVt E{(bf16_t*)(ws + WS_V)};
                pg8::gemm_phase(lds, g, S, E);
            }
        }
        SYNC_AFTER(k0 + 1);
        PROBE_END(1) }
        { PROBE_BEGIN(2)
        if (IN(k0 + 2)) { Params q; load_params(q, p); phase_mixer(q, l, lds); }
        SYNC_AFTER(k0 + 2);
        PROBE_END(2) }
        { PROBE_BEGIN(3)
        if (IN(k0 + 3)) {
            Params q; load_params(q, p); unsigned char* ws = q.ws;
            DenseGemm8 g{ws + WS_BUF, ws + WS_WOUT + (size_t)l * 1024 * 1024, 1024, nullptr, nullptr};
            pg8::StaticOrder S; S.init(NTOK, 1024, G, (int)blockIdx.x);
            const float* g1p = (const float*)(ws + WS_MOD) + (size_t)(l * 4) * 6144 + 2048;
            if (l == 0) { EpiOutB<true> E{q.in[0], (bf16_t*)(ws + WS_XB), g1p, (float*)(ws + WS_SSQ)}; pg8::gemm_phase(lds, g, S, E); }
            else { EpiOutB<false> E{nullptr, (bf16_t*)(ws + WS_XB), g1p, (float*)(ws + WS_SSQ)}; pg8::gemm_phase(lds, g, S, E); }
        }
        SYNC_AFTER(k0 + 3);
        PROBE_END(3) }
        { PROBE_BEGIN(4)
        if (IN(k0 + 4)) { Params q; load_params(q, p); phase_route(q, l, lds); }
        SYNC_AFTER(k0 + 4);
        PROBE_END(4) }
        { PROBE_BEGIN(5)
        if (IN(k0 + 5)) {
            Params q; load_params(q, p); unsigned char* ws = q.ws;
            LAS int* pre = (LAS int*)(lds + pg8::STAGE_BYTES); LAS int* cntl = pre + 64;
            load_prefix(q, l, pre, cntl);
            const int cfirst = l == 0 ? 0 : T_DN + T_GU, ccount = l == 0 ? T_DN + SIDE_GU0 : T_DN;
            const SidePlan sp = side_plan(pre[NEXP] * 4, ccount);
            if (!sp.conv) {
                GatherGemm g{ws + WS_BUF, ws + WS_WGU + (size_t)l * NEXP * 1024 * 1024, (const u32x2*)(ws + WS_LIST2), 1024, 1, (size_t)1024 * 1024};
                pg8::GroupedOrder S{pre, cntl, sp.gp, sp.v};
                EpiGU E{ws + WS_ACT};
                pg8::gemm_phase(lds, g, S, E);
            }
            side_convert(q, lds, pre, cfirst, ccount, SIDE_CC_GU);
        }
        SYNC_AFTER(k0 + 5);
        PROBE_END(5) }
        { PROBE_BEGIN(6)
        if (IN(k0 + 6)) {
            Params q; load_params(q, p); unsigned char* ws = q.ws;
            LAS int* pre = (LAS int*)(lds + pg8::STAGE_BYTES); LAS int* cntl = pre + 64;
            load_prefix(q, l, pre, cntl);
            const int cfirst = T_DN + SIDE_GU0, ccount = l == 0 ? T_GU - SIDE_GU0 : 0;
            const SidePlan sp = side_plan(pre[NEXP] * 4, ccount);
            if (!sp.conv) {
                GatherGemm g{ws + WS_ACT, ws + WS_WD + (size_t)l * NEXP * 1024 * 512, (const u32x2*)(ws + WS_LIST2), 512, 0, (size_t)1024 * 512};
                pg8::GroupedOrder S{pre, cntl, sp.gp, sp.v};
                EpiDn E{(unsigned char*)(ws + WS_Y)};
                pg8::gemm_phase(lds, g, S, E);
            }
            if (ccount > 0) side_convert(q, lds, pre, cfirst, ccount, SIDE_CC_DN);
        }
        SYNC_AFTER(k0 + 6);
        PROBE_END(6) }
    }
    if (IN(15)) { Params q; load_params(q, p); phase_final(q, lds); }
#undef PROBE_BEGIN
#undef PROBE_END
#undef IN
#undef SYNC_AFTER
}

extern "C" void kernel_launch(void* const* d_in, const int* in_sizes, int n_in, void* d_out, int out_size, void* d_ws, size_t ws_size, hipStream_t stream) {
    static int grid = 0;
    if (grid == 0) {
        if (n_in != 20 || out_size != NTOK * DM || ws_size < WS_END) { fprintf(stderr, "kernel_launch: unexpected shapes (n_in %d out %d ws %zu)\n", n_in, out_size, ws_size); grid = -1; return; }
        int dev = 0, cus = 0, per_cu = 0;
        hipGetDevice(&dev);
        hipDeviceGetAttribute(&cus, hipDeviceAttributeMultiprocessorCount, dev);
        hipFuncSetAttribute((const void*)fwd_kernel, hipFuncAttributeMaxDynamicSharedMemorySize, LDS_BYTES);
        hipOccupancyMaxActiveBlocksPerMultiprocessor(&per_cu, (const void*)fwd_kernel, NTHREADS, LDS_BYTES);
        if (per_cu < 1) per_cu = 1;
        if (per_cu > 1) per_cu = 1;
        grid = cus * per_cu;
        (void)hipGetLastError();
    }
    if (grid < 0) return;
    if (hipMemsetAsync((char*)d_ws + WS_CTL, 0, 65536, stream) != hipSuccess) { fprintf(stderr, "memset failed\n"); return; }
    Params p{};
    for (int i = 0; i < 20; ++i) p.in[i] = (const float*)d_in[i];
    p.out = (float*)d_out; p.ws = (unsigned char*)d_ws; p.ph_lo = 0; p.ph_hi = 16;
    void* args[] = {&p};
    hipError_t e = hipLaunchCooperativeKernel((const void*)fwd_kernel, dim3(grid), dim3(NTHREADS), args, LDS_BYTES, stream);
    if (e != hipSuccess) fprintf(stderr, "cooperative launch failed: %s (grid %d)\n", hipGetErrorString(e), grid);
}
```

```cpp
#include <hip/hip_runtime.h>
#include <hip/hip_cooperative_groups.h>
#include <cstdio>
#include <cstdint>
namespace cg = cooperative_groups;

#define LAS __attribute__((address_space(3)))
typedef unsigned short bf16_t;
typedef short bf16x8 __attribute__((ext_vector_type(8)));
typedef float f32x4 __attribute__((ext_vector_type(4)));
typedef float f32x16 __attribute__((ext_vector_type(16)));
typedef unsigned u32x4 __attribute__((ext_vector_type(4)));
typedef int i32x4 __attribute__((ext_vector_type(4)));
typedef int i32x8 __attribute__((ext_vector_type(8)));
typedef unsigned u32x2 __attribute__((ext_vector_type(2)));
typedef float f32x2_t __attribute__((ext_vector_type(2)));
typedef __bf16 bf16x2_t __attribute__((ext_vector_type(2)));

constexpr int BATCH = 4, SEQ = 8192, DM = 1024, NTOK = BATCH * SEQ, DEPTH = 2;
constexpr int NHEAD = 8, HD = 64, NEXP = 32, DEXP = 512;
constexpr float EPS = 1e-6f;
constexpr float LOG2E = 1.4426950408889634f;

constexpr size_t MiB = 1u << 20;
constexpr size_t WS_CTL = 0;
constexpr size_t WS_MOD = 1 * MiB;
constexpr size_t WS_TBL = 1 * MiB + 512 * 1024;
constexpr size_t WS_RW = 2 * MiB;
constexpr size_t WS_RWB = 2 * MiB + 512 * 1024;
constexpr size_t WS_LIST = 3 * MiB;
constexpr size_t WS_EW = 7 * MiB;
constexpr size_t WS_WIN = 8 * MiB;
constexpr size_t WS_WOUT = 16 * MiB;
constexpr size_t WS_WGU = 20 * MiB;
constexpr size_t WS_WD = 148 * MiB;
constexpr size_t WS_BUF = 212 * MiB;
constexpr size_t WS_U = 276 * MiB;
constexpr size_t WS_Q = 308 * MiB;
constexpr size_t WS_K = 340 * MiB;
constexpr size_t WS_V = 372 * MiB;
constexpr size_t WS_Y = 276 * MiB;
constexpr size_t WS_ACT = 404 * MiB;
constexpr size_t WS_SSQ = 468 * MiB;
constexpr size_t WS_XB = 470 * MiB;
constexpr size_t WS_LIST2 = 534 * MiB;
constexpr size_t WS_RS = 542 * MiB;
constexpr size_t WS_CS = 543 * MiB;
constexpr size_t WS_END = 544 * MiB;

constexpr int LDS_BYTES = 163840;
constexpr int NWAVES = 8, NTHREADS = 512;

struct Params {
    const float* in[20];
    float* out;
    unsigned char* ws;
    int ph_lo, ph_hi;
};

__device__ __forceinline__ unsigned cvtpk(float lo, float hi) { f32x2_t v = {lo, hi}; bf16x2_t b = __builtin_convertvector(v, bf16x2_t); return __builtin_bit_cast(unsigned, b); }
__device__ __forceinline__ float bf_lo(unsigned w) { return __uint_as_float(w << 16); }
__device__ __forceinline__ float bf_hi(unsigned w) { return __uint_as_float(w & 0xffff0000u); }
__device__ __forceinline__ float fast_exp2(float x) { return __builtin_amdgcn_exp2f(x); }
__device__ __forceinline__ float fast_rcp(float x) { return __builtin_amdgcn_rcpf(x); }

__device__ __forceinline__ float clamp8(float x) { return __builtin_amdgcn_fmed3f(x, -448.0f, 448.0f); }
__device__ __forceinline__ unsigned pk_fp8x4(float a, float b, float c, float d) { int w = 0; w = __builtin_amdgcn_cvt_pk_fp8_f32(a, b, w, false); w = __builtin_amdgcn_cvt_pk_fp8_f32(c, d, w, true); return (unsigned)w; }
__device__ __forceinline__ unsigned pk_i8x4(float a, float b, float c, float d) {
    const unsigned ua = __float_as_uint(a + 12582912.0f), ub = __float_as_uint(b + 12582912.0f), uc = __float_as_uint(c + 12582912.0f), ud = __float_as_uint(d + 12582912.0f);
    return __builtin_amdgcn_perm(__builtin_amdgcn_perm(ud, uc, 0x0c0c0400u), __builtin_amdgcn_perm(ub, ua, 0x0c0c0400u), 0x05040100u);
}
__device__ __forceinline__ f32x4 i2f(const f32x4& a) { return __builtin_convertvector(__builtin_bit_cast(i32x4, a), f32x4); }
__device__ __forceinline__ float shx(float v, int k, int lane) { return __int_as_float(__builtin_amdgcn_ds_bpermute((lane ^ k) << 2, __float_as_int(v))); }
__device__ __forceinline__ unsigned bpx(unsigned v, int src_lane) { return (unsigned)__builtin_amdgcn_ds_bpermute(src_lane << 2, (int)v); }
__device__ __forceinline__ int opaque_tid() { int t = threadIdx.x; asm volatile("" : "+v"(t)); return t; }
__device__ __forceinline__ int opaque_bid() { int t = blockIdx.x; asm volatile("" : "+s"(t)); return t; }

namespace pg8 {
constexpr int BM = 256, BK = 64, HALF = 128, HTB = HALF * BK * 2, STAGE_BYTES = 8 * HTB, NXCD = 8, WGM = 8;
__host__ __device__ __forceinline__ int lds_byte(int r, int c) { const int st = (r >> 4) * 2 + (c >> 5), rr = r & 15, cc = c & 31, ob = rr * 64 + cc * 2; return st * 1024 + (ob ^ (((ob >> 9) & 1) << 5)); }
__host__ __device__ __forceinline__ void stage_rc(unsigned b, int& R, int& C) { const unsigned st = b >> 10, sb = b & 1023u, swz = sb ^ (((sb >> 9) & 1u) << 5); R = (int)((st >> 1) * 16u + (swz >> 6)); C = (int)((st & 1u) * 32u + ((swz & 63u) >> 1)); }
__host__ __device__ __forceinline__ int perm32(int rho) { const int n = rho >> 4, i = rho & 15; return 8 * (i >> 2) + 4 * n + (i & 3); }

struct Unit { int pm, pn, e, rows; };

struct StaticOrder {
    int nM, nN, nwg, G, c;
    __device__ void init(int M, int N, int G_, int c_) { nM = M / BM; nN = N / BM; nwg = nM * nN; G = G_; c = c_; }
    __device__ bool next(int i, Unit& u) const {
        const long L = (long)i * G + c; if (L >= nwg) return false;
        int wgid = (int)L; { const int q = nwg / NXCD, r = nwg % NXCD, xcd = wgid % NXCD, off = wgid / NXCD; wgid = (xcd < r ? xcd * (q + 1) : r * (q + 1) + (xcd - r) * q) + off; }
        const int nig = WGM * nN, gid = wgid / nig, fm = gid * WGM, gsz = (nM - fm) < WGM ? (nM - fm) : WGM;
        u.pm = fm + ((wgid % nig) % gsz); u.pn = (wgid % nig) / gsz; u.e = 0; u.rows = BM; return true;
    }
};

struct GroupedOrder {
    const LAS int* prefix; const LAS int* cnt; int G, v;
    __device__ bool next(int i, Unit& u) const {
        const int L = i * G + v; const int total = prefix[NEXP];
        if (L >= total * 4) return false;
        const int rt = L >> 2; int e = 0;
#pragma unroll 1
        for (int j = 1; j < NEXP; ++j) if (prefix[j] <= rt) e = j;
        u.e = e; u.pm = rt - prefix[e]; u.pn = L & 3; const int rem = cnt[e] - u.pm * BM; u.rows = rem < BM ? rem : BM; return true;
    }
};

template <class G, class Epi, class Sched>
__device__ __forceinline__ void gemm_phase(LAS unsigned char* lds, const G g, const Sched& S, const Epi& E) {
    int tid = threadIdx.x; asm volatile("" : "+v"(tid));
    const int wid = __builtin_amdgcn_readfirstlane(tid >> 6), lane = tid & 63, wr = wid >> 2, wc = wid & 3, fr = lane & 15, fq = lane >> 4;
    const int K = g.K, KB = K * G::ES, nt = KB / (BK * 2);
    unsigned voffB[2];
#pragma unroll
    for (int i = 0; i < 2; ++i) { int R, C; stage_rc(tid * 16 + i * 8192, R, C); const int Rb = Epi::PERM ? ((R & ~31) + perm32(R & 31)) : R;
        voffB[i] = (unsigned)(Rb * KB + C * 2); }
#define PG8_AOFF(u, i, h) ({ int t_ = tid; asm volatile("" : "+v"(t_)); int R_, C_; stage_rc((unsigned)t_ * 16u + (i) * 8192u, R_, C_); g.a_off(u, (h) * HALF + R_, C_); })
    const size_t kstep = (size_t)(BK * 2);
    const size_t hstep = (size_t)HALF * KB;
    const unsigned ldsw = (unsigned)wid * 1024u;
    const int aoff = lds_byte(wr * 64 + fr, fq * 8), boff = lds_byte(wc * 32 + fr, fq * 8);
#define PG8_SA(b, h) (((b) * 2 + (h)) * HTB)
#define PG8_SB(b, h) ((4 + (b) * 2 + (h)) * HTB)
#define PG8_STAGE2(bufoff, gbase, o0, o1) do { \
        __builtin_amdgcn_global_load_lds((const unsigned*)((const char*)(gbase) + (o0)), (LAS unsigned*)(lds + (bufoff) + ldsw), 16, 0, 0); \
        __builtin_amdgcn_global_load_lds((const unsigned*)((const char*)(gbase) + (o1)), (LAS unsigned*)(lds + (bufoff) + ldsw + 8192), 16, 0, 0); } while (0)
#define PG8_STAGEB(bufoff, gbase) PG8_STAGE2(bufoff, gbase, voffB[0], voffB[1])
#define PG8_LDA(dst, b, h) do { _Pragma("unroll") for (int m = 0; m < 4; ++m) _Pragma("unroll") for (int k = 0; k < 2; ++k) dst[m][k] = *(const LAS bf16x8*)(lds + PG8_SA(b, h) + aoff + m * 2048 + k * 1024); } while (0)
#define PG8_LDB(dst, b, h) do { _Pragma("unroll") for (int n = 0; n < 2; ++n) _Pragma("unroll") for (int k = 0; k < 2; ++k) dst[n][k] = *(const LAS bf16x8*)(lds + PG8_SB(b, h) + boff + n * 2048 + k * 1024); } while (0)
#define PG8_F8(v0, v1) __builtin_shufflevector(__builtin_bit_cast(i32x4, v0), __builtin_bit_cast(i32x4, v1), 0, 1, 2, 3, 4, 5, 6, 7)
#define PG8_MMA(ai, bj, At, Bt) do { __builtin_amdgcn_s_setprio(1); \
        if (G::MODE == 1) { const i32x8 a0_ = PG8_F8(At[0][0], At[0][1]), a1_ = PG8_F8(At[1][0], At[1][1]), a2_ = PG8_F8(At[2][0], At[2][1]), a3_ = PG8_F8(At[3][0], At[3][1]), b0_ = PG8_F8(Bt[0][0], Bt[0][1]), b1_ = PG8_F8(Bt[1][0], Bt[1][1]); \
            asm volatile("s_nop 1\n\tv_mfma_f32_16x16x128_f8f6f4 %0, %12, %8, %0\n\tv_mfma_f32_16x16x128_f8f6f4 %1, %13, %8, %1\n\tv_mfma_f32_16x16x128_f8f6f4 %2, %12, %9, %2\n\tv_mfma_f32_16x16x128_f8f6f4 %3, %13, %9, %3\n\t" \
                         "v_mfma_f32_16x16x128_f8f6f4 %4, %12, %10, %4\n\tv_mfma_f32_16x16x128_f8f6f4 %5, %13, %10, %5\n\tv_mfma_f32_16x16x128_f8f6f4 %6, %12, %11, %6\n\tv_mfma_f32_16x16x128_f8f6f4 %7, %13, %11, %7" \
                         : "+v"(acc[ai][bj][0][0]), "+v"(acc[ai][bj][0][1]), "+v"(acc[ai][bj][1][0]), "+v"(acc[ai][bj][1][1]), "+v"(acc[ai][bj][2][0]), "+v"(acc[ai][bj][2][1]), "+v"(acc[ai][bj][3][0]), "+v"(acc[ai][bj][3][1]) \
                         : "v"(a0_), "v"(a1_), "v"(a2_), "v"(a3_), "v"(b0_), "v"(b1_)); } \
        else if (G::MODE == 2) { _Pragma("unroll") for (int m = 0; m < 4; ++m) _Pragma("unroll") for (int n = 0; n < 2; ++n) _Pragma("unroll") for (int k = 0; k < 2; ++k) \
            acc[ai][bj][m][n] = __builtin_bit_cast(f32x4, __builtin_amdgcn_mfma_i32_16x16x64_i8(__builtin_bit_cast(i32x4, Bt[n][k]), __builtin_bit_cast(i32x4, At[m][k]), __builtin_bit_cast(i32x4, acc[ai][bj][m][n]), 0, 0, 0)); } \
        else { _Pragma("unroll") for (int m = 0; m < 4; ++m) _Pragma("unroll") for (int n = 0; n < 2; ++n) _Pragma("unroll") for (int k = 0; k < 2; ++k) \
            acc[ai][bj][m][n] = __builtin_amdgcn_mfma_f32_16x16x32_bf16(Bt[n][k], At[m][k], acc[ai][bj][m][n], 0, 0, 0); } __builtin_amdgcn_s_setprio(0); } while (0)
#define PG8_WAIT_V(n) asm volatile("s_waitcnt vmcnt(" #n ")" ::: "memory")
#define PG8_WAIT_L(n) asm volatile("s_waitcnt lgkmcnt(" #n ")" ::: "memory")
#define PG8_BAR __builtin_amdgcn_s_barrier()
#define PG8_SCHED __builtin_amdgcn_sched_barrier(0)
    Unit cur, nxt; int ui = 0;
    if (!S.next(0, cur)) return;
    LAS u32x2* const tab = (LAS u32x2*)(lds + STAGE_BYTES + 1024);
#define PG8_TABLE(u, par) do { if (G::TABLE) { if (wid < 2) { const unsigned long long ts_ = (unsigned long long)g.tab_src(u, wid); \
        const char* tb_ = (const char*)(((unsigned long long)(unsigned)__builtin_amdgcn_readfirstlane((int)(ts_ >> 32)) << 32) | (unsigned)__builtin_amdgcn_readfirstlane((int)ts_));     \
        unsigned lo_ = (unsigned)lane * 16u; asm volatile("" : "+v"(lo_));     \
        __builtin_amdgcn_global_load_lds((const unsigned*)(tb_ + lo_), (LAS unsigned*)((LAS unsigned char*)tab + (par) * 2048 + wid * 1024), 16, 0, 0); } } } while (0)
    PG8_TABLE(cur, 0);
    f32x4 acc[2][2][4][2];
#pragma unroll
    for (int a = 0; a < 2; ++a)
#pragma unroll
        for (int b = 0; b < 2; ++b)
#pragma unroll
            for (int m = 0; m < 4; ++m)
#pragma unroll
                for (int n = 0; n < 2; ++n) acc[a][b][m][n] = (f32x4){0.f, 0.f, 0.f, 0.f};
    bf16x8 At[4][2], B0[2][2], B1[2][2];
    const char* cA = g.a_base(cur); const char* cB = g.b_base(cur);
    unsigned c00 = PG8_AOFF(cur, 0, 0), c01 = PG8_AOFF(cur, 1, 0), c10 = PG8_AOFF(cur, 0, 1), c11 = PG8_AOFF(cur, 1, 1);
    PG8_STAGEB(PG8_SB(0, 0), cB); PG8_STAGEB(PG8_SB(0, 1), cB + hstep); PG8_STAGE2(PG8_SA(0, 0), cA, c00, c01); PG8_STAGE2(PG8_SA(0, 1), cA, c10, c11);
    if (wr == 1) PG8_BAR;
    PG8_WAIT_V(2); PG8_BAR;
    PG8_STAGEB(PG8_SB(1, 0), cB + kstep); PG8_STAGE2(PG8_SA(1, 0), cA + kstep, c00, c01); PG8_STAGEB(PG8_SB(1, 1), cB + hstep + kstep);
    PG8_WAIT_V(6); PG8_BAR;
    for (;;) {
        const bool has_next = S.next(ui + 1, nxt);
        const char* nA = has_next ? g.a_base(nxt) : cA; const char* nB = has_next ? g.b_base(nxt) : cB;
        unsigned n00 = c00, n01 = c01, n10 = c10, n11 = c11;
        if (G::GATHER && has_next) { n00 = PG8_AOFF(nxt, 0, 0); n01 = PG8_AOFF(nxt, 1, 0); n10 = PG8_AOFF(nxt, 0, 1); n11 = PG8_AOFF(nxt, 1, 1); }
#pragma unroll 1
        for (int t = 0; t < nt; t += 2) {
            const bool last = (t == nt - 2);
            const char* a1 = cA + (size_t)(t + 1) * kstep;
            const char* a2 = last ? nA : cA + (size_t)(t + 2) * kstep; const char* b2 = last ? nB : cB + (size_t)(t + 2) * kstep;
            const char* a3 = a2 + kstep; const char* b3 = b2 + kstep;
            const unsigned x00 = last ? n00 : c00, x01 = last ? n01 : c01, x10 = last ? n10 : c10, x11 = last ? n11 : c11;
            PG8_LDB(B0, 0, 0); PG8_LDB(B1, 0, 1); PG8_SCHED; PG8_LDA(At, 0, 0); PG8_STAGE2(PG8_SA(1, 1), a1, c10, c11);
            PG8_WAIT_V(8); PG8_WAIT_L(0); PG8_BAR; PG8_MMA(0, 0, At, B0); PG8_MMA(0, 1, At, B1); PG8_BAR; PG8_SCHED;
            PG8_LDA(At, 0, 1); PG8_STAGEB(PG8_SB(0, 0), b2); PG8_STAGEB(PG8_SB(0, 1), b2 + hstep); PG8_STAGE2(PG8_SA(0, 0), a2, x00, x01);
            PG8_WAIT_V(8); PG8_WAIT_L(0); PG8_BAR; PG8_MMA(1, 0, At, B0); PG8_MMA(1, 1, At, B1); PG8_BAR; PG8_SCHED;
            PG8_LDB(B0, 1, 0); PG8_LDB(B1, 1, 1); PG8_SCHED; PG8_LDA(At, 1, 0); PG8_STAGE2(PG8_SA(0, 1), a2, x10, x11);
            PG8_WAIT_V(8); PG8_WAIT_L(0); PG8_BAR; PG8_MMA(0, 0, At, B0); PG8_MMA(0, 1, At, B1); PG8_BAR; PG8_SCHED;
            PG8_LDA(At, 1, 1); PG8_STAGEB(PG8_SB(1, 0), b3); PG8_STAGEB(PG8_SB(1, 1), b3 + hstep); PG8_STAGE2(PG8_SA(1, 0), a3, x00, x01);
            PG8_WAIT_V(8); PG8_WAIT_L(0); PG8_BAR; PG8_MMA(1, 0, At, B0); PG8_MMA(1, 1, At, B1); PG8_BAR; PG8_SCHED;
        }
        if (G::MODE == 1) asm volatile("s_nop 15\n\ts_nop 15" ::: "memory");
        if (wr == 0) PG8_BAR;
        E(acc, cur, wr, wc, fr, fq, tab + (ui & 1) * 256);
        if (!has_next) break;
#pragma unroll
        for (int a = 0; a < 2; ++a)
#pragma unroll
            for (int b = 0; b < 2; ++b)
#pragma unroll
                for (int m = 0; m < 4; ++m)
#pragma unroll
                    for (int n = 0; n < 2; ++n) acc[a][b][m][n] = (f32x4){0.f, 0.f, 0.f, 0.f};
        cur = nxt; cA = nA; cB = nB; c00 = n00; c01 = n01; c10 = n10; c11 = n11; ++ui;
        PG8_TABLE(cur, ui & 1);
        if (wr == 1) PG8_BAR;
    }
    PG8_WAIT_V(0);
    PG8_BAR;
#undef PG8_TABLE
#undef PG8_AOFF
#undef PG8_SA
#undef PG8_SB
#undef PG8_STAGE2
#undef PG8_STAGEB
#undef PG8_LDA
#undef PG8_LDB
#undef PG8_MMA
#undef PG8_F8
#undef PG8_WAIT_V
#undef PG8_WAIT_L
#undef PG8_BAR
#undef PG8_SCHED
}
}
using pg8::Unit;

template <int MODE_>
struct DenseGemmT {
    static constexpr bool GATHER = false, TABLE = MODE_ == 2; static constexpr int MODE = MODE_, ES = MODE_ == 0 ? 2 : 1;
    const void* A; const void* Bt; int K; const float* sA; const float* sB;
    __device__ __forceinline__ const char* tab_src(const Unit& u, int w) const { return (const char*)(w == 0 ? sA + u.pm * 256 : sB + u.pn * 256); }
    __device__ __forceinline__ const char* a_base(const Unit& u) const { return (const char*)A + (size_t)u.pm * 256 * K * ES; }
    __device__ __forceinline__ const char* b_base(const Unit& u) const { return (const char*)Bt + (size_t)u.pn * 256 * K * ES; }
    __device__ __forceinline__ unsigned a_off(const Unit&, int r, int c) const { return (unsigned)(r * K * ES + c * 2); }
};
typedef DenseGemmT<0> DenseGemm;
typedef DenseGemmT<2> DenseGemmI8;
typedef DenseGemmT<1> DenseGemm8;
struct GatherGemm {
    static constexpr bool GATHER = true, TABLE = true; static constexpr int MODE = 1, ES = 1;
    const unsigned char* A; const unsigned char* Bt; const u32x2* list; int K; int a_shift;
    size_t b_expert_stride;
    __device__ __forceinline__ const char* tab_src(const Unit& u, int w) const { return (const char*)(list + (size_t)u.e * NTOK + u.pm * 256) + w * 1024; }
    __device__ __forceinline__ const char* a_base(const Unit&) const { return (const char*)A; }
    __device__ __forceinline__ const char* b_base(const Unit& u) const { return (const char*)Bt + (size_t)u.e * b_expert_stride + (size_t)u.pn * 256 * K; }
    __device__ __forceinline__ unsigned a_off(const Unit& u, int r, int c) const {
        const int rr = r < u.rows ? r : u.rows - 1;
        const int slot = (int)list[(size_t)u.e * NTOK + u.pm * 256 + rr].x;
        return (unsigned)((slot >> a_shift) * K + c * 2);
    }
};


struct EpiIn {
    static constexpr bool PERM = true;
    bf16_t* U; bf16_t* Qf; bf16_t* Kf; const LAS float* gl;
    __device__ __forceinline__ void operator()(const f32x4 (&acc)[2][2][4][2], const Unit& u, int wr, int wc, int fr, int fq, const LAS u32x2* tab) const {
        const LAS float* tf = (const LAS float*)tab;
        const int cix = 256 + wc * 32 + fq * 8;
        if (u.pn < 2) {
#pragma unroll
            for (int ai = 0; ai < 2; ++ai)
#pragma unroll
                for (int m = 0; m < 4; ++m) {
                    int z = 0; asm volatile("" : "+v"(z));
                    const int r = ai * 128 + wr * 64 + m * 16 + fr;
                    const float rr = tf[r + z];
                    const int row = u.pm * 256 + r;
#pragma unroll
                    for (int bj = 0; bj < 2; ++bj) {
                        const f32x4 c0 = *(const LAS f32x4*)(tf + cix + bj * 128 + z), c1 = *(const LAS f32x4*)(tf + cix + bj * 128 + 4 + z);
                        const f32x4 v0 = i2f(acc[ai][bj][m][0]) * c0 * rr, v1 = i2f(acc[ai][bj][m][1]) * c1 * rr;
                        u32x4 w; w.x = cvtpk(v0[0], v0[1]); w.y = cvtpk(v0[2], v0[3]); w.z = cvtpk(v1[0], v1[1]); w.w = cvtpk(v1[2], v1[3]);
                        *(u32x4*)(U + (size_t)row * 512 + u.pn * 256 + bj * 128 + wc * 32 + fq * 8) = w;
                    }
                }
        } else {
            const bool isq = u.pn < 4;
            bf16_t* dst = isq ? Qf : Kf;
            const LAS float* gg = gl + (isq ? 0 : 64) + fq * 8;
            const int head = (u.pn & 1) * 4 + wc;
#pragma unroll
            for (int ai = 0; ai < 2; ++ai)
#pragma unroll
                for (int m = 0; m < 4; ++m) {
                    int z = 0; asm volatile("" : "+v"(z));
                    const int r = ai * 128 + wr * 64 + m * 16 + fr;
                    const float rr = tf[r + z];
                    f32x4 val[2][2];
                    float ss = 0.f;
#pragma unroll
                    for (int bj = 0; bj < 2; ++bj)
#pragma unroll
                        for (int n = 0; n < 2; ++n) { const f32x4 v = i2f(acc[ai][bj][m][n]) * *(const LAS f32x4*)(tf + cix + bj * 128 + n * 4 + z); val[bj][n] = v; ss += (v[0] * v[0] + v[1] * v[1]) + (v[2] * v[2] + v[3] * v[3]); }
                    ss += shx(ss, 16, fq * 16 + fr); ss += shx(ss, 32, fq * 16 + fr);
                    const float rstd = rsqrtf(ss * (rr * rr) * (1.0f / 64.0f) + EPS) * rr;
                    const int row = u.pm * 256 + r;
                    const int b = row >> 13, s = row & (SEQ - 1), rb = s >> 5, r32 = s & 31;
#pragma unroll
                    for (int bj = 0; bj < 2; ++bj) {
                        const f32x4 v0 = val[bj][0] * rstd * *(const LAS f32x4*)(gg + bj * 32 + z), v1 = val[bj][1] * rstd * *(const LAS f32x4*)(gg + bj * 32 + 4 + z);
                        u32x4 w; w.x = cvtpk(v0[0], v0[1]); w.y = cvtpk(v0[2], v0[3]); w.z = cvtpk(v1[0], v1[1]); w.w = cvtpk(v1[2], v1[3]);
                        const int d0 = 2 * bj + (fq >> 1), hi = fq & 1;
                        const size_t piece = (((size_t)(b * NHEAD + head) * 256 + rb) * 4 + d0);
                        *(u32x4*)(dst + (piece * 64 + hi * 32 + r32) * 8) = w;
                    }
                }
        }
    }
};

struct EpiVt {
    static constexpr bool PERM = true;
    bf16_t* Vf;
    __device__ __forceinline__ void operator()(const f32x4 (&acc)[2][2][4][2], const Unit& u, int wr, int wc, int fr, int fq, const LAS u32x2* tab) const {
        const LAS float* tf = (const LAS float*)tab;
        f32x4 rv[2][2];
#pragma unroll
        for (int bj = 0; bj < 2; ++bj)
#pragma unroll
            for (int n = 0; n < 2; ++n) rv[bj][n] = *(const LAS f32x4*)(tf + 256 + bj * 128 + wc * 32 + fq * 8 + n * 4);
#pragma unroll
        for (int ai = 0; ai < 2; ++ai)
#pragma unroll
            for (int m = 0; m < 4; ++m) {
                const int r = ai * 128 + wr * 64 + m * 16 + fr;
                const float cc = tf[r];
                const int hd = u.pm * 256 + r;
                const int head = hd >> 6, dblk = (hd >> 5) & 1, dl = hd & 31;
#pragma unroll
                for (int bj = 0; bj < 2; ++bj) {
                    const int tok0 = u.pn * 256 + bj * 128 + wc * 32;
                    const int b = tok0 >> 13, kb = (tok0 & (SEQ - 1)) >> 5;
                    const size_t piece = ((((size_t)(b * NHEAD + head) * 256 + kb) * 2 + (fq >> 1)) * 2 + dblk);
                    u32x2 w[2];
#pragma unroll
                    for (int n = 0; n < 2; ++n) { const f32x4 v = i2f(acc[ai][bj][m][n]) * rv[bj][n] * cc; w[n].x = cvtpk(v[0], v[1]); w[n].y = cvtpk(v[2], v[3]); }
                    const int odd = fq & 1, partner = (fq ^ 1) * 16 + fr;
                    const u32x2 snd = odd ? w[0] : w[1];
                    u32x2 rcv; rcv.x = bpx(snd.x, partner); rcv.y = bpx(snd.y, partner);
                    u32x4 o4; if (odd) { o4.x = rcv.x; o4.y = rcv.y; o4.z = w[1].x; o4.w = w[1].y; } else { o4.x = w[0].x; o4.y = w[0].y; o4.z = rcv.x; o4.w = rcv.y; }
                    *(u32x4*)((char*)Vf + (piece * 64 + odd * 32 + dl) * 16) = o4;
                }
            }
    }
};

template <bool XF>
struct EpiOutB {
    static constexpr bool PERM = true;
    const float* xf; bf16_t* XB; const float* g1; float* ssq;
    __device__ __forceinline__ void operator()(const f32x4 (&acc)[2][2][4][2], const Unit& u, int wr, int wc, int fr, int fq, const LAS u32x2* tab) const {
        const int b = (u.pm * 256) >> 13;
        const int col0 = u.pn * 256 + wc * 32 + 8 * fq;
        f32x4 gv[2][2];
#pragma unroll
        for (int bj = 0; bj < 2; ++bj)
#pragma unroll
            for (int n = 0; n < 2; ++n) gv[bj][n] = *(const f32x4*)(g1 + (size_t)b * 6144 + col0 + bj * 128 + n * 4) * (1.0f / 4096.0f);
        float keep = 0.f;
#pragma unroll
        for (int ai = 0; ai < 2; ++ai)
#pragma unroll
            for (int m = 0; m < 4; ++m) {
                const int row = u.pm * 256 + ai * 128 + wr * 64 + m * 16 + fr;
                const size_t off = (size_t)row * DM + col0;
                f32x4 xb[2][2];
                if (XF) {
#pragma unroll
                    for (int bj = 0; bj < 2; ++bj) { xb[bj][0] = *(const f32x4*)(xf + off + bj * 128); xb[bj][1] = *(const f32x4*)(xf + off + bj * 128 + 4); }
                } else {
#pragma unroll
                    for (int bj = 0; bj < 2; ++bj) { const u32x4 w = *(const u32x4*)(XB + off + bj * 128);
                        xb[bj][0] = (f32x4){bf_lo(w.x), bf_hi(w.x), bf_lo(w.y), bf_hi(w.y)}; xb[bj][1] = (f32x4){bf_lo(w.z), bf_hi(w.z), bf_lo(w.w), bf_hi(w.w)}; }
                }
                float ss = 0.f;
#pragma unroll
                for (int bj = 0; bj < 2; ++bj) {
                    const f32x4 x0 = xb[bj][0] + gv[bj][0] * acc[ai][bj][m][0], x1 = xb[bj][1] + gv[bj][1] * acc[ai][bj][m][1];
                    u32x4 w; w.x = cvtpk(x0[0], x0[1]); w.y = cvtpk(x0[2], x0[3]); w.z = cvtpk(x1[0], x1[1]); w.w = cvtpk(x1[2], x1[3]);
                    *(u32x4*)(XB + off + bj * 128) = w;
                    const float r0 = bf_lo(w.x), r1 = bf_hi(w.x), r2 = bf_lo(w.y), r3 = bf_hi(w.y), r4 = bf_lo(w.z), r5 = bf_hi(w.z), r6 = bf_lo(w.w), r7 = bf_hi(w.w);
                    ss += ((r0 * r0 + r1 * r1) + (r2 * r2 + r3 * r3)) + ((r4 * r4 + r5 * r5) + (r6 * r6 + r7 * r7));
                }
                ss += shx(ss, 16, fq * 16 + fr); ss += shx(ss, 32, fq * 16 + fr);
                if (fq == m) keep = ss;
                if (m == 3) ssq[(size_t)(u.pn * 4 + wc) * NTOK + u.pm * 256 + ai * 128 + wr * 64 + fq * 16 + fr] = keep;
            }
    }
};

struct EpiGU {
    static constexpr bool PERM = true;
    unsigned char* ACT;
    __device__ __forceinline__ void operator()(const f32x4 (&acc)[2][2][4][2], const Unit& u, int wr, int wc, int fr, int fq, const LAS u32x2* tab) const {
        constexpr float SI = 1.0f / 2048.0f;
        const int odd = fq & 1, partner = (fq ^ 1) * 16 + fr;
#pragma unroll
        for (int ai = 0; ai < 2; ++ai)
#pragma unroll
            for (int mp = 0; mp < 2; ++mp) {
                u32x2 w[2];
#pragma unroll
                for (int h = 0; h < 2; ++h) {
                    const int m = 2 * mp + h;
                    float o[8];
#pragma unroll
                    for (int n = 0; n < 2; ++n)
#pragma unroll
                        for (int e = 0; e < 4; ++e) { const float gte = acc[ai][0][m][n][e] * SI, up = acc[ai][1][m][n][e] * (4.0f * SI);
                            o[n * 4 + e] = clamp8(gte * fast_rcp(1.0f + fast_exp2(-gte * LOG2E)) * up); }
                    w[h].x = pk_fp8x4(o[0], o[1], o[2], o[3]); w[h].y = pk_fp8x4(o[4], o[5], o[6], o[7]);
                }
                const u32x2 snd = odd ? w[0] : w[1];
                u32x2 rcv; rcv.x = bpx(snd.x, partner); rcv.y = bpx(snd.y, partner);
                const int r = ai * 128 + wr * 64 + (2 * mp + odd) * 16 + fr;
                const int slot = (int)tab[r].x;
                u32x4 o4; if (odd) { o4.x = rcv.x; o4.y = rcv.y; o4.z = w[1].x; o4.w = w[1].y; } else { o4.x = w[0].x; o4.y = w[0].y; o4.z = rcv.x; o4.w = rcv.y; }
                if (r < u.rows) *(u32x4*)(ACT + (size_t)slot * DEXP + u.pn * 128 + wc * 32 + (fq & 2) * 8) = o4;
            }
    }
};

struct EpiDn {
    static constexpr bool PERM = true;
    unsigned char* Y8;
    __device__ __forceinline__ void operator()(const f32x4 (&acc)[2][2][4][2], const Unit& u, int wr, int wc, int fr, int fq, const LAS u32x2* tab) const {
        const int odd = fq & 1, partner = (fq ^ 1) * 16 + fr;
#pragma unroll
        for (int ai = 0; ai < 2; ++ai)
#pragma unroll
            for (int m = 0; m < 4; ++m) {
                const int r = ai * 128 + wr * 64 + m * 16 + fr;
                const u32x2 en = tab[r];
                const int slot = (int)en.x;
                const float w8 = __uint_as_float(en.y) * (16.0f / 1024.0f);
                u32x2 w[2];
#pragma unroll
                for (int bj = 0; bj < 2; ++bj) {
                    const f32x4 v0 = acc[ai][bj][m][0] * w8, v1 = acc[ai][bj][m][1] * w8;
                    w[bj].x = pk_fp8x4(v0[0], v0[1], v0[2], v0[3]); w[bj].y = pk_fp8x4(v1[0], v1[1], v1[2], v1[3]);
                }
                const u32x2 snd = odd ? w[0] : w[1];
                u32x2 rcv; rcv.x = bpx(snd.x, partner); rcv.y = bpx(snd.y, partner);
                u32x4 o4; if (odd) { o4.x = rcv.x; o4.y = rcv.y; o4.z = w[1].x; o4.w = w[1].y; } else { o4.x = w[0].x; o4.y = w[0].y; o4.z = rcv.x; o4.w = rcv.y; }
                if (r < u.rows) *(u32x4*)(Y8 + (size_t)slot * DM + u.pn * 256 + odd * 128 + wc * 32 + (fq & 2) * 8) = o4;
            }
    }
};

struct TItem { const float* src; unsigned char* dst; int N, dstK, koff, k0, n0, map, f8; };
__device__ __forceinline__ int t_rowmap(int map, int n) {
    if (map == 0) return n;
    if (map == 1) { if (n < 512 || n >= 1536) return n; const int t = n & 255, wc = t >> 6, bj = (t >> 5) & 1, c = t & 31; return (n & ~255) + 128 * bj + 32 * wc + c; }
    return 256 * (n >> 7) + 128 * (map - 2) + (n & 127);
}
__device__ __forceinline__ void t_load(const TItem& d, f32x4 (&v)[16], int lane) {
    const int kr = lane >> 4, c4 = lane & 15;
#pragma unroll
    for (int i = 0; i < 16; ++i) v[i] = *(const f32x4*)(d.src + (size_t)(d.k0 + 4 * i + kr) * d.N + d.n0 + 4 * c4);
}
__device__ __forceinline__ void t_process(const TItem& d, const f32x4 (&v)[16], LAS float* scr, int lane) {
    const int kr = lane >> 4, c4 = lane & 15;
#pragma unroll
    for (int i = 0; i < 16; ++i) { LAS float* s = scr + (4 * i + kr) * 65 + 4 * c4; s[0] = v[i][0]; s[1] = v[i][1]; s[2] = v[i][2]; s[3] = v[i][3]; }
    asm volatile("s_waitcnt lgkmcnt(0)" ::: "memory");
    if (d.f8) {
        const int nr = lane >> 2, kc = lane & 3;
#pragma unroll
        for (int i = 0; i < 4; ++i) { const int n = 16 * i + nr; const LAS float* s = scr + (16 * kc) * 65 + n;
            const size_t eo = (size_t)t_rowmap(d.map, d.n0 + n) * d.dstK + d.koff + d.k0 + 16 * kc;
            u32x4 o;
            if (d.f8 == 2) { o.x = pk_i8x4(s[0], s[65], s[2 * 65], s[3 * 65]); o.y = pk_i8x4(s[4 * 65], s[5 * 65], s[6 * 65], s[7 * 65]);
                o.z = pk_i8x4(s[8 * 65], s[9 * 65], s[10 * 65], s[11 * 65]); o.w = pk_i8x4(s[12 * 65], s[13 * 65], s[14 * 65], s[15 * 65]); }
            else { o.x = pk_fp8x4(s[0] * 256.0f, s[65] * 256.0f, s[2 * 65] * 256.0f, s[3 * 65] * 256.0f); o.y = pk_fp8x4(s[4 * 65] * 256.0f, s[5 * 65] * 256.0f, s[6 * 65] * 256.0f, s[7 * 65] * 256.0f);
                o.z = pk_fp8x4(s[8 * 65] * 256.0f, s[9 * 65] * 256.0f, s[10 * 65] * 256.0f, s[11 * 65] * 256.0f); o.w = pk_fp8x4(s[12 * 65] * 256.0f, s[13 * 65] * 256.0f, s[14 * 65] * 256.0f, s[15 * 65] * 256.0f); }
            *(u32x4*)(d.dst + eo) = o; }
    } else {
        const int nr = lane >> 3, kc = lane & 7;
#pragma unroll
        for (int i = 0; i < 8; ++i) { const int n = 8 * i + nr; const LAS float* s = scr + (8 * kc) * 65 + n;
            const size_t eo = (size_t)t_rowmap(d.map, d.n0 + n) * d.dstK + d.koff + d.k0 + 8 * kc;
            u32x4 o; o.x = cvtpk(s[0], s[65]); o.y = cvtpk(s[2 * 65], s[3 * 65]); o.z = cvtpk(s[4 * 65], s[5 * 65]); o.w = cvtpk(s[6 * 65], s[7 * 65]);
            *(u32x4*)(d.dst + eo * 2) = o; }
    }
    asm volatile("s_waitcnt lgkmcnt(0)" ::: "memory");
}
constexpr int T_OUT = 128, T_GU = NEXP * 256, T_DN = NEXP * 128;
constexpr int SIDE_GU0 = 2048, SIDE_CC_GU = 130, SIDE_CC_DN = 90;
constexpr int T_NA = 2 * T_OUT + T_GU, T_NB = T_DN + T_GU + T_DN;
__device__ __forceinline__ void t_item_out(const Params& p, int l, int r, TItem& d) {
    d.src = p.in[12] + ((size_t)l * 1024 + 512) * 1024; d.N = 1024; d.f8 = 1; d.dst = p.ws + WS_WOUT + (size_t)l * 1024 * 1024; d.dstK = 1024; d.koff = 512; d.k0 = (r >> 4) * 64; d.n0 = (r & 15) * 64; d.map = 0;
}
__device__ __forceinline__ void t_item_gu(const Params& p, int l, int j, TItem& d) {
    const int e = j >> 8; int q = j & 255; const int up = q >> 7; q &= 127;
    d.src = (up ? p.in[18] : p.in[17]) + ((size_t)l * NEXP + e) * 1024 * 512; d.N = 512; d.f8 = 1; d.dst = p.ws + WS_WGU + ((size_t)l * NEXP + e) * 1024 * 1024; d.dstK = 1024; d.koff = 0; d.k0 = (q >> 3) * 64; d.n0 = (q & 7) * 64; d.map = 2 + up;
}
__device__ __forceinline__ void t_item_dn(const Params& p, int l, int j, TItem& d) {
    const int e = j >> 7, q = j & 127;
    d.src = p.in[19] + ((size_t)l * NEXP + e) * 512 * 1024; d.N = 1024; d.f8 = 1; d.dst = p.ws + WS_WD + ((size_t)l * NEXP + e) * 1024 * 512; d.dstK = 512; d.koff = 0; d.k0 = (q >> 4) * 64; d.n0 = (q & 15) * 64; d.map = 0;
}
template <bool SPACE_B>
__device__ __forceinline__ void t_decode(const Params& p, int it, TItem& d) {
    if (SPACE_B) { if (it < T_DN) t_item_dn(p, 0, it, d); else if (it < T_DN + T_GU) t_item_gu(p, 1, it - T_DN, d); else t_item_dn(p, 1, it - T_DN - T_GU, d); }
    else { if (it < T_OUT) t_item_out(p, 0, it, d); else if (it < 2 * T_OUT) t_item_out(p, 1, it - T_OUT, d); else t_item_gu(p, 0, it - 2 * T_OUT, d); }
}
template <bool SPACE_B>
__device__ __forceinline__ void t_run(const Params& p, int it, int stride, int nit, LAS float* scr, int lane) {
    if (it >= nit) return;
    TItem dA, dB; f32x4 vA[16], vB[16];
    t_decode<SPACE_B>(p, it, dA); t_load(dA, vA, lane);
    for (;;) {
        int nx = it + stride; const bool hasB = nx < nit;
        if (hasB) { t_decode<SPACE_B>(p, nx, dB); t_load(dB, vB, lane); }
        t_process(dA, vA, scr, lane);
        if (!hasB) break;
        it = nx + stride; const bool hasA = it < nit;
        if (hasA) { t_decode<SPACE_B>(p, it, dA); t_load(dA, vA, lane); }
        t_process(dB, vB, scr, lane);
        if (!hasA) break;
    }
}
struct SidePlan { int gp, v, nconv, cidx; bool conv; };
__device__ __forceinline__ SidePlan side_plan(int total_units, int count) {
    const int G = gridDim.x, bid = blockIdx.x;
    SidePlan s; s.gp = G; s.v = (G % 8 == 0) ? (bid % 8) * (G / 8) + bid / 8 : bid; s.nconv = 0; s.cidx = 0; s.conv = false;
    if (G % 8 == 0 && count > 0 && total_units > 0) {
        const int rounds = (total_units + G - 1) / G, need = (total_units + rounds - 1) / rounds;
        const int cpx = (G - need) / 8, per = G / 8 - cpx;
        if (cpx > 0) { s.gp = 8 * per; s.nconv = 8 * cpx; s.conv = bid / 8 >= per; s.v = (bid % 8) * per + bid / 8; s.cidx = (bid / 8 - per) * 8 + bid % 8; }
    }
    return s;
}
__device__ __forceinline__ void side_convert(const Params& p, LAS unsigned char* lds, const LAS int* pre, int first, int count, int cc) {
    const int tid = opaque_tid(), lane = tid & 63, wave = tid >> 6, G = gridDim.x;
    const SidePlan s = side_plan(pre[NEXP] * 4, count);
    int p1 = s.nconv * cc; if (p1 > count) p1 = count;
    __syncthreads();
    LAS float* scr = (LAS float*)(lds + wave * 16640);
    if (s.conv) t_run<true>(p, first + s.cidx + s.nconv * wave, s.nconv * NWAVES, first + p1, scr, lane);
    t_run<true>(p, first + p1 + (int)blockIdx.x + G * wave, G * NWAVES, first + count, scr, lane);
    __syncthreads();
}

__device__ __forceinline__ void phase_prologue(const Params& p, LAS unsigned char* lds) {
    const int tid = opaque_tid(), lane = tid & 63, wave = tid >> 6, G = gridDim.x;
    unsigned char* ws = p.ws;
    {
        LAS float* cact = (LAS float*)lds;
        LAS float* red = (LAS float*)(lds + 16384);
        const float* c = p.in[1];
        for (int i = tid; i < 4096; i += NTHREADS) { const float v = c[i]; cact[i] = v / (1.0f + __expf(-v)); }
        __syncthreads();
        float* mod = (float*)(ws + WS_MOD);
        for (int item = blockIdx.x; item < 2 * 192; item += G) {
            const int l = item / 192, cgp = item % 192;
            const float* W = p.in[2] + (size_t)l * 1024 * 6144 + cgp * 32;
            const int c4 = lane & 7, rr = lane >> 3;
            f32x4 wv[16];
#pragma unroll
            for (int i = 0; i < 16; ++i) wv[i] = *(const f32x4*)(W + (size_t)(wave * 128 + 8 * i + rr) * 6144 + 4 * c4);
            f32x4 a[4];
#pragma unroll
            for (int bb = 0; bb < 4; ++bb) a[bb] = (f32x4){0.f, 0.f, 0.f, 0.f};
#pragma unroll
            for (int i = 0; i < 16; ++i) { const int k = wave * 128 + 8 * i + rr;
#pragma unroll
                for (int bb = 0; bb < 4; ++bb) a[bb] += wv[i] * cact[bb * 1024 + k]; }
#pragma unroll
            for (int bb = 0; bb < 4; ++bb)
#pragma unroll
                for (int e = 0; e < 4; ++e) { float s = a[bb][e]; s += shx(s, 8, lane); s += shx(s, 16, lane); s += shx(s, 32, lane); a[bb][e] = s; }
            if (lane < 8) {
#pragma unroll
                for (int bb = 0; bb < 4; ++bb) *(LAS f32x4*)(red + (wave * 4 + bb) * 32 + 4 * c4) = a[bb];
            }
            __syncthreads();
            if (tid < 128) { const int b = tid >> 5, cc = tid & 31; float s = 0.f;
#pragma unroll
                for (int w = 0; w < 8; ++w) s += red[(w * 4 + b) * 32 + cc];
                mod[(size_t)(l * 4 + b) * 6144 + cgp * 32 + cc] = s + p.in[3][l * 6144 + cgp * 32 + cc]; }
            __syncthreads();
        }
    }
    {
        float* tbl = (float*)(ws + WS_TBL);
        for (int job = blockIdx.x; job < 2; job += G) {
            const int l = job;
            LAS float* sm = (LAS float*)(lds + 32768);
            float mq = 0.f, mk = 0.f, mb = 0.f;
            if (tid < 64) { mq = fabsf(p.in[9][l * 64 + tid]); mk = fabsf(p.in[10][l * 64 + tid]); }
            for (int i = tid; i < NHEAD * 257; i += NTHREADS) mb = fmaxf(mb, fabsf(p.in[11][i]));
#pragma unroll
            for (int o = 1; o < 64; o <<= 1) { mq = fmaxf(mq, shx(mq, o, lane)); mk = fmaxf(mk, shx(mk, o, lane)); mb = fmaxf(mb, shx(mb, o, lane)); }
            if (lane == 0) { sm[wave * 4 + 0] = mq; sm[wave * 4 + 1] = mk; sm[wave * 4 + 2] = mb; }
            __syncthreads();
            mq = 0.f; mk = 0.f; mb = 0.f;
            for (int w = 0; w < 8; ++w) { mq = fmaxf(mq, sm[w * 4 + 0]); mk = fmaxf(mk, sm[w * 4 + 1]); mb = fmaxf(mb, sm[w * 4 + 2]); }
            const float shift = LOG2E * (8.0f * mq * mk + mb);
            for (int i = tid; i < NHEAD * 256; i += NTHREADS) { const int h = i >> 8, j = i & 255; int rel = j - 63; if (rel > 128) rel = 128;
                tbl[(size_t)l * 2048 + i] = (j < 255) ? p.in[11][h * 257 + rel + 128] * LOG2E - shift : 0.f; }
            __syncthreads();
        }
        for (int job = blockIdx.x; job < 2 * 48; job += G) {
            const int l = job / 48, n = job % 48;
            bf16_t* hi = (bf16_t*)(ws + WS_RW) + (size_t)l * 2 * 48 * 1024;
            bf16_t* lo = hi + 48 * 1024;
            for (int k = tid; k < 1024; k += NTHREADS) {
                float w = 0.f;
                if (n < 32) w = p.in[15][((size_t)l * 1024 + k) * 32 + n]; else if (n < 36) w = p.in[13][((size_t)l * 1024 + k) * 4 + (n - 32)];
                const unsigned h2 = cvtpk(w, 0.f) & 0xffffu; const float r = w - bf_lo(h2);
                const size_t idx = ((size_t)((k >> 5) * 3 + (n >> 4)) * 64 + ((k & 31) >> 3) * 16 + (n & 15)) * 8 + (k & 7);
                hi[idx] = (bf16_t)h2; lo[idx] = (bf16_t)(cvtpk(r, 0.f) & 0xffffu);
            }
            if (tid == 0) { float bsv = 0.f; if (n < 32) bsv = p.in[16][l * 32 + n]; else if (n < 36) bsv = p.in[14][l * 4 + (n - 32)]; ((float*)(ws + WS_RWB))[l * 48 + n] = bsv; }
        }
    }
    __syncthreads();
    {
        LAS float* wsc = (LAS float*)lds;
        LAS float* pwl = (LAS float*)(lds + 32768);
        for (int item = blockIdx.x; item < 2 * 4 * 16; item += G) {
            const int l = item >> 6, g = (item >> 4) & 3, nb = item & 15;
            const float* wo = p.in[12] + ((size_t)l * 1024 + g * 128) * 1024 + nb * 64;
            const float* sc = p.in[8] + l * 512 + g * 128;
            const float* pw = p.in[7] + ((size_t)l * 4 + g) * 128 * 128;
            for (int i = tid; i < 128 * 64; i += NTHREADS) { const int d = i >> 6, n = i & 63; wsc[i] = wo[(size_t)d * 1024 + n] * sc[d]; }
            for (int i = tid; i < 128 * 128 / 4; i += NTHREADS) *(LAS f32x4*)(pwl + 4 * i) = *(const f32x4*)(pw + 4 * i);
            __syncthreads();
            const int n = tid & 63, cgp = tid >> 6;
            float a[16];
#pragma unroll
            for (int j = 0; j < 16; ++j) a[j] = 0.f;
#pragma unroll 2
            for (int d4 = 0; d4 < 32; ++d4) {
                const float w0 = wsc[(4 * d4 + 0) * 64 + n], w1 = wsc[(4 * d4 + 1) * 64 + n], w2 = wsc[(4 * d4 + 2) * 64 + n], w3 = wsc[(4 * d4 + 3) * 64 + n];
#pragma unroll
                for (int j = 0; j < 16; ++j) { const f32x4 pv = *(const LAS f32x4*)(pwl + (cgp * 16 + j) * 128 + 4 * d4); a[j] += (pv[0] * w0 + pv[1] * w1) + (pv[2] * w2 + pv[3] * w3); }
            }
            unsigned char* dst = ws + WS_WOUT + ((size_t)l * 1024 + nb * 64 + n) * 1024 + g * 128 + cgp * 16;
#pragma unroll
            for (int j = 0; j < 16; ++j) a[j] *= 256.0f;
            u32x4 o0; o0.x = pk_fp8x4(a[0], a[1], a[2], a[3]); o0.y = pk_fp8x4(a[4], a[5], a[6], a[7]); o0.z = pk_fp8x4(a[8], a[9], a[10], a[11]); o0.w = pk_fp8x4(a[12], a[13], a[14], a[15]);
            *(u32x4*)dst = o0;
            __syncthreads();
        }
    }
    {
        LAS float* scr = (LAS float*)(lds + wave * 16640);
        LAS float* wmax = (LAS float*)(lds + 8 * 16640);
        LAS float* winv = wmax + 512;
        for (int item = blockIdx.x; item < 2 * 32; item += G) {
            const int l = item >> 5, n0 = (item & 31) * 64;
            TItem d0, d1;
            d0.src = p.in[6] + (size_t)l * 1024 * 2048; d0.N = 2048; d0.f8 = 2; d0.dst = ws + WS_WIN + (size_t)l * 2048 * 1024; d0.dstK = 1024; d0.koff = 0; d0.k0 = wave * 128; d0.n0 = n0; d0.map = 1;
            d1 = d0; d1.k0 = wave * 128 + 64;
            f32x4 v0[16], v1[16];
            t_load(d0, v0, lane); t_load(d1, v1, lane);
            f32x4 cm = {0.f, 0.f, 0.f, 0.f};
#pragma unroll
            for (int i = 0; i < 16; ++i)
#pragma unroll
                for (int e = 0; e < 4; ++e) cm[e] = fmaxf(cm[e], fmaxf(fabsf(v0[i][e]), fabsf(v1[i][e])));
#pragma unroll
            for (int e = 0; e < 4; ++e) { cm[e] = fmaxf(cm[e], shx(cm[e], 16, lane)); cm[e] = fmaxf(cm[e], shx(cm[e], 32, lane)); }
            if (lane < 16) *(LAS f32x4*)(wmax + wave * 64 + 4 * lane) = cm;
            __syncthreads();
            if (tid < 64) { float m = 0.f;
#pragma unroll
                for (int w = 0; w < 8; ++w) m = fmaxf(m, wmax[w * 64 + tid]);
                winv[tid] = m > 0.f ? 127.0f / m : 0.f;
                ((float*)(ws + WS_CS))[l * 2048 + t_rowmap(1, n0 + tid)] = m * (1.0f / 127.0f); }
            __syncthreads();
            const f32x4 iv = *(const LAS f32x4*)(winv + 4 * (lane & 15));
#pragma unroll
            for (int i = 0; i < 16; ++i) { v0[i] *= iv; v1[i] *= iv; }
            t_process(d0, v0, scr, lane); t_process(d1, v1, scr, lane);
            __syncthreads();
        }
    }
    {
        LAS float* scr = (LAS float*)(lds + wave * 16640);
        t_run<false>(p, blockIdx.x * NWAVES + wave, G * NWAVES, T_NA, scr, lane);
    }
}

typedef float f32x2v __attribute__((ext_vector_type(2)));
__device__ __forceinline__ f32x4 y_pair4(unsigned a, unsigned b) {
    const f32x2v a0 = __builtin_amdgcn_cvt_pk_f32_fp8((int)a, false), a1 = __builtin_amdgcn_cvt_pk_f32_fp8((int)a, true);
    const f32x2v b0 = __builtin_amdgcn_cvt_pk_f32_fp8((int)b, false), b1 = __builtin_amdgcn_cvt_pk_f32_fp8((int)b, true);
    f32x4 ys; ys[0] = (a0[0] + b0[0]) * 0.0625f; ys[1] = (a0[1] + b0[1]) * 0.0625f; ys[2] = (a1[0] + b1[0]) * 0.0625f; ys[3] = (a1[1] + b1[1]) * 0.0625f; return ys;
}
__device__ __forceinline__ void bf8_to_f32(const u32x4& w, f32x4& lo, f32x4& hi) { lo = (f32x4){bf_lo(w.x), bf_hi(w.x), bf_lo(w.y), bf_hi(w.y)}; hi = (f32x4){bf_lo(w.z), bf_hi(w.z), bf_lo(w.w), bf_hi(w.w)}; }
template <int NR, bool UPD> struct N1Raw { f32x4 xf[UPD ? 1 : NR][4]; u32x4 xw[UPD ? NR : 1][2], ya[UPD ? NR : 1], yb[UPD ? NR : 1]; };
template <int NR, bool UPD>
__device__ __forceinline__ void n1_load(const Params& p, N1Raw<NR, UPD>& R, int row0, int lane) {
    const int c0 = 16 * lane;
    if (!UPD) {
#pragma unroll
        for (int r = 0; r < NR; ++r)
#pragma unroll
            for (int j = 0; j < 4; ++j) R.xf[r][j] = *(const f32x4*)(p.in[0] + (size_t)(row0 + r) * DM + c0 + 4 * j);
    } else {
        const unsigned char* Y = (const unsigned char*)(p.ws + WS_Y);
        const bf16_t* XB = (const bf16_t*)(p.ws + WS_XB);
#pragma unroll
        for (int r = 0; r < NR; ++r) {
            R.xw[r][0] = *(const u32x4*)(XB + (size_t)(row0 + r) * DM + c0); R.xw[r][1] = *(const u32x4*)(XB + (size_t)(row0 + r) * DM + c0 + 8);
            R.ya[r] = *(const u32x4*)(Y + (size_t)(2 * (row0 + r)) * DM + c0); R.yb[r] = *(const u32x4*)(Y + (size_t)(2 * (row0 + r) + 1) * DM + c0);
        }
    }
}
template <int NR, bool UPD>
__device__ __forceinline__ void n1_process(const Params& p, const N1Raw<NR, UPD>& R, int l, int row0, int lane) {
    const float* mod = (const float*)(p.ws + WS_MOD);
    const float* gn = p.in[4] + l * 1024;
    unsigned char* H8 = p.ws + WS_BUF;
    bf16_t* XB = (bf16_t*)(p.ws + WS_XB);
    const int b = row0 >> 13, c0 = 16 * lane;
    f32x4 v[NR][4];
    if (!UPD) {
#pragma unroll
        for (int r = 0; r < NR; ++r)
#pragma unroll
            for (int j = 0; j < 4; ++j) v[r][j] = R.xf[r][j];
    } else {
        const float* g2 = mod + (size_t)((l - 1) * 4 + b) * 6144 + 5120;
        f32x4 gg[4];
#pragma unroll
        for (int j = 0; j < 4; ++j) gg[j] = *(const f32x4*)(g2 + c0 + 4 * j);
#pragma unroll
        for (int r = 0; r < NR; ++r) {
            bf8_to_f32(R.xw[r][0], v[r][0], v[r][1]); bf8_to_f32(R.xw[r][1], v[r][2], v[r][3]);
            u32x4 o[2];
#pragma unroll
            for (int j = 0; j < 4; ++j) {
                const f32x4 xn = v[r][j] + gg[j] * y_pair4(R.ya[r][j], R.yb[r][j]);
                const unsigned w0 = cvtpk(xn[0], xn[1]), w1 = cvtpk(xn[2], xn[3]);
                if (j & 1) { o[j >> 1].z = w0; o[j >> 1].w = w1; } else { o[j >> 1].x = w0; o[j >> 1].y = w1; }
                v[r][j] = (f32x4){bf_lo(w0), bf_hi(w0), bf_lo(w1), bf_hi(w1)};
            }
            *(u32x4*)(XB + (size_t)(row0 + r) * DM + c0) = o[0]; *(u32x4*)(XB + (size_t)(row0 + r) * DM + c0 + 8) = o[1];
        }
    }
    float ss[NR];
#pragma unroll
    for (int r = 0; r < NR; ++r) { ss[r] = 0.f;
#pragma unroll
        for (int j = 0; j < 4; ++j) ss[r] += (v[r][j][0] * v[r][j][0] + v[r][j][1] * v[r][j][1]) + (v[r][j][2] * v[r][j][2] + v[r][j][3] * v[r][j][3]); }
#pragma unroll
    for (int o = 1; o < 64; o <<= 1)
#pragma unroll
        for (int r = 0; r < NR; ++r) ss[r] += shx(ss[r], o, lane);
    const float* sh = mod + (size_t)(l * 4 + b) * 6144; const float* sc = sh + 1024;
    float rstd[NR], mx[NR];
#pragma unroll
    for (int r = 0; r < NR; ++r) { rstd[r] = rsqrtf(ss[r] * (1.0f / DM) + EPS); mx[r] = 0.f; }
#pragma unroll
    for (int j = 0; j < 4; ++j) {
        const int c = c0 + 4 * j;
        const f32x4 g = *(const f32x4*)(gn + c), s1 = *(const f32x4*)(sc + c), s0 = *(const f32x4*)(sh + c);
        const f32x4 a = g * (s1 + 1.0f);
#pragma unroll
        for (int r = 0; r < NR; ++r) {
            const f32x4 h = v[r][j] * rstd[r] * a + s0;
            v[r][j] = h;
            mx[r] = fmaxf(mx[r], fmaxf(fmaxf(fabsf(h[0]), fabsf(h[1])), fmaxf(fabsf(h[2]), fabsf(h[3]))));
        }
    }
#pragma unroll
    for (int o = 1; o < 64; o <<= 1)
#pragma unroll
        for (int r = 0; r < NR; ++r) mx[r] = fmaxf(mx[r], shx(mx[r], o, lane));
    float* RS = (float*)(p.ws + WS_RS);
#pragma unroll
    for (int r = 0; r < NR; ++r) {
        const float inv = mx[r] > 0.f ? 127.0f / mx[r] : 0.f;
        if (lane == 0) RS[row0 + r] = mx[r] * (1.0f / 127.0f);
        u32x4 q8;
        { const f32x4 q = v[r][0] * inv; q8.x = pk_i8x4(q[0], q[1], q[2], q[3]); } { const f32x4 q = v[r][1] * inv; q8.y = pk_i8x4(q[0], q[1], q[2], q[3]); }
        { const f32x4 q = v[r][2] * inv; q8.z = pk_i8x4(q[0], q[1], q[2], q[3]); } { const f32x4 q = v[r][3] * inv; q8.w = pk_i8x4(q[0], q[1], q[2], q[3]); }
        *(u32x4*)(H8 + (size_t)(row0 + r) * DM + c0) = q8;
    }
}
template <int NR, bool UPD>
__device__ __forceinline__ void n1_run(const Params& p, int l, int gw, int NGW, int lane) {
    constexpr int N = NTOK / NR;
    int rq = gw; if (rq >= N) return;
    N1Raw<NR, UPD> A, B;
    n1_load<NR, UPD>(p, A, rq * NR, lane);
    for (;;) {
        const int nx = rq + NGW; const bool hb = nx < N;
        if (hb) n1_load<NR, UPD>(p, B, nx * NR, lane);
        n1_process<NR, UPD>(p, A, l, rq * NR, lane);
        if (!hb) break;
        rq = nx + NGW; const bool ha = rq < N;
        if (ha) n1_load<NR, UPD>(p, A, rq * NR, lane);
        n1_process<NR, UPD>(p, B, l, nx * NR, lane);
        if (!ha) break;
    }
}
__device__ __forceinline__ void phase_norm1(const Params& p, int l) {
    const int tid = opaque_tid(), lane = tid & 63, wave = tid >> 6, G = gridDim.x;
    const int gw = blockIdx.x * NWAVES + wave, NGW = G * NWAVES;
    if (l == 0) n1_run<4, false>(p, l, gw, NGW, lane); else n1_run<2, true>(p, l, gw, NGW, lane);
}

struct FinRaw { u32x4 xw[4][2], ya[4], yb[4]; };
__device__ __forceinline__ void fin_load(const Params& p, FinRaw& R, int row0, int lane) {
    const unsigned char* Y = (const unsigned char*)(p.ws + WS_Y);
    const bf16_t* XB = (const bf16_t*)(p.ws + WS_XB);
    const int c0 = 16 * lane;
#pragma unroll
    for (int r = 0; r < 4; ++r) {
        R.xw[r][0] = *(const u32x4*)(XB + (size_t)(row0 + r) * DM + c0); R.xw[r][1] = *(const u32x4*)(XB + (size_t)(row0 + r) * DM + c0 + 8);
        R.ya[r] = *(const u32x4*)(Y + (size_t)(2 * (row0 + r)) * DM + c0); R.yb[r] = *(const u32x4*)(Y + (size_t)(2 * (row0 + r) + 1) * DM + c0);
    }
}
__device__ __forceinline__ void fin_process(const Params& p, const FinRaw& R, int row0, int lane, LAS float* scr) {
    const float* mod = (const float*)(p.ws + WS_MOD);
    const int b = row0 >> 13, c0 = 16 * lane;
    const float* g2 = mod + (size_t)((DEPTH - 1) * 4 + b) * 6144 + 5120;
    f32x4 gg[4];
#pragma unroll
    for (int j = 0; j < 4; ++j) gg[j] = *(const f32x4*)(g2 + c0 + 4 * j);
#pragma unroll
    for (int r = 0; r < 4; ++r) {
        f32x4 v[4];
        bf8_to_f32(R.xw[r][0], v[0], v[1]); bf8_to_f32(R.xw[r][1], v[2], v[3]);
#pragma unroll
        for (int j = 0; j < 4; ++j) *(LAS f32x4*)(scr + r * 1024 + c0 + 4 * j) = v[j] + gg[j] * y_pair4(R.ya[r][j], R.yb[r][j]);
    }
    asm volatile("s_waitcnt lgkmcnt(0)" ::: "memory");
#pragma unroll
    for (int r = 0; r < 4; ++r)
#pragma unroll
        for (int s = 0; s < 4; ++s) *(f32x4*)(p.out + (size_t)(row0 + r) * DM + 256 * s + 4 * lane) = *(const LAS f32x4*)(scr + r * 1024 + 256 * s + 4 * lane);
    asm volatile("s_waitcnt lgkmcnt(0)" ::: "memory");
}
__device__ __forceinline__ void phase_final(const Params& p, LAS unsigned char* lds) {
    const int tid = opaque_tid(), lane = tid & 63, wave = tid >> 6, G = gridDim.x;
    const int gw = blockIdx.x * NWAVES + wave, NGW = G * NWAVES;
    constexpr int N = NTOK / 4;
    int rq = gw; if (rq >= N) return;
    FinRaw A, B;
    LAS float* scr = (LAS float*)(lds + wave * 16384);
    fin_load(p, A, rq * 4, lane);
    for (;;) {
        const int nx = rq + NGW; const bool hb = nx < N;
        if (hb) fin_load(p, B, nx * 4, lane);
        fin_process(p, A, rq * 4, lane, scr);
        if (!hb) break;
        rq = nx + NGW; const bool ha = rq < N;
        if (ha) fin_load(p, A, rq * 4, lane);
        fin_process(p, B, nx * 4, lane, scr);
        if (!ha) break;
    }
}

__device__ __forceinline__ int crow(int r, int hi) { return (r & 3) + 8 * (r >> 2) + 4 * hi; }

__device__ __forceinline__ void acc8(float (&S)[8], const u32x4& w, float sg) {
    S[0] += sg * bf_lo(w.x); S[1] += sg * bf_hi(w.x); S[2] += sg * bf_lo(w.y); S[3] += sg * bf_hi(w.y); S[4] += sg * bf_lo(w.z); S[5] += sg * bf_hi(w.z); S[6] += sg * bf_lo(w.w); S[7] += sg * bf_hi(w.w);
}
__device__ __forceinline__ void pool_strip(const Params& p, int strip, int lane) {
    const bf16_t* U = (const bf16_t*)(p.ws + WS_U); unsigned char* MIX = p.ws + WS_BUF;
    const int tok0 = strip * 16, s0 = tok0 & (SEQ - 1);
    const int g = lane >> 4, win = 2 << g;
    u32x4 w[31];
#pragma unroll
    for (int d = 0; d < 31; ++d) { w[d] = (u32x4){0u, 0u, 0u, 0u}; if (d >= 15 || s0 > 0) w[d] = *(const u32x4*)(U + (size_t)(tok0 - 15 + d) * 512 + lane * 8); }
    float S[8];
#pragma unroll
    for (int j = 0; j < 8; ++j) S[j] = 0.f;
#pragma unroll
    for (int k = 1; k < 16; ++k) acc8(S, w[15 - k], (k < win) ? 1.0f : 0.0f);
#pragma unroll
    for (int i = 0; i < 16; ++i) {
        const int s = s0 + i;
        const u32x4 x = w[15 + i];
        float uv[8] = {bf_lo(x.x), bf_hi(x.x), bf_lo(x.y), bf_hi(x.y), bf_lo(x.z), bf_hi(x.z), bf_lo(x.w), bf_hi(x.w)};
#pragma unroll
        for (int j = 0; j < 8; ++j) S[j] += uv[j];
        const int cn = (s + 1 < win) ? s + 1 : win;
        const float inv = 1.0f / (float)cn;
        float o[8];
#pragma unroll
        for (int j = 0; j < 8; ++j) o[j] = clamp8((S[j] * inv - uv[j]) * 16.0f);
        u32x2 ow; ow.x = pk_fp8x4(o[0], o[1], o[2], o[3]); ow.y = pk_fp8x4(o[4], o[5], o[6], o[7]);
        *(u32x2*)(MIX + (size_t)(tok0 + i) * DM + lane * 8) = ow;
        const u32x4 l0 = w[15 + i - 1], l1 = (i + 12 >= 0) ? w[15 + i - 3 < 0 ? 0 : 15 + i - 3] : l0, l2 = w[15 + i - 7 < 0 ? 0 : 15 + i - 7], l3 = w[15 + i - 15 < 0 ? 0 : 15 + i - 15];
        u32x4 lv;
        lv.x = g == 0 ? l0.x : g == 1 ? l1.x : g == 2 ? l2.x : l3.x; lv.y = g == 0 ? l0.y : g == 1 ? l1.y : g == 2 ? l2.y : l3.y;
        lv.z = g == 0 ? l0.z : g == 1 ? l1.z : g == 2 ? l2.z : l3.z; lv.w = g == 0 ? l0.w : g == 1 ? l1.w : g == 2 ? l2.w : l3.w;
        acc8(S, lv, -1.0f);
    }
}

__device__ __forceinline__ void attn_unit(const Params& p, int b, int h, int ch, int qh, int lane, const LAS float* tbl, LAS unsigned char* stg) {
    const int r32 = lane & 31, hi = lane >> 5;
    const char* Qf = (const char*)(p.ws + WS_Q); const char* Kf = (const char*)(p.ws + WS_K); const char* Vf = (const char*)(p.ws + WS_V);
    unsigned char* MIX = p.ws + WS_BUF;
    const size_t bh = (size_t)(b * NHEAD + h) * 256;
    bf16x8 qr[4];
#pragma unroll
    for (int d0 = 0; d0 < 4; ++d0) qr[d0] = *(const bf16x8*)(Qf + (((bh + ch * 2 + qh) * 4 + d0) * 64 + lane) * 16);
    f32x16 o0 = {}, o1 = {};
    float lsum = 0.f;
    const LAS float* th = tbl + h * 256;
    f32x16 cfv; { const float cfar = th[254];
#pragma unroll
        for (int r = 0; r < 16; ++r) cfv[r] = cfar; }
    const int t0 = ch < 8 ? 8 - ch : 0;
    const char* kp = Kf + (bh * 4 * 64 + lane) * 16 + (ptrdiff_t)(ch - 8 + t0) * 8192;
    const char* vp = Vf + (bh * 4 * 64 + lane) * 16 + (ptrdiff_t)(ch - 8 + t0) * 8192;
    bf16x8 kk[8];
#define ATT_LD8(dst, ptr) do { const char* pa_ = (ptr); const char* pb_ = pa_ + 4096; _Pragma("unroll") for (int i_ = 0; i_ < 4; ++i_) { dst[i_] = *(const bf16x8*)(pa_ + i_ * 1024); dst[4 + i_] = *(const bf16x8*)(pb_ + i_ * 1024); } } while (0)
#define ATT_REST(P0, P1) do { \
        float sacc_ = 0.f; \
        _Pragma("unroll") for (int r = 0; r < 16; ++r) { P0[r] = fast_exp2(P0[r]); P1[r] = fast_exp2(P1[r]); sacc_ += P0[r] + P1[r]; } \
        lsum += sacc_; \
        u32x4 pa_[4]; \
        _Pragma("unroll") for (int s = 0; s < 2; ++s) { \
            pa_[s].x = cvtpk(P0[8 * s + 0], P0[8 * s + 1]); pa_[s].y = cvtpk(P0[8 * s + 2], P0[8 * s + 3]); pa_[s].z = cvtpk(P0[8 * s + 4], P0[8 * s + 5]); pa_[s].w = cvtpk(P0[8 * s + 6], P0[8 * s + 7]); \
            pa_[2 + s].x = cvtpk(P1[8 * s + 0], P1[8 * s + 1]); pa_[2 + s].y = cvtpk(P1[8 * s + 2], P1[8 * s + 3]); pa_[2 + s].z = cvtpk(P1[8 * s + 4], P1[8 * s + 5]); pa_[2 + s].w = cvtpk(P1[8 * s + 6], P1[8 * s + 7]); } \
        _Pragma("unroll") for (int i = 0; i < 4; ++i) { const bf16x8 pf_ = __builtin_bit_cast(bf16x8, pa_[i]); \
            o0 = __builtin_amdgcn_mfma_f32_32x32x16_bf16(pf_, vv[2 * i], o0, 0, 0, 0); o1 = __builtin_amdgcn_mfma_f32_32x32x16_bf16(pf_, vv[2 * i + 1], o1, 0, 0, 0); } \
    } while (0)
    ATT_LD8(kk, kp);
    int t = t0;
#pragma unroll 1
    for (; t <= 5; ++t) {
        bf16x8 vv[8]; ATT_LD8(vv, vp); vp += 8192;
        f32x16 p0 = __builtin_amdgcn_mfma_f32_32x32x16_bf16(kk[0], qr[0], cfv, 0, 0, 0);
        f32x16 p1 = __builtin_amdgcn_mfma_f32_32x32x16_bf16(kk[4], qr[0], cfv, 0, 0, 0);
#pragma unroll
        for (int d0 = 1; d0 < 4; ++d0) { p0 = __builtin_amdgcn_mfma_f32_32x32x16_bf16(kk[d0], qr[d0], p0, 0, 0, 0); p1 = __builtin_amdgcn_mfma_f32_32x32x16_bf16(kk[4 + d0], qr[d0], p1, 0, 0, 0); }
        kp += 8192; ATT_LD8(kk, kp);
        ATT_REST(p0, p1);
    }
#pragma unroll 1
    for (; t <= 8; ++t) {
        bf16x8 vv[8]; ATT_LD8(vv, vp); vp += 8192;
        f32x16 p0, p1;
        { const int base_ = 64 * (8 - t) + 32 * qh + r32 + 63 - 4 * hi;
#pragma unroll
          for (int r = 0; r < 16; ++r) { const int kj = (r & 3) + 8 * (r >> 2); p0[r] = th[base_ - kj]; p1[r] = th[base_ - kj - 32]; } }
#pragma unroll
        for (int d0 = 0; d0 < 4; ++d0) { p0 = __builtin_amdgcn_mfma_f32_32x32x16_bf16(kk[d0], qr[d0], p0, 0, 0, 0); p1 = __builtin_amdgcn_mfma_f32_32x32x16_bf16(kk[4 + d0], qr[d0], p1, 0, 0, 0); }
        if (t < 8) { kp += 8192; ATT_LD8(kk, kp); }
        ATT_REST(p0, p1);
    }
#undef ATT_LD8
#undef ATT_REST
    lsum += shx(lsum, 32, lane);
    const float linv = 1.0f / lsum;
#pragma unroll
    for (int r = 0; r < 16; ++r) {
        const int q = crow(r, hi);
        const float li = __int_as_float(__builtin_amdgcn_ds_bpermute(q << 2, __float_as_int(linv))) * 16.0f;
        const unsigned w = pk_fp8x4(clamp8(o0[r] * li), clamp8(o1[r] * li), 0.f, 0.f);
        stg[q * 80 + r32] = (unsigned char)(w & 0xffu);
        stg[q * 80 + 32 + r32] = (unsigned char)((w >> 8) & 0xffu);
    }
    asm volatile("s_waitcnt lgkmcnt(0)" ::: "memory");
    unsigned char* orow = MIX + ((size_t)b * SEQ + ch * 64 + qh * 32 + (lane >> 2)) * DM + 512 + h * 64 + (lane & 3) * 16;
    const LAS unsigned char* srow = stg + (lane >> 2) * 80 + (lane & 3) * 16;
#pragma unroll
    for (int i = 0; i < 2; ++i) *(u32x4*)(orow + (size_t)i * 16 * DM) = *(const LAS u32x4*)(srow + i * 16 * 80);
    asm volatile("s_waitcnt lgkmcnt(0)" ::: "memory");
}

__device__ __forceinline__ void phase_mixer(const Params& p, int l, LAS unsigned char* lds) {
    const int tid = opaque_tid(), lane = tid & 63, wave = tid >> 6, G = gridDim.x;
    LAS float* tbl = (LAS float*)lds;
    const float* gt = (const float*)(p.ws + WS_TBL) + (size_t)l * 2048;
    for (int i = tid; i < 2048; i += NTHREADS) tbl[i] = gt[i];
    __syncthreads();
    const int gw = blockIdx.x * NWAVES + wave, NGW = G * NWAVES;
    LAS unsigned char* stg = lds + 8192 + wave * 4608;
    for (int it = gw; it < NTOK / 16; it += NGW) pool_strip(p, it, lane);
    if (G % 8 == 0) {
        const int x = (int)blockIdx.x & 7, lw = ((int)blockIdx.x >> 3) * NWAVES + wave, nlw = (G >> 3) * NWAVES;
        for (int pr = x; pr < BATCH * NHEAD; pr += 8)
            for (int u = lw; u < 256; u += nlw) attn_unit(p, pr >> 3, pr & 7, u >> 1, u & 1, lane, tbl, stg);
    } else {
        for (int wu = gw; wu < BATCH * NHEAD * 256; wu += NGW) attn_unit(p, wu >> 11, (wu >> 8) & 7, (wu >> 1) & 127, wu & 1, lane, tbl, stg);
    }
}

__device__ __forceinline__ void phase_route(const Params& p, int l, LAS unsigned char* lds) {
    const int tid = opaque_tid(), lane = tid & 63, wave = __builtin_amdgcn_readfirstlane(tid >> 6), G = gridDim.x;
    LAS float* a2c = (LAS float*)(lds + 49152);
    LAS float* shc = (LAS float*)(lds + 49152 + 1024);
    LAS float* lg = (LAS float*)(lds + 53248) + wave * (16 * 48);
    LAS int* lcnt = (LAS int*)(lds + 77824);
    LAS int* gbase = (LAS int*)(lds + 77824 + 128);
    LAS int* tmp_e = (LAS int*)(lds + 77824 + 256);
    LAS int* tmp_r = (LAS int*)(lds + 77824 + 256 + 1024);
    LAS float* tmp_w = (LAS float*)(lds + 77824 + 256 + 2048);
    const float* mod = (const float*)(p.ws + WS_MOD);
    const float* gn = p.in[5] + l * 1024;
    unsigned char* H8 = p.ws + WS_BUF;
    const char* RW = (const char*)(p.ws + WS_RW) + (size_t)l * 2 * 48 * 1024 * 2;
    const float* rwb = (const float*)(p.ws + WS_RWB) + l * 48;
    const float* ssq = (const float*)(p.ws + WS_SSQ);
    int* gcnt = (int*)(p.ws + WS_CTL) + l * 32;
    u32x2* list = (u32x2*)(p.ws + WS_LIST2);
    const int r = lane & 15, kg = lane >> 4;
    for (int it = blockIdx.x; it < NTOK / 128; it += G) {
        const int row0 = it * 128 + wave * 16, row = row0 + r, b = (it * 128) >> 13;
        const bf16_t* xr = (const bf16_t*)(p.ws + WS_XB) + (size_t)row * DM + 8 * kg;
        float ss; { const float* sq = ssq + (size_t)(4 * kg) * NTOK + row; ss = (sq[0] + sq[NTOK]) + (sq[2 * (size_t)NTOK] + sq[3 * (size_t)NTOK]); }
        ss += shx(ss, 16, lane); ss += shx(ss, 32, lane);
        const float rstd = rsqrtf(ss * (1.0f / DM) + EPS);
        const float* sh = mod + (size_t)(l * 4 + b) * 6144 + 3072; const float* sc = sh + 1024;
        f32x4 acc[3];
#pragma unroll
        for (int nb = 0; nb < 3; ++nb) acc[nb] = (f32x4){0.f, 0.f, 0.f, 0.f};
        u32x4 xsb[2][8];
#pragma unroll
        for (int i = 0; i < 8; ++i) xsb[0][i] = *(const u32x4*)(xr + 32 * i);
#pragma unroll
        for (int c = 0; c < 4; ++c) {
            __syncthreads();
            if (c == 0 && tid < 32) lcnt[tid] = 0;
#pragma unroll
            for (int i = 0; i < 6; ++i) { const int q = wave * 6 + i; const char* src = RW + (q < 24 ? (size_t)(c * 24 + q) * 1024 : (size_t)98304 + (size_t)(c * 24 + q - 24) * 1024);
                __builtin_amdgcn_global_load_lds((const unsigned*)(src + lane * 16), (LAS unsigned*)(lds + q * 1024), 16, 0, 0); }
            if (tid < 256) { const int k = 256 * c + tid; a2c[tid] = gn[k] * (1.0f + sc[k]); shc[tid] = sh[k]; }
            asm volatile("s_waitcnt vmcnt(0) lgkmcnt(0)" : "+v"(xsb[c & 1][0]), "+v"(xsb[c & 1][1]), "+v"(xsb[c & 1][2]), "+v"(xsb[c & 1][3]), "+v"(xsb[c & 1][4]), "+v"(xsb[c & 1][5]), "+v"(xsb[c & 1][6]), "+v"(xsb[c & 1][7]) :: "memory");
            if (c < 3) {
#pragma unroll
                for (int i = 0; i < 8; ++i) xsb[(c + 1) & 1][i] = *(const u32x4*)(xr + 256 * (c + 1) + 32 * i);
            }
            __builtin_amdgcn_s_barrier();
            const u32x4 (&xs)[8] = xsb[c & 1];
#pragma unroll
            for (int i = 0; i < 8; ++i) {
                float hv[8];
#pragma unroll
                for (int q = 0; q < 2; ++q) {
                    const f32x4 a = *(const LAS f32x4*)(a2c + 32 * i + 8 * kg + 4 * q), s0 = *(const LAS f32x4*)(shc + 32 * i + 8 * kg + 4 * q);
                    const f32x4 xv = q == 0 ? (f32x4){bf_lo(xs[i].x), bf_hi(xs[i].x), bf_lo(xs[i].y), bf_hi(xs[i].y)} : (f32x4){bf_lo(xs[i].z), bf_hi(xs[i].z), bf_lo(xs[i].w), bf_hi(xs[i].w)};
                    const f32x4 hh = xv * rstd * a + s0;
                    hv[4 * q + 0] = hh[0]; hv[4 * q + 1] = hh[1]; hv[4 * q + 2] = hh[2]; hv[4 * q + 3] = hh[3];
                }
                u32x4 hp; hp.x = cvtpk(hv[0], hv[1]); hp.y = cvtpk(hv[2], hv[3]); hp.z = cvtpk(hv[4], hv[5]); hp.w = cvtpk(hv[6], hv[7]);
                { u32x2 h8; h8.x = pk_fp8x4(clamp8(hv[0] * 8.0f), clamp8(hv[1] * 8.0f), clamp8(hv[2] * 8.0f), clamp8(hv[3] * 8.0f)); h8.y = pk_fp8x4(clamp8(hv[4] * 8.0f), clamp8(hv[5] * 8.0f), clamp8(hv[6] * 8.0f), clamp8(hv[7] * 8.0f));
                  *(u32x2*)(H8 + (size_t)row * DM + 256 * c + 32 * i + 8 * kg) = h8; }
                u32x4 lp;
                lp.x = cvtpk(hv[0] - bf_lo(hp.x), hv[1] - bf_hi(hp.x)); lp.y = cvtpk(hv[2] - bf_lo(hp.y), hv[3] - bf_hi(hp.y));
                lp.z = cvtpk(hv[4] - bf_lo(hp.z), hv[5] - bf_hi(hp.z)); lp.w = cvtpk(hv[6] - bf_lo(hp.w), hv[7] - bf_hi(hp.w));
                const bf16x8 xhi = __builtin_bit_cast(bf16x8, hp), xlo = __builtin_bit_cast(bf16x8, lp);
#pragma unroll
                for (int nb = 0; nb < 3; ++nb) {
                    const bf16x8 whi = *(const LAS bf16x8*)(lds + (i * 3 + nb) * 1024 + lane * 16);
                    const bf16x8 wlo = *(const LAS bf16x8*)(lds + 24576 + (i * 3 + nb) * 1024 + lane * 16);
                    acc[nb] = __builtin_amdgcn_mfma_f32_16x16x32_bf16(whi, xhi, acc[nb], 0, 0, 0);
                    acc[nb] = __builtin_amdgcn_mfma_f32_16x16x32_bf16(whi, xlo, acc[nb], 0, 0, 0);
                    acc[nb] = __builtin_amdgcn_mfma_f32_16x16x32_bf16(wlo, xhi, acc[nb], 0, 0, 0);
                }
            }
        }
#pragma unroll
        for (int nb = 0; nb < 3; ++nb)
#pragma unroll
            for (int q = 0; q < 4; ++q) lg[r * 48 + 16 * nb + 4 * kg + q] = acc[nb][q];
        asm volatile("s_waitcnt lgkmcnt(0)" ::: "memory");
        if (lane < 16) {
            const LAS float* my = lg + lane * 48;
            float gl[4]; int gi = 0; float gm;
#pragma unroll
            for (int i = 0; i < 4; ++i) gl[i] = my[32 + i] + rwb[32 + i];
            gm = gl[0];
#pragma unroll
            for (int i = 1; i < 4; ++i) if (gl[i] > gm) { gm = gl[i]; gi = i; }
            float den = 0.f;
#pragma unroll
            for (int i = 0; i < 4; ++i) den += __expf(gl[i] - gm);
            const float gpv = 1.0f / den;
            float el[8];
#pragma unroll
            for (int i = 0; i < 8; ++i) el[i] = my[8 * gi + i] + rwb[8 * gi + i];
            int i0 = 0; float v0 = el[0];
#pragma unroll
            for (int i = 1; i < 8; ++i) if (el[i] > v0) { v0 = el[i]; i0 = i; }
            int i1 = -1; float v1 = -3.0e38f;
#pragma unroll
            for (int i = 0; i < 8; ++i) if (i != i0 && el[i] > v1) { v1 = el[i]; i1 = i; }
            const float dd = __expf(v1 - v0);
            const float w0 = gpv / (1.0f + dd), w1 = gpv * dd / (1.0f + dd);
            const int e0 = 8 * gi + i0, e1 = 8 * gi + i1;
            const int tok = row0 + lane, lt = wave * 16 + lane;
            tmp_w[2 * lt] = w0; tmp_w[2 * lt + 1] = w1;
            tmp_e[2 * lt] = e0; tmp_e[2 * lt + 1] = e1;
            tmp_r[2 * lt] = __hip_atomic_fetch_add(lcnt + e0, 1, __ATOMIC_RELAXED, __HIP_MEMORY_SCOPE_WORKGROUP);
            tmp_r[2 * lt + 1] = __hip_atomic_fetch_add(lcnt + e1, 1, __ATOMIC_RELAXED, __HIP_MEMORY_SCOPE_WORKGROUP);
        }
        __syncthreads();
        if (tid < 32) gbase[tid] = __hip_atomic_fetch_add(gcnt + tid, lcnt[tid], __ATOMIC_RELAXED, __HIP_MEMORY_SCOPE_AGENT);
        __syncthreads();
        if (tid < 256) { const int e = tmp_e[tid]; u32x2 en; en.x = (unsigned)(it * 256 + tid); en.y = __float_as_uint(tmp_w[tid]); list[(size_t)e * NTOK + gbase[e] + tmp_r[tid]] = en; }
    }
    __syncthreads();
}

#define XB_TMO      128
#define XB_XCNT(j)  (256  + 64 * (j))
#define XB_XSUB(j)  (1280 + 64 * (j))
#define XB_XGEN(j)  (2304 + 64 * (j))
#define XB_TOP      3328
#define XB_TOPGEN   3392
#define XCD_BAR_WORDS 3456
#define XB_SPIN_CAP (1u << 18)
__device__ __forceinline__ unsigned xb_ld(unsigned* p)              { return __hip_atomic_load(p, __ATOMIC_RELAXED, __HIP_MEMORY_SCOPE_AGENT); }
__device__ __forceinline__ unsigned xb_add(unsigned* p, unsigned v) { return __hip_atomic_fetch_add(p, v, __ATOMIC_RELAXED, __HIP_MEMORY_SCOPE_AGENT); }
__device__ __forceinline__ unsigned xb_xcc_id() { return (unsigned)__builtin_amdgcn_s_getreg((3 << 11) | 20) & 0xFu; }
#define XB_SPIN(cond, bar) do { unsigned _sp = 0; while (cond) { __builtin_amdgcn_s_sleep(1); \
    if ((++_sp & 255u) == 0u) { if (xb_ld(&(bar)[XB_TMO])) break; if (_sp > XB_SPIN_CAP) { atomicAdd(&(bar)[XB_TMO], 1u); break; } } } } while (0)
struct XcdBarrier { unsigned* bar; unsigned x; volatile LAS unsigned* st; };
__device__ __forceinline__ XcdBarrier xcd_barrier_post(unsigned* bar, volatile LAS unsigned* st) {
    XcdBarrier b; b.bar = bar; b.x = xb_xcc_id(); b.st = st;
    if (threadIdx.x == 0) (void)xb_add(&bar[XB_XCNT(b.x)], 1u);
    return b;
}
__device__ __forceinline__ void xcd_barrier_complete(unsigned* bar, unsigned x, unsigned& nloc, unsigned& nx) {
    const unsigned G = gridDim.x * gridDim.y * gridDim.z;
    unsigned sum, cnt, mine, sp = 0u;
    for (;;) {
        sum = 0u; cnt = 0u; mine = 0u;
#pragma unroll
        for (unsigned j = 0; j < 16; ++j) { const unsigned c = xb_ld(&bar[XB_XCNT(j)]); sum += c; cnt += (c > 0u) ? 1u : 0u; mine = (j == x) ? c : mine; }
        if (sum == G) break;
        __builtin_amdgcn_s_sleep(1);
        if ((++sp & 255u) == 0u) { if (xb_ld(&bar[XB_TMO])) break; if (sp > XB_SPIN_CAP) { atomicAdd(&bar[XB_TMO], 1u); break; } }
    }
    nloc = mine > 0u ? mine : 1u; nx = cnt > 0u ? cnt : 1u;
}
__device__ __forceinline__ void xcd_barrier(const XcdBarrier& b) {
    asm volatile("s_waitcnt vmcnt(0)" ::: "memory");
    __syncthreads();
    if (threadIdx.x == 0) {
        unsigned* bar = b.bar;
        __builtin_amdgcn_s_waitcnt(0);
        unsigned nloc = b.st[0], nx = b.st[1];
        if (nloc == 0u) { xcd_barrier_complete(bar, b.x, nloc, nx); b.st[0] = nloc; b.st[1] = nx; }
        const unsigned old = xb_add(&bar[XB_XSUB(b.x)], 1u);
        const unsigned gen = old / nloc;
        if (old + 1u == (gen + 1u) * nloc) {
            __builtin_amdgcn_fence(__ATOMIC_RELEASE, "agent");
            asm volatile("s_waitcnt vmcnt(0)" ::: "memory");
            const unsigned og = xb_add(&bar[XB_TOP], 1u);
            const unsigned tg = og / nx;
            if (og + 1u == (tg + 1u) * nx) xb_add(&bar[XB_TOPGEN], 1u);
            else XB_SPIN(xb_ld(&bar[XB_TOPGEN]) == tg, bar);
            __builtin_amdgcn_fence(__ATOMIC_ACQUIRE, "agent");
            xb_add(&bar[XB_XGEN(b.x)], 1u);
            asm volatile("s_waitcnt vmcnt(0)" ::: "memory");
        } else {
            XB_SPIN(xb_ld(&bar[XB_XGEN(b.x)]) == gen, bar);
            __builtin_amdgcn_fence(__ATOMIC_ACQUIRE, "agent");
            asm volatile("s_waitcnt vmcnt(0)" ::: "memory");
        }
    }
    __syncthreads();
}

__device__ __forceinline__ void load_params(Params& q, const Params& p) {
#if defined(__HIP_DEVICE_COMPILE__)
    const unsigned long long a = (unsigned long long)__builtin_amdgcn_kernarg_segment_ptr();
    unsigned alo = __builtin_amdgcn_readfirstlane((unsigned)a), ahi = __builtin_amdgcn_readfirstlane((unsigned)(a >> 32));
    asm volatile("" : "+s"(alo), "+s"(ahi));
    q = *(const __attribute__((address_space(4))) Params*)(((unsigned long long)ahi << 32) | alo);
#else
    q = p;
#endif
}
__device__ __forceinline__ void load_prefix(const Params& p, int l, LAS int* pre, LAS int* cntl) {
    const int* gcnt = (const int*)(p.ws + WS_CTL) + l * 32;
    const int tid = opaque_tid();
    if (tid < 64) {
        const int c = tid < NEXP ? gcnt[tid] : 0;
        const int t0 = (c + 255) >> 8;
        int t = t0;
#pragma unroll
        for (int o = 1; o < 32; o <<= 1) { const int v = __builtin_amdgcn_ds_bpermute(((tid - o) & 63) << 2, t); if (tid >= o) t += v; }
        if (tid < NEXP) { cntl[tid] = c; pre[tid] = t - t0; }
        if (tid == NEXP - 1) pre[NEXP] = t;
    }
    __syncthreads();
}

__global__ void __launch_bounds__(NTHREADS, 2) fwd_kernel(Params p) {
    extern __shared__ __attribute__((aligned(16))) unsigned char lds_raw[];
    LAS unsigned char* lds = (LAS unsigned char*)lds_raw;
    const int G = gridDim.x;
    unsigned char* ws = p.ws;
    volatile LAS unsigned* bst = (volatile LAS unsigned*)(lds + LDS_BYTES - 16);
    if (threadIdx.x < 2) bst[threadIdx.x] = 0u;
    __syncthreads();
    const XcdBarrier bar = xcd_barrier_post((unsigned*)(ws + WS_CTL) + 4096, bst);
    const int lo = p.ph_lo, hi = p.ph_hi;
#define IN(k) (lo <= (k) && (k) < hi)
#define SYNC_AFTER(k) do { if (IN(k) && IN((k) + 1)) xcd_barrier(bar); } while (0)
#define PROBE_REL (-1)
#define PROBE_BEGIN(j) unsigned long long pt0_ = 0; if (PROBE_REL == (j)) pt0_ = __builtin_amdgcn_s_memrealtime();
#define PROBE_END(j) if (PROBE_REL == (j)) { if (blockIdx.x == 0 && threadIdx.x == 0) { const unsigned long long t1_ = __builtin_amdgcn_s_memrealtime(); const unsigned long long dt_ = t1_ - pt0_; \
        while (__builtin_amdgcn_s_memrealtime() - t1_ < dt_) __builtin_amdgcn_s_sleep(8); } xcd_barrier(bar); }
    { PROBE_BEGIN(7)
    if (IN(0)) { Params q; load_params(q, p); phase_prologue(q, lds); }
    SYNC_AFTER(0);
    PROBE_END(7) }
#pragma unroll 1
    for (int l = 0; l < DEPTH; ++l) {
        const int k0 = 1 + 7 * l;
        { PROBE_BEGIN(0)
        if (IN(k0 + 0)) { Params q; load_params(q, p); phase_norm1(q, l); }
        SYNC_AFTER(k0 + 0);
        PROBE_END(0) }
        { PROBE_BEGIN(1)
        if (IN(k0 + 1)) {
            Params q; load_params(q, p); unsigned char* ws = q.ws;
            {
                DenseGemmI8 g{ws + WS_BUF, ws + WS_WIN + (size_t)l * 2048 * 1024, 1024, (const float*)(ws + WS_RS), (const float*)(ws + WS_CS) + l * 2048};
                pg8::StaticOrder S; S.init(NTOK, 1536, G, (int)blockIdx.x);
                LAS float* gl = (LAS float*)(lds + pg8::STAGE_BYTES + 5120);
                { const int t_ = opaque_tid(); if (t_ < 128) gl[t_] = t_ < 64 ? q.in[9][l * 64 + t_] * (0.125f * LOG2E) : q.in[10][l * 64 + t_ - 64]; __syncthreads(); }
                EpiIn E{(bf16_t*)(ws + WS_U), (bf16_t*)(ws + WS_Q), (bf16_t*)(ws + WS_K), gl};
                pg8::gemm_phase(lds, g, S, E);
            }
            {
                DenseGemmI8 g{ws + WS_WIN + (size_t)l * 2048 * 1024 + (size_t)1536 * 1024, ws + WS_BUF, 1024, (const float*)(ws + WS_CS) + l * 2048 + 1536, (const float*)(ws + WS_RS)};
                pg8::StaticOrder S; S.init(512, NTOK, G, (int)blockIdx.x);
                EpiVt E{(bf16_t*)(ws + WS_V)};
                pg8::gemm_phase(lds, g, S, E);
            }
        }
        SYNC_AFTER(k0 + 1);
        PROBE_END(1) }
        { PROBE_BEGIN(2)
        if (IN(k0 + 2)) { Params q; load_params(q, p); phase_mixer(q, l, lds); }
        SYNC_AFTER(k0 + 2);
        PROBE_END(2) }
        { PROBE_BEGIN(3)
        if (IN(k0 + 3)) {
            Params q; load_params(q, p); unsigned char* ws = q.ws;
            DenseGemm8 g{ws + WS_BUF, ws + WS_WOUT + (size_t)l * 1024 * 1024, 1024, nullptr, nullptr};
            pg8::StaticOrder S; S.init(NTOK, 1024, G, (int)blockIdx.x);
            const float* g1p = (const float*)(ws + WS_MOD) + (size_t)(l * 4) * 6144 + 2048;
            if (l == 0) { EpiOutB<true> E{q.in[0], (bf16_t*)(ws + WS_XB), g1p, (float*)(ws + WS_SSQ)}; pg8::gemm_phase(lds, g, S, E); }
            else { EpiOutB<false> E{nullptr, (bf16_t*)(ws + WS_XB), g1p, (float*)(ws + WS_SSQ)}; pg8::gemm_phase(lds, g, S, E); }
        }
        SYNC_AFTER(k0 + 3);
        PROBE_END(3) }
        { PROBE_BEGIN(4)
        if (IN(k0 + 4)) { Params q; load_params(q, p); phase_route(q, l, lds); }
        SYNC_AFTER(k0 + 4);
        PROBE_END(4) }
        { PROBE_BEGIN(5)
        if (IN(k0 + 5)) {
            Params q; load_params(q, p); unsigned char* ws = q.ws;
            LAS int* pre = (LAS int*)(lds + pg8::STAGE_BYTES); LAS int* cntl = pre + 64;
            load_prefix(q, l, pre, cntl);
            const int cfirst = l == 0 ? 0 : T_DN + T_GU, ccount = l == 0 ? T_DN + SIDE_GU0 : T_DN;
            const SidePlan sp = side_plan(pre[NEXP] * 4, ccount);
            if (!sp.conv) {
                GatherGemm g{ws + WS_BUF, ws + WS_WGU + (size_t)l * NEXP * 1024 * 1024, (const u32x2*)(ws + WS_LIST2), 1024, 1, (size_t)1024 * 1024};
                pg8::GroupedOrder S{pre, cntl, sp.gp, sp.v};
                EpiGU E{ws + WS_ACT};
                pg8::gemm_phase(lds, g, S, E);
            }
            side_convert(q, lds, pre, cfirst, ccount, SIDE_CC_GU);
        }
        SYNC_AFTER(k0 + 5);
        PROBE_END(5) }
        { PROBE_BEGIN(6)
        if (IN(k0 + 6)) {
            Params q; load_params(q, p); unsigned char* ws = q.ws;
            LAS int* pre = (LAS int*)(lds + pg8::STAGE_BYTES); LAS int* cntl = pre + 64;
            load_prefix(q, l, pre, cntl);
            const int cfirst = T_DN + SIDE_GU0, ccount = l == 0 ? T_GU - SIDE_GU0 : 0;
            const SidePlan sp = side_plan(pre[NEXP] * 4, ccount);
            if (!sp.conv) {
                GatherGemm g{ws + WS_ACT, ws + WS_WD + (size_t)l * NEXP * 1024 * 512, (const u32x2*)(ws + WS_LIST2), 512, 0, (size_t)1024 * 512};
                pg8::GroupedOrder S{pre, cntl, sp.gp, sp.v};
                EpiDn E{(unsigned char*)(ws + WS_Y)};
                pg8::gemm_phase(lds, g, S, E);
            }
            if (ccount > 0) side_convert(q, lds, pre, cfirst, ccount, SIDE_CC_DN);
        }
        SYNC_AFTER(k0 + 6);
        PROBE_END(6) }
    }
    if (IN(15)) { Params q; load_params(q, p); phase_final(q, lds); }
#undef PROBE_BEGIN
#undef PROBE_END
#undef IN
#undef SYNC_AFTER
}

extern "C" void kernel_launch(void* const* d_in, const int* in_sizes, int n_in, void* d_out, int out_size, void* d_ws, size_t ws_size, hipStream_t stream) {
    static int grid = 0;
    if (grid == 0) {
        if (n_in != 20 || out_size != NTOK * DM || ws_size < WS_END) { fprintf(stderr, "kernel_launch: unexpected shapes (n_in %d out %d ws %zu)\n", n_in, out_size, ws_size); grid = -1; return; }
        int dev = 0, cus = 0, per_cu = 0;
        hipGetDevice(&dev);
        hipDeviceGetAttribute(&cus, hipDeviceAttributeMultiprocessorCount, dev);
        hipFuncSetAttribute((const void*)fwd_kernel, hipFuncAttributeMaxDynamicSharedMemorySize, LDS_BYTES);
        hipOccupancyMaxActiveBlocksPerMultiprocessor(&per_cu, (const void*)fwd_kernel, NTHREADS, LDS_BYTES);
        if (per_cu < 1) per_cu = 1;
        if (per_cu > 1) per_cu = 1;
        grid = cus * per_cu;
        (void)hipGetLastError();
    }
    if (grid < 0) return;
    if (hipMemsetAsync((char*)d_ws + WS_CTL, 0, 65536, stream) != hipSuccess) { fprintf(stderr, "memset failed\n"); return; }
    Params p{};
    for (int i = 0; i < 20; ++i) p.in[i] = (const float*)d_in[i];
    p.out = (float*)d_out; p.ws = (unsigned char*)d_ws; p.ph_lo = 0; p.ph_hi = 16;
    void* args[] = {&p};
    hipError_t e = hipLaunchCooperativeKernel((const void*)fwd_kernel, dim3(grid), dim3(NTHREADS), args, LDS_BYTES, stream);
    if (e != hipSuccess) fprintf(stderr, "cooperative launch failed: %s (grid %d)\n", hipGetErrorString(e), grid);
}
```

```cpp
#include <hip/hip_runtime.h>
#include <hip/hip_cooperative_groups.h>
#include <cstdio>
#include <cstdint>
namespace cg = cooperative_groups;

#define LAS __attribute__((address_space(3)))
typedef unsigned short bf16_t;
typedef short bf16x8 __attribute__((ext_vector_type(8)));
typedef float f32x4 __attribute__((ext_vector_type(4)));
typedef float f32x16 __attribute__((ext_vector_type(16)));
typedef unsigned u32x4 __attribute__((ext_vector_type(4)));
typedef int i32x4 __attribute__((ext_vector_type(4)));
typedef int i32x8 __attribute__((ext_vector_type(8)));
typedef unsigned u32x2 __attribute__((ext_vector_type(2)));
typedef float f32x2_t __attribute__((ext_vector_type(2)));
typedef __bf16 bf16x2_t __attribute__((ext_vector_type(2)));

constexpr int BATCH = 4, SEQ = 8192, DM = 1024, NTOK = BATCH * SEQ, DEPTH = 2;
constexpr int NHEAD = 8, HD = 64, NEXP = 32, DEXP = 512;
constexpr float EPS = 1e-6f;
constexpr float LOG2E = 1.4426950408889634f;

constexpr size_t MiB = 1u << 20;
constexpr size_t WS_CTL = 0;
constexpr size_t WS_MOD = 1 * MiB;
constexpr size_t WS_TBL = 1 * MiB + 512 * 1024;
constexpr size_t WS_RW = 2 * MiB;
constexpr size_t WS_RWB = 2 * MiB + 512 * 1024;
constexpr size_t WS_LIST = 3 * MiB;
constexpr size_t WS_EW = 7 * MiB;
constexpr size_t WS_WIN = 8 * MiB;
constexpr size_t WS_WOUT = 16 * MiB;
constexpr size_t WS_WGU = 20 * MiB;
constexpr size_t WS_WD = 148 * MiB;
constexpr size_t WS_BUF = 212 * MiB;
constexpr size_t WS_U = 276 * MiB;
constexpr size_t WS_Q = 308 * MiB;
constexpr size_t WS_K = 340 * MiB;
constexpr size_t WS_V = 372 * MiB;
constexpr size_t WS_Y = 276 * MiB;
constexpr size_t WS_ACT = 404 * MiB;
constexpr size_t WS_SSQ = 468 * MiB;
constexpr size_t WS_XB = 470 * MiB;
constexpr size_t WS_LIST2 = 534 * MiB;
constexpr size_t WS_RS = 542 * MiB;
constexpr size_t WS_CS = 543 * MiB;
constexpr size_t WS_END = 544 * MiB;

constexpr int LDS_BYTES = 163840;
constexpr int NWAVES = 8, NTHREADS = 512;
constexpr int LDS_KEEP = 139264, LDS_TBL = 140288;

struct Params {
    const float* in[20];
    float* out;
    unsigned char* ws;
    int ph_lo, ph_hi;
};

__device__ __forceinline__ unsigned cvtpk(float lo, float hi) { f32x2_t v = {lo, hi}; bf16x2_t b = __builtin_convertvector(v, bf16x2_t); return __builtin_bit_cast(unsigned, b); }
__device__ __forceinline__ float bf_lo(unsigned w) { return __uint_as_float(w << 16); }
__device__ __forceinline__ float bf_hi(unsigned w) { return __uint_as_float(w & 0xffff0000u); }
__device__ __forceinline__ float fast_exp2(float x) { return __builtin_amdgcn_exp2f(x); }
__device__ __forceinline__ float fast_rcp(float x) { return __builtin_amdgcn_rcpf(x); }

__device__ __forceinline__ float clamp8(float x) { return __builtin_amdgcn_fmed3f(x, -448.0f, 448.0f); }
__device__ __forceinline__ unsigned pk_fp8x4(float a, float b, float c, float d) { int w = 0; w = __builtin_amdgcn_cvt_pk_fp8_f32(a, b, w, false); w = __builtin_amdgcn_cvt_pk_fp8_f32(c, d, w, true); return (unsigned)w; }
__device__ __forceinline__ unsigned pk_i8x4(float a, float b, float c, float d) {
    const unsigned ua = __float_as_uint(a + 12582912.0f), ub = __float_as_uint(b + 12582912.0f), uc = __float_as_uint(c + 12582912.0f), ud = __float_as_uint(d + 12582912.0f);
    return __builtin_amdgcn_perm(__builtin_amdgcn_perm(ud, uc, 0x0c0c0400u), __builtin_amdgcn_perm(ub, ua, 0x0c0c0400u), 0x05040100u);
}
__device__ __forceinline__ f32x4 i2f(const f32x4& a) { return __builtin_convertvector(__builtin_bit_cast(i32x4, a), f32x4); }
__device__ __forceinline__ float shx(float v, int k, int lane) { return __int_as_float(__builtin_amdgcn_ds_bpermute((lane ^ k) << 2, __float_as_int(v))); }
__device__ __forceinline__ unsigned bpx(unsigned v, int src_lane) { return (unsigned)__builtin_amdgcn_ds_bpermute(src_lane << 2, (int)v); }
extern __shared__ __attribute__((aligned(16))) unsigned char lds_raw[];
__device__ __forceinline__ unsigned hw_wave_key() { return (unsigned)__builtin_amdgcn_s_getreg((5 << 11) | 4) & 63u; }
__device__ __forceinline__ int opaque_tid() {
    const volatile LAS unsigned char* wt = (const volatile LAS unsigned char*)lds_raw + (LDS_BYTES - 96);
    const int w = __builtin_amdgcn_readfirstlane((int)wt[hw_wave_key()]);
    int t = w * 64 + (int)__builtin_amdgcn_mbcnt_hi(~0u, __builtin_amdgcn_mbcnt_lo(~0u, 0u));
    asm volatile("" : "+v"(t)); return t;
}
__device__ __forceinline__ int opaque_bid() { int t = blockIdx.x; asm volatile("" : "+s"(t)); return t; }

namespace pg8 {
constexpr int BM = 256, BK = 64, HALF = 128, HTB = HALF * BK * 2, STAGE_BYTES = 8 * HTB, NXCD = 8, WGM = 8;
__host__ __device__ __forceinline__ int lds_byte(int r, int c) { const int st = (r >> 4) * 2 + (c >> 5), rr = r & 15, cc = c & 31, ob = rr * 64 + cc * 2; return st * 1024 + (ob ^ (((ob >> 9) & 1) << 5)); }
__host__ __device__ __forceinline__ void stage_rc(unsigned b, int& R, int& C) { const unsigned st = b >> 10, sb = b & 1023u, swz = sb ^ (((sb >> 9) & 1u) << 5); R = (int)((st >> 1) * 16u + (swz >> 6)); C = (int)((st & 1u) * 32u + ((swz & 63u) >> 1)); }
__host__ __device__ __forceinline__ int perm32(int rho) { const int n = rho >> 4, i = rho & 15; return 8 * (i >> 2) + 4 * n + (i & 3); }

struct Unit { int pm, pn, e, rows; };

struct StaticOrder {
    int nM, nN, nwg, G, c;
    __device__ void init(int M, int N, int G_, int c_) { nM = M / BM; nN = N / BM; nwg = nM * nN; G = G_; c = c_; }
    __device__ bool next(int i, Unit& u) const {
        const long L = (long)i * G + c; if (L >= nwg) return false;
        int wgid = (int)L; { const int q = nwg / NXCD, r = nwg % NXCD, xcd = wgid % NXCD, off = wgid / NXCD; wgid = (xcd < r ? xcd * (q + 1) : r * (q + 1) + (xcd - r) * q) + off; }
        const int nig = WGM * nN, gid = wgid / nig, fm = gid * WGM, gsz = (nM - fm) < WGM ? (nM - fm) : WGM;
        u.pm = fm + ((wgid % nig) % gsz); u.pn = (wgid % nig) / gsz; u.e = 0; u.rows = BM; return true;
    }
};

struct GroupedOrder {
    const LAS int* prefix; const LAS int* cnt; int G, v;
    __device__ bool next(int i, Unit& u) const {
        const int L = i * G + v; const int total = prefix[NEXP];
        if (L >= total * 4) return false;
        const int rt = L >> 2;
        const int ln_ = (int)__builtin_amdgcn_mbcnt_hi(~0u, __builtin_amdgcn_mbcnt_lo(~0u, 0u));
        const unsigned m_ = (unsigned)__builtin_amdgcn_ballot_w64(prefix[ln_ & (NEXP - 1)] <= rt);
        const int e = 31 - __builtin_clz(m_);
        u.e = e; u.pm = rt - prefix[e]; u.pn = L & 3; const int rem = cnt[e] - u.pm * BM; u.rows = rem < BM ? rem : BM; return true;
    }
};

template <class G, class Epi, class Sched>
__device__ __forceinline__ void gemm_phase(LAS unsigned char* lds, const G g, const Sched& S, const Epi& E) {
    const int tid = opaque_tid();
    const int wid = __builtin_amdgcn_readfirstlane(tid >> 6), lane = tid & 63, wr = wid >> 2, wc = wid & 3, fr = lane & 15, fq = lane >> 4;
    const int K = g.K, KB = K * G::ES, nt = KB / (BK * 2);
    unsigned voffB[2];
#pragma unroll
    for (int i = 0; i < 2; ++i) { int R, C; stage_rc(tid * 16 + i * 8192, R, C); const int Rb = Epi::PERM ? ((R & ~31) + perm32(R & 31)) : R;
        voffB[i] = (unsigned)(Rb * KB + C * 2); }
#define PG8_AOFF(u, i, h) ({ int t_ = tid; asm volatile("" : "+v"(t_)); int R_, C_; stage_rc((unsigned)t_ * 16u + (i) * 8192u, R_, C_); g.a_off(u, (h) * HALF + R_, C_); })
    const size_t kstep = (size_t)(BK * 2);
    const size_t hstep = (size_t)HALF * KB;
    const unsigned ldsw = (unsigned)wid * 1024u;
    const int aoff = lds_byte(wr * 64 + fr, fq * 8), boff = lds_byte(wc * 32 + fr, fq * 8);
#define PG8_SA(b, h) (((b) * 2 + (h)) * HTB)
#define PG8_SB(b, h) ((4 + (b) * 2 + (h)) * HTB)
#define PG8_STAGE2(bufoff, gbase, o0, o1) do { \
        __builtin_amdgcn_global_load_lds((const unsigned*)((const char*)(gbase) + (o0)), (LAS unsigned*)(lds + (bufoff) + ldsw), 16, 0, 0); \
        __builtin_amdgcn_global_load_lds((const unsigned*)((const char*)(gbase) + (o1)), (LAS unsigned*)(lds + (bufoff) + ldsw + 8192), 16, 0, 0); } while (0)
#define PG8_STAGEB(bufoff, gbase) PG8_STAGE2(bufoff, gbase, voffB[0], voffB[1])
#define PG8_LDA(dst, b, h) do { _Pragma("unroll") for (int m = 0; m < 4; ++m) _Pragma("unroll") for (int k = 0; k < 2; ++k) dst[m][k] = *(const LAS bf16x8*)(lds + PG8_SA(b, h) + aoff + m * 2048 + k * 1024); } while (0)
#define PG8_LDB(dst, b, h) do { _Pragma("unroll") for (int n = 0; n < 2; ++n) _Pragma("unroll") for (int k = 0; k < 2; ++k) dst[n][k] = *(const LAS bf16x8*)(lds + PG8_SB(b, h) + boff + n * 2048 + k * 1024); } while (0)
#define PG8_F8(v0, v1) __builtin_shufflevector(__builtin_bit_cast(i32x4, v0), __builtin_bit_cast(i32x4, v1), 0, 1, 2, 3, 4, 5, 6, 7)
#define PG8_MMA(ai, bj, At, Bt) do { __builtin_amdgcn_s_setprio(1); \
        if (G::MODE == 1) { const i32x8 a0_ = PG8_F8(At[0][0], At[0][1]), a1_ = PG8_F8(At[1][0], At[1][1]), a2_ = PG8_F8(At[2][0], At[2][1]), a3_ = PG8_F8(At[3][0], At[3][1]), b0_ = PG8_F8(Bt[0][0], Bt[0][1]), b1_ = PG8_F8(Bt[1][0], Bt[1][1]); \
            asm volatile("s_nop 1\n\tv_mfma_f32_16x16x128_f8f6f4 %0, %12, %8, %0\n\tv_mfma_f32_16x16x128_f8f6f4 %1, %13, %8, %1\n\tv_mfma_f32_16x16x128_f8f6f4 %2, %12, %9, %2\n\tv_mfma_f32_16x16x128_f8f6f4 %3, %13, %9, %3\n\t" \
                         "v_mfma_f32_16x16x128_f8f6f4 %4, %12, %10, %4\n\tv_mfma_f32_16x16x128_f8f6f4 %5, %13, %10, %5\n\tv_mfma_f32_16x16x128_f8f6f4 %6, %12, %11, %6\n\tv_mfma_f32_16x16x128_f8f6f4 %7, %13, %11, %7" \
                         : "+v"(acc[ai][bj][0][0]), "+v"(acc[ai][bj][0][1]), "+v"(acc[ai][bj][1][0]), "+v"(acc[ai][bj][1][1]), "+v"(acc[ai][bj][2][0]), "+v"(acc[ai][bj][2][1]), "+v"(acc[ai][bj][3][0]), "+v"(acc[ai][bj][3][1]) \
                         : "v"(a0_), "v"(a1_), "v"(a2_), "v"(a3_), "v"(b0_), "v"(b1_)); } \
        else if (G::MODE == 2) { _Pragma("unroll") for (int m = 0; m < 4; ++m) _Pragma("unroll") for (int n = 0; n < 2; ++n) _Pragma("unroll") for (int k = 0; k < 2; ++k) \
            acc[ai][bj][m][n] = __builtin_bit_cast(f32x4, __builtin_amdgcn_mfma_i32_16x16x64_i8(__builtin_bit_cast(i32x4, Bt[n][k]), __builtin_bit_cast(i32x4, At[m][k]), __builtin_bit_cast(i32x4, acc[ai][bj][m][n]), 0, 0, 0)); } \
        else { _Pragma("unroll") for (int m = 0; m < 4; ++m) _Pragma("unroll") for (int n = 0; n < 2; ++n) _Pragma("unroll") for (int k = 0; k < 2; ++k) \
            acc[ai][bj][m][n] = __builtin_amdgcn_mfma_f32_16x16x32_bf16(Bt[n][k], At[m][k], acc[ai][bj][m][n], 0, 0, 0); } __builtin_amdgcn_s_setprio(0); } while (0)
#define PG8_WAIT_V(n) asm volatile("s_waitcnt vmcnt(" #n ")" ::: "memory")
#define PG8_WAIT_L(n) asm volatile("s_waitcnt lgkmcnt(" #n ")" ::: "memory")
#define PG8_BAR __builtin_amdgcn_s_barrier()
#define PG8_SCHED __builtin_amdgcn_sched_barrier(0)
    Unit cur, nxt; int ui = 0;
    if (!S.next(0, cur)) return;
    LAS u32x2* const tab = (LAS u32x2*)(lds + STAGE_BYTES + 1024);
#define PG8_TABLE(u, par) do { if (G::TABLE) { if (wid < 2) { const unsigned long long ts_ = (unsigned long long)g.tab_src(u, wid); \
        const char* tb_ = (const char*)(((unsigned long long)(unsigned)__builtin_amdgcn_readfirstlane((int)(ts_ >> 32)) << 32) | (unsigned)__builtin_amdgcn_readfirstlane((int)ts_));     \
        unsigned lo_ = (unsigned)lane * 16u; asm volatile("" : "+v"(lo_));     \
        __builtin_amdgcn_global_load_lds((const unsigned*)(tb_ + lo_), (LAS unsigned*)((LAS unsigned char*)tab + (par) * 2048 + wid * 1024), 16, 0, 0); } } } while (0)
    int sl = 0;
    PG8_TABLE(cur, 0);
    f32x4 acc[2][2][4][2];
#pragma unroll
    for (int a = 0; a < 2; ++a)
#pragma unroll
        for (int b = 0; b < 2; ++b)
#pragma unroll
            for (int m = 0; m < 4; ++m)
#pragma unroll
                for (int n = 0; n < 2; ++n) acc[a][b][m][n] = (f32x4){0.f, 0.f, 0.f, 0.f};
    bf16x8 At[4][2], B0[2][2], B1[2][2];
    const char* cA = g.a_base(cur); const char* cB = g.b_base(cur);
    unsigned c00 = PG8_AOFF(cur, 0, 0), c01 = PG8_AOFF(cur, 1, 0), c10 = PG8_AOFF(cur, 0, 1), c11 = PG8_AOFF(cur, 1, 1);
    PG8_STAGEB(PG8_SB(0, 0), cB); PG8_STAGEB(PG8_SB(0, 1), cB + hstep); PG8_STAGE2(PG8_SA(0, 0), cA, c00, c01); PG8_STAGE2(PG8_SA(0, 1), cA, c10, c11);
    if (wr == 1) PG8_BAR;
    PG8_WAIT_V(2); PG8_BAR;
    PG8_STAGEB(PG8_SB(1, 0), cB + kstep); PG8_STAGE2(PG8_SA(1, 0), cA + kstep, c00, c01); PG8_STAGEB(PG8_SB(1, 1), cB + hstep + kstep);
    PG8_WAIT_V(6); PG8_BAR;
    for (;;) {
        const bool has_next = S.next(ui + 1, nxt);
        const char* nA = has_next ? g.a_base(nxt) : cA; const char* nB = has_next ? g.b_base(nxt) : cB;
        unsigned n00 = c00, n01 = c01, n10 = c10, n11 = c11;
        const int sn = sl == 2 ? 0 : sl + 1;
        if (has_next) PG8_TABLE(nxt, sn);
#define PG8_AOFF_L(u, i, h) ({ int t_ = tid; asm volatile("" : "+v"(t_)); int R_, C_; stage_rc((unsigned)t_ * 16u + (i) * 8192u, R_, C_); const int r_ = (h) * HALF + R_; \
            const int rr_ = r_ < (u).rows ? r_ : (u).rows - 1; g.a_off_slot((int)tab[sn * 256 + rr_].x, C_); })
#pragma unroll 1
        for (int t = 0; t < nt; t += 2) {
            const bool last = (t == nt - 2);
            const char* a1 = cA + (size_t)(t + 1) * kstep;
            const char* a2 = last ? nA : cA + (size_t)(t + 2) * kstep; const char* b2 = last ? nB : cB + (size_t)(t + 2) * kstep;
            const char* a3 = a2 + kstep; const char* b3 = b2 + kstep;
            if (G::GATHER && last && has_next) { n00 = PG8_AOFF_L(nxt, 0, 0); n01 = PG8_AOFF_L(nxt, 1, 0); n10 = PG8_AOFF_L(nxt, 0, 1); n11 = PG8_AOFF_L(nxt, 1, 1); }
            const unsigned x00 = last ? n00 : c00, x01 = last ? n01 : c01, x10 = last ? n10 : c10, x11 = last ? n11 : c11;
            PG8_LDB(B0, 0, 0); PG8_LDB(B1, 0, 1); PG8_SCHED; PG8_LDA(At, 0, 0); PG8_STAGE2(PG8_SA(1, 1), a1, c10, c11);
            PG8_WAIT_V(8); PG8_WAIT_L(0); PG8_BAR; PG8_MMA(0, 0, At, B0); PG8_MMA(0, 1, At, B1); PG8_BAR; PG8_SCHED;
            PG8_LDA(At, 0, 1); PG8_STAGEB(PG8_SB(0, 0), b2); PG8_STAGEB(PG8_SB(0, 1), b2 + hstep); PG8_STAGE2(PG8_SA(0, 0), a2, x00, x01);
            PG8_WAIT_V(8); PG8_WAIT_L(0); PG8_BAR; PG8_MMA(1, 0, At, B0); PG8_MMA(1, 1, At, B1); PG8_BAR; PG8_SCHED;
            PG8_LDB(B0, 1, 0); PG8_LDB(B1, 1, 1); PG8_SCHED; PG8_LDA(At, 1, 0); PG8_STAGE2(PG8_SA(0, 1), a2, x10, x11);
            PG8_WAIT_V(8); PG8_WAIT_L(0); PG8_BAR; PG8_MMA(0, 0, At, B0); PG8_MMA(0, 1, At, B1); PG8_BAR; PG8_SCHED;
            PG8_LDA(At, 1, 1); PG8_STAGEB(PG8_SB(1, 0), b3); PG8_STAGEB(PG8_SB(1, 1), b3 + hstep); PG8_STAGE2(PG8_SA(1, 0), a3, x00, x01);
            PG8_WAIT_V(8); PG8_WAIT_L(0); PG8_BAR; PG8_MMA(1, 0, At, B0); PG8_MMA(1, 1, At, B1); PG8_BAR; PG8_SCHED;
        }
        if (G::MODE == 1) asm volatile("s_nop 15\n\ts_nop 15" ::: "memory");
        if (wr == 0) PG8_BAR;
        E(acc, cur, wr, wc, fr, fq, tab + sl * 256);
        if (!has_next) break;
#pragma unroll
        for (int a = 0; a < 2; ++a)
#pragma unroll
            for (int b = 0; b < 2; ++b)
#pragma unroll
                for (int m = 0; m < 4; ++m)
#pragma unroll
                    for (int n = 0; n < 2; ++n) acc[a][b][m][n] = (f32x4){0.f, 0.f, 0.f, 0.f};
        cur = nxt; cA = nA; cB = nB; c00 = n00; c01 = n01; c10 = n10; c11 = n11; ++ui; sl = sn;
        if (wr == 1) PG8_BAR;
    }
    PG8_WAIT_V(0);
    PG8_BAR;
#undef PG8_TABLE
#undef PG8_AOFF
#undef PG8_AOFF_L
#undef PG8_SA
#undef PG8_SB
#undef PG8_STAGE2
#undef PG8_STAGEB
#undef PG8_LDA
#undef PG8_LDB
#undef PG8_MMA
#undef PG8_F8
#undef PG8_WAIT_V
#undef PG8_WAIT_L
#undef PG8_BAR
#undef PG8_SCHED
}
}
using pg8::Unit;

template <int MODE_>
struct DenseGemmT {
    static constexpr bool GATHER = false, TABLE = MODE_ == 2; static constexpr int MODE = MODE_, ES = MODE_ == 0 ? 2 : 1;
    const void* A; const void* Bt; int K; const float* sA; const float* sB;
    __device__ __forceinline__ const char* tab_src(const Unit& u, int w) const { return (const char*)(w == 0 ? sA + u.pm * 256 : sB + u.pn * 256); }
    __device__ __forceinline__ const char* a_base(const Unit& u) const { return (const char*)A + (size_t)u.pm * 256 * K * ES; }
    __device__ __forceinline__ const char* b_base(const Unit& u) const { return (const char*)Bt + (size_t)u.pn * 256 * K * ES; }
    __device__ __forceinline__ unsigned a_off(const Unit&, int r, int c) const { return (unsigned)(r * K * ES + c * 2); }
    __device__ __forceinline__ unsigned a_off_slot(int, int) const { return 0u; }
};
typedef DenseGemmT<0> DenseGemm;
typedef DenseGemmT<2> DenseGemmI8;
typedef DenseGemmT<1> DenseGemm8;
struct GatherGemm {
    static constexpr bool GATHER = true, TABLE = true; static constexpr int MODE = 1, ES = 1;
    const unsigned char* A; const unsigned char* Bt; const u32x2* list; int K; int a_shift;
    size_t b_expert_stride;
    __device__ __forceinline__ const char* tab_src(const Unit& u, int w) const { return (const char*)(list + (size_t)u.e * NTOK + u.pm * 256) + w * 1024; }
    __device__ __forceinline__ const char* a_base(const Unit&) const { return (const char*)A; }
    __device__ __forceinline__ const char* b_base(const Unit& u) const { return (const char*)Bt + (size_t)u.e * b_expert_stride + (size_t)u.pn * 256 * K; }
    __device__ __forceinline__ unsigned a_off(const Unit& u, int r, int c) const {
        const int rr = r < u.rows ? r : u.rows - 1;
        const int slot = (int)list[(size_t)u.e * NTOK + u.pm * 256 + rr].x;
        return (unsigned)((slot >> a_shift) * K + c * 2);
    }
    __device__ __forceinline__ unsigned a_off_slot(int slot, int c) const { return (unsigned)((slot >> a_shift) * K + c * 2); }
};


struct EpiIn {
    static constexpr bool PERM = true;
    bf16_t* U; bf16_t* Qf; bf16_t* Kf; const LAS float* gl;
    __device__ __forceinline__ void operator()(const f32x4 (&acc)[2][2][4][2], const Unit& u, int wr, int wc, int fr, int fq, const LAS u32x2* tab) const {
        const LAS float* tf = (const LAS float*)tab;
        const int cix = 256 + wc * 32 + fq * 8;
        if (u.pn < 2) {
#pragma unroll
            for (int ai = 0; ai < 2; ++ai)
#pragma unroll
                for (int m = 0; m < 4; ++m) {
                    int z = 0; asm volatile("" : "+v"(z));
                    const int r = ai * 128 + wr * 64 + m * 16 + fr;
                    const float rr = tf[r + z];
                    const int row = u.pm * 256 + r;
#pragma unroll
                    for (int bj = 0; bj < 2; ++bj) {
                        const f32x4 c0 = *(const LAS f32x4*)(tf + cix + bj * 128 + z), c1 = *(const LAS f32x4*)(tf + cix + bj * 128 + 4 + z);
                        const f32x4 v0 = i2f(acc[ai][bj][m][0]) * c0 * rr, v1 = i2f(acc[ai][bj][m][1]) * c1 * rr;
                        u32x4 w; w.x = cvtpk(v0[0], v0[1]); w.y = cvtpk(v0[2], v0[3]); w.z = cvtpk(v1[0], v1[1]); w.w = cvtpk(v1[2], v1[3]);
                        *(u32x4*)(U + (size_t)row * 512 + u.pn * 256 + bj * 128 + wc * 32 + fq * 8) = w;
                    }
                }
        } else {
            const bool isq = u.pn < 4;
            bf16_t* dst = isq ? Qf : Kf;
            const LAS float* gg = gl + (isq ? 0 : 64) + fq * 8;
            const int head = (u.pn & 1) * 4 + wc;
#pragma unroll
            for (int ai = 0; ai < 2; ++ai)
#pragma unroll
                for (int m = 0; m < 4; ++m) {
                    int z = 0; asm volatile("" : "+v"(z));
                    const int r = ai * 128 + wr * 64 + m * 16 + fr;
                    const float rr = tf[r + z];
                    f32x4 val[2][2];
                    float ss = 0.f;
#pragma unroll
                    for (int bj = 0; bj < 2; ++bj)
#pragma unroll
                        for (int n = 0; n < 2; ++n) { const f32x4 v = i2f(acc[ai][bj][m][n]) * *(const LAS f32x4*)(tf + cix + bj * 128 + n * 4 + z); val[bj][n] = v; ss += (v[0] * v[0] + v[1] * v[1]) + (v[2] * v[2] + v[3] * v[3]); }
                    ss += shx(ss, 16, fq * 16 + fr); ss += shx(ss, 32, fq * 16 + fr);
                    const float rstd = rsqrtf(ss * (rr * rr) * (1.0f / 64.0f) + EPS) * rr;
                    const int row = u.pm * 256 + r;
                    const int b = row >> 13, s = row & (SEQ - 1), rb = s >> 5, r32 = s & 31;
#pragma unroll
                    for (int bj = 0; bj < 2; ++bj) {
                        const f32x4 v0 = val[bj][0] * rstd * *(const LAS f32x4*)(gg + bj * 32 + z), v1 = val[bj][1] * rstd * *(const LAS f32x4*)(gg + bj * 32 + 4 + z);
                        u32x4 w; w.x = cvtpk(v0[0], v0[1]); w.y = cvtpk(v0[2], v0[3]); w.z = cvtpk(v1[0], v1[1]); w.w = cvtpk(v1[2], v1[3]);
                        const int d0 = 2 * bj + (fq >> 1), hi = fq & 1;
                        const size_t piece = (((size_t)(b * NHEAD + head) * 256 + rb) * 4 + d0);
                        *(u32x4*)(dst + (piece * 64 + hi * 32 + r32) * 8) = w;
                    }
                }
        }
    }
};

struct EpiVt {
    static constexpr bool PERM = true;
    bf16_t* Vf;
    __device__ __forceinline__ void operator()(const f32x4 (&acc)[2][2][4][2], const Unit& u, int wr, int wc, int fr, int fq, const LAS u32x2* tab) const {
        const LAS float* tf = (const LAS float*)tab;
        f32x4 rv[2][2];
#pragma unroll
        for (int bj = 0; bj < 2; ++bj)
#pragma unroll
            for (int n = 0; n < 2; ++n) rv[bj][n] = *(const LAS f32x4*)(tf + 256 + bj * 128 + wc * 32 + fq * 8 + n * 4);
#pragma unroll
        for (int ai = 0; ai < 2; ++ai)
#pragma unroll
            for (int m = 0; m < 4; ++m) {
                const int r = ai * 128 + wr * 64 + m * 16 + fr;
                const float cc = tf[r];
                const int hd = u.pm * 256 + r;
                const int head = hd >> 6, dblk = (hd >> 5) & 1, dl = hd & 31;
#pragma unroll
                for (int bj = 0; bj < 2; ++bj) {
                    const int tok0 = u.pn * 256 + bj * 128 + wc * 32;
                    const int b = tok0 >> 13, kb = (tok0 & (SEQ - 1)) >> 5;
                    const size_t piece = ((((size_t)(b * NHEAD + head) * 256 + kb) * 2 + (fq >> 1)) * 2 + dblk);
                    u32x2 w[2];
#pragma unroll
                    for (int n = 0; n < 2; ++n) { const f32x4 v = i2f(acc[ai][bj][m][n]) * rv[bj][n] * cc; w[n].x = cvtpk(v[0], v[1]); w[n].y = cvtpk(v[2], v[3]); }
                    const int odd = fq & 1, partner = (fq ^ 1) * 16 + fr;
                    const u32x2 snd = odd ? w[0] : w[1];
                    u32x2 rcv; rcv.x = bpx(snd.x, partner); rcv.y = bpx(snd.y, partner);
                    u32x4 o4; if (odd) { o4.x = rcv.x; o4.y = rcv.y; o4.z = w[1].x; o4.w = w[1].y; } else { o4.x = w[0].x; o4.y = w[0].y; o4.z = rcv.x; o4.w = rcv.y; }
                    *(u32x4*)((char*)Vf + (piece * 64 + odd * 32 + dl) * 16) = o4;
                }
            }
    }
};

template <bool XF>
struct EpiOutB {
    static constexpr bool PERM = true;
    const float* xf; bf16_t* XB; const float* g1; float* ssq;
    __device__ __forceinline__ void operator()(const f32x4 (&acc)[2][2][4][2], const Unit& u, int wr, int wc, int fr, int fq, const LAS u32x2* tab) const {
        const int b = (u.pm * 256) >> 13;
        const int col0 = u.pn * 256 + wc * 32 + 8 * fq;
        f32x4 gv[2][2];
#pragma unroll
        for (int bj = 0; bj < 2; ++bj)
#pragma unroll
            for (int n = 0; n < 2; ++n) gv[bj][n] = *(const f32x4*)(g1 + (size_t)b * 6144 + col0 + bj * 128 + n * 4) * (1.0f / 4096.0f);
        float keep = 0.f;
#pragma unroll
        for (int ai = 0; ai < 2; ++ai)
#pragma unroll
            for (int m = 0; m < 4; ++m) {
                const int row = u.pm * 256 + ai * 128 + wr * 64 + m * 16 + fr;
                const size_t off = (size_t)row * DM + col0;
                f32x4 xb[2][2];
                if (XF) {
#pragma unroll
                    for (int bj = 0; bj < 2; ++bj) { xb[bj][0] = *(const f32x4*)(xf + off + bj * 128); xb[bj][1] = *(const f32x4*)(xf + off + bj * 128 + 4); }
                } else {
#pragma unroll
                    for (int bj = 0; bj < 2; ++bj) { const u32x4 w = *(const u32x4*)(XB + off + bj * 128);
                        xb[bj][0] = (f32x4){bf_lo(w.x), bf_hi(w.x), bf_lo(w.y), bf_hi(w.y)}; xb[bj][1] = (f32x4){bf_lo(w.z), bf_hi(w.z), bf_lo(w.w), bf_hi(w.w)}; }
                }
                float ss = 0.f;
#pragma unroll
                for (int bj = 0; bj < 2; ++bj) {
                    const f32x4 x0 = xb[bj][0] + gv[bj][0] * acc[ai][bj][m][0], x1 = xb[bj][1] + gv[bj][1] * acc[ai][bj][m][1];
                    u32x4 w; w.x = cvtpk(x0[0], x0[1]); w.y = cvtpk(x0[2], x0[3]); w.z = cvtpk(x1[0], x1[1]); w.w = cvtpk(x1[2], x1[3]);
                    *(u32x4*)(XB + off + bj * 128) = w;
                    const float r0 = bf_lo(w.x), r1 = bf_hi(w.x), r2 = bf_lo(w.y), r3 = bf_hi(w.y), r4 = bf_lo(w.z), r5 = bf_hi(w.z), r6 = bf_lo(w.w), r7 = bf_hi(w.w);
                    ss += ((r0 * r0 + r1 * r1) + (r2 * r2 + r3 * r3)) + ((r4 * r4 + r5 * r5) + (r6 * r6 + r7 * r7));
                }
                ss += shx(ss, 16, fq * 16 + fr); ss += shx(ss, 32, fq * 16 + fr);
                if (fq == m) keep = ss;
                if (m == 3) ssq[(size_t)(u.pn * 4 + wc) * NTOK + u.pm * 256 + ai * 128 + wr * 64 + fq * 16 + fr] = keep;
            }
    }
};

struct EpiGU {
    static constexpr bool PERM = true;
    unsigned char* ACT;
    __device__ __forceinline__ void operator()(const f32x4 (&acc)[2][2][4][2], const Unit& u, int wr, int wc, int fr, int fq, const LAS u32x2* tab) const {
        constexpr float SI = 1.0f / 2048.0f;
        const int odd = fq & 1, partner = (fq ^ 1) * 16 + fr;
#pragma unroll
        for (int ai = 0; ai < 2; ++ai)
#pragma unroll
            for (int mp = 0; mp < 2; ++mp) {
                u32x2 w[2];
#pragma unroll
                for (int h = 0; h < 2; ++h) {
                    const int m = 2 * mp + h;
                    float o[8];
#pragma unroll
                    for (int n = 0; n < 2; ++n)
#pragma unroll
                        for (int e = 0; e < 4; ++e) { const float gte = acc[ai][0][m][n][e] * SI, up = acc[ai][1][m][n][e] * (4.0f * SI);
                            o[n * 4 + e] = clamp8(gte * fast_rcp(1.0f + fast_exp2(-gte * LOG2E)) * up); }
                    w[h].x = pk_fp8x4(o[0], o[1], o[2], o[3]); w[h].y = pk_fp8x4(o[4], o[5], o[6], o[7]);
                }
                const u32x2 snd = odd ? w[0] : w[1];
                u32x2 rcv; rcv.x = bpx(snd.x, partner); rcv.y = bpx(snd.y, partner);
                const int r = ai * 128 + wr * 64 + (2 * mp + odd) * 16 + fr;
                const int slot = (int)tab[r].x;
                u32x4 o4; if (odd) { o4.x = rcv.x; o4.y = rcv.y; o4.z = w[1].x; o4.w = w[1].y; } else { o4.x = w[0].x; o4.y = w[0].y; o4.z = rcv.x; o4.w = rcv.y; }
                if (r < u.rows) *(u32x4*)(ACT + (size_t)slot * DEXP + u.pn * 128 + wc * 32 + (fq & 2) * 8) = o4;
            }
    }
};

struct EpiDn {
    static constexpr bool PERM = true;
    unsigned char* Y8;
    __device__ __forceinline__ void operator()(const f32x4 (&acc)[2][2][4][2], const Unit& u, int wr, int wc, int fr, int fq, const LAS u32x2* tab) const {
        const int odd = fq & 1, partner = (fq ^ 1) * 16 + fr;
#pragma unroll
        for (int ai = 0; ai < 2; ++ai)
#pragma unroll
            for (int m = 0; m < 4; ++m) {
                const int r = ai * 128 + wr * 64 + m * 16 + fr;
                const u32x2 en = tab[r];
                const int slot = (int)en.x;
                const float w8 = __uint_as_float(en.y) * (16.0f / 1024.0f);
                u32x2 w[2];
#pragma unroll
                for (int bj = 0; bj < 2; ++bj) {
                    const f32x4 v0 = acc[ai][bj][m][0] * w8, v1 = acc[ai][bj][m][1] * w8;
                    w[bj].x = pk_fp8x4(v0[0], v0[1], v0[2], v0[3]); w[bj].y = pk_fp8x4(v1[0], v1[1], v1[2], v1[3]);
                }
                const u32x2 snd = odd ? w[0] : w[1];
                u32x2 rcv; rcv.x = bpx(snd.x, partner); rcv.y = bpx(snd.y, partner);
                u32x4 o4; if (odd) { o4.x = rcv.x; o4.y = rcv.y; o4.z = w[1].x; o4.w = w[1].y; } else { o4.x = w[0].x; o4.y = w[0].y; o4.z = rcv.x; o4.w = rcv.y; }
                if (r < u.rows) *(u32x4*)(Y8 + (size_t)slot * DM + u.pn * 256 + odd * 128 + wc * 32 + (fq & 2) * 8) = o4;
            }
    }
};

struct TItem { const float* src; unsigned char* dst; int N, dstK, koff, k0, n0, map, f8; };
__device__ __forceinline__ int t_rowmap(int map, int n) {
    if (map == 0) return n;
    if (map == 1) { if (n < 512 || n >= 1536) return n; const int t = n & 255, wc = t >> 6, bj = (t >> 5) & 1, c = t & 31; return (n & ~255) + 128 * bj + 32 * wc + c; }
    return 256 * (n >> 7) + 128 * (map - 2) + (n & 127);
}
__device__ __forceinline__ void t_load(const TItem& d, f32x4 (&v)[16], int lane) {
    const int kr = lane >> 4, c4 = lane & 15;
#pragma unroll
    for (int i = 0; i < 16; ++i) v[i] = *(const f32x4*)(d.src + (size_t)(d.k0 + 4 * i + kr) * d.N + d.n0 + 4 * c4);
}
__device__ __forceinline__ void t_process(const TItem& d, const f32x4 (&v)[16], LAS float* scr, int lane) {
    const int kr = lane >> 4, c4 = lane & 15;
#pragma unroll
    for (int i = 0; i < 16; ++i) { LAS float* s = scr + (4 * i + kr) * 65 + 4 * c4; s[0] = v[i][0]; s[1] = v[i][1]; s[2] = v[i][2]; s[3] = v[i][3]; }
    asm volatile("s_waitcnt lgkmcnt(0)" ::: "memory");
    if (d.f8) {
        const int nr = lane >> 2, kc = lane & 3;
#pragma unroll
        for (int i = 0; i < 4; ++i) { const int n = 16 * i + nr; const LAS float* s = scr + (16 * kc) * 65 + n;
            const size_t eo = (size_t)t_rowmap(d.map, d.n0 + n) * d.dstK + d.koff + d.k0 + 16 * kc;
            u32x4 o;
            if (d.f8 == 2) { o.x = pk_i8x4(s[0], s[65], s[2 * 65], s[3 * 65]); o.y = pk_i8x4(s[4 * 65], s[5 * 65], s[6 * 65], s[7 * 65]);
                o.z = pk_i8x4(s[8 * 65], s[9 * 65], s[10 * 65], s[11 * 65]); o.w = pk_i8x4(s[12 * 65], s[13 * 65], s[14 * 65], s[15 * 65]); }
            else { o.x = pk_fp8x4(s[0] * 256.0f, s[65] * 256.0f, s[2 * 65] * 256.0f, s[3 * 65] * 256.0f); o.y = pk_fp8x4(s[4 * 65] * 256.0f, s[5 * 65] * 256.0f, s[6 * 65] * 256.0f, s[7 * 65] * 256.0f);
                o.z = pk_fp8x4(s[8 * 65] * 256.0f, s[9 * 65] * 256.0f, s[10 * 65] * 256.0f, s[11 * 65] * 256.0f); o.w = pk_fp8x4(s[12 * 65] * 256.0f, s[13 * 65] * 256.0f, s[14 * 65] * 256.0f, s[15 * 65] * 256.0f); }
            *(u32x4*)(d.dst + eo) = o; }
    } else {
        const int nr = lane >> 3, kc = lane & 7;
#pragma unroll
        for (int i = 0; i < 8; ++i) { const int n = 8 * i + nr; const LAS float* s = scr + (8 * kc) * 65 + n;
            const size_t eo = (size_t)t_rowmap(d.map, d.n0 + n) * d.dstK + d.koff + d.k0 + 8 * kc;
            u32x4 o; o.x = cvtpk(s[0], s[65]); o.y = cvtpk(s[2 * 65], s[3 * 65]); o.z = cvtpk(s[4 * 65], s[5 * 65]); o.w = cvtpk(s[6 * 65], s[7 * 65]);
            *(u32x4*)(d.dst + eo * 2) = o; }
    }
    asm volatile("s_waitcnt lgkmcnt(0)" ::: "memory");
}
constexpr int T_OUT = 128, T_GU = NEXP * 256, T_DN = NEXP * 128;
constexpr int SIDE_GU0 = 2048, SIDE_CC_GU = 130, SIDE_CC_DN = 90;
constexpr int T_NA = 2 * T_OUT + T_GU, T_NB = T_DN + T_GU + T_DN;
__device__ __forceinline__ void t_item_out(const Params& p, int l, int r, TItem& d) {
    d.src = p.in[12] + ((size_t)l * 1024 + 512) * 1024; d.N = 1024; d.f8 = 1; d.dst = p.ws + WS_WOUT + (size_t)l * 1024 * 1024; d.dstK = 1024; d.koff = 512; d.k0 = (r >> 4) * 64; d.n0 = (r & 15) * 64; d.map = 0;
}
__device__ __forceinline__ void t_item_gu(const Params& p, int l, int j, TItem& d) {
    const int e = j >> 8; int q = j & 255; const int up = q >> 7; q &= 127;
    d.src = (up ? p.in[18] : p.in[17]) + ((size_t)l * NEXP + e) * 1024 * 512; d.N = 512; d.f8 = 1; d.dst = p.ws + WS_WGU + ((size_t)l * NEXP + e) * 1024 * 1024; d.dstK = 1024; d.koff = 0; d.k0 = (q >> 3) * 64; d.n0 = (q & 7) * 64; d.map = 2 + up;
}
__device__ __forceinline__ void t_item_dn(const Params& p, int l, int j, TItem& d) {
    const int e = j >> 7, q = j & 127;
    d.src = p.in[19] + ((size_t)l * NEXP + e) * 512 * 1024; d.N = 1024; d.f8 = 1; d.dst = p.ws + WS_WD + ((size_t)l * NEXP + e) * 1024 * 512; d.dstK = 512; d.koff = 0; d.k0 = (q >> 4) * 64; d.n0 = (q & 15) * 64; d.map = 0;
}
template <bool SPACE_B>
__device__ __forceinline__ void t_decode(const Params& p, int it, TItem& d) {
    if (SPACE_B) { if (it < T_DN) t_item_dn(p, 0, it, d); else if (it < T_DN + T_GU) t_item_gu(p, 1, it - T_DN, d); else t_item_dn(p, 1, it - T_DN - T_GU, d); }
    else { if (it < T_OUT) t_item_out(p, 0, it, d); else if (it < 2 * T_OUT) t_item_out(p, 1, it - T_OUT, d); else t_item_gu(p, 0, it - 2 * T_OUT, d); }
}
template <bool SPACE_B>
__device__ __forceinline__ void t_run(const Params& p, int it, int stride, int nit, LAS float* scr, int lane) {
    if (it >= nit) return;
    TItem dA, dB; f32x4 vA[16], vB[16];
    t_decode<SPACE_B>(p, it, dA); t_load(dA, vA, lane);
    for (;;) {
        int nx = it + stride; const bool hasB = nx < nit;
        if (hasB) { t_decode<SPACE_B>(p, nx, dB); t_load(dB, vB, lane); }
        t_process(dA, vA, scr, lane);
        if (!hasB) break;
        it = nx + stride; const bool hasA = it < nit;
        if (hasA) { t_decode<SPACE_B>(p, it, dA); t_load(dA, vA, lane); }
        t_process(dB, vB, scr, lane);
        if (!hasA) break;
    }
}
struct SidePlan { int gp, v, nconv, cidx; bool conv; };
__device__ __forceinline__ SidePlan side_plan(int total_units, int count) {
    const int G = gridDim.x, bid = blockIdx.x;
    SidePlan s; s.gp = G; s.v = (G % 8 == 0) ? (bid % 8) * (G / 8) + bid / 8 : bid; s.nconv = 0; s.cidx = 0; s.conv = false;
    if (G % 8 == 0 && count > 0 && total_units > 0) {
        const int rounds = (total_units + G - 1) / G, need = (total_units + rounds - 1) / rounds;
        const int cpx = (G - need) / 8, per = G / 8 - cpx;
        if (cpx > 0) { s.gp = 8 * per; s.nconv = 8 * cpx; s.conv = bid / 8 >= per; s.v = (bid % 8) * per + bid / 8; s.cidx = (bid / 8 - per) * 8 + bid % 8; }
    }
    return s;
}
__device__ __forceinline__ void side_convert(const Params& p, LAS unsigned char* lds, const LAS int* pre, int first, int count, int cc) {
    const int tid = opaque_tid(), lane = tid & 63, wave = tid >> 6, G = gridDim.x;
    const SidePlan s = side_plan(pre[NEXP] * 4, count);
    int p1 = s.nconv * cc; if (p1 > count) p1 = count;
    __syncthreads();
    LAS float* scr = (LAS float*)(lds + wave * 16640);
    if (s.conv) t_run<true>(p, first + s.cidx + s.nconv * wave, s.nconv * NWAVES, first + p1, scr, lane);
    t_run<true>(p, first + p1 + (int)blockIdx.x + G * wave, G * NWAVES, first + count, scr, lane);
    __syncthreads();
}

__device__ __forceinline__ void phase_prologue(const Params& p, LAS unsigned char* lds) {
    const int tid = opaque_tid(), lane = tid & 63, wave = tid >> 6, G = gridDim.x;
    unsigned char* ws = p.ws;
    {
        LAS float* cact = (LAS float*)lds;
        LAS float* red = (LAS float*)(lds + 16384);
        const float* c = p.in[1];
        for (int i = tid; i < 4096; i += NTHREADS) { const float v = c[i]; cact[i] = v / (1.0f + __expf(-v)); }
        __syncthreads();
        float* mod = (float*)(ws + WS_MOD);
        for (int item = blockIdx.x; item < 2 * 128; item += G) {
            const int l = item >> 7, cgp = item & 127;
            const float* W = p.in[2] + (size_t)l * 1024 * 6144 + cgp * 48;
            const int c4 = lane & 15, rr = lane >> 4; const bool act = c4 < 12;
            f32x4 wv[32];
#pragma unroll
            for (int i = 0; i < 32; ++i) wv[i] = act ? *(const f32x4*)(W + (size_t)(wave * 128 + 4 * i + rr) * 6144 + 4 * c4) : (f32x4){0.f, 0.f, 0.f, 0.f};
            f32x4 a[4];
#pragma unroll
            for (int bb = 0; bb < 4; ++bb) a[bb] = (f32x4){0.f, 0.f, 0.f, 0.f};
#pragma unroll
            for (int i = 0; i < 32; ++i) { const int k = wave * 128 + 4 * i + rr;
#pragma unroll
                for (int bb = 0; bb < 4; ++bb) a[bb] += wv[i] * cact[bb * 1024 + k]; }
#pragma unroll
            for (int bb = 0; bb < 4; ++bb)
#pragma unroll
                for (int e = 0; e < 4; ++e) { float s = a[bb][e]; s += shx(s, 16, lane); s += shx(s, 32, lane); a[bb][e] = s; }
            if (lane < 12) {
#pragma unroll
                for (int bb = 0; bb < 4; ++bb) *(LAS f32x4*)(red + (wave * 4 + bb) * 48 + 4 * c4) = a[bb];
            }
            __syncthreads();
            if (tid < 192) { const int b = tid / 48, cc = tid % 48; float s = 0.f;
#pragma unroll
                for (int w = 0; w < 8; ++w) s += red[(w * 4 + b) * 48 + cc];
                mod[(size_t)(l * 4 + b) * 6144 + cgp * 48 + cc] = s + p.in[3][l * 6144 + cgp * 48 + cc]; }
            __syncthreads();
        }
    }
}
__device__ __forceinline__ void phase_prep(const Params& p, LAS unsigned char* lds) {
    const int tid = opaque_tid(), lane = tid & 63, wave = tid >> 6, G = gridDim.x;
    unsigned char* ws = p.ws;
    const int vbC = blockIdx.x, vbE = ((int)blockIdx.x + G - (128 % G)) % G, vbD = ((int)blockIdx.x + G - (192 % G)) % G;
    {
        float* tbl = (float*)(ws + WS_TBL);
        for (int job = vbD; job < 2; job += G) {
            const int l = job;
            LAS float* sm = (LAS float*)(lds + 32768);
            float mq = 0.f, mk = 0.f, mb = 0.f;
            if (tid < 64) { mq = fabsf(p.in[9][l * 64 + tid]); mk = fabsf(p.in[10][l * 64 + tid]); }
            for (int i = tid; i < NHEAD * 257; i += NTHREADS) mb = fmaxf(mb, fabsf(p.in[11][i]));
#pragma unroll
            for (int o = 1; o < 64; o <<= 1) { mq = fmaxf(mq, shx(mq, o, lane)); mk = fmaxf(mk, shx(mk, o, lane)); mb = fmaxf(mb, shx(mb, o, lane)); }
            if (lane == 0) { sm[wave * 4 + 0] = mq; sm[wave * 4 + 1] = mk; sm[wave * 4 + 2] = mb; }
            __syncthreads();
            mq = 0.f; mk = 0.f; mb = 0.f;
            for (int w = 0; w < 8; ++w) { mq = fmaxf(mq, sm[w * 4 + 0]); mk = fmaxf(mk, sm[w * 4 + 1]); mb = fmaxf(mb, sm[w * 4 + 2]); }
            const float shift = LOG2E * (8.0f * mq * mk + mb);
            for (int i = tid; i < NHEAD * 256; i += NTHREADS) { const int h = i >> 8, j = i & 255; int rel = j - 63; if (rel > 128) rel = 128;
                tbl[(size_t)l * 2048 + i] = (j < 255) ? p.in[11][h * 257 + rel + 128] * LOG2E - shift : 0.f; }
            __syncthreads();
        }
        for (int job = vbD; job < 2 * 48; job += G) {
            const int l = job / 48, n = job % 48;
            bf16_t* hi = (bf16_t*)(ws + WS_RW) + (size_t)l * 2 * 48 * 1024;
            bf16_t* lo = hi + 48 * 1024;
            for (int k = tid; k < 1024; k += NTHREADS) {
                float w = 0.f;
                if (n < 32) w = p.in[15][((size_t)l * 1024 + k) * 32 + n]; else if (n < 36) w = p.in[13][((size_t)l * 1024 + k) * 4 + (n - 32)];
                const unsigned h2 = cvtpk(w, 0.f) & 0xffffu; const float r = w - bf_lo(h2);
                const size_t idx = ((size_t)((k >> 5) * 3 + (n >> 4)) * 64 + ((k & 31) >> 3) * 16 + (n & 15)) * 8 + (k & 7);
                hi[idx] = (bf16_t)h2; lo[idx] = (bf16_t)(cvtpk(r, 0.f) & 0xffffu);
            }
            if (tid == 0) { float bsv = 0.f; if (n < 32) bsv = p.in[16][l * 32 + n]; else if (n < 36) bsv = p.in[14][l * 4 + (n - 32)]; ((float*)(ws + WS_RWB))[l * 48 + n] = bsv; }
        }
    }
    __syncthreads();
    {
        LAS float* wsc = (LAS float*)lds;
        LAS float* pwl = (LAS float*)(lds + 32768);
        for (int item = vbC; item < 2 * 4 * 16; item += G) {
            const int l = item >> 6, g = (item >> 4) & 3, nb = item & 15;
            const float* wo = p.in[12] + ((size_t)l * 1024 + g * 128) * 1024 + nb * 64;
            const float* sc = p.in[8] + l * 512 + g * 128;
            const float* pw = p.in[7] + ((size_t)l * 4 + g) * 128 * 128;
            for (int i = tid; i < 128 * 64; i += NTHREADS) { const int d = i >> 6, n = i & 63; wsc[i] = wo[(size_t)d * 1024 + n] * sc[d]; }
            for (int i = tid; i < 128 * 128 / 4; i += NTHREADS) *(LAS f32x4*)(pwl + 4 * i) = *(const f32x4*)(pw + 4 * i);
            __syncthreads();
            const int n = tid & 63, cgp = tid >> 6;
            float a[16];
#pragma unroll
            for (int j = 0; j < 16; ++j) a[j] = 0.f;
#pragma unroll 2
            for (int d4 = 0; d4 < 32; ++d4) {
                const float w0 = wsc[(4 * d4 + 0) * 64 + n], w1 = wsc[(4 * d4 + 1) * 64 + n], w2 = wsc[(4 * d4 + 2) * 64 + n], w3 = wsc[(4 * d4 + 3) * 64 + n];
#pragma unroll
                for (int j = 0; j < 16; ++j) { const f32x4 pv = *(const LAS f32x4*)(pwl + (cgp * 16 + j) * 128 + 4 * d4); a[j] += (pv[0] * w0 + pv[1] * w1) + (pv[2] * w2 + pv[3] * w3); }
            }
            unsigned char* dst = ws + WS_WOUT + ((size_t)l * 1024 + nb * 64 + n) * 1024 + g * 128 + cgp * 16;
#pragma unroll
            for (int j = 0; j < 16; ++j) a[j] *= 256.0f;
            u32x4 o0; o0.x = pk_fp8x4(a[0], a[1], a[2], a[3]); o0.y = pk_fp8x4(a[4], a[5], a[6], a[7]); o0.z = pk_fp8x4(a[8], a[9], a[10], a[11]); o0.w = pk_fp8x4(a[12], a[13], a[14], a[15]);
            *(u32x4*)dst = o0;
            __syncthreads();
        }
    }
    {
        LAS float* scr = (LAS float*)(lds + wave * 16640);
        LAS float* wmax = (LAS float*)(lds + 8 * 16640);
        LAS float* winv = wmax + 512;
        for (int item = vbE; item < 2 * 32; item += G) {
            const int l = item >> 5, n0 = (item & 31) * 64;
            TItem d0, d1;
            d0.src = p.in[6] + (size_t)l * 1024 * 2048; d0.N = 2048; d0.f8 = 2; d0.dst = ws + WS_WIN + (size_t)l * 2048 * 1024; d0.dstK = 1024; d0.koff = 0; d0.k0 = wave * 128; d0.n0 = n0; d0.map = 1;
            d1 = d0; d1.k0 = wave * 128 + 64;
            f32x4 v0[16], v1[16];
            t_load(d0, v0, lane); t_load(d1, v1, lane);
            f32x4 cm = {0.f, 0.f, 0.f, 0.f};
#pragma unroll
            for (int i = 0; i < 16; ++i)
#pragma unroll
                for (int e = 0; e < 4; ++e) cm[e] = fmaxf(cm[e], fmaxf(fabsf(v0[i][e]), fabsf(v1[i][e])));
#pragma unroll
            for (int e = 0; e < 4; ++e) { cm[e] = fmaxf(cm[e], shx(cm[e], 16, lane)); cm[e] = fmaxf(cm[e], shx(cm[e], 32, lane)); }
            if (lane < 16) *(LAS f32x4*)(wmax + wave * 64 + 4 * lane) = cm;
            __syncthreads();
            if (tid < 64) { float m = 0.f;
#pragma unroll
                for (int w = 0; w < 8; ++w) m = fmaxf(m, wmax[w * 64 + tid]);
                winv[tid] = m > 0.f ? 127.0f / m : 0.f;
                ((float*)(ws + WS_CS))[l * 2048 + t_rowmap(1, n0 + tid)] = m * (1.0f / 127.0f); }
            __syncthreads();
            const f32x4 iv = *(const LAS f32x4*)(winv + 4 * (lane & 15));
#pragma unroll
            for (int i = 0; i < 16; ++i) { v0[i] *= iv; v1[i] *= iv; }
            t_process(d0, v0, scr, lane); t_process(d1, v1, scr, lane);
            __syncthreads();
        }
    }
}

typedef float f32x2v __attribute__((ext_vector_type(2)));
__device__ __forceinline__ f32x4 y_pair4(unsigned a, unsigned b) {
    const f32x2v a0 = __builtin_amdgcn_cvt_pk_f32_fp8((int)a, false), a1 = __builtin_amdgcn_cvt_pk_f32_fp8((int)a, true);
    const f32x2v b0 = __builtin_amdgcn_cvt_pk_f32_fp8((int)b, false), b1 = __builtin_amdgcn_cvt_pk_f32_fp8((int)b, true);
    f32x4 ys; ys[0] = (a0[0] + b0[0]) * 0.0625f; ys[1] = (a0[1] + b0[1]) * 0.0625f; ys[2] = (a1[0] + b1[0]) * 0.0625f; ys[3] = (a1[1] + b1[1]) * 0.0625f; return ys;
}
__device__ __forceinline__ void bf8_to_f32(const u32x4& w, f32x4& lo, f32x4& hi) { lo = (f32x4){bf_lo(w.x), bf_hi(w.x), bf_lo(w.y), bf_hi(w.y)}; hi = (f32x4){bf_lo(w.z), bf_hi(w.z), bf_lo(w.w), bf_hi(w.w)}; }
template <int NR, bool UPD> struct N1Raw { f32x4 xf[UPD ? 1 : NR][4]; u32x4 xw[UPD ? NR : 1][2], ya[UPD ? NR : 1], yb[UPD ? NR : 1]; };
template <int NR, bool UPD>
__device__ __forceinline__ void n1_load(const Params& p, N1Raw<NR, UPD>& R, int row0, int lane) {
    const int c0 = 16 * lane;
    if (!UPD) {
#pragma unroll
        for (int r = 0; r < NR; ++r)
#pragma unroll
            for (int j = 0; j < 4; ++j) R.xf[r][j] = *(const f32x4*)(p.in[0] + (size_t)(row0 + r) * DM + 256 * j + 4 * lane);
    } else {
        const unsigned char* Y = (const unsigned char*)(p.ws + WS_Y);
        const bf16_t* XB = (const bf16_t*)(p.ws + WS_XB);
#pragma unroll
        for (int r = 0; r < NR; ++r) {
            R.xw[r][0] = *(const u32x4*)(XB + (size_t)(row0 + r) * DM + c0); R.xw[r][1] = *(const u32x4*)(XB + (size_t)(row0 + r) * DM + c0 + 8);
            R.ya[r] = *(const u32x4*)(Y + (size_t)(2 * (row0 + r)) * DM + c0); R.yb[r] = *(const u32x4*)(Y + (size_t)(2 * (row0 + r) + 1) * DM + c0);
        }
    }
}
template <int NR, bool UPD>
__device__ __forceinline__ void n1_process(const Params& p, const N1Raw<NR, UPD>& R, int l, int row0, int lane) {
    const float* mod = (const float*)(p.ws + WS_MOD);
    const float* gn = p.in[4] + l * 1024;
    unsigned char* H8 = p.ws + WS_BUF;
    bf16_t* XB = (bf16_t*)(p.ws + WS_XB);
    const int b = row0 >> 13, c0 = 16 * lane;
    f32x4 v[NR][4];
    if (!UPD) {
#pragma unroll
        for (int r = 0; r < NR; ++r)
#pragma unroll
            for (int j = 0; j < 4; ++j) v[r][j] = R.xf[r][j];
    } else {
        const float* g2 = mod + (size_t)((l - 1) * 4 + b) * 6144 + 5120;
        f32x4 gg[4];
#pragma unroll
        for (int j = 0; j < 4; ++j) gg[j] = *(const f32x4*)(g2 + c0 + 4 * j);
#pragma unroll
        for (int r = 0; r < NR; ++r) {
            bf8_to_f32(R.xw[r][0], v[r][0], v[r][1]); bf8_to_f32(R.xw[r][1], v[r][2], v[r][3]);
            u32x4 o[2];
#pragma unroll
            for (int j = 0; j < 4; ++j) {
                const f32x4 xn = v[r][j] + gg[j] * y_pair4(R.ya[r][j], R.yb[r][j]);
                const unsigned w0 = cvtpk(xn[0], xn[1]), w1 = cvtpk(xn[2], xn[3]);
                if (j & 1) { o[j >> 1].z = w0; o[j >> 1].w = w1; } else { o[j >> 1].x = w0; o[j >> 1].y = w1; }
                v[r][j] = (f32x4){bf_lo(w0), bf_hi(w0), bf_lo(w1), bf_hi(w1)};
            }
            *(u32x4*)(XB + (size_t)(row0 + r) * DM + c0) = o[0]; *(u32x4*)(XB + (size_t)(row0 + r) * DM + c0 + 8) = o[1];
        }
    }
    float ss[NR];
#pragma unroll
    for (int r = 0; r < NR; ++r) { ss[r] = 0.f;
#pragma unroll
        for (int j = 0; j < 4; ++j) ss[r] += (v[r][j][0] * v[r][j][0] + v[r][j][1] * v[r][j][1]) + (v[r][j][2] * v[r][j][2] + v[r][j][3] * v[r][j][3]); }
#pragma unroll
    for (int o = 1; o < 64; o <<= 1)
#pragma unroll
        for (int r = 0; r < NR; ++r) ss[r] += shx(ss[r], o, lane);
    const float* sh = mod + (size_t)(l * 4 + b) * 6144; const float* sc = sh + 1024;
    float rstd[NR], mx[NR];
#pragma unroll
    for (int r = 0; r < NR; ++r) { rstd[r] = rsqrtf(ss[r] * (1.0f / DM) + EPS); mx[r] = 0.f; }
#pragma unroll
    for (int j = 0; j < 4; ++j) {
        const int c = UPD ? c0 + 4 * j : 256 * j + 4 * lane;
        const f32x4 g = *(const f32x4*)(gn + c), s1 = *(const f32x4*)(sc + c), s0 = *(const f32x4*)(sh + c);
        const f32x4 a = g * (s1 + 1.0f);
#pragma unroll
        for (int r = 0; r < NR; ++r) {
            const f32x4 h = v[r][j] * rstd[r] * a + s0;
            v[r][j] = h;
            mx[r] = fmaxf(mx[r], fmaxf(fmaxf(fabsf(h[0]), fabsf(h[1])), fmaxf(fabsf(h[2]), fabsf(h[3]))));
        }
    }
#pragma unroll
    for (int o = 1; o < 64; o <<= 1)
#pragma unroll
        for (int r = 0; r < NR; ++r) mx[r] = fmaxf(mx[r], shx(mx[r], o, lane));
    float* RS = (float*)(p.ws + WS_RS);
#pragma unroll
    for (int r = 0; r < NR; ++r) {
        const float inv = mx[r] > 0.f ? 127.0f / mx[r] : 0.f;
        if (lane == 0) RS[row0 + r] = mx[r] * (1.0f / 127.0f);
        u32x4 q8;
        { const f32x4 q = v[r][0] * inv; q8.x = pk_i8x4(q[0], q[1], q[2], q[3]); } { const f32x4 q = v[r][1] * inv; q8.y = pk_i8x4(q[0], q[1], q[2], q[3]); }
        { const f32x4 q = v[r][2] * inv; q8.z = pk_i8x4(q[0], q[1], q[2], q[3]); } { const f32x4 q = v[r][3] * inv; q8.w = pk_i8x4(q[0], q[1], q[2], q[3]); }
        if (UPD) *(u32x4*)(H8 + (size_t)(row0 + r) * DM + c0) = q8;
        else { unsigned char* hp = H8 + (size_t)(row0 + r) * DM + 4 * lane; *(unsigned*)hp = q8.x; *(unsigned*)(hp + 256) = q8.y; *(unsigned*)(hp + 512) = q8.z; *(unsigned*)(hp + 768) = q8.w; }
    }
}
template <int NR, bool UPD>
__device__ __forceinline__ void n1_run(const Params& p, int l, int gw, int NGW, int lane) {
    constexpr int N = NTOK / NR;
    int rq = gw; if (rq >= N) return;
    N1Raw<NR, UPD> A, B;
    n1_load<NR, UPD>(p, A, rq * NR, lane);
    for (;;) {
        const int nx = rq + NGW; const bool hb = nx < N;
        if (hb) n1_load<NR, UPD>(p, B, nx * NR, lane);
        n1_process<NR, UPD>(p, A, l, rq * NR, lane);
        if (!hb) break;
        rq = nx + NGW; const bool ha = rq < N;
        if (ha) n1_load<NR, UPD>(p, A, rq * NR, lane);
        n1_process<NR, UPD>(p, B, l, nx * NR, lane);
        if (!ha) break;
    }
}
__device__ __forceinline__ void phase_norm1(const Params& p, int l) {
    const int tid = opaque_tid(), lane = tid & 63, wave = tid >> 6, G = gridDim.x;
    const int gw = blockIdx.x * NWAVES + wave, NGW = G * NWAVES;
    n1_run<2, true>(p, l, gw, NGW, lane);
}
struct FinRaw { u32x4 xw[4][2], ya[4], yb[4]; };
__device__ __forceinline__ void fin_load(const Params& p, FinRaw& R, int row0, int lane) {
    const unsigned char* Y = (const unsigned char*)(p.ws + WS_Y);
    const bf16_t* XB = (const bf16_t*)(p.ws + WS_XB);
    const int c0 = 16 * lane;
#pragma unroll
    for (int r = 0; r < 4; ++r) {
        R.xw[r][0] = *(const u32x4*)(XB + (size_t)(row0 + r) * DM + c0); R.xw[r][1] = *(const u32x4*)(XB + (size_t)(row0 + r) * DM + c0 + 8);
        R.ya[r] = *(const u32x4*)(Y + (size_t)(2 * (row0 + r)) * DM + c0); R.yb[r] = *(const u32x4*)(Y + (size_t)(2 * (row0 + r) + 1) * DM + c0);
    }
}
__device__ __forceinline__ void fin_process(const Params& p, const FinRaw& R, int row0, int lane, LAS float* scr) {
    const float* mod = (const float*)(p.ws + WS_MOD);
    const int b = row0 >> 13, c0 = 16 * lane;
    const float* g2 = mod + (size_t)((DEPTH - 1) * 4 + b) * 6144 + 5120;
    f32x4 gg[4];
#pragma unroll
    for (int j = 0; j < 4; ++j) gg[j] = *(const f32x4*)(g2 + c0 + 4 * j);
#pragma unroll
    for (int r = 0; r < 4; ++r) {
        f32x4 v[4];
        bf8_to_f32(R.xw[r][0], v[0], v[1]); bf8_to_f32(R.xw[r][1], v[2], v[3]);
#pragma unroll
        for (int j = 0; j < 4; ++j) *(LAS f32x4*)(scr + r * 1024 + c0 + 4 * j) = v[j] + gg[j] * y_pair4(R.ya[r][j], R.yb[r][j]);
    }
    asm volatile("s_waitcnt lgkmcnt(0)" ::: "memory");
#pragma unroll
    for (int r = 0; r < 4; ++r)
#pragma unroll
        for (int s = 0; s < 4; ++s) *(f32x4*)(p.out + (size_t)(row0 + r) * DM + 256 * s + 4 * lane) = *(const LAS f32x4*)(scr + r * 1024 + 256 * s + 4 * lane);
    asm volatile("s_waitcnt lgkmcnt(0)" ::: "memory");
}
__device__ __forceinline__ void phase_final(const Params& p, LAS unsigned char* lds) {
    const int tid = opaque_tid(), lane = tid & 63, wave = tid >> 6, G = gridDim.x;
    const int gw = blockIdx.x * NWAVES + wave, NGW = G * NWAVES;
    constexpr int N = NTOK / 4;
    int rq = gw; if (rq >= N) return;
    FinRaw A, B;
    LAS float* scr = (LAS float*)(lds + wave * 16384);
    fin_load(p, A, rq * 4, lane);
    for (;;) {
        const int nx = rq + NGW; const bool hb = nx < N;
        if (hb) fin_load(p, B, nx * 4, lane);
        fin_process(p, A, rq * 4, lane, scr);
        if (!hb) break;
        rq = nx + NGW; const bool ha = rq < N;
        if (ha) fin_load(p, A, rq * 4, lane);
        fin_process(p, B, nx * 4, lane, scr);
        if (!ha) break;
    }
}

__device__ __forceinline__ int crow(int r, int hi) { return (r & 3) + 8 * (r >> 2) + 4 * hi; }

__device__ __forceinline__ void acc8(float (&S)[8], const u32x4& w, float sg) {
    S[0] += sg * bf_lo(w.x); S[1] += sg * bf_hi(w.x); S[2] += sg * bf_lo(w.y); S[3] += sg * bf_hi(w.y); S[4] += sg * bf_lo(w.z); S[5] += sg * bf_hi(w.z); S[6] += sg * bf_lo(w.w); S[7] += sg * bf_hi(w.w);
}
__device__ __forceinline__ void pool_strip(const Params& p, int strip, int lane) {
    const bf16_t* U = (const bf16_t*)(p.ws + WS_U); unsigned char* MIX = p.ws + WS_BUF;
    const int tok0 = strip * 16, s0 = tok0 & (SEQ - 1);
    const int g = lane >> 4, win = 2 << g;
    u32x4 w[31];
#pragma unroll
    for (int d = 0; d < 31; ++d) { w[d] = (u32x4){0u, 0u, 0u, 0u}; if (d >= 15 || s0 > 0) w[d] = *(const u32x4*)(U + (size_t)(tok0 - 15 + d) * 512 + lane * 8); }
    float S[8];
#pragma unroll
    for (int j = 0; j < 8; ++j) S[j] = 0.f;
#pragma unroll
    for (int k = 1; k < 16; ++k) acc8(S, w[15 - k], (k < win) ? 1.0f : 0.0f);
#pragma unroll
    for (int i = 0; i < 16; ++i) {
        const int s = s0 + i;
        const u32x4 x = w[15 + i];
        float uv[8] = {bf_lo(x.x), bf_hi(x.x), bf_lo(x.y), bf_hi(x.y), bf_lo(x.z), bf_hi(x.z), bf_lo(x.w), bf_hi(x.w)};
#pragma unroll
        for (int j = 0; j < 8; ++j) S[j] += uv[j];
        const int cn = (s + 1 < win) ? s + 1 : win;
        const float inv = 1.0f / (float)cn;
        float o[8];
#pragma unroll
        for (int j = 0; j < 8; ++j) o[j] = clamp8((S[j] * inv - uv[j]) * 16.0f);
        u32x2 ow; ow.x = pk_fp8x4(o[0], o[1], o[2], o[3]); ow.y = pk_fp8x4(o[4], o[5], o[6], o[7]);
        *(u32x2*)(MIX + (size_t)(tok0 + i) * DM + lane * 8) = ow;
        const u32x4 l0 = w[15 + i - 1], l1 = (i + 12 >= 0) ? w[15 + i - 3 < 0 ? 0 : 15 + i - 3] : l0, l2 = w[15 + i - 7 < 0 ? 0 : 15 + i - 7], l3 = w[15 + i - 15 < 0 ? 0 : 15 + i - 15];
        u32x4 lv;
        lv.x = g == 0 ? l0.x : g == 1 ? l1.x : g == 2 ? l2.x : l3.x; lv.y = g == 0 ? l0.y : g == 1 ? l1.y : g == 2 ? l2.y : l3.y;
        lv.z = g == 0 ? l0.z : g == 1 ? l1.z : g == 2 ? l2.z : l3.z; lv.w = g == 0 ? l0.w : g == 1 ? l1.w : g == 2 ? l2.w : l3.w;
        acc8(S, lv, -1.0f);
    }
}

__device__ __forceinline__ void attn_prefetch(const Params& p, int nu, int lane, bf16x8 (&qr)[4], bf16x8 (&kk)[8]) {
    const char* Qf = (const char*)(p.ws + WS_Q); const char* Kf = (const char*)(p.ws + WS_K);
    const int nch = (nu >> 1) & 127, nqh = nu & 1; const size_t nbh = (size_t)(nu >> 8) * 256; const int nt0 = nch < 8 ? 8 - nch : 0;
#pragma unroll
    for (int d0 = 0; d0 < 4; ++d0) qr[d0] = *(const bf16x8*)(Qf + (((nbh + nch * 2 + nqh) * 4 + d0) * 64 + lane) * 16);
    const char* pa = Kf + (nbh * 4 * 64 + lane) * 16 + (ptrdiff_t)(nch - 8 + nt0) * 8192; const char* pb = pa + 4096;
#pragma unroll
    for (int i = 0; i < 4; ++i) { kk[i] = *(const bf16x8*)(pa + i * 1024); kk[4 + i] = *(const bf16x8*)(pb + i * 1024); }
}
__device__ __forceinline__ void attn_unit(const Params& p, int b, int h, int ch, int qh, int lane, const LAS float* tbl, LAS unsigned char* stg,
                                          bf16x8 (&qr)[4], bf16x8 (&kk)[8], int nu) {
    const int r32 = lane & 31, hi = lane >> 5;
    const char* Qf = (const char*)(p.ws + WS_Q); const char* Kf = (const char*)(p.ws + WS_K); const char* Vf = (const char*)(p.ws + WS_V);
    unsigned char* MIX = p.ws + WS_BUF;
    const size_t bh = (size_t)(b * NHEAD + h) * 256;
    f32x16 o0 = {}, o1 = {};
    float lsum = 0.f;
    const LAS float* th = tbl + h * 256;
    f32x16 cfv; { const float cfar = th[254];
#pragma unroll
        for (int r = 0; r < 16; ++r) cfv[r] = cfar; }
    const int t0 = ch < 8 ? 8 - ch : 0;
    const char* kp = Kf + (bh * 4 * 64 + lane) * 16 + (ptrdiff_t)(ch - 8 + t0) * 8192;
    const char* vp = Vf + (bh * 4 * 64 + lane) * 16 + (ptrdiff_t)(ch - 8 + t0) * 8192;
#define ATT_LD8(dst, ptr) do { const char* pa_ = (ptr); const char* pb_ = pa_ + 4096; _Pragma("unroll") for (int i_ = 0; i_ < 4; ++i_) { dst[i_] = *(const bf16x8*)(pa_ + i_ * 1024); dst[4 + i_] = *(const bf16x8*)(pb_ + i_ * 1024); } } while (0)
#define ATT_REST(P0, P1) do { \
        float sacc_ = 0.f; \
        _Pragma("unroll") for (int r = 0; r < 16; ++r) { P0[r] = fast_exp2(P0[r]); P1[r] = fast_exp2(P1[r]); sacc_ += P0[r] + P1[r]; } \
        lsum += sacc_; \
        u32x4 pa_[4]; \
        _Pragma("unroll") for (int s = 0; s < 2; ++s) { \
            pa_[s].x = cvtpk(P0[8 * s + 0], P0[8 * s + 1]); pa_[s].y = cvtpk(P0[8 * s + 2], P0[8 * s + 3]); pa_[s].z = cvtpk(P0[8 * s + 4], P0[8 * s + 5]); pa_[s].w = cvtpk(P0[8 * s + 6], P0[8 * s + 7]); \
            pa_[2 + s].x = cvtpk(P1[8 * s + 0], P1[8 * s + 1]); pa_[2 + s].y = cvtpk(P1[8 * s + 2], P1[8 * s + 3]); pa_[2 + s].z = cvtpk(P1[8 * s + 4], P1[8 * s + 5]); pa_[2 + s].w = cvtpk(P1[8 * s + 6], P1[8 * s + 7]); } \
        _Pragma("unroll") for (int i = 0; i < 4; ++i) { const bf16x8 pf_ = __builtin_bit_cast(bf16x8, pa_[i]); \
            o0 = __builtin_amdgcn_mfma_f32_32x32x16_bf16(pf_, vv[2 * i], o0, 0, 0, 0); o1 = __builtin_amdgcn_mfma_f32_32x32x16_bf16(pf_, vv[2 * i + 1], o1, 0, 0, 0); } \
    } while (0)
    int t = t0;
#pragma unroll 1
    for (; t <= 5; ++t) {
        bf16x8 vv[8]; ATT_LD8(vv, vp); vp += 8192;
        f32x16 p0 = __builtin_amdgcn_mfma_f32_32x32x16_bf16(kk[0], qr[0], cfv, 0, 0, 0);
        f32x16 p1 = __builtin_amdgcn_mfma_f32_32x32x16_bf16(kk[4], qr[0], cfv, 0, 0, 0);
#pragma unroll
        for (int d0 = 1; d0 < 4; ++d0) { p0 = __builtin_amdgcn_mfma_f32_32x32x16_bf16(kk[d0], qr[d0], p0, 0, 0, 0); p1 = __builtin_amdgcn_mfma_f32_32x32x16_bf16(kk[4 + d0], qr[d0], p1, 0, 0, 0); }
        kp += 8192; ATT_LD8(kk, kp);
        ATT_REST(p0, p1);
    }
#pragma unroll 1
    for (; t <= 8; ++t) {
        bf16x8 vv[8]; ATT_LD8(vv, vp); vp += 8192;
        f32x16 p0, p1;
        { const int base_ = 64 * (8 - t) + 32 * qh + r32 + 63 - 4 * hi;
#pragma unroll
          for (int r = 0; r < 16; ++r) { const int kj = (r & 3) + 8 * (r >> 2); p0[r] = th[base_ - kj]; p1[r] = th[base_ - kj - 32]; } }
#pragma unroll
        for (int d0 = 0; d0 < 4; ++d0) { p0 = __builtin_amdgcn_mfma_f32_32x32x16_bf16(kk[d0], qr[d0], p0, 0, 0, 0); p1 = __builtin_amdgcn_mfma_f32_32x32x16_bf16(kk[4 + d0], qr[d0], p1, 0, 0, 0); }
        if (t < 8) { kp += 8192; ATT_LD8(kk, kp); }
        else if (nu >= 0) attn_prefetch(p, nu, lane, qr, kk);
        ATT_REST(p0, p1);
    }
#undef ATT_LD8
#undef ATT_REST
    lsum += shx(lsum, 32, lane);
    const float linv = 1.0f / lsum;
#pragma unroll
    for (int r = 0; r < 16; ++r) {
        const int q = crow(r, hi);
        const float li = __int_as_float(__builtin_amdgcn_ds_bpermute(q << 2, __float_as_int(linv))) * 16.0f;
        const unsigned w = pk_fp8x4(clamp8(o0[r] * li), clamp8(o1[r] * li), 0.f, 0.f);
        stg[q * 80 + r32] = (unsigned char)(w & 0xffu);
        stg[q * 80 + 32 + r32] = (unsigned char)((w >> 8) & 0xffu);
    }
    asm volatile("s_waitcnt lgkmcnt(0)" ::: "memory");
    unsigned char* orow = MIX + ((size_t)b * SEQ + ch * 64 + qh * 32 + (lane >> 2)) * DM + 512 + h * 64 + (lane & 3) * 16;
    const LAS unsigned char* srow = stg + (lane >> 2) * 80 + (lane & 3) * 16;
#pragma unroll
    for (int i = 0; i < 2; ++i) *(u32x4*)(orow + (size_t)i * 16 * DM) = *(const LAS u32x4*)(srow + i * 16 * 80);
    asm volatile("s_waitcnt lgkmcnt(0)" ::: "memory");
}

__device__ __forceinline__ void phase_mixer(const Params& p, int l, LAS unsigned char* lds) {
    const int tid = opaque_tid(), lane = tid & 63, wave = tid >> 6, G = gridDim.x;
    LAS float* tbl = (LAS float*)(lds + LDS_TBL);
    const int gw = blockIdx.x * NWAVES + wave, NGW = G * NWAVES;
    LAS unsigned char* stg = lds + 8192 + wave * 4608;
    for (int it = gw; it < NTOK / 16; it += NGW) pool_strip(p, it, lane);
    bf16x8 qr[4], kk[8];
    if (G % 8 == 0) {
        const int x = (int)blockIdx.x & 7, lw = ((int)blockIdx.x >> 3) * NWAVES + wave, nlw = (G >> 3) * NWAVES;
        int pr = x, u = lw;
        if (pr < BATCH * NHEAD && u < 256) attn_prefetch(p, pr * 256 + u, lane, qr, kk);
        while (pr < BATCH * NHEAD && u < 256) {
            const int cpr = pr, cu = u;
            u += nlw; if (u >= 256) { u = lw; pr += 8; }
            attn_unit(p, cpr >> 3, cpr & 7, cu >> 1, cu & 1, lane, tbl, stg, qr, kk, pr < BATCH * NHEAD ? pr * 256 + u : -1);
        }
    } else {
        if (gw < BATCH * NHEAD * 256) attn_prefetch(p, gw, lane, qr, kk);
        for (int wu = gw; wu < BATCH * NHEAD * 256; wu += NGW) {
            const int nw = wu + NGW;
            attn_unit(p, wu >> 11, (wu >> 8) & 7, (wu >> 1) & 127, wu & 1, lane, tbl, stg, qr, kk, nw < BATCH * NHEAD * 256 ? nw : -1);
        }
    }
}

__device__ __forceinline__ void phase_route(const Params& p, int l, LAS unsigned char* lds) {
    const int tid = opaque_tid(), lane = tid & 63, wave = __builtin_amdgcn_readfirstlane(tid >> 6), G = gridDim.x;
    LAS float* a2c = (LAS float*)(lds + 98304);
    LAS float* shc = (LAS float*)(lds + 98304 + 4096);
    LAS float* lg = (LAS float*)(lds + 106496) + wave * (16 * 48);
    LAS int* lcnt = (LAS int*)(lds + 131072);
    LAS int* gbase = (LAS int*)(lds + 131072 + 128);
    LAS int* tmp_e = (LAS int*)(lds + 131072 + 256);
    LAS int* tmp_r = (LAS int*)(lds + 131072 + 256 + 1024);
    LAS float* tmp_w = (LAS float*)(lds + 131072 + 256 + 2048);
    const float* mod = (const float*)(p.ws + WS_MOD);
    const float* gn = p.in[5] + l * 1024;
    unsigned char* H8 = p.ws + WS_BUF;
    const char* RW = (const char*)(p.ws + WS_RW) + (size_t)l * 2 * 48 * 1024 * 2;
    const float* rwb = (const float*)(p.ws + WS_RWB) + l * 48;
    const float* ssq = (const float*)(p.ws + WS_SSQ);
    int* gcnt = (int*)(p.ws + WS_CTL) + l * 32;
    u32x2* list = (u32x2*)(p.ws + WS_LIST2);
    const int r = lane & 15, kg = lane >> 4;
    for (int it = blockIdx.x; it < NTOK / 128; it += G) {
        const int row0 = it * 128 + wave * 16, row = row0 + r, b = (it * 128) >> 13;
        const bf16_t* xr = (const bf16_t*)(p.ws + WS_XB) + (size_t)row * DM + 8 * kg;
        float ss; { const float* sq = ssq + (size_t)(4 * kg) * NTOK + row; ss = (sq[0] + sq[NTOK]) + (sq[2 * (size_t)NTOK] + sq[3 * (size_t)NTOK]); }
        ss += shx(ss, 16, lane); ss += shx(ss, 32, lane);
        const float rstd = rsqrtf(ss * (1.0f / DM) + EPS);
        const float* sh = mod + (size_t)(l * 4 + b) * 6144 + 3072; const float* sc = sh + 1024;
        f32x4 acc[3];
#pragma unroll
        for (int nb = 0; nb < 3; ++nb) acc[nb] = (f32x4){0.f, 0.f, 0.f, 0.f};
        u32x4 xsb[2][8];
#pragma unroll
        for (int i = 0; i < 8; ++i) xsb[0][i] = *(const u32x4*)(xr + 32 * i);
#define RT_STAGE(c) do { LAS unsigned char* rb_ = lds + ((c) & 1) * 49152; \
            _Pragma("unroll") for (int i_ = 0; i_ < 6; ++i_) { const int q_ = wave * 6 + i_; const char* src_ = RW + (q_ < 24 ? (size_t)((c) * 24 + q_) * 1024 : (size_t)98304 + (size_t)((c) * 24 + q_ - 24) * 1024); \
                __builtin_amdgcn_global_load_lds((const unsigned*)(src_ + lane * 16), (LAS unsigned*)(rb_ + q_ * 1024), 16, 0, 0); } } while (0)
        __syncthreads();
        if (tid < 32) lcnt[tid] = 0;
        { const f32x2_t g2 = *(const f32x2_t*)(gn + 2 * tid), c2 = *(const f32x2_t*)(sc + 2 * tid), s2 = *(const f32x2_t*)(sh + 2 * tid);
          a2c[2 * tid] = g2[0] * (1.0f + c2[0]); a2c[2 * tid + 1] = g2[1] * (1.0f + c2[1]); shc[2 * tid] = s2[0]; shc[2 * tid + 1] = s2[1]; }
        RT_STAGE(0);
#pragma unroll
        for (int c = 0; c < 4; ++c) {
            asm volatile("s_waitcnt vmcnt(0) lgkmcnt(0)" : "+v"(xsb[c & 1][0]), "+v"(xsb[c & 1][1]), "+v"(xsb[c & 1][2]), "+v"(xsb[c & 1][3]), "+v"(xsb[c & 1][4]), "+v"(xsb[c & 1][5]), "+v"(xsb[c & 1][6]), "+v"(xsb[c & 1][7]) :: "memory");
            __builtin_amdgcn_s_barrier();
            if (c < 3) {
                RT_STAGE(c + 1);
#pragma unroll
                for (int i = 0; i < 8; ++i) xsb[(c + 1) & 1][i] = *(const u32x4*)(xr + 256 * (c + 1) + 32 * i);
            }
            const LAS unsigned char* rb = lds + (c & 1) * 49152;
            const u32x4 (&xs)[8] = xsb[c & 1];
#pragma unroll
            for (int i = 0; i < 8; ++i) {
                float hv[8];
#pragma unroll
                for (int q = 0; q < 2; ++q) {
                    const f32x4 a = *(const LAS f32x4*)(a2c + 256 * c + 32 * i + 8 * kg + 4 * q), s0 = *(const LAS f32x4*)(shc + 256 * c + 32 * i + 8 * kg + 4 * q);
                    const f32x4 xv = q == 0 ? (f32x4){bf_lo(xs[i].x), bf_hi(xs[i].x), bf_lo(xs[i].y), bf_hi(xs[i].y)} : (f32x4){bf_lo(xs[i].z), bf_hi(xs[i].z), bf_lo(xs[i].w), bf_hi(xs[i].w)};
                    const f32x4 hh = xv * rstd * a + s0;
                    hv[4 * q + 0] = hh[0]; hv[4 * q + 1] = hh[1]; hv[4 * q + 2] = hh[2]; hv[4 * q + 3] = hh[3];
                }
                u32x4 hp; hp.x = cvtpk(hv[0], hv[1]); hp.y = cvtpk(hv[2], hv[3]); hp.z = cvtpk(hv[4], hv[5]); hp.w = cvtpk(hv[6], hv[7]);
                { u32x2 h8; h8.x = pk_fp8x4(clamp8(hv[0] * 8.0f), clamp8(hv[1] * 8.0f), clamp8(hv[2] * 8.0f), clamp8(hv[3] * 8.0f)); h8.y = pk_fp8x4(clamp8(hv[4] * 8.0f), clamp8(hv[5] * 8.0f), clamp8(hv[6] * 8.0f), clamp8(hv[7] * 8.0f));
                  *(u32x2*)(H8 + (size_t)row * DM + 256 * c + 32 * i + 8 * kg) = h8; }
                u32x4 lp;
                lp.x = cvtpk(hv[0] - bf_lo(hp.x), hv[1] - bf_hi(hp.x)); lp.y = cvtpk(hv[2] - bf_lo(hp.y), hv[3] - bf_hi(hp.y));
                lp.z = cvtpk(hv[4] - bf_lo(hp.z), hv[5] - bf_hi(hp.z)); lp.w = cvtpk(hv[6] - bf_lo(hp.w), hv[7] - bf_hi(hp.w));
                const bf16x8 xhi = __builtin_bit_cast(bf16x8, hp), xlo = __builtin_bit_cast(bf16x8, lp);
#pragma unroll
                for (int nb = 0; nb < 3; ++nb) {
                    const bf16x8 whi = *(const LAS bf16x8*)(rb + (i * 3 + nb) * 1024 + lane * 16);
                    const bf16x8 wlo = *(const LAS bf16x8*)(rb + 24576 + (i * 3 + nb) * 1024 + lane * 16);
                    acc[nb] = __builtin_amdgcn_mfma_f32_16x16x32_bf16(whi, xhi, acc[nb], 0, 0, 0);
                    acc[nb] = __builtin_amdgcn_mfma_f32_16x16x32_bf16(whi, xlo, acc[nb], 0, 0, 0);
                    acc[nb] = __builtin_amdgcn_mfma_f32_16x16x32_bf16(wlo, xhi, acc[nb], 0, 0, 0);
                }
            }
        }
#undef RT_STAGE
#pragma unroll
        for (int nb = 0; nb < 3; ++nb)
#pragma unroll
            for (int q = 0; q < 4; ++q) lg[r * 48 + 16 * nb + 4 * kg + q] = acc[nb][q];
        asm volatile("s_waitcnt lgkmcnt(0)" ::: "memory");
        if (lane < 16) {
            const LAS float* my = lg + lane * 48;
            float gl[4]; int gi = 0; float gm;
#pragma unroll
            for (int i = 0; i < 4; ++i) gl[i] = my[32 + i] + rwb[32 + i];
            gm = gl[0];
#pragma unroll
            for (int i = 1; i < 4; ++i) if (gl[i] > gm) { gm = gl[i]; gi = i; }
            float den = 0.f;
#pragma unroll
            for (int i = 0; i < 4; ++i) den += __expf(gl[i] - gm);
            const float gpv = 1.0f / den;
            float el[8];
#pragma unroll
            for (int i = 0; i < 8; ++i) el[i] = my[8 * gi + i] + rwb[8 * gi + i];
            int i0 = 0; float v0 = el[0];
#pragma unroll
            for (int i = 1; i < 8; ++i) if (el[i] > v0) { v0 = el[i]; i0 = i; }
            int i1 = -1; float v1 = -3.0e38f;
#pragma unroll
            for (int i = 0; i < 8; ++i) if (i != i0 && el[i] > v1) { v1 = el[i]; i1 = i; }
            const float dd = __expf(v1 - v0);
            const float w0 = gpv / (1.0f + dd), w1 = gpv * dd / (1.0f + dd);
            const int e0 = 8 * gi + i0, e1 = 8 * gi + i1;
            const int tok = row0 + lane, lt = wave * 16 + lane;
            tmp_w[2 * lt] = w0; tmp_w[2 * lt + 1] = w1;
            tmp_e[2 * lt] = e0; tmp_e[2 * lt + 1] = e1;
            tmp_r[2 * lt] = __hip_atomic_fetch_add(lcnt + e0, 1, __ATOMIC_RELAXED, __HIP_MEMORY_SCOPE_WORKGROUP);
            tmp_r[2 * lt + 1] = __hip_atomic_fetch_add(lcnt + e1, 1, __ATOMIC_RELAXED, __HIP_MEMORY_SCOPE_WORKGROUP);
        }
        __syncthreads();
        if (tid < 32) gbase[tid] = __hip_atomic_fetch_add(gcnt + tid, lcnt[tid], __ATOMIC_RELAXED, __HIP_MEMORY_SCOPE_AGENT);
        __syncthreads();
        if (tid < 256) { const int e = tmp_e[tid]; u32x2 en; en.x = (unsigned)(it * 256 + tid); en.y = __float_as_uint(tmp_w[tid]); list[(size_t)e * NTOK + gbase[e] + tmp_r[tid]] = en; }
    }
    __syncthreads();
}

#define XB_TMO      128
#define XB_XCNT(j)  (256  + 64 * (j))
#define XB_XSUB(j)  (1280 + 64 * (j))
#define XB_XGEN(j)  (2304 + 64 * (j))
#define XB_TOP      3328
#define XB_TOPGEN   3392
#define XCD_BAR_WORDS 3456
#define XB_SPIN_CAP (1u << 18)
__device__ __forceinline__ unsigned xb_ld(unsigned* p)              { return __hip_atomic_load(p, __ATOMIC_RELAXED, __HIP_MEMORY_SCOPE_AGENT); }
__device__ __forceinline__ unsigned xb_add(unsigned* p, unsigned v) { return __hip_atomic_fetch_add(p, v, __ATOMIC_RELAXED, __HIP_MEMORY_SCOPE_AGENT); }
__device__ __forceinline__ unsigned xb_xcc_id() { return (unsigned)__builtin_amdgcn_s_getreg((3 << 11) | 20) & 0xFu; }
#define XB_SPIN(cond, bar) do { unsigned _sp = 0; while (cond) { __builtin_amdgcn_s_sleep(1); \
    if ((++_sp & 255u) == 0u) { if (xb_ld(&(bar)[XB_TMO])) break; if (_sp > XB_SPIN_CAP) { atomicAdd(&(bar)[XB_TMO], 1u); break; } } } } while (0)
struct XcdBarrier { unsigned* bar; unsigned x; volatile LAS unsigned* st; };
__device__ __forceinline__ XcdBarrier xcd_barrier_post(unsigned* bar, volatile LAS unsigned* st) {
    XcdBarrier b; b.bar = bar; b.x = xb_xcc_id(); b.st = st;
    if (opaque_tid() == 0) (void)xb_add(&bar[XB_XCNT(b.x)], 1u);
    return b;
}
__device__ __forceinline__ void xcd_barrier_complete(unsigned* bar, unsigned x, unsigned& nloc, unsigned& nx) {
    const unsigned G = gridDim.x * gridDim.y * gridDim.z;
    unsigned sum, cnt, mine, sp = 0u;
    for (;;) {
        sum = 0u; cnt = 0u; mine = 0u;
#pragma unroll
        for (unsigned j = 0; j < 16; ++j) { const unsigned c = xb_ld(&bar[XB_XCNT(j)]); sum += c; cnt += (c > 0u) ? 1u : 0u; mine = (j == x) ? c : mine; }
        if (sum == G) break;
        __builtin_amdgcn_s_sleep(1);
        if ((++sp & 255u) == 0u) { if (xb_ld(&bar[XB_TMO])) break; if (sp > XB_SPIN_CAP) { atomicAdd(&bar[XB_TMO], 1u); break; } }
    }
    nloc = mine > 0u ? mine : 1u; nx = cnt > 0u ? cnt : 1u;
}
__device__ __forceinline__ void xcd_barrier(const XcdBarrier& b) {
    asm volatile("s_waitcnt vmcnt(0)" ::: "memory");
    __syncthreads();
    if (opaque_tid() == 0) {
        unsigned* bar = b.bar;
        __builtin_amdgcn_s_waitcnt(0);
        unsigned nloc = b.st[0], nx = b.st[1];
        if (nloc == 0u) { xcd_barrier_complete(bar, b.x, nloc, nx); b.st[0] = nloc; b.st[1] = nx; }
        const unsigned old = xb_add(&bar[XB_XSUB(b.x)], 1u);
        asm volatile("buffer_inv sc1" ::: "memory");
        const unsigned gen = old / nloc;
        if (old + 1u == (gen + 1u) * nloc) {
            __builtin_amdgcn_fence(__ATOMIC_RELEASE, "agent");
            asm volatile("s_waitcnt vmcnt(0)" ::: "memory");
            const unsigned og = xb_add(&bar[XB_TOP], 1u);
            const unsigned tg = og / nx;
            if (og + 1u != (tg + 1u) * nx) XB_SPIN(xb_ld(&bar[XB_TOP]) < (tg + 1u) * nx, bar);
            xb_add(&bar[XB_XGEN(b.x)], 1u);
            asm volatile("s_waitcnt vmcnt(0)" ::: "memory");
        } else {
            XB_SPIN(xb_ld(&bar[XB_XGEN(b.x)]) == gen, bar);
            asm volatile("s_waitcnt vmcnt(0)" ::: "memory");
        }
    }
    __syncthreads();
}

#define MODFLAG_WORD (XCD_BAR_WORDS + 64)
__device__ __forceinline__ void mod_signal(unsigned* bar) {
    asm volatile("s_waitcnt vmcnt(0)" ::: "memory");
    __syncthreads();
    if (opaque_tid() == 0) { __builtin_amdgcn_fence(__ATOMIC_RELEASE, "agent"); asm volatile("s_waitcnt vmcnt(0)" ::: "memory"); (void)xb_add(&bar[MODFLAG_WORD], 1u); }
}
__device__ __forceinline__ void mod_wait(unsigned* bar) {
    if (opaque_tid() == 0) { const unsigned n = gridDim.x; XB_SPIN(xb_ld(&bar[MODFLAG_WORD]) < n, bar); __builtin_amdgcn_fence(__ATOMIC_ACQUIRE, "agent"); asm volatile("s_waitcnt vmcnt(0)" ::: "memory"); }
    __syncthreads();
}
__device__ __forceinline__ void preload_gl(const Params& q, int l, LAS unsigned char* lds) {
    const int t_ = opaque_tid();
    LAS float* gl = (LAS float*)(lds + pg8::STAGE_BYTES + 7168);
    if (t_ < 128) gl[t_] = t_ < 64 ? q.in[9][l * 64 + t_] * (0.125f * LOG2E) : q.in[10][l * 64 + t_ - 64];
}
__device__ __forceinline__ void phase_prep_waves(const Params& p, LAS unsigned char* lds, unsigned* bar) {
    const int G = gridDim.x;
    { const int tid = opaque_tid(), lane = tid & 63, wave = __builtin_amdgcn_readfirstlane(tid >> 6);
      t_run<false>(p, blockIdx.x * NWAVES + wave, G * NWAVES, T_NA, (LAS float*)(lds + wave * 16640), lane); }
    mod_wait(bar);
    preload_gl(p, 0, lds);
    { const int tid = opaque_tid(), lane = tid & 63, wave = __builtin_amdgcn_readfirstlane(tid >> 6);
      n1_run<4, false>(p, 0, blockIdx.x * NWAVES + wave, G * NWAVES, lane); }
}

__device__ __forceinline__ void load_params(Params& q, const Params& p) {
#if defined(__HIP_DEVICE_COMPILE__)
    const unsigned long long a = (unsigned long long)__builtin_amdgcn_kernarg_segment_ptr();
    unsigned alo = __builtin_amdgcn_readfirstlane((unsigned)a), ahi = __builtin_amdgcn_readfirstlane((unsigned)(a >> 32));
    asm volatile("" : "+s"(alo), "+s"(ahi));
    q = *(const __attribute__((address_space(4))) Params*)(((unsigned long long)ahi << 32) | alo);
#else
    q = p;
#endif
}
__device__ __forceinline__ void load_prefix(const Params& p, int l, LAS int* pre, LAS int* cntl) {
    const int* gcnt = (const int*)(p.ws + WS_CTL) + l * 32;
    const int tid = opaque_tid();
    if (tid < 64) {
        const int c = tid < NEXP ? gcnt[tid] : 0;
        const int t0 = (c + 255) >> 8;
        int t = t0;
#pragma unroll
        for (int o = 1; o < 32; o <<= 1) { const int v = __builtin_amdgcn_ds_bpermute(((tid - o) & 63) << 2, t); if (tid >= o) t += v; }
        if (tid < NEXP) { cntl[tid] = c; pre[tid] = t - t0; }
        if (tid == NEXP - 1) pre[NEXP] = t;
    }
    __syncthreads();
}

__global__ void __launch_bounds__(NTHREADS, 2) fwd_kernel(Params p) {
    LAS unsigned char* lds = (LAS unsigned char*)lds_raw;
    const int G = gridDim.x;
    unsigned char* ws = p.ws;
    volatile LAS unsigned* bst = (volatile LAS unsigned*)(lds + LDS_BYTES - 16);
    if (threadIdx.x < 2) bst[threadIdx.x] = 0u;
    if ((threadIdx.x & 63) == 0) ((LAS unsigned char*)lds_raw)[LDS_BYTES - 96 + hw_wave_key()] = (unsigned char)(threadIdx.x >> 6);
    __syncthreads();
    const XcdBarrier bar = xcd_barrier_post((unsigned*)(ws + WS_CTL) + 4096, bst);
    const int lo = p.ph_lo, hi = p.ph_hi;
#define IN(k) (lo <= (k) && (k) < hi)
#define SYNC_AFTER(k) do { if (IN(k) && IN((k) + 1)) xcd_barrier(bar); } while (0)
#define PROBE_REL (-1)
#define PROBE_BEGIN(j) unsigned long long pt0_ = 0; if (PROBE_REL == (j)) pt0_ = __builtin_amdgcn_s_memrealtime();
#define PROBE_END(j) if (PROBE_REL == (j)) { if (blockIdx.x == 0 && opaque_tid() == 0) { const unsigned long long t1_ = __builtin_amdgcn_s_memrealtime(); const unsigned long long dt_ = t1_ - pt0_; \
        while (__builtin_amdgcn_s_memrealtime() - t1_ < dt_) __builtin_amdgcn_s_sleep(8); } xcd_barrier(bar); }
    { PROBE_BEGIN(7)
    if (IN(0)) { Params q; load_params(q, p); phase_prologue(q, lds); mod_signal(bar.bar); }
    PROBE_END(7) }
#pragma unroll 1
    for (int l = 0; l < DEPTH; ++l) {
        const int k0 = 1 + 7 * l;
        { PROBE_BEGIN(0)
        if (IN(k0 + 0)) { Params q; load_params(q, p); if (l == 0) { phase_prep(q, lds); phase_prep_waves(q, lds, bar.bar); } else { preload_gl(q, l, lds); phase_norm1(q, l); } }
        SYNC_AFTER(k0 + 0);
        PROBE_END(0) }
        { PROBE_BEGIN(1)
        if (IN(k0 + 1)) {
            Params q; load_params(q, p); unsigned char* ws = q.ws;
            {
                DenseGemmI8 g{ws + WS_BUF, ws + WS_WIN + (size_t)l * 2048 * 1024, 1024, (const float*)(ws + WS_RS), (const float*)(ws + WS_CS) + l * 2048};
                pg8::StaticOrder S; S.init(NTOK, 1536, G, (int)blockIdx.x);
                LAS float* gl = (LAS float*)(lds + pg8::STAGE_BYTES + 7168);
                { const int t_ = opaque_tid(); const int w_ = __builtin_amdgcn_readfirstlane(t_ >> 6);
                  __builtin_amdgcn_global_load_lds((const unsigned*)((const float*)(ws + WS_TBL) + (size_t)l * 2048 + t_ * 4), (LAS unsigned*)(lds + LDS_TBL + w_ * 1024), 16, 0, 0); }
                EpiIn E{(bf16_t*)(ws + WS_U), (bf16_t*)(ws + WS_Q), (bf16_t*)(ws + WS_K), gl};
                pg8::gemm_phase(lds, g, S, E);
            }
            {
                DenseGemmI8 g{ws + WS_WIN + (size_t)l * 2048 * 1024 + (size_t)1536 * 1024, ws + WS_BUF, 1024, (const float*)(ws + WS_CS) + l * 2048 + 1536, (const float*)(ws + WS_RS)};
                pg8::StaticOrder S; S.init(512, NTOK, G, (int)blockIdx.x);
                EpiVt E{(bf16_t*)(ws + WS_V)};
                pg8::gemm_phase(lds, g, S, E);
            }
        }
        SYNC_AFTER(k0 + 1);
        PROBE_END(1) }
        { PROBE_BEGIN(2)
        if (IN(k0 + 2)) { Params q; load_params(q, p); phase_mixer(q, l, lds); }
        SYNC_AFTER(k0 + 2);
        PROBE_END(2) }
        { PROBE_BEGIN(3)
        if (IN(k0 + 3)) {
            Params q; load_params(q, p); unsigned char* ws = q.ws;
            DenseGemm8 g{ws + WS_BUF, ws + WS_WOUT + (size_t)l * 1024 * 1024, 1024, nullptr, nullptr};
            pg8::StaticOrder S; S.init(NTOK, 1024, G, (int)blockIdx.x);
            const float* g1p = (const float*)(ws + WS_MOD) + (size_t)(l * 4) * 6144 + 2048;
            if (l == 0) { EpiOutB<true> E{q.in[0], (bf16_t*)(ws + WS_XB), g1p, (float*)(ws + WS_SSQ)}; pg8::gemm_phase(lds, g, S, E); }
            else { EpiOutB<false> E{nullptr, (bf16_t*)(ws + WS_XB), g1p, (float*)(ws + WS_SSQ)}; pg8::gemm_phase(lds, g, S, E); }
        }
        SYNC_AFTER(k0 + 3);
        PROBE_END(3) }
        { PROBE_BEGIN(4)
        if (IN(k0 + 4)) { Params q; load_params(q, p); phase_route(q, l, lds); }
        SYNC_AFTER(k0 + 4);
        PROBE_END(4) }
        { PROBE_BEGIN(5)
        if (IN(k0 + 5)) {
            Params q; load_params(q, p); unsigned char* ws = q.ws;
            LAS int* pre = (LAS int*)(lds + LDS_KEEP); LAS int* cntl = pre + 64;
            load_prefix(q, l, pre, cntl);
            const int cfirst = l == 0 ? 0 : T_DN + T_GU, ccount = l == 0 ? T_DN + SIDE_GU0 : T_DN;
            const SidePlan sp = side_plan(pre[NEXP] * 4, ccount);
            if (!sp.conv) {
                GatherGemm g{ws + WS_BUF, ws + WS_WGU + (size_t)l * NEXP * 1024 * 1024, (const u32x2*)(ws + WS_LIST2), 1024, 1, (size_t)1024 * 1024};
                pg8::GroupedOrder S{pre, cntl, sp.gp, sp.v};
                EpiGU E{ws + WS_ACT};
                pg8::gemm_phase(lds, g, S, E);
            }
            side_convert(q, lds, pre, cfirst, ccount, SIDE_CC_GU);
        }
        SYNC_AFTER(k0 + 5);
        PROBE_END(5) }
        { PROBE_BEGIN(6)
        if (IN(k0 + 6)) {
            Params q; load_params(q, p); unsigned char* ws = q.ws;
            LAS int* pre = (LAS int*)(lds + LDS_KEEP); LAS int* cntl = pre + 64;
            const int cfirst = T_DN + SIDE_GU0, ccount = l == 0 ? T_GU - SIDE_GU0 : 0;
            const SidePlan sp = side_plan(pre[NEXP] * 4, ccount);
            if (!sp.conv) {
                GatherGemm g{ws + WS_ACT, ws + WS_WD + (size_t)l * NEXP * 1024 * 512, (const u32x2*)(ws + WS_LIST2), 512, 0, (size_t)1024 * 512};
                pg8::GroupedOrder S{pre, cntl, sp.gp, sp.v};
                EpiDn E{(unsigned char*)(ws + WS_Y)};
                pg8::gemm_phase(lds, g, S, E);
            }
            if (ccount > 0) side_convert(q, lds, pre, cfirst, ccount, SIDE_CC_DN);
        }
        SYNC_AFTER(k0 + 6);
        PROBE_END(6) }
    }
    if (IN(15)) { Params q; load_params(q, p); phase_final(q, lds); }
#undef PROBE_BEGIN
#undef PROBE_END
#undef IN
#undef SYNC_AFTER
}

extern "C" void kernel_launch(void* const* d_in, const int* in_sizes, int n_in, void* d_out, int out_size, void* d_ws, size_t ws_size, hipStream_t stream) {
    static int grid = 0;
    if (grid == 0) {
        if (n_in != 20 || out_size != NTOK * DM || ws_size < WS_END) { fprintf(stderr, "kernel_launch: unexpected shapes (n_in %d out %d ws %zu)\n", n_in, out_size, ws_size); grid = -1; return; }
        int dev = 0, cus = 0, per_cu = 0;
        hipGetDevice(&dev);
        hipDeviceGetAttribute(&cus, hipDeviceAttributeMultiprocessorCount, dev);
        hipFuncSetAttribute((const void*)fwd_kernel, hipFuncAttributeMaxDynamicSharedMemorySize, LDS_BYTES);
        hipOccupancyMaxActiveBlocksPerMultiprocessor(&per_cu, (const void*)fwd_kernel, NTHREADS, LDS_BYTES);
        if (per_cu < 1) per_cu = 1;
        if (per_cu > 1) per_cu = 1;
        grid = cus * per_cu;
        (void)hipGetLastError();
    }
    if (grid < 0) return;
    if (hipMemsetAsync((char*)d_ws + WS_CTL, 0, 65536, stream) != hipSuccess) { fprintf(stderr, "memset failed\n"); return; }
    Params p{};
    for (int i = 0; i < 20; ++i) p.in[i] = (const float*)d_in[i];
    p.out = (float*)d_out; p.ws = (unsigned char*)d_ws; p.ph_lo = 0; p.ph_hi = 16;
    void* args[] = {&p};
    hipError_t e = hipLaunchCooperativeKernel((const void*)fwd_kernel, dim3(grid), dim3(NTHREADS), args, LDS_BYTES, stream);
    if (e != hipSuccess) fprintf(stderr, "cooperative launch failed: %s (grid %d)\n", hipGetErrorString(e), grid);
}
```
